# Optimizing an MI355X kernel written in HIP

```python
import jax, jax.numpy as jnp
from jax import lax
import numpy as np

D_MODEL = 1024
BATCH = 8
SEQ = 4096
DEPTH = 2

N_A_LAYERS = DEPTH // 2
N_B_LAYERS = DEPTH - N_A_LAYERS
N_DENSE = (DEPTH + 1) // 2
N_MOE = DEPTH // 2
RMS_EPS = 1e-6
A_HEADS = 4
A_INNER = D_MODEL
A_HEAD_DIM = A_INNER // A_HEADS
A_CONV = 4
A_CHUNK = 64
B_HEADS = 16
B_HEAD_DIM = D_MODEL // B_HEADS
B_KV_GROUPS = 4
B_REP = B_HEADS // B_KV_GROUPS
CMP_LEN = 32
CMP_STRIDE = 16
CMP_HIDDEN = 256
SEL_BLOCK = 64
SEL_TOPN = 16
WINDOW = 512
NSA_Q_BLOCK = 32
FORCED_SCORE = 1e4
FFN_DENSE = 2816
N_EXPERTS = 8
TOP_K = 2
FFN_EXPERT = 3584
FFN_TOKEN_BLOCK = 128

kernel_name = "yoco_mlstm_nsa_moe_block"


def rmsnorm(x, g):
    xf = x.astype(jnp.float32)
    y = xf * lax.rsqrt(jnp.mean(xf * xf, axis=-1, keepdims=True) + RMS_EPS) * g.astype(jnp.float32)
    return y.astype(x.dtype)


def alibi_slopes(n):
    return jnp.asarray(np.power(2.0, -8.0 * np.arange(1, n + 1) / n).astype(np.float32))


def safe_softmax(s):
    m = jnp.max(s, axis=-1, keepdims=True)
    m = jnp.where(jnp.isfinite(m), m, 0.0)
    e = jnp.exp(s - m)
    d = jnp.sum(e, axis=-1, keepdims=True)
    return e / jnp.where(d > 0, d, 1.0)


def causal_dwconv(x, w):
    K = w.shape[0]
    T = x.shape[1]
    xp = jnp.pad(x, ((0, 0), (K - 1, 0), (0, 0)))
    y = xp[:, 0:T] * w[0]
    for j in range(1, K):
        y = y + xp[:, j:j + T] * w[j]
    return y


def _mlstm_chunk(carry, inp):
    c, n, m = carry
    q, k, v, log_i, log_f = inp
    L = q.shape[2]
    causal = jnp.tril(jnp.ones((L, L), dtype=bool))
    b = jnp.cumsum(log_f, axis=-1)
    d = jnp.where(causal, b[..., :, None] - b[..., None, :] + log_i[..., None, :], -jnp.inf)
    inter = b + m[..., None]
    m_t = jnp.maximum(inter, jnp.max(d, axis=-1))
    w_intra = jnp.exp(d - m_t[..., None])
    w_inter = jnp.exp(inter - m_t)
    s = jnp.einsum('bhtd,bhsd->bhts', q, k) * w_intra
    num = jnp.einsum('bhts,bhsd->bhtd', s, v) + w_inter[..., None] * jnp.einsum('bhvk,bhtk->bhtv', c, q)
    den = jnp.sum(s, axis=-1) + w_inter * jnp.einsum('bhk,bhtk->bht', n, q)
    h = num / jnp.maximum(jnp.abs(den), jnp.exp(-m_t))[..., None]
    b_last = b[..., -1]
    g = b_last[..., None] - b + log_i
    m_new = jnp.maximum(b_last + m, jnp.max(g, axis=-1))
    a_prev = jnp.exp(b_last + m - m_new)
    a_s = jnp.exp(g - m_new[..., None])
    c_new = a_prev[..., None, None] * c + jnp.einsum('bhsv,bhsk->bhvk', v * a_s[..., None], k)
    n_new = a_prev[..., None] * n + jnp.einsum('bhs,bhsk->bhk', a_s, k)
    return (c_new, n_new, m_new), h


def mlstm_mixer(h, w_in, b_gate, conv_w, g_out, w_out):
    B, T, _ = h.shape
    f32 = jnp.float32
    proj = h @ w_in
    qk = causal_dwconv(proj[..., :2 * A_INNER], conv_w)
    q = qk[..., :A_INNER]
    k = qk[..., A_INNER:]
    v = proj[..., 2 * A_INNER:3 * A_INNER]
    o = proj[..., 3 * A_INNER:4 * A_INNER]
    gl = (proj[..., 4 * A_INNER:] + b_gate).astype(f32)
    log_i = gl[..., :A_HEADS]
    log_f = jax.nn.log_sigmoid(gl[..., A_HEADS:])
    nc = T // A_CHUNK

    def to_chunks(a):
        return a.astype(f32).reshape(B, nc, A_CHUNK, A_HEADS, A_HEAD_DIM).transpose(1, 0, 3, 2, 4)

    def gate_chunks(a):
        return a.reshape(B, nc, A_CHUNK, A_HEADS).transpose(1, 0, 3, 2)

    qc = to_chunks(q)
    kc = to_chunks(k) * (A_HEAD_DIM ** -0.5)
    vc = to_chunks(v)
    init = (jnp.zeros((B, A_HEADS, A_HEAD_DIM, A_HEAD_DIM), f32),
            jnp.zeros((B, A_HEADS, A_HEAD_DIM), f32),
            jnp.zeros((B, A_HEADS), f32))
    _, hc = lax.scan(_mlstm_chunk, init, (qc, kc, vc, gate_chunks(log_i), gate_chunks(log_f)))
    hs = hc.transpose(1, 0, 3, 2, 4).reshape(B, T, A_HEADS, A_HEAD_DIM)
    hs = hs * lax.rsqrt(jnp.mean(hs * hs, axis=-1, keepdims=True) + RMS_EPS)
    hs = hs.reshape(B, T, A_INNER) * g_out.astype(f32) * jax.nn.sigmoid(o.astype(f32))
    return hs.astype(h.dtype) @ w_out


def nsa_shared_kv(hkv, w_kv, cmp_pos, cmp_w1, cmp_w2):
    B, T, _ = hkv.shape
    G, Dh = B_KV_GROUPS, B_HEAD_DIM
    kv = (hkv @ w_kv).reshape(B, T, 6, G, Dh)
    n_cmp = (T - CMP_LEN) // CMP_STRIDE + 1
    idx = np.arange(n_cmp)[:, None] * CMP_STRIDE + np.arange(CMP_LEN)[None, :]
    blk = kv[:, idx, :2]
    blk = blk + cmp_pos[None, None, :, :, None, :]
    blk = blk.transpose(0, 3, 4, 1, 2, 5).reshape(B, 2, G, n_cmp, CMP_LEN * Dh)
    hid = jax.nn.silu(jnp.einsum('bcgnf,cfh->bcgnh', blk, cmp_w1))
    kvc = jnp.einsum('bcgnh,chd->bcgnd', hid, cmp_w2)
    n_sel = T // SEL_BLOCK
    k_slc = kv[:, :, 2].transpose(0, 2, 1, 3).reshape(B, G, n_sel, SEL_BLOCK, Dh)
    v_slc = kv[:, :, 3].transpose(0, 2, 1, 3).reshape(B, G, n_sel, SEL_BLOCK, Dh)
    pad = ((0, 0), (0, 0), (WINDOW, 0), (0, 0))
    k_win = jnp.pad(kv[:, :, 4].transpose(0, 2, 1, 3), pad)
    v_win = jnp.pad(kv[:, :, 5].transpose(0, 2, 1, 3), pad)
    return (kvc[:, 0], kvc[:, 1], k_slc, v_slc, k_win, v_win)


def nsa_mixer(h, shared, w_q, b_gate, w_out):
    k_cmp, v_cmp, k_slc, v_slc, k_win, v_win = shared
    B, T, _ = h.shape
    G, R, Dh = B_KV_GROUPS, B_REP, B_HEAD_DIM
    HD = B_HEADS * Dh
    f32 = jnp.float32
    scale = Dh ** -0.5
    proj = h @ w_q
    q = proj[..., :HD].reshape(B, T, G, R, Dh).transpose(0, 2, 3, 1, 4)
    gates = jax.nn.sigmoid((proj[..., HD:] + b_gate).astype(f32))
    gates = gates.reshape(B, T, G, R, 3).transpose(0, 2, 3, 1, 4)
    slopes = alibi_slopes(B_HEADS).reshape(G, R)
    sl5 = slopes[None, :, :, None, None]
    sl6 = slopes[None, :, :, None, None, None]
    n_cmp = k_cmp.shape[2]
    n_sel = k_slc.shape[2]
    n_top = min(SEL_TOPN, n_sel)
    cmp_end = jnp.arange(n_cmp) * CMP_STRIDE + (CMP_LEN - 1)
    ci = np.arange(n_cmp)[:, None] * CMP_STRIDE
    sj = np.arange(n_sel)[None, :] * SEL_BLOCK
    overlap = jnp.asarray(((ci < sj + SEL_BLOCK) & (ci + CMP_LEN > sj)).astype(np.float32))
    blk_j = jnp.arange(n_sel)
    bi = jnp.arange(B)[:, None, None, None]
    gi = jnp.arange(G)[None, :, None, None]
    QB = NSA_Q_BLOCK

    def block_fn(iq):
        t0 = iq * QB
        tpos = t0 + jnp.arange(QB)
        qb = lax.dynamic_slice_in_dim(q, t0, QB, axis=3)
        gb = lax.dynamic_slice_in_dim(gates, t0, QB, axis=3)
        dist_c = (tpos[:, None] - cmp_end[None, :]).astype(f32)
        s_c = jnp.einsum('bgrqd,bgcd->bgrqc', qb, k_cmp).astype(f32) * scale - sl5 * dist_c
        p_cmp = safe_softmax(jnp.where(dist_c >= 0, s_c, -jnp.inf))
        o_cmp = jnp.einsum('bgrqc,bgcd->bgrqd', p_cmp, v_cmp)
        imp = jnp.einsum('bgrqc,cj->bgqj', p_cmp, overlap)
        cur = tpos // SEL_BLOCK
        forced = (blk_j[None, :] == 0) | (blk_j[None, :] == cur[:, None]) | (blk_j[None, :] == cur[:, None] - 1)
        valid = blk_j[None, :] * SEL_BLOCK <= tpos[:, None]
        imp = jnp.where(forced[None, None], FORCED_SCORE, imp)
        imp = jnp.where(valid[None, None], imp, -jnp.inf)
        _, idx = lax.top_k(imp, n_top)
        ks = k_slc[bi, gi, idx]
        vs = v_slc[bi, gi, idx]
        kpos = idx[..., None] * SEL_BLOCK + jnp.arange(SEL_BLOCK)
        dist_s = (tpos[:, None, None] - kpos).astype(f32)
        s_s = jnp.einsum('bgrqd,bgqnkd->bgrqnk', qb, ks).astype(f32) * scale - sl6 * dist_s[:, :, None]
        s_s = jnp.where((dist_s >= 0)[:, :, None], s_s, -jnp.inf).reshape(B, G, R, QB, n_top * SEL_BLOCK)
        p_s = safe_softmax(s_s)
        o_slc = jnp.einsum('bgrqk,bgqkd->bgrqd', p_s, vs.reshape(B, G, QB, n_top * SEL_BLOCK, Dh))
        kw = lax.dynamic_slice_in_dim(k_win, t0, WINDOW + QB, axis=2)
        vw = lax.dynamic_slice_in_dim(v_win, t0, WINDOW + QB, axis=2)
        spos = t0 - WINDOW + jnp.arange(WINDOW + QB)
        dist_w = tpos[:, None] - spos[None, :]
        mask_w = (dist_w >= 0) & (dist_w < WINDOW) & (spos[None, :] >= 0)
        s_w = jnp.einsum('bgrqd,bgkd->bgrqk', qb, kw).astype(f32) * scale - sl5 * dist_w.astype(f32)
        p_w = safe_softmax(jnp.where(mask_w, s_w, -jnp.inf))
        o_win = jnp.einsum('bgrqk,bgkd->bgrqd', p_w, vw)
        return gb[..., 0:1] * o_cmp + gb[..., 1:2] * o_slc + gb[..., 2:3] * o_win

    outs = lax.map(block_fn, jnp.arange(T // QB))
    o = outs.transpose(1, 0, 4, 2, 3, 5).reshape(B, T, HD)
    return o.astype(h.dtype) @ w_out


def token_block_map(fn, x):
    B, T, D = x.shape
    nb = T // FFN_TOKEN_BLOCK
    xb = x.reshape(B, nb, FFN_TOKEN_BLOCK, D).transpose(1, 0, 2, 3).reshape(nb, B * FFN_TOKEN_BLOCK, D)
    yb = lax.map(fn, xb)
    return yb.reshape(nb, B, FFN_TOKEN_BLOCK, D).transpose(1, 0, 2, 3).reshape(B, T, D)


def swiglu_dense(h, w_gu, w_down):
    def fn(t):
        gu = t @ w_gu
        return (jax.nn.silu(gu[..., :FFN_DENSE]) * gu[..., FFN_DENSE:]) @ w_down
    return token_block_map(fn, h)


def moe_swiglu(h, w_router, w_gu, w_down):
    def fn(t):
        logits = (t @ w_router).astype(jnp.float32)
        top_v, top_i = lax.top_k(logits, TOP_K)
        top_w = jax.nn.softmax(top_v, axis=-1)
        gate = jnp.sum(jax.nn.one_hot(top_i, N_EXPERTS, dtype=jnp.float32) * top_w[..., None], axis=1)
        gu = jnp.einsum('nd,edf->nef', t, w_gu)
        act = jax.nn.silu(gu[..., :FFN_EXPERT]) * gu[..., FFN_EXPERT:] * gate[..., None].astype(t.dtype)
        return jnp.einsum('nef,efd->nd', act, w_down)
    return token_block_map(fn, h)


def setup_inputs(seed: int = 0) -> dict:
    key = jax.random.key(seed)
    ks = jax.random.split(key, 24)
    f32 = jnp.float32

    def nrm(k, shape, s):
        return jax.random.normal(k, shape, f32) * s

    D = D_MODEL
    HD = B_HEADS * B_HEAD_DIM
    GD = B_KV_GROUPS * B_HEAD_DIM
    i_bias = nrm(ks[4], (N_A_LAYERS, A_HEADS), 0.1)
    f_bias = jnp.linspace(3.0, 6.0, A_HEADS, dtype=f32)[None, :] + nrm(ks[5], (N_A_LAYERS, A_HEADS), 0.1)
    return {
        "x": nrm(ks[0], (BATCH, SEQ, D), 1.0),
        "norm_mix": 1.0 + nrm(ks[1], (DEPTH, D), 0.02),
        "norm_ffn": 1.0 + nrm(ks[2], (DEPTH, D), 0.02),
        "a_w_in": nrm(ks[3], (N_A_LAYERS, D, 4 * A_INNER + 2 * A_HEADS), D ** -0.5),
        "a_b_gate": jnp.concatenate([i_bias, f_bias], axis=-1),
        "a_conv": nrm(ks[6], (N_A_LAYERS, A_CONV, 2 * A_INNER), A_CONV ** -0.5),
        "a_norm_h": 1.0 + nrm(ks[7], (N_A_LAYERS, A_INNER), 0.02),
        "a_w_out": nrm(ks[8], (N_A_LAYERS, A_INNER, D), A_INNER ** -0.5),
        "norm_kv": 1.0 + nrm(ks[9], (D,), 0.02),
        "b_w_kv": nrm(ks[10], (D, 6 * GD), D ** -0.5),
        "b_cmp_pos": nrm(ks[11], (CMP_LEN, 2, B_HEAD_DIM), 0.02),
        "b_cmp_w1": nrm(ks[12], (2, CMP_LEN * B_HEAD_DIM, CMP_HIDDEN), (CMP_LEN * B_HEAD_DIM) ** -0.5),
        "b_cmp_w2": nrm(ks[13], (2, CMP_HIDDEN, B_HEAD_DIM), CMP_HIDDEN ** -0.5),
        "b_w_q": nrm(ks[14], (N_B_LAYERS, D, HD + 3 * B_HEADS), D ** -0.5),
        "b_b_gate": nrm(ks[15], (N_B_LAYERS, 3 * B_HEADS), 0.02),
        "b_w_out": nrm(ks[16], (N_B_LAYERS, HD, D), HD ** -0.5),
        "f_w_gu": nrm(ks[17], (N_DENSE, D, 2 * FFN_DENSE), D ** -0.5),
        "f_w_down": nrm(ks[18], (N_DENSE, FFN_DENSE, D), FFN_DENSE ** -0.5),
        "m_router": nrm(ks[19], (N_MOE, D, N_EXPERTS), D ** -0.5),
        "m_w_gu": nrm(ks[20], (N_MOE, N_EXPERTS, D, 2 * FFN_EXPERT), D ** -0.5),
        "m_w_down": nrm(ks[21], (N_MOE, N_EXPERTS, FFN_EXPERT, D), FFN_EXPERT ** -0.5),
        "norm_final": 1.0 + nrm(ks[22], (D,), 0.02),
    }


def reference(x, norm_mix, norm_ffn, a_w_in, a_b_gate, a_conv, a_norm_h, a_w_out, norm_kv, b_w_kv,
              b_cmp_pos, b_cmp_w1, b_cmp_w2, b_w_q, b_b_gate, b_w_out, f_w_gu, f_w_down,
              m_router, m_w_gu, m_w_down, norm_final):
    shared = None
    for i in range(DEPTH):
        if i < N_A_LAYERS:
            x = x + mlstm_mixer(rmsnorm(x, norm_mix[i]), a_w_in[i], a_b_gate[i], a_conv[i],
                                a_norm_h[i], a_w_out[i])
        else:
            if i == N_A_LAYERS:
                shared = nsa_shared_kv(rmsnorm(x, norm_kv), b_w_kv, b_cmp_pos, b_cmp_w1, b_cmp_w2)
            j = i - N_A_LAYERS
            x = x + nsa_mixer(rmsnorm(x, norm_mix[i]), shared, b_w_q[j], b_b_gate[j], b_w_out[j])
        hf = rmsnorm(x, norm_ffn[i])
        if i % 2 == 0:
            x = x + swiglu_dense(hf, f_w_gu[i // 2], f_w_down[i // 2])
        else:
            x = x + moe_swiglu(hf, m_router[i // 2], m_w_gu[i // 2], m_w_down[i // 2])
    return rmsnorm(x, norm_final)
```

```cpp
#include <hip/hip_runtime.h>
#include <cstdio>
#include <cstdint>

#ifndef MK_PER_PHASE
#define MK_PER_PHASE 0
#endif

#define LAS __attribute__((address_space(3)))
#define GAS __attribute__((address_space(1)))
typedef unsigned short bf16_t;
typedef short bf16x8 __attribute__((ext_vector_type(8)));
typedef float f32x4 __attribute__((ext_vector_type(4)));
typedef float f32x2 __attribute__((ext_vector_type(2)));
typedef unsigned u32x4 __attribute__((ext_vector_type(4)));
typedef unsigned u32x2 __attribute__((ext_vector_type(2)));
typedef unsigned long long u64;

constexpr int BATCH = 8, SEQ = 4096, D = 1024, M = BATCH * SEQ;
constexpr int A_HEADS = 4, A_HD = 256, NPROJ = 4096, NPROJ_SRC = 4104;
constexpr int FFD = 2816, NE = 8, FE = 3584;
constexpr int KVG = 4, HD = 64, NH = 16, NKVQ = 2816, NQSRC = 1072;
constexpr float EPS = 1e-6f;
constexpr int MOE_MAXT = 264;
constexpr int MOE_ROWS = MOE_MAXT * 256;

constexpr size_t MiB = 1u << 20;
constexpr size_t WS_CTL = 0, CTL_ZERO_BYTES = 1 * MiB;
constexpr size_t WS_SMALL = 1 * MiB;
constexpr size_t WS_WIN = 2 * MiB, WS_WOUTA = 10 * MiB, WS_WGU = 12 * MiB, WS_WDOWN = 23 * MiB, WS_WKVQ = 29 * MiB, WS_WCMP1 = 35 * MiB, WS_WOUTB = 37 * MiB;
constexpr size_t WS_MGU = 40 * MiB, WS_MDOWN = 152 * MiB, WS_XH = 208 * MiB, WS_GA = 272 * MiB, WS_ROWINFO = 273 * MiB, WS_BIG = 274 * MiB;
constexpr size_t WS_PROJ3 = WS_BIG, WS_OG = WS_BIG + 192 * MiB, WS_IMG = WS_BIG + 256 * MiB, WS_DN = WS_BIG + 536 * MiB, WS_HS = WS_BIG, WS_HN = WS_BIG + 128 * MiB;
constexpr size_t IMG_Q = 0, IMG_K = 34816, IMG_KT = 67584, IMG_VT = 100352, IMG_G = 141312, IMG_STRIDE = 142080;
static_assert((size_t)2048 * IMG_STRIDE <= 280 * MiB, "scan images");
constexpr size_t WS_ACT = WS_BIG;
constexpr size_t WS_KV = WS_BIG, WS_QB = WS_BIG + 96 * MiB, WS_GATEB = WS_BIG + 160 * MiB, WS_HID = WS_BIG + 166 * MiB, WS_KC = WS_BIG + 174 * MiB, WS_VC = WS_BIG + 175 * MiB, WS_OB = WS_BIG + 176 * MiB, WS_VT2 = WS_BIG + 240 * MiB;
constexpr size_t WS_XG = WS_BIG, WS_ACTS = WS_BIG + 132 * MiB, WS_Y1 = WS_BIG;
constexpr size_t WS_END = WS_BIG + 594 * MiB;
constexpr size_t WS_SSP = WS_END, WS_RS = WS_END + 2 * MiB, WS_END2 = WS_END + 3 * MiB;
static_assert((size_t)MOE_ROWS * 1024 * 2 <= 132 * MiB && (size_t)MOE_ROWS * FE * 2 <= 462 * MiB, "moe buffers");
constexpr int CW_BAR = 4096;

constexpr int NWAVES = 8, NTHR = 512;
constexpr int LDS_BYTES = 159744;
constexpr int MISC_OFF = 159744 - 256;

__device__ __forceinline__ unsigned f2bf(float f) { unsigned u = __builtin_bit_cast(unsigned, f); return (u + 0x7fffu + ((u >> 16) & 1u)) >> 16; }
__device__ __forceinline__ unsigned pk2(float lo, float hi) { return f2bf(lo) | (f2bf(hi) << 16); }
__device__ __forceinline__ float bf2f(unsigned short b) { return __builtin_bit_cast(float, ((unsigned)b) << 16); }
__device__ __forceinline__ float bflo(unsigned w) { return __builtin_bit_cast(float, w << 16); }
__device__ __forceinline__ float bfhi(unsigned w) { return __builtin_bit_cast(float, w & 0xffff0000u); }
__device__ __forceinline__ float wave_sum(float v) {
#pragma unroll
    for (int o = 1; o < 64; o <<= 1) v += __shfl_xor(v, o);
    return v;
}
__device__ __forceinline__ float sigmoidf_(float x) { return __builtin_amdgcn_rcpf(1.0f + __builtin_amdgcn_exp2f(-1.4426950408889634f * x)); }
__device__ __forceinline__ float siluf_(float x) { return x * __builtin_amdgcn_rcpf(1.0f + __builtin_amdgcn_exp2f(-1.4426950408889634f * x)); }
__device__ __forceinline__ float ex2(float x) { return __builtin_amdgcn_exp2f(x); }
__device__ __forceinline__ unsigned pk_fp8x4(float a, float b, float c, float d) { unsigned w = 0u; w = __builtin_amdgcn_cvt_pk_fp8_f32(a, b, w, false); w = __builtin_amdgcn_cvt_pk_fp8_f32(c, d, w, true); return w; }
#define LDS_WAIT() asm volatile("s_waitcnt lgkmcnt(0)" ::: "memory")
#define LDS_BARRIER() do { asm volatile("s_waitcnt lgkmcnt(0)" ::: "memory"); __builtin_amdgcn_s_barrier(); asm volatile("" ::: "memory"); } while (0)

#define XB_TMO      128
#define XB_XCNT(j)  (256  + 64 * (j))
#define XB_XSUB(j)  (1280 + 64 * (j))
#define XB_XGEN(j)  (2304 + 64 * (j))
#define XB_TOP      3328
#define XB_TOPGEN   3392
#define XCD_BAR_WORDS 3456
#define XB_SPIN_CAP (1u << 22)
__device__ __forceinline__ unsigned xb_ld(unsigned* p)              { return __hip_atomic_load(p, __ATOMIC_RELAXED, __HIP_MEMORY_SCOPE_AGENT); }
__device__ __forceinline__ unsigned xb_add(unsigned* p, unsigned v) { return __hip_atomic_fetch_add(p, v, __ATOMIC_RELAXED, __HIP_MEMORY_SCOPE_AGENT); }
__device__ __forceinline__ unsigned xb_xcc_id() { return (unsigned)__builtin_amdgcn_s_getreg((3 << 11) | 20) & 0xFu; }
#define XB_SPIN(cond, bar) do { unsigned _sp = 0; while (cond) { __builtin_amdgcn_s_sleep(1); \
    if ((++_sp & 255u) == 0u) { if (xb_ld(&(bar)[XB_TMO])) break; if (_sp > XB_SPIN_CAP) { atomicAdd(&(bar)[XB_TMO], 1u); break; } } } } while (0)
struct XcdBarrier { unsigned* bar; unsigned x; volatile LAS unsigned* st; };
__device__ __forceinline__ XcdBarrier xcd_barrier_post(unsigned* bar, volatile LAS unsigned* st) {
    XcdBarrier b; b.bar = bar; b.x = xb_xcc_id(); b.st = st;
    if (threadIdx.x == 0) (void)xb_add(&bar[XB_XCNT(b.x)], 1u);
    return b;
}
__device__ __forceinline__ void xcd_barrier_complete(unsigned* bar, unsigned x, unsigned& nloc, unsigned& nx) {
    const unsigned G = gridDim.x * gridDim.y * gridDim.z;
    unsigned sum, cnt, mine, sp = 0u;
    for (;;) {
        sum = 0u; cnt = 0u; mine = 0u;
#pragma unroll
        for (unsigned j = 0; j < 16; ++j) { const unsigned c = xb_ld(&bar[XB_XCNT(j)]); sum += c; cnt += (c > 0u) ? 1u : 0u; mine = (j == x) ? c : mine; }
        if (sum == G) break;
        __builtin_amdgcn_s_sleep(1);
        if ((++sp & 255u) == 0u) { if (xb_ld(&bar[XB_TMO])) break; if (sp > XB_SPIN_CAP) { atomicAdd(&bar[XB_TMO], 1u); break; } }
    }
    nloc = mine > 0u ? mine : 1u; nx = cnt > 0u ? cnt : 1u;
}
__device__ __forceinline__ void xcd_barrier(const XcdBarrier& b) {
    asm volatile("s_waitcnt vmcnt(0)" ::: "memory");
    __syncthreads();
    if (threadIdx.x == 0) {
        unsigned* bar = b.bar;
        __builtin_amdgcn_s_waitcnt(0);
        unsigned nloc = b.st[0], nx = b.st[1];
        if (nloc == 0u) { xcd_barrier_complete(bar, b.x, nloc, nx); b.st[0] = nloc; b.st[1] = nx; }
        const unsigned old = xb_add(&bar[XB_XSUB(b.x)], 1u);
        const unsigned gen = old / nloc;
        if (old + 1u == (gen + 1u) * nloc) {
            __builtin_amdgcn_fence(__ATOMIC_RELEASE, "agent");
            asm volatile("s_waitcnt vmcnt(0)" ::: "memory");
            const unsigned og = xb_add(&bar[XB_TOP], 1u);
            const unsigned tg = og / nx;
            if (og + 1u == (tg + 1u) * nx) xb_add(&bar[XB_TOPGEN], 1u);
            else XB_SPIN(xb_ld(&bar[XB_TOPGEN]) == tg, bar);
            __builtin_amdgcn_fence(__ATOMIC_ACQUIRE, "agent");
            xb_add(&bar[XB_XGEN(b.x)], 1u);
            asm volatile("s_waitcnt vmcnt(0)" ::: "memory");
        } else {
            XB_SPIN(xb_ld(&bar[XB_XGEN(b.x)]) == gen, bar);
            __builtin_amdgcn_fence(__ATOMIC_ACQUIRE, "agent");
            asm volatile("s_waitcnt vmcnt(0)" ::: "memory");
        }
    }
    __syncthreads();
}

namespace pg8 {
constexpr int BM = 256, BK = 64, HALF = 128, HTB = HALF * BK * 2, STAGE_BYTES = 8 * HTB, NXCD = 8, WGM = 8;
__host__ __device__ __forceinline__ int lds_byte(int r, int c) { const int st = (r >> 4) * 2 + (c >> 5), rr = r & 15, cc = c & 31, ob = rr * 64 + cc * 2; return st * 1024 + (ob ^ (((ob >> 9) & 1) << 5)); }
__host__ __device__ __forceinline__ void stage_rc(int b, int& R, int& C) { const int st = b / 1024, sb = b % 1024, swz = sb ^ (((sb >> 9) & 1) << 5); R = (st >> 1) * 16 + swz / 64; C = (st & 1) * 32 + (swz % 64) / 2; }
__host__ __device__ __forceinline__ int perm32(int rho) { const int n = rho >> 4, i = rho & 15; return 8 * (i >> 2) + 4 * n + (i & 3); }
struct Unit { int pm, pn; const char* a; const char* b; };
struct Dims { int K, lda, ldb; int sa = 127, sb = 127; };
typedef __bf16 bf16x2_t __attribute__((ext_vector_type(2)));
__device__ __forceinline__ unsigned cvt_pk_bf16(float lo, float hi) { const f32x2 v = {lo, hi}; const bf16x2_t b = __builtin_convertvector(v, bf16x2_t); return __builtin_bit_cast(unsigned, b); }

__device__ __forceinline__ bool tile_order(int i, int G, int c, int nM, int nN, int& pm, int& pn) {
    const int nwg = nM * nN; const long L = (long)i * G + c; if (L >= nwg) return false;
    int wgid = (int)L; { const int q = nwg / NXCD, r = nwg % NXCD, xcd = wgid % NXCD, off = wgid / NXCD; wgid = (xcd < r ? xcd * (q + 1) : r * (q + 1) + (xcd - r) * q) + off; }
    const int nig = WGM * nN, gid = wgid / nig, fm = gid * WGM, gsz = (nM - fm) < WGM ? (nM - fm) : WGM;
    pm = fm + ((wgid % nig) % gsz); pn = (wgid % nig) / gsz; return true;
}
struct PlainOrder {
    int nM, nN, G, c; const char* A; const char* B; size_t tA, tB;
    __device__ __forceinline__ void init(const bf16_t* A_, const bf16_t* B_, int M_, int N_, int lda, int ldb, int G_, int c_) { nM = M_ / BM; nN = N_ / BM; G = G_; c = c_; A = (const char*)A_; B = (const char*)B_; tA = (size_t)BM * lda * 2; tB = (size_t)BM * ldb * 2; }
    __device__ __forceinline__ bool next(int i, Unit& u) const { if (!tile_order(i, G, c, nM, nN, u.pm, u.pn)) return false; u.a = A + (size_t)u.pm * tA; u.b = B + (size_t)u.pn * tB; return true; }
};

template <class Epi, class Sched, bool ALIGN_EPI = true, bool SP2 = true, bool FP8 = false>
__device__ __forceinline__ void gemm_phase(LAS unsigned char* lds, const Dims g, const Sched& S, const Epi& E) {
    const int tid = threadIdx.x, wid = __builtin_amdgcn_readfirstlane(tid >> 6), lane = tid & 63, wr = wid >> 2, wc = wid & 3, fr = lane & 15, fq = lane >> 4;
    const int K = g.K, nt = K / BK;
    unsigned voffA[2], voffB[2];
#pragma unroll
    for (int i = 0; i < 2; ++i) { int R, C; stage_rc(tid * 16 + i * 8192, R, C); const int Rb = Epi::PERM ? ((R & ~31) + perm32(R & 31)) : R;
        voffA[i] = (unsigned)(R * g.lda + C) * 2u; voffB[i] = (unsigned)(Rb * g.ldb + C) * 2u; }
    const size_t kstep = (size_t)(BK * 2);
    const size_t hstepA = (size_t)HALF * g.lda * 2, hstepB = (size_t)HALF * g.ldb * 2;
    const unsigned ldsw = (unsigned)wid * 1024u;
    const int aoff = lds_byte(wr * 64 + fr, fq * 8), boff = lds_byte(wc * 32 + fr, fq * 8);
#define PG8_SA(b, h) (((b) * 2 + (h)) * HTB)
#define PG8_SB(b, h) ((4 + (b) * 2 + (h)) * HTB)
#define PG8_STAGE(bufoff, gbase, voff) do { _Pragma("unroll") for (int _i = 0; _i < 2; ++_i) \
        __builtin_amdgcn_global_load_lds((const unsigned*)((const char*)(gbase) + (voff)[_i]), (LAS unsigned*)(lds + (bufoff) + ldsw + _i * 8192), 16, 0, 0); } while (0)
    typedef int v8i_t __attribute__((ext_vector_type(8))); typedef int v4i_t __attribute__((ext_vector_type(4)));
#define PG8_RD8(p) __builtin_shufflevector(*(const LAS v4i_t*)(p), *(const LAS v4i_t*)((p) + 1024), 0, 1, 2, 3, 4, 5, 6, 7)
#define PG8_LDA(dst, b, h) do { if constexpr (FP8) { _Pragma("unroll") for (int m = 0; m < 4; ++m) dst##8[m] = PG8_RD8(lds + PG8_SA(b, h) + aoff + m * 2048); } \
        else { _Pragma("unroll") for (int m = 0; m < 4; ++m) _Pragma("unroll") for (int k = 0; k < 2; ++k) dst[m][k] = *(const LAS bf16x8*)(lds + PG8_SA(b, h) + aoff + m * 2048 + k * 1024); } } while (0)
#define PG8_LDB(dst, b, h) do { if constexpr (FP8) { _Pragma("unroll") for (int n = 0; n < 2; ++n) dst##8[n] = PG8_RD8(lds + PG8_SB(b, h) + boff + n * 2048); } \
        else { _Pragma("unroll") for (int n = 0; n < 2; ++n) _Pragma("unroll") for (int k = 0; k < 2; ++k) dst[n][k] = *(const LAS bf16x8*)(lds + PG8_SB(b, h) + boff + n * 2048 + k * 1024); } } while (0)
#define PG8_MMA(ai, bj, At, Bt) do { __builtin_amdgcn_s_setprio(1); \
        if constexpr (FP8) { _Pragma("unroll") for (int m = 0; m < 4; ++m) _Pragma("unroll") for (int n = 0; n < 2; ++n) \
            asm volatile("v_mfma_scale_f32_16x16x128_f8f6f4 %0, %1, %2, %0, %3, %4 op_sel_hi:[0,0,0]" : "+v"(acc[ai][bj][m][n]) : "v"(Bt##8[n]), "v"(At##8[m]), "v"(sbv), "v"(sav)); } \
        else { _Pragma("unroll") for (int m = 0; m < 4; ++m) _Pragma("unroll") for (int n = 0; n < 2; ++n) _Pragma("unroll") for (int k = 0; k < 2; ++k) \
            acc[ai][bj][m][n] = __builtin_amdgcn_mfma_f32_16x16x32_bf16(Bt[n][k], At[m][k], acc[ai][bj][m][n], 0, 0, 0); } \
        __builtin_amdgcn_s_setprio(0); } while (0)
#define PG8_WAIT_V(n) asm volatile("s_waitcnt vmcnt(" #n ")" ::: "memory")
#define PG8_WAIT_L(n) asm volatile("s_waitcnt lgkmcnt(" #n ")" ::: "memory")
#define PG8_BAR __builtin_amdgcn_s_barrier()
#define PG8_SCHED __builtin_amdgcn_sched_barrier(0)
    Unit cur, nxt; int ui = 0;
    if (!S.next(0, cur)) return;
    f32x4 acc[2][2][4][2];
#pragma unroll
    for (int a = 0; a < 2; ++a)
#pragma unroll
        for (int b = 0; b < 2; ++b)
#pragma unroll
            for (int m = 0; m < 4; ++m)
#pragma unroll
                for (int n = 0; n < 2; ++n) acc[a][b][m][n] = (f32x4){0.f, 0.f, 0.f, 0.f};
    bf16x8 At[4][2], B0[2][2], B1[2][2]; v8i_t At8[4], B08[2], B18[2];
    const int sbv = g.sb, sav = g.sa;
    const char* cA = cur.a; const char* cB = cur.b;
    if constexpr (SP2) {
        PG8_STAGE(PG8_SB(0, 0), cB, voffB); PG8_STAGE(PG8_SB(0, 1), cB + hstepB, voffB); PG8_STAGE(PG8_SA(0, 0), cA, voffA); PG8_STAGE(PG8_SA(0, 1), cA + hstepA, voffA);
        if (wr == 1) PG8_BAR;
        PG8_WAIT_V(2); PG8_BAR;
        PG8_STAGE(PG8_SB(1, 0), cB + kstep, voffB); PG8_STAGE(PG8_SA(1, 0), cA + kstep, voffA); PG8_STAGE(PG8_SB(1, 1), cB + hstepB + kstep, voffB);
        PG8_WAIT_V(6); PG8_BAR;
    } else {
        PG8_STAGE(PG8_SB(0, 0), cB, voffB); PG8_STAGE(PG8_SA(0, 0), cA, voffA); PG8_STAGE(PG8_SB(0, 1), cB + hstepB, voffB); PG8_STAGE(PG8_SA(0, 1), cA + hstepA, voffA);
        if (wr == 1) PG8_BAR;
        PG8_WAIT_V(4); PG8_BAR;
        PG8_STAGE(PG8_SB(1, 0), cB + kstep, voffB); PG8_STAGE(PG8_SA(1, 0), cA + kstep, voffA); PG8_STAGE(PG8_SB(1, 1), cB + hstepB + kstep, voffB);
        PG8_WAIT_V(6); PG8_BAR;
    }
    for (;;) {
        const bool has_next = S.next(ui + 1, nxt);
        const char* nA = has_next ? nxt.a : cA; const char* nB = has_next ? nxt.b : cB;
#pragma unroll 1
        for (int t = 0; t < nt; t += 2) {
            const bool last = (t == nt - 2);
            const char* a1 = cA + (size_t)(t + 1) * kstep;
            const char* a2 = last ? nA : cA + (size_t)(t + 2) * kstep; const char* b2 = last ? nB : cB + (size_t)(t + 2) * kstep;
            const char* a3 = a2 + kstep; const char* b3 = b2 + kstep;
            if constexpr (SP2) {
            PG8_LDB(B0, 0, 0); PG8_LDB(B1, 0, 1); PG8_SCHED; PG8_LDA(At, 0, 0); PG8_STAGE(PG8_SA(1, 1), a1 + hstepA, voffA);
            PG8_WAIT_V(8); PG8_WAIT_L(0); PG8_BAR; PG8_MMA(0, 0, At, B0); PG8_MMA(0, 1, At, B1); PG8_BAR; PG8_SCHED;
            PG8_LDA(At, 0, 1); PG8_STAGE(PG8_SB(0, 0), b2, voffB); PG8_STAGE(PG8_SB(0, 1), b2 + hstepB, voffB); PG8_STAGE(PG8_SA(0, 0), a2, voffA);
            PG8_WAIT_V(8); PG8_WAIT_L(0); PG8_BAR; PG8_MMA(1, 0, At, B0); PG8_MMA(1, 1, At, B1); PG8_BAR; PG8_SCHED;
            PG8_LDB(B0, 1, 0); PG8_LDB(B1, 1, 1); PG8_SCHED; PG8_LDA(At, 1, 0); PG8_STAGE(PG8_SA(0, 1), a2 + hstepA, voffA);
            PG8_WAIT_V(8); PG8_WAIT_L(0); PG8_BAR; PG8_MMA(0, 0, At, B0); PG8_MMA(0, 1, At, B1); PG8_BAR; PG8_SCHED;
            PG8_LDA(At, 1, 1); PG8_STAGE(PG8_SB(1, 0), b3, voffB); PG8_STAGE(PG8_SB(1, 1), b3 + hstepB, voffB); PG8_STAGE(PG8_SA(1, 0), a3, voffA);
            PG8_WAIT_V(8); PG8_WAIT_L(0); PG8_BAR; PG8_MMA(1, 0, At, B0); PG8_MMA(1, 1, At, B1); PG8_BAR; PG8_SCHED;
            } else {
            PG8_LDB(B0, 0, 0); PG8_SCHED; PG8_LDA(At, 0, 0); PG8_STAGE(PG8_SA(1, 1), a1 + hstepA, voffA);
            PG8_WAIT_L(8); PG8_BAR; PG8_WAIT_L(0); PG8_MMA(0, 0, At, B0); PG8_BAR; PG8_SCHED;
            PG8_LDB(B1, 0, 1); PG8_STAGE(PG8_SB(0, 0), b2, voffB);
            PG8_BAR; PG8_WAIT_L(0); PG8_MMA(0, 1, At, B1); PG8_BAR;
            PG8_LDA(At, 0, 1); PG8_STAGE(PG8_SA(0, 0), a2, voffA);
            PG8_BAR; PG8_WAIT_L(0); PG8_MMA(1, 0, At, B0); PG8_BAR; PG8_SCHED;
            PG8_STAGE(PG8_SB(0, 1), b2 + hstepB, voffB);
            PG8_WAIT_V(6); PG8_BAR; PG8_MMA(1, 1, At, B1); PG8_BAR;
            PG8_LDB(B0, 1, 0); PG8_SCHED; PG8_LDA(At, 1, 0); PG8_STAGE(PG8_SA(0, 1), a2 + hstepA, voffA);
            PG8_WAIT_L(8); PG8_BAR; PG8_WAIT_L(0); PG8_MMA(0, 0, At, B0); PG8_BAR; PG8_SCHED;
            PG8_LDB(B1, 1, 1); PG8_STAGE(PG8_SB(1, 0), b3, voffB);
            PG8_BAR; PG8_WAIT_L(0); PG8_MMA(0, 1, At, B1); PG8_BAR;
            PG8_LDA(At, 1, 1); PG8_STAGE(PG8_SA(1, 0), a3, voffA);
            PG8_BAR; PG8_WAIT_L(0); PG8_MMA(1, 0, At, B0); PG8_BAR; PG8_SCHED;
            PG8_STAGE(PG8_SB(1, 1), b3 + hstepB, voffB);
            PG8_WAIT_V(6); PG8_BAR; PG8_MMA(1, 1, At, B1); PG8_BAR;
            }
        }
        if constexpr (ALIGN_EPI) { if (wr == 0) PG8_BAR; }
        if constexpr (FP8) asm volatile("s_nop 15\n\ts_nop 15" ::: "memory");
        E(acc, cur, wr, wc, fr, fq);
        if (!has_next) break;
#pragma unroll
        for (int a = 0; a < 2; ++a)
#pragma unroll
            for (int b = 0; b < 2; ++b)
#pragma unroll
                for (int m = 0; m < 4; ++m)
#pragma unroll
                    for (int n = 0; n < 2; ++n) acc[a][b][m][n] = (f32x4){0.f, 0.f, 0.f, 0.f};
        cur = nxt; cA = nA; cB = nB; ++ui;
        if constexpr (ALIGN_EPI) { if (wr == 1) PG8_BAR; }
    }
    PG8_WAIT_V(0);
    if constexpr (!ALIGN_EPI) { if (wr == 0) PG8_BAR; }
    PG8_BAR;
#undef PG8_SA
#undef PG8_SB
#undef PG8_STAGE
#undef PG8_LDA
#undef PG8_LDB
#undef PG8_MMA
#undef PG8_RD8
#undef PG8_WAIT_V
#undef PG8_WAIT_L
#undef PG8_BAR
#undef PG8_SCHED
}

typedef const f32x4 (&AccRef)[2][2][4][2];
struct EpiBf16Plain {
    static constexpr bool PERM = true;
    bf16_t* O; int ldc;
    __device__ __forceinline__ void operator()(AccRef acc, const Unit& u, int wr, int wc, int fr, int fq) const {
        const int row0 = u.pm * BM + wr * 64 + fr, col0 = u.pn * BM + wc * 32 + 8 * fq;
#pragma unroll
        for (int ai = 0; ai < 2; ++ai)
#pragma unroll
            for (int m = 0; m < 4; ++m) { bf16_t* rowp = O + (size_t)(row0 + ai * HALF + m * 16) * ldc + col0;
#pragma unroll
                for (int bj = 0; bj < 2; ++bj) { const f32x4 v0 = acc[ai][bj][m][0], v1 = acc[ai][bj][m][1];
                    u32x4 w; w.x = cvt_pk_bf16(v0[0], v0[1]); w.y = cvt_pk_bf16(v0[2], v0[3]); w.z = cvt_pk_bf16(v1[0], v1[1]); w.w = cvt_pk_bf16(v1[2], v1[3]);
                    *(u32x4*)(rowp + bj * HALF) = w; } }
    }
};
struct EpiProjSplit {
    static constexpr bool PERM = true;
    bf16_t* P3; bf16_t* OG;
    __device__ __forceinline__ void operator()(AccRef acc, const Unit& u, int wr, int wc, int fr, int fq) const {
        const int row0 = u.pm * BM + wr * 64 + fr; const bool og = u.pn >= 12; const int ldc = og ? 1024 : 3072; bf16_t* base = (og ? OG + (u.pn - 12) * BM : P3 + u.pn * BM) + wc * 32 + 8 * fq;
#pragma unroll
        for (int ai = 0; ai < 2; ++ai)
#pragma unroll
            for (int m = 0; m < 4; ++m) { bf16_t* rowp = base + (size_t)(row0 + ai * HALF + m * 16) * ldc;
#pragma unroll
                for (int bj = 0; bj < 2; ++bj) { const f32x4 v0 = acc[ai][bj][m][0], v1 = acc[ai][bj][m][1];
                    u32x4 w; w.x = cvt_pk_bf16(v0[0], v0[1]); w.y = cvt_pk_bf16(v0[2], v0[3]); w.z = cvt_pk_bf16(v1[0], v1[1]); w.w = cvt_pk_bf16(v1[2], v1[3]);
                    *(u32x4*)(rowp + bj * HALF) = w; } }
    }
};
struct EpiResF32 {
    static constexpr bool PERM = false;
    const float* base; float* out; int ldc;
    __device__ __forceinline__ void operator()(AccRef acc, const Unit& u, int wr, int wc, int fr, int fq) const {
        const int row0 = u.pm * BM + wr * 64 + fr, col0 = u.pn * BM + wc * 32 + 4 * fq;
#pragma unroll
        for (int ai = 0; ai < 2; ++ai)
#pragma unroll
            for (int m = 0; m < 4; ++m) { const size_t off = (size_t)(row0 + ai * HALF + m * 16) * ldc + col0;
#pragma unroll
                for (int bj = 0; bj < 2; ++bj)
#pragma unroll
                    for (int n = 0; n < 2; ++n) { const f32x4 bs = *(const f32x4*)(base + off + bj * HALF + n * 16); *(f32x4*)(out + off + bj * HALF + n * 16) = bs + acc[ai][bj][m][n]; } }
    }
};
__device__ __forceinline__ float row_rs16(const float* ss, int row) { const f32x4* p = (const f32x4*)(ss + (size_t)row * 16); const f32x4 a = p[0], b = p[1], c = p[2], d = p[3];
    const float t = (((a[0] + a[1]) + (a[2] + a[3])) + ((b[0] + b[1]) + (b[2] + b[3]))) + (((c[0] + c[1]) + (c[2] + c[3])) + ((d[0] + d[1]) + (d[2] + d[3]))); return 1.0f / sqrtf(t * (1.f / 1024.f) + EPS); }
struct EpiResF32Stat {
    static constexpr bool PERM = false;
    const float* base; float* out; bf16_t* XHo; float* SS; int ldc;
    __device__ __forceinline__ void operator()(AccRef acc, const Unit& u, int wr, int wc, int fr, int fq) const {
        const int row0 = u.pm * BM + wr * 64 + fr, col0 = u.pn * BM + wc * 32 + 4 * fq;
#pragma unroll
        for (int ai = 0; ai < 2; ++ai)
#pragma unroll
            for (int m = 0; m < 4; ++m) { const int row = row0 + ai * HALF + m * 16; const size_t off = (size_t)row * ldc + col0; float ss = 0.f;
#pragma unroll
                for (int bj = 0; bj < 2; ++bj)
#pragma unroll
                    for (int n = 0; n < 2; ++n) { const f32x4 o = *(const f32x4*)(base + off + bj * HALF + n * 16) + acc[ai][bj][m][n]; *(f32x4*)(out + off + bj * HALF + n * 16) = o;
                        ss += (o[0] * o[0] + o[1] * o[1]) + (o[2] * o[2] + o[3] * o[3]);
                        u32x2 w; w.x = cvt_pk_bf16(o[0], o[1]); w.y = cvt_pk_bf16(o[2], o[3]); *(u32x2*)(XHo + off + bj * HALF + n * 16) = w; }
                ss += __shfl_xor(ss, 16); ss += __shfl_xor(ss, 32);
                if (fq == 0) SS[(size_t)row * 16 + u.pn * 4 + wc] = ss; }
    }
};
struct EpiSwiGLU {
    static constexpr bool PERM = true;
    bf16_t* O; int ldc; const float* rsv;
    __device__ __forceinline__ void operator()(AccRef acc, const Unit& u, int wr, int wc, int fr, int fq) const {
        const int row0 = u.pm * BM + wr * 64 + fr, col0 = u.pn * HALF + wc * 32 + 8 * fq;
#pragma unroll
        for (int ai = 0; ai < 2; ++ai)
#pragma unroll
            for (int m = 0; m < 4; ++m) { const int row = row0 + ai * HALF + m * 16; bf16_t* rowp = O + (size_t)row * ldc + col0; const float rs = rsv ? rsv[row] : 1.0f;
                float o[8];
#pragma unroll
                for (int n = 0; n < 2; ++n)
#pragma unroll
                    for (int j = 0; j < 4; ++j) { const float gv = acc[ai][0][m][n][j] * rs, uv = acc[ai][1][m][n][j] * rs; o[n * 4 + j] = siluf_(gv) * uv; }
                u32x4 w; w.x = cvt_pk_bf16(o[0], o[1]); w.y = cvt_pk_bf16(o[2], o[3]); w.z = cvt_pk_bf16(o[4], o[5]); w.w = cvt_pk_bf16(o[6], o[7]);
                *(u32x4*)rowp = w; }
    }
};
struct EpiSwiGLU8 {
    static constexpr bool PERM = true;
    unsigned char* O8; int ldc; float oscale;
    __device__ __forceinline__ void operator()(AccRef acc, const Unit& u, int wr, int wc, int fr, int fq) const {
        const int row0 = u.pm * BM + wr * 64 + fr, col0 = u.pn * HALF + wc * 32 + 8 * fq;
#pragma unroll
        for (int ai = 0; ai < 2; ++ai)
#pragma unroll
            for (int m = 0; m < 4; ++m) { unsigned char* rowp = O8 + (size_t)(row0 + ai * HALF + m * 16) * ldc + col0;
                float o[8];
#pragma unroll
                for (int n = 0; n < 2; ++n)
#pragma unroll
                    for (int j = 0; j < 4; ++j) { const float gv = acc[ai][0][m][n][j], uv = acc[ai][1][m][n][j]; o[n * 4 + j] = siluf_(gv) * uv * oscale; }
                u32x2 w; w.x = pk_fp8x4(o[0], o[1], o[2], o[3]); w.y = pk_fp8x4(o[4], o[5], o[6], o[7]);
                *(u32x2*)rowp = w; }
    }
};
struct EpiKVQ {
    static constexpr bool PERM = true;
    bf16_t* KV; bf16_t* Q; float* GATE; const float* bgate; const float* rsv;
    __device__ __forceinline__ void operator()(AccRef acc, const Unit& u, int wr, int wc, int fr, int fq) const {
        const int row0 = u.pm * BM + wr * 64 + fr, cin = wc * 32 + 8 * fq;
#pragma unroll
        for (int ai = 0; ai < 2; ++ai)
#pragma unroll
            for (int m = 0; m < 4; ++m) { const int row = row0 + ai * HALF + m * 16; const float rs = rsv[row];
#pragma unroll
                for (int bj = 0; bj < 2; ++bj) { const f32x4 v0 = acc[ai][bj][m][0] * rs, v1 = acc[ai][bj][m][1] * rs; const int col = cin + bj * HALF;
                    if (u.pn < 6) { const int b = row >> 12, t = row & 4095, g = col >> 6, d = col & 63;
                        u32x4 w; w.x = cvt_pk_bf16(v0[0], v0[1]); w.y = cvt_pk_bf16(v0[2], v0[3]); w.z = cvt_pk_bf16(v1[0], v1[1]); w.w = cvt_pk_bf16(v1[2], v1[3]);
                        *(u32x4*)(KV + ((((size_t)u.pn * 8 + b) * 4 + g) * 4096 + t) * 64 + d) = w;
                    } else if (u.pn < 10) { const float s = 0.125f * 1.4426950408889634f;
                        u32x4 w; w.x = cvt_pk_bf16(v0[0] * s, v0[1] * s); w.y = cvt_pk_bf16(v0[2] * s, v0[3] * s); w.z = cvt_pk_bf16(v1[0] * s, v1[1] * s); w.w = cvt_pk_bf16(v1[2] * s, v1[3] * s);
                        *(u32x4*)(Q + (size_t)row * 1024 + (u.pn - 6) * 256 + col) = w;
                    } else if (col < 48) { const f32x4 b0 = *(const f32x4*)(bgate + col), b1 = *(const f32x4*)(bgate + col + 4);
                        f32x4 o0, o1;
#pragma unroll
                        for (int j = 0; j < 4; ++j) { o0[j] = sigmoidf_(v0[j] + b0[j]); o1[j] = sigmoidf_(v1[j] + b1[j]); }
                        *(f32x4*)(GATE + (size_t)row * 48 + col) = o0; *(f32x4*)(GATE + (size_t)row * 48 + col + 4) = o1; } } }
    }
};
struct EpiCmp {
    static constexpr bool PERM = true;
    bf16_t* O; const float* bias;
    __device__ __forceinline__ void operator()(AccRef acc, const Unit& u, int wr, int wc, int fr, int fq) const {
        const int row0 = u.pm * BM + wr * 64 + fr, col0 = wc * 32 + 8 * fq; const float* bp = bias + (u.pm >> 5) * 256 + col0;
#pragma unroll
        for (int ai = 0; ai < 2; ++ai)
#pragma unroll
            for (int m = 0; m < 4; ++m) { bf16_t* rowp = O + (size_t)(row0 + ai * HALF + m * 16) * 256 + col0;
#pragma unroll
                for (int bj = 0; bj < 2; ++bj) { const f32x4 b0 = *(const f32x4*)(bp + bj * HALF), b1 = *(const f32x4*)(bp + bj * HALF + 4);
                    const f32x4 v0 = acc[ai][bj][m][0] + b0, v1 = acc[ai][bj][m][1] + b1;
                    u32x4 w; w.x = cvt_pk_bf16(siluf_(v0[0]), siluf_(v0[1])); w.y = cvt_pk_bf16(siluf_(v0[2]), siluf_(v0[3])); w.z = cvt_pk_bf16(siluf_(v1[0]), siluf_(v1[1])); w.w = cvt_pk_bf16(siluf_(v1[2]), siluf_(v1[3]));
                    *(u32x4*)(rowp + bj * HALF) = w; } }
    }
};
}

struct MoeOrder {
    int nN, G, c; const char* A; const char* B; size_t tA, tBe, tBn; volatile LAS int* tb;
    __device__ __forceinline__ int expert_of(int pm) const { int e = 0;
#pragma unroll
        for (int i = 1; i < 8; ++i) e += (pm >= __builtin_amdgcn_readfirstlane(tb[i])) ? 1 : 0;
        return e; }
    __device__ __forceinline__ bool next(int i, pg8::Unit& u) const {
        const int nM = __builtin_amdgcn_readfirstlane(tb[8]);
        if (!pg8::tile_order(i, G, c, nM, nN, u.pm, u.pn)) return false;
        u.a = A + (size_t)u.pm * tA; u.b = B + (size_t)expert_of(u.pm) * tBe + (size_t)u.pn * tBn; return true; }
};
struct EpiMoeDown {
    static constexpr bool PERM = false;
    float* out; float* Y1; const u32x2* rowinfo; const float* ew; volatile LAS int* tb;
    __device__ __forceinline__ void operator()(pg8::AccRef acc, const pg8::Unit& u, int wr, int wc, int fr, int fq) const {
        int e = 0;
#pragma unroll
        for (int i = 1; i < 8; ++i) e += (u.pm >= __builtin_amdgcn_readfirstlane(tb[i])) ? 1 : 0;
        const int nvalid = __builtin_amdgcn_readfirstlane(tb[16 + e]) - (u.pm - __builtin_amdgcn_readfirstlane(tb[e])) * 256;
        const int rin0 = wr * 64 + fr, col0 = u.pn * 256 + wc * 32 + 4 * fq;
#pragma unroll
        for (int ai = 0; ai < 2; ++ai)
#pragma unroll
            for (int m = 0; m < 4; ++m) { const int rin = rin0 + ai * 128 + m * 16;
                if (rin < nvalid) { const u32x2 info = rowinfo[(size_t)u.pm * 256 + rin]; const int token = (int)(info.x >> 1), slot = (int)(info.x & 1u); const float w = ew[2 * (size_t)token + slot];
                    float* dst = (slot ? Y1 : out) + (size_t)token * 1024 + col0;
#pragma unroll
                    for (int bj = 0; bj < 2; ++bj)
#pragma unroll
                        for (int n = 0; n < 2; ++n) { f32x4 v = acc[ai][bj][m][n] * w; if (!slot) v = v + *(const f32x4*)(dst + bj * 128 + n * 16); *(f32x4*)(dst + bj * 128 + n * 16) = v; } } }
    }
};

__device__ __forceinline__ void conv_item(const float* W, int ld, int srcc0, int nvalid, bf16_t* WT, int ldd, int dstr0, const float* gain, int k0, int lane) {
    const int n4 = lane & 7, c = lane >> 3;
    f32x4 v[8];
#pragma unroll
    for (int i = 0; i < 8; ++i) { v[i] = (f32x4){0.f, 0.f, 0.f, 0.f};
        if (4 * n4 < nvalid) { v[i] = *(const f32x4*)(W + (size_t)(k0 + 8 * c + i) * ld + srcc0 + 4 * n4); if (gain) v[i] = v[i] * gain[k0 + 8 * c + i]; } }
#pragma unroll
    for (int j = 0; j < 4; ++j) { u32x4 o; o.x = pk2(v[0][j], v[1][j]); o.y = pk2(v[2][j], v[3][j]); o.z = pk2(v[4][j], v[5][j]); o.w = pk2(v[6][j], v[7][j]);
        *(u32x4*)(WT + (size_t)(dstr0 + 4 * n4 + j) * ldd + k0 + 8 * c) = o; }
}

struct W8 { const float* src; const float* gain; unsigned char* dst; int ld, ldd; float scale, gm, ga; };
__device__ __forceinline__ void conv8_load(const W8& d, int lane, f32x4 (&v)[16], f32x4 (&g)[4]) {
    const int n4 = lane & 7, c = lane >> 3;
#pragma unroll
    for (int i = 0; i < 16; ++i) v[i] = *(const f32x4*)(d.src + (size_t)(16 * c + i) * d.ld + 4 * n4);
#pragma unroll
    for (int q = 0; q < 4; ++q) g[q] = *(const f32x4*)(d.gain + 16 * c + 4 * q);
}
__device__ __forceinline__ void conv8_store(const W8& d, int lane, const f32x4 (&v)[16], const f32x4 (&g)[4]) {
    const int n4 = lane & 7, c = lane >> 3;
    f32x4 gs[4];
#pragma unroll
    for (int q = 0; q < 4; ++q) gs[q] = (g[q] * d.gm + d.ga) * d.scale;
#pragma unroll
    for (int j = 0; j < 4; ++j) { u32x4 o;
        o.x = pk_fp8x4(v[0][j] * gs[0].x, v[1][j] * gs[0].y, v[2][j] * gs[0].z, v[3][j] * gs[0].w);
        o.y = pk_fp8x4(v[4][j] * gs[1].x, v[5][j] * gs[1].y, v[6][j] * gs[1].z, v[7][j] * gs[1].w);
        o.z = pk_fp8x4(v[8][j] * gs[2].x, v[9][j] * gs[2].y, v[10][j] * gs[2].z, v[11][j] * gs[2].w);
        o.w = pk_fp8x4(v[12][j] * gs[3].x, v[13][j] * gs[3].y, v[14][j] * gs[3].z, v[15][j] * gs[3].w);
        *(u32x4*)(d.dst + (size_t)(4 * n4 + j) * d.ldd + 16 * c) = o; }
}

struct Args { const float* in[22]; float* out; unsigned char* ws; int ph_lo, ph_hi; };
typedef const __attribute__((address_space(4))) Args* CArgsP;
__device__ __forceinline__ CArgsP argp() { CArgsP p = (CArgsP)__builtin_amdgcn_kernarg_segment_ptr(); asm volatile("" : "+s"(p)); return p; }
#define A_IN(i) ((const float*)argp()->in[i])
enum { I_X = 0, I_NORM_MIX, I_NORM_FFN, I_A_W_IN, I_A_B_GATE, I_A_CONV, I_A_NORM_H, I_A_W_OUT, I_NORM_KV, I_B_W_KV, I_B_CMP_POS, I_B_CMP_W1, I_B_CMP_W2,
       I_B_W_Q, I_B_B_GATE, I_B_W_OUT, I_F_W_GU, I_F_W_DOWN, I_M_ROUTER, I_M_W_GU, I_M_W_DOWN, I_NORM_FINAL };

__device__ __forceinline__ W8 w8_decode(unsigned char* ws, int r) {
    constexpr int N8 = 8 * 8 * 224;
    W8 d;
    if (r < N8) { const int e = r / (8 * 224), rr = r % (8 * 224), kb = rr / 224, db = rr % 224, tile = db >> 3, w = db & 7; const int sc = (w < 4) ? (128 * tile + 32 * w) : (FE + 128 * tile + 32 * (w - 4));
        d.src = A_IN(I_M_W_GU) + (size_t)e * 1024 * 2 * FE + (size_t)(128 * kb) * (2 * FE) + sc; d.ld = 2 * FE; d.gain = A_IN(I_NORM_FFN) + 1024 + 128 * kb; d.scale = 128.f; d.gm = 1.f; d.ga = 0.f;
        d.dst = ws + WS_MGU + (size_t)e * 2 * FE * 1024 + (size_t)(32 * db) * 1024 + 128 * kb; d.ldd = 1024; }
    else { r -= N8; const int e = r / (28 * 32), rr = r % (28 * 32), kb = rr / 32, db = rr % 32;
        d.src = A_IN(I_M_W_DOWN) + (size_t)e * FE * 1024 + (size_t)(128 * kb) * 1024 + 32 * db; d.ld = 1024; d.gain = A_IN(I_NORM_FFN); d.scale = 256.f; d.gm = 0.f; d.ga = 1.f;
        d.dst = ws + WS_MDOWN + (size_t)e * 1024 * FE + (size_t)(32 * db) * FE + 128 * kb; d.ldd = FE; }
    return d;
}
__device__ __forceinline__ void p0_item16(unsigned char* ws, int r, int lane) {
    constexpr int N1 = 16 * 128, N2 = 16 * 32, N3 = 16 * 176, N4 = 44 * 32, N5 = 16 * 88, N6 = 2 * 32 * 8;
    if (r < N1) { const int kb = r / 128, db = r % 128; conv_item(A_IN(I_A_W_IN), NPROJ_SRC, 32 * db, 32, (bf16_t*)(ws + WS_WIN), 1024, 32 * db, A_IN(I_NORM_MIX), 64 * kb, lane); return; } r -= N1;
    if (r < N2) { const int kb = r / 32, db = r % 32; conv_item(A_IN(I_A_W_OUT), 1024, 32 * db, 32, (bf16_t*)(ws + WS_WOUTA), 1024, 32 * db, nullptr, 64 * kb, lane); return; } r -= N2;
    if (r < N3) { const int kb = r / 176, db = r % 176, tile = db >> 3, w = db & 7; const int sc = (w < 4) ? (128 * tile + 32 * w) : (FFD + 128 * tile + 32 * (w - 4));
        conv_item(A_IN(I_F_W_GU), 2 * FFD, sc, 32, (bf16_t*)(ws + WS_WGU), 1024, 32 * db, A_IN(I_NORM_FFN), 64 * kb, lane); return; } r -= N3;
    if (r < N4) { const int kb = r / 32, db = r % 32; conv_item(A_IN(I_F_W_DOWN), 1024, 32 * db, 32, (bf16_t*)(ws + WS_WDOWN), FFD, 32 * db, nullptr, 64 * kb, lane); return; } r -= N4;
    if (r < N5) { const int kb = r / 88, db = r % 88;
        if (db < 48) conv_item(A_IN(I_B_W_KV), 1536, 32 * db, 32, (bf16_t*)(ws + WS_WKVQ), 1024, 32 * db, A_IN(I_NORM_KV), 64 * kb, lane);
        else { const int sc = 32 * (db - 48); int nv = NQSRC - sc; nv = nv < 0 ? 0 : (nv > 32 ? 32 : nv);
            conv_item(A_IN(I_B_W_Q), NQSRC, sc, nv, (bf16_t*)(ws + WS_WKVQ), 1024, 32 * db, A_IN(I_NORM_MIX) + 1024, 64 * kb, lane); }
        return; } r -= N5;
    if (r < N6) { const int c = r / 256, rr = r % 256, kb = rr / 8, db = rr % 8; conv_item(A_IN(I_B_CMP_W1) + (size_t)c * 2048 * 256, 256, 32 * db, 32, (bf16_t*)(ws + WS_WCMP1) + (size_t)c * 256 * 2048, 2048, 32 * db, nullptr, 64 * kb, lane); return; } r -= N6;
    { const int kb = r / 32, db = r % 32; conv_item(A_IN(I_B_W_OUT), 1024, 32 * db, 32, (bf16_t*)(ws + WS_WOUTB), 1024, 32 * db, nullptr, 64 * kb, lane); }
}
__device__ __forceinline__ void p0_weights(unsigned char* ws, LAS unsigned char* lds, int gw, int NGW, int wave, int lane) {
    constexpr int N1 = 16 * 128, N2 = 16 * 32, N3 = 16 * 176, N4 = 44 * 32, N5 = 16 * 88, N6 = 2 * 32 * 8, N7 = 16 * 32;
    constexpr int NB16 = N1 + N2 + N3 + N4 + N5 + N6 + N7, NT8 = 8 * 8 * 224 + 8 * 28 * 32;
    {   f32x4 va[16], ga[4], vb[16], gb[4]; W8 da, db;
        int it = gw;
        da = w8_decode(ws, it); conv8_load(da, lane, va, ga);
        for (;;) {
            int nx = it + NGW; db = w8_decode(ws, nx < NT8 ? nx : NT8 - 1); if (nx >= NT8) db.ld = 0;
            conv8_load(db, lane, vb, gb); __builtin_amdgcn_sched_barrier(0);
            conv8_store(da, lane, va, ga);
            if (nx >= NT8) break;
            it = nx; nx = it + NGW; da = w8_decode(ws, nx < NT8 ? nx : NT8 - 1); if (nx >= NT8) da.ld = 0;
            conv8_load(da, lane, va, ga); __builtin_amdgcn_sched_barrier(0);
            conv8_store(db, lane, vb, gb);
            if (nx >= NT8) break;
            it = nx; }
    }
    for (int it = gw; it < NB16; it += NGW) p0_item16(ws, it, lane);
}

__device__ __forceinline__ void load_row(const float* row, int lane, f32x4 (&v)[4]) {
    const f32x4* xr = (const f32x4*)row + lane;
#pragma unroll
    for (int j = 0; j < 4; ++j) v[j] = xr[64 * j];
}
__device__ __forceinline__ float row_rstd(const f32x4 (&v)[4]) {
    float s = 0.f;
#pragma unroll
    for (int j = 0; j < 4; ++j) s += (v[j].x * v[j].x + v[j].y * v[j].y) + (v[j].z * v[j].z + v[j].w * v[j].w);
    return 1.0f / sqrtf(wave_sum(s) * (1.f / 1024.f) + EPS);
}
__device__ __forceinline__ void store_row_bf16(bf16_t* orow, int lane, const f32x4 (&v)[4], float sc) {
    u64* o8 = (u64*)orow + lane;
#pragma unroll
    for (int j = 0; j < 4; ++j) o8[64 * j] = (u64)pk2(v[j].x * sc, v[j].y * sc) | ((u64)pk2(v[j].z * sc, v[j].w * sc) << 32);
}

__device__ __forceinline__ f32x4 mma_lds(const LAS bf16_t* A, int lda, const LAS bf16_t* Bt, int ldb, int K, f32x4 acc, int lane) {
    const int r = lane & 15, q = lane >> 4;
    const LAS bf16_t* ap = A + r * lda + 8 * q; const LAS bf16_t* bp = Bt + r * ldb + 8 * q;
    for (int k = 0; k < K; k += 32) { const bf16x8 a = *(const LAS bf16x8*)(ap + k), b = *(const LAS bf16x8*)(bp + k); acc = __builtin_amdgcn_mfma_f32_16x16x32_bf16(a, b, acc, 0, 0, 0); }
    return acc;
}

__device__ __forceinline__ void scanprep_phase(LAS unsigned char* lds, const bf16_t* P3, const float* GA, const float* conv_w, unsigned char* IMG, int vcu, int G) {
    const int tid = threadIdx.x, wave = __builtin_amdgcn_readfirstlane(tid >> 6), lane = tid & 63;
    constexpr int QS = 272, LDP = 3072;
    LAS bf16_t* Qs = (LAS bf16_t*)(lds + 0);
    LAS bf16_t* Kd = (LAS bf16_t*)(lds + 34816);
    LAS float* fg = (LAS float*)(lds + 67584);
    LAS float* cw = (LAS float*)(lds + 68352);
    const bool same_h = (G & 255) == 0; int h_loaded = -1;
    for (int item = vcu; item < 2048; item += G) {
        const int b = item >> 8, h = (item >> 6) & 3, ci = item & 63, t0 = ci * 64; const size_t rb = (size_t)b * SEQ + t0;
        unsigned char* img = IMG + (size_t)item * IMG_STRIDE;
        const int cg = tid & 31, rg = tid >> 5;
        u32x4 rawq[7], rawk[7];
#pragma unroll
        for (int r7 = 0; r7 < 7; ++r7) { const int tt = 4 * rg - 3 + r7; rawq[r7] = (u32x4){0u, 0u, 0u, 0u}; rawk[r7] = (u32x4){0u, 0u, 0u, 0u};
            if (t0 + tt >= 0) { const bf16_t* p = P3 + (rb + tt) * LDP + h * 256 + 8 * cg; rawq[r7] = *(const u32x4*)p; rawk[r7] = *(const u32x4*)(p + 1024); } }
        const int vv = tid & 255, hf = tid >> 8; unsigned short ev[32];
        { const bf16_t* vp = P3 + (rb + 32 * hf) * LDP + 2048 + h * 256 + vv;
#pragma unroll
          for (int i = 0; i < 32; ++i) ev[i] = vp[(size_t)i * LDP]; }
        float gli = 0.f, glf = 0.f; if (wave == 7) { gli = GA[(rb + lane) * 8 + h]; glf = GA[(rb + lane) * 8 + 4 + h]; }
        __syncthreads();
        if (h != h_loaded || !same_h) {
            for (int i = tid; i < 2048; i += NTHR) { const int j = i >> 8, kk = i & 255; cw[i] = conv_w[(j & 3) * 2048 + (j >> 2) * 1024 + h * 256 + kk]; }
            for (int i = tid; i < 64 * 16; i += NTHR) { const int r = i >> 4, c = i & 15; Qs[r * QS + 256 + c] = 0; }
            h_loaded = h; __syncthreads(); }
        { bf16_t* op = (bf16_t*)(img + IMG_VT) + vv * 80 + 32 * hf;
#pragma unroll
          for (int g8 = 0; g8 < 4; ++g8) { u32x4 w; w.x = ev[8 * g8] | ((unsigned)ev[8 * g8 + 1] << 16); w.y = ev[8 * g8 + 2] | ((unsigned)ev[8 * g8 + 3] << 16); w.z = ev[8 * g8 + 4] | ((unsigned)ev[8 * g8 + 5] << 16); w.w = ev[8 * g8 + 6] | ((unsigned)ev[8 * g8 + 7] << 16);
              *(u32x4*)(op + 8 * g8) = w; }
          *(u32x4*)((bf16_t*)(img + IMG_VT) + vv * 80 + 64 + 8 * hf) = (u32x4){0u, 0u, 0u, 0u}; }
        {
#pragma unroll
          for (int which = 0; which < 2; ++which) {
            float x[7][8];
#pragma unroll
            for (int r7 = 0; r7 < 7; ++r7) { const u32x4 raw = which ? rawk[r7] : rawq[r7];
                x[r7][0] = bflo(raw.x); x[r7][1] = bfhi(raw.x); x[r7][2] = bflo(raw.y); x[r7][3] = bfhi(raw.y); x[r7][4] = bflo(raw.z); x[r7][5] = bfhi(raw.z); x[r7][6] = bflo(raw.w); x[r7][7] = bfhi(raw.w); }
            float w[4][8];
#pragma unroll
            for (int tap = 0; tap < 4; ++tap) { const f32x4 w0 = *(const LAS f32x4*)(cw + (which * 4 + tap) * 256 + 8 * cg), w1 = *(const LAS f32x4*)(cw + (which * 4 + tap) * 256 + 8 * cg + 4);
                w[tap][0] = w0.x; w[tap][1] = w0.y; w[tap][2] = w0.z; w[tap][3] = w0.w; w[tap][4] = w1.x; w[tap][5] = w1.y; w[tap][6] = w1.z; w[tap][7] = w1.w; }
            const float sc = which ? 0.0625f : 1.0f;
#pragma unroll
            for (int j = 0; j < 4; ++j) { float o[8];
#pragma unroll
                for (int c = 0; c < 8; ++c) o[c] = (w[0][c] * x[j][c] + w[1][c] * x[j + 1][c] + w[2][c] * x[j + 2][c] + w[3][c] * x[j + 3][c]) * sc;
                u32x4 p; p.x = pg8::cvt_pk_bf16(o[0], o[1]); p.y = pg8::cvt_pk_bf16(o[2], o[3]); p.z = pg8::cvt_pk_bf16(o[4], o[5]); p.w = pg8::cvt_pk_bf16(o[6], o[7]);
                if (which) *(LAS u32x4*)(Kd + (4 * rg + j) * 256 + 8 * cg) = p; else *(LAS u32x4*)(Qs + (4 * rg + j) * QS + 8 * cg) = p; }
          }
          if (wave == 7) { const float li = gli, lf = glf;
              float bc = lf;
#pragma unroll
              for (int o = 1; o < 64; o <<= 1) { const float t = __shfl_up(bc, o); if (lane >= o) bc += t; }
              const float uu = li - bc; float pm = uu;
#pragma unroll
              for (int o = 1; o < 64; o <<= 1) { const float t = __shfl_up(pm, o); if (lane >= o) pm = fmaxf(pm, t); }
              fg[lane] = bc; fg[64 + lane] = uu; fg[128 + lane] = pm; }
        }
        __syncthreads();
        { const int k = tid & 255; bf16_t* op = (bf16_t*)(img + IMG_KT) + k * 64 + 32 * hf;
#pragma unroll
          for (int g8 = 0; g8 < 4; ++g8) { unsigned short e[8];
#pragma unroll
              for (int i = 0; i < 8; ++i) e[i] = Kd[(32 * hf + 8 * g8 + i) * 256 + k];
              u32x4 w; w.x = e[0] | ((unsigned)e[1] << 16); w.y = e[2] | ((unsigned)e[3] << 16); w.z = e[4] | ((unsigned)e[5] << 16); w.w = e[6] | ((unsigned)e[7] << 16);
              *(u32x4*)(op + 8 * g8) = w; } }
        for (int i = tid; i < 67584 / 16; i += NTHR) *(u32x4*)(img + (size_t)i * 16) = *(const LAS u32x4*)(lds + i * 16);
        if (tid < 48) *(u32x4*)(img + IMG_G + tid * 16) = *(const LAS u32x4*)(lds + 67584 + tid * 16);
    }
}

__device__ __forceinline__ void scan_phase(LAS unsigned char* lds, const unsigned char* IMG, float* HS, float* DN, int vcu, int G) {
    const int tid = threadIdx.x, wave = __builtin_amdgcn_readfirstlane(tid >> 6), lane = tid & 63, cl = lane & 15, q4 = lane >> 4;
    constexpr int QS = 272, TS = 80;
    LAS bf16_t* Qs = (LAS bf16_t*)(lds + 0);
    LAS bf16_t* Cbs = (LAS bf16_t*)(lds + 34816);
    LAS bf16_t* VTs = (LAS bf16_t*)(lds + 52768);
    LAS bf16_t* VaTs = (LAS bf16_t*)(lds + 58048);
    LAS bf16_t* Sws = (LAS bf16_t*)(lds + 63328);
    LAS float* fg = (LAS float*)(lds + 73568);
    const int r2 = cl ? 32 : 32;
    for (int u = vcu; u < 256; u += G) {
        const int b = u >> 5, h = (u >> 3) & 3, vs = u & 7;
        const unsigned char* img0 = IMG + (size_t)((b * 4 + h) * 64) * IMG_STRIDE;
        __syncthreads();
        for (int i = tid; i < 33 * QS; i += NTHR) Cbs[i] = 0;
        for (int i = tid; i < TS; i += NTHR) { VTs[32 * TS + i] = (i < 64) ? (bf16_t)0x3F80 : (bf16_t)0; VaTs[32 * TS + i] = 0; }
        f32x4 Cacc[2][3];
#pragma unroll
        for (int kk = 0; kk < 2; ++kk)
#pragma unroll
            for (int vt = 0; vt < 3; ++vt) Cacc[kk][vt] = (f32x4){0.f, 0.f, 0.f, 0.f};
        float mstate = 0.f;
        u32x4 pfq[5], pfv, pfg;
        bf16x8 kfr[8], ktf[2][2];
#define SCAN_LOAD(ci_) do { const unsigned char* ip = img0 + (size_t)(ci_) * IMG_STRIDE; \
            _Pragma("unroll") for (int k = 0; k < 5; ++k) { const int id = tid + 512 * k; if (id < 2176) pfq[k] = *(const u32x4*)(ip + (size_t)id * 16); } \
            if (tid < 320) pfv = *(const u32x4*)(ip + IMG_VT + vs * 5120 + tid * 16); \
            if (tid < 48) pfg = *(const u32x4*)(ip + IMG_G + tid * 16); } while (0)
#define SCAN_LOAD_K(ci_) do { if (wave >= 4) { const bf16_t* kp = (const bf16_t*)(img0 + (size_t)(ci_) * IMG_STRIDE + IMG_K) + (16 * (wave - 4) + cl) * 256 + 8 * q4; \
            _Pragma("unroll") for (int ks = 0; ks < 8; ++ks) kfr[ks] = *(const bf16x8*)(kp + 32 * ks); } } while (0)
#define SCAN_LOAD_KT(ci_) do { const bf16_t* kp = (const bf16_t*)(img0 + (size_t)(ci_) * IMG_STRIDE + IMG_KT) + (32 * wave + cl) * 64 + 8 * q4; \
            _Pragma("unroll") for (int kk = 0; kk < 2; ++kk) _Pragma("unroll") for (int ks = 0; ks < 2; ++ks) ktf[kk][ks] = *(const bf16x8*)(kp + kk * 1024 + 32 * ks); } while (0)
        SCAN_LOAD(0); SCAN_LOAD_K(0); SCAN_LOAD_KT(0);
        for (int ci = 0; ci < 64; ++ci) {
            const size_t rb = (size_t)b * SEQ + ci * 64;
#pragma unroll
            for (int k = 0; k < 5; ++k) { const int id = tid + 512 * k; if (id < 2176) *(LAS u32x4*)(lds + id * 16) = pfq[k]; }
            if (tid < 320) *(LAS u32x4*)((LAS unsigned char*)VTs + tid * 16) = pfv;
            if (tid < 48) *(LAS u32x4*)((LAS unsigned char*)fg + tid * 16) = pfg;
            if (ci + 1 < 64) SCAN_LOAD(ci + 1);
            LDS_BARRIER();
            const float pm63 = fg[128 + 63], bc63 = fg[63];
            const float M63 = fmaxf(mstate, pm63), aprev = ex2((mstate - M63) * 1.4426950408889634f);
            f32x4 hacc[3];
            if (wave < 4) {
                const int ti = wave;
#pragma unroll
                for (int vt = 0; vt < 3; ++vt) hacc[vt] = (f32x4){0.f, 0.f, 0.f, 0.f};
#pragma unroll
                for (int ks = 0; ks < 8; ++ks) { const bf16x8 a = *(const LAS bf16x8*)(Qs + (16 * ti + cl) * QS + 32 * ks + 8 * q4);
                    const bf16x8 b0 = *(const LAS bf16x8*)(Cbs + cl * QS + 32 * ks + 8 * q4), b1 = *(const LAS bf16x8*)(Cbs + (16 + cl) * QS + 32 * ks + 8 * q4), b2 = *(const LAS bf16x8*)(Cbs + r2 * QS + 32 * ks + 8 * q4);
                    hacc[0] = __builtin_amdgcn_mfma_f32_16x16x32_bf16(a, b0, hacc[0], 0, 0, 0); hacc[1] = __builtin_amdgcn_mfma_f32_16x16x32_bf16(a, b1, hacc[1], 0, 0, 0); hacc[2] = __builtin_amdgcn_mfma_f32_16x16x32_bf16(a, b2, hacc[2], 0, 0, 0); }
#pragma unroll
                for (int j = 0; j < 4; ++j) { const float wint = ex2((mstate - fmaxf(mstate, fg[128 + 16 * ti + 4 * q4 + j])) * 1.4426950408889634f); hacc[0][j] *= wint; hacc[1][j] *= wint; hacc[2][j] *= wint; }
            } else {
                const int si = wave - 4; f32x4 us4;
#pragma unroll
                for (int j = 0; j < 4; ++j) us4[j] = fg[64 + 16 * si + 4 * q4 + j];
#pragma unroll
                for (int ti = 0; ti < 4; ++ti) { u32x2 w = (u32x2){0u, 0u};
                    if (ti >= si) { f32x4 sacc = (f32x4){0.f, 0.f, 0.f, 0.f};
#pragma unroll
                        for (int ks = 0; ks < 8; ++ks) { const bf16x8 qb = *(const LAS bf16x8*)(Qs + (16 * ti + cl) * QS + 32 * ks + 8 * q4); sacc = __builtin_amdgcn_mfma_f32_16x16x32_bf16(kfr[ks], qb, sacc, 0, 0, 0); }
                        const int t = 16 * ti + cl; const float Mt = fmaxf(mstate, fg[128 + t]); float p[4];
#pragma unroll
                        for (int j = 0; j < 4; ++j) { const int s_ = 16 * si + 4 * q4 + j; p[j] = (s_ <= t) ? sacc[j] * ex2((us4[j] - Mt) * 1.4426950408889634f) : 0.f; }
                        w.x = pg8::cvt_pk_bf16(p[0], p[1]); w.y = pg8::cvt_pk_bf16(p[2], p[3]); }
                    *(LAS u32x2*)(Sws + (16 * ti + cl) * TS + 16 * si + 4 * q4) = w; }
                if (ci + 1 < 64) SCAN_LOAD_K(ci + 1);
            }
            if (tid < 264) { const int v = tid >> 3, s8 = (tid & 7) * 8; const u32x4 raw = *(const LAS u32x4*)(VTs + v * TS + s8); float a[8];
#pragma unroll
                for (int i = 0; i < 8; ++i) a[i] = ex2((fg[64 + s8 + i] - M63) * 1.4426950408889634f);
                u32x4 w; w.x = pg8::cvt_pk_bf16(bflo(raw.x) * a[0], bfhi(raw.x) * a[1]); w.y = pg8::cvt_pk_bf16(bflo(raw.y) * a[2], bfhi(raw.y) * a[3]); w.z = pg8::cvt_pk_bf16(bflo(raw.z) * a[4], bfhi(raw.z) * a[5]); w.w = pg8::cvt_pk_bf16(bflo(raw.w) * a[6], bfhi(raw.w) * a[7]);
                *(LAS u32x4*)(VaTs + v * TS + s8) = w; }
            LDS_BARRIER();
            if (wave < 4) {
                const int ti = wave;
#pragma unroll
                for (int ks = 0; ks < 2; ++ks) { const bf16x8 a = *(const LAS bf16x8*)(Sws + (16 * ti + cl) * TS + 32 * ks + 8 * q4);
                    const bf16x8 b0 = *(const LAS bf16x8*)(VTs + cl * TS + 32 * ks + 8 * q4), b1 = *(const LAS bf16x8*)(VTs + (16 + cl) * TS + 32 * ks + 8 * q4), b2 = *(const LAS bf16x8*)(VTs + r2 * TS + 32 * ks + 8 * q4);
                    hacc[0] = __builtin_amdgcn_mfma_f32_16x16x32_bf16(a, b0, hacc[0], 0, 0, 0); hacc[1] = __builtin_amdgcn_mfma_f32_16x16x32_bf16(a, b1, hacc[1], 0, 0, 0); hacc[2] = __builtin_amdgcn_mfma_f32_16x16x32_bf16(a, b2, hacc[2], 0, 0, 0); }
#pragma unroll
                for (int j = 0; j < 4; ++j) { const int t = 16 * ti + 4 * q4 + j; float* hp = HS + (rb + t) * 1024 + h * 256 + vs * 32 + cl; hp[0] = hacc[0][j]; hp[16] = hacc[1][j];
                    if (vs == 0 && cl == 0) { const float Mtt = fmaxf(mstate, fg[128 + t]); DN[(rb + t) * 4 + h] = fmaxf(fabsf(hacc[2][j]), ex2(-(fg[t] + Mtt) * 1.4426950408889634f)); } }
            }
#pragma unroll
            for (int kk = 0; kk < 2; ++kk)
#pragma unroll
                for (int vt = 0; vt < 3; ++vt) Cacc[kk][vt] = Cacc[kk][vt] * aprev;
#pragma unroll
            for (int ks = 0; ks < 2; ++ks) { const bf16x8 b0 = *(const LAS bf16x8*)(VaTs + cl * TS + 32 * ks + 8 * q4), b1 = *(const LAS bf16x8*)(VaTs + (16 + cl) * TS + 32 * ks + 8 * q4), b2 = *(const LAS bf16x8*)(VaTs + r2 * TS + 32 * ks + 8 * q4);
#pragma unroll
                for (int kk = 0; kk < 2; ++kk) { Cacc[kk][0] = __builtin_amdgcn_mfma_f32_16x16x32_bf16(ktf[kk][ks], b0, Cacc[kk][0], 0, 0, 0); Cacc[kk][1] = __builtin_amdgcn_mfma_f32_16x16x32_bf16(ktf[kk][ks], b1, Cacc[kk][1], 0, 0, 0);
                    Cacc[kk][2] = __builtin_amdgcn_mfma_f32_16x16x32_bf16(ktf[kk][ks], b2, Cacc[kk][2], 0, 0, 0); } }
#pragma unroll
            for (int kk = 0; kk < 2; ++kk)
#pragma unroll
                for (int vt = 0; vt < 3; ++vt) { if (vt < 2 || cl == 0) { u32x2 w; w.x = pg8::cvt_pk_bf16(Cacc[kk][vt][0], Cacc[kk][vt][1]); w.y = pg8::cvt_pk_bf16(Cacc[kk][vt][2], Cacc[kk][vt][3]);
                        *(LAS u32x2*)(Cbs + (16 * vt + cl) * QS + 32 * wave + 16 * kk + 4 * q4) = w; } }
            if (ci + 1 < 64) SCAN_LOAD_KT(ci + 1);
            mstate = bc63 + M63;
            LDS_BARRIER();
        }
#undef SCAN_LOAD
#undef SCAN_LOAD_K
#undef SCAN_LOAD_KT
    }
}

template <int MODE, bool EDGE>
__device__ __forceinline__ void attn_tile2(const LAS bf16_t* Kt, const LAS bf16_t* VTt, LAS bf16_t* Pw, const bf16x8 (&qa)[2], const f32x4 bv0, int jb, int t0, int th, float slope2,
                                           u64 tsel, f32x4 (&O)[4], float& mrow, float& lrow, int lane) {
    const int cl = lane & 15, q4 = lane >> 4; constexpr int TS = 72;
    f32x4 s[4];
#pragma unroll
    for (int nt = 0; nt < 4; ++nt) { s[nt] = bv0;
#pragma unroll
        for (int ks = 0; ks < 2; ++ks) { const bf16x8 kb = *(const LAS bf16x8*)(Kt + (16 * nt + cl) * TS + 32 * ks + 8 * q4); s[nt] = __builtin_amdgcn_mfma_f32_16x16x32_bf16(kb, qa[ks], s[nt], 0, 0, 0); } }
    const float b0 = slope2 * (float)(64 * jb - (t0 + 31)), o16 = slope2 * 16.f;
    bool rowok = true; if (MODE == 0) rowok = ((tsel >> (16 * th + cl)) & 1ull) != 0ull;
    if (EDGE) { const int dbase = t0 + 16 * th + cl - (64 * jb + 4 * q4);
#pragma unroll
        for (int nt = 0; nt < 4; ++nt)
#pragma unroll
            for (int j = 0; j < 4; ++j) { const int dist = dbase - (16 * nt + j); const bool ok = dist >= 0 && (MODE == 0 || dist < 512); s[nt][j] = ok ? s[nt][j] : -INFINITY; } }
    float mx = fmaxf(fmaxf(s[0][0], s[0][1]), fmaxf(s[0][2], s[0][3]));
#pragma unroll
    for (int n = 1; n < 4; ++n) mx = fmaxf(mx, fmaxf(fmaxf(s[n][0], s[n][1]), fmaxf(s[n][2], s[n][3])) + (float)n * o16);
    mx = rowok ? mx + b0 : -INFINITY;
    mx = fmaxf(mx, __shfl_xor(mx, 16)); mx = fmaxf(mx, __shfl_xor(mx, 32));
    const float mold = mrow, mnew = fmaxf(mold, mx), msafe = (mnew == -INFINITY) ? 0.f : mnew;
    const float alpha = (mold == -INFINITY) ? 0.f : ex2(mold - msafe);
    const float ref = rowok ? (msafe - b0) : INFINITY;
    float rs = 0.f;
#pragma unroll
    for (int nt = 0; nt < 4; ++nt) { float p[4]; const float refn = ref - (float)nt * o16;
#pragma unroll
        for (int j = 0; j < 4; ++j) { p[j] = ex2(s[nt][j] - refn); rs += p[j]; }
        u32x2 w; w.x = pg8::cvt_pk_bf16(p[0], p[1]); w.y = pg8::cvt_pk_bf16(p[2], p[3]);
        *(LAS u32x2*)(Pw + cl * TS + 16 * nt + 4 * q4) = w; }
    rs += __shfl_xor(rs, 16); rs += __shfl_xor(rs, 32);
    lrow = lrow * alpha + rs; mrow = mnew;
#pragma unroll
    for (int dt = 0; dt < 4; ++dt) O[dt] = O[dt] * alpha;
    LDS_WAIT();
#pragma unroll
    for (int ks = 0; ks < 2; ++ks) { const bf16x8 pa = *(const LAS bf16x8*)(Pw + cl * TS + 32 * ks + 8 * q4);
#pragma unroll
        for (int dt = 0; dt < 4; ++dt) { const bf16x8 vb = *(const LAS bf16x8*)(VTt + (16 * dt + cl) * TS + 32 * ks + 8 * q4); O[dt] = __builtin_amdgcn_mfma_f32_16x16x32_bf16(vb, pa, O[dt], 0, 0, 0); } }
}

template <int MODE>
__device__ __forceinline__ void attn_pair(const LAS bf16_t* KtA, const LAS bf16_t* KtB, LAS bf16_t* Pw, const bf16x8 (&qa)[2], const f32x4 bv0, int jA, int jB, int t0, int th, float slope2,
                                          u64 tselA, u64 tselB, f32x4 (&O)[4], float& mrow, float& lrow, int lane) {
    const int cl = lane & 15, q4 = lane >> 4; constexpr int TS = 72, PP = 136;
    f32x4 s[8];
#pragma unroll
    for (int nt = 0; nt < 8; ++nt) { const LAS bf16_t* Kt = (nt < 4) ? KtA : KtB; s[nt] = bv0;
#pragma unroll
        for (int ks = 0; ks < 2; ++ks) { const bf16x8 kb = *(const LAS bf16x8*)(Kt + (16 * (nt & 3) + cl) * TS + 32 * ks + 8 * q4); s[nt] = __builtin_amdgcn_mfma_f32_16x16x32_bf16(kb, qa[ks], s[nt], 0, 0, 0); } }
    const float o16 = slope2 * 16.f, bA = slope2 * (float)(64 * jA - (t0 + 31)), bB = slope2 * (float)(64 * jB - (t0 + 31));
    bool okA = true, okB = true; if (MODE == 0) { okA = ((tselA >> (16 * th + cl)) & 1ull) != 0ull; okB = ((tselB >> (16 * th + cl)) & 1ull) != 0ull; }
    float mA = fmaxf(fmaxf(s[0][0], s[0][1]), fmaxf(s[0][2], s[0][3])), mB = fmaxf(fmaxf(s[4][0], s[4][1]), fmaxf(s[4][2], s[4][3]));
#pragma unroll
    for (int n = 1; n < 4; ++n) { mA = fmaxf(mA, fmaxf(fmaxf(s[n][0], s[n][1]), fmaxf(s[n][2], s[n][3])) + (float)n * o16); mB = fmaxf(mB, fmaxf(fmaxf(s[4 + n][0], s[4 + n][1]), fmaxf(s[4 + n][2], s[4 + n][3])) + (float)n * o16); }
    float mx = fmaxf(okA ? mA + bA : -INFINITY, okB ? mB + bB : -INFINITY);
    mx = fmaxf(mx, __shfl_xor(mx, 16)); mx = fmaxf(mx, __shfl_xor(mx, 32));
    const float mold = mrow, mnew = fmaxf(mold, mx), msafe = (mnew == -INFINITY) ? 0.f : mnew;
    const float alpha = (mold == -INFINITY) ? 0.f : ex2(mold - msafe);
    const float refA = okA ? (msafe - bA) : INFINITY, refB = okB ? (msafe - bB) : INFINITY;
    float rs = 0.f;
#pragma unroll
    for (int nt = 0; nt < 8; ++nt) { float p[4]; const float refn = ((nt < 4) ? refA : refB) - (float)(nt & 3) * o16;
#pragma unroll
        for (int j = 0; j < 4; ++j) { p[j] = ex2(s[nt][j] - refn); rs += p[j]; }
        u32x2 w; w.x = pg8::cvt_pk_bf16(p[0], p[1]); w.y = pg8::cvt_pk_bf16(p[2], p[3]);
        *(LAS u32x2*)(Pw + cl * PP + 16 * nt + 4 * q4) = w; }
    rs += __shfl_xor(rs, 16); rs += __shfl_xor(rs, 32);
    lrow = lrow * alpha + rs; mrow = mnew;
#pragma unroll
    for (int dt = 0; dt < 4; ++dt) O[dt] = O[dt] * alpha;
    LDS_WAIT();
#pragma unroll
    for (int ks = 0; ks < 4; ++ks) { const bf16x8 pa = *(const LAS bf16x8*)(Pw + cl * PP + 32 * ks + 8 * q4); const LAS bf16_t* VTt = ((ks < 2) ? KtA : KtB) + 4608;
#pragma unroll
        for (int dt = 0; dt < 4; ++dt) { const bf16x8 vb = *(const LAS bf16x8*)(VTt + (16 * dt + cl) * TS + 32 * (ks & 1) + 8 * q4); O[dt] = __builtin_amdgcn_mfma_f32_16x16x32_bf16(vb, pa, O[dt], 0, 0, 0); } }
    LDS_WAIT();
}

template <int MODE>
__device__ __forceinline__ void attn_pair_fast(const LAS bf16_t* KtA, const LAS bf16_t* KtB, LAS bf16_t* Pw, const bf16x8 (&qa)[2], const f32x4 bv0, int jA, int jB, int t0, int th, float slope2,
                                               u64 tselA, u64 tselB, f32x4 (&O)[4], float mrow, float& lrow, int lane) {
    const int cl = lane & 15, q4 = lane >> 4; constexpr int TS = 72, PP = 136;
    f32x4 s[8];
#pragma unroll
    for (int nt = 0; nt < 8; ++nt) { const LAS bf16_t* Kt = (nt < 4) ? KtA : KtB; s[nt] = bv0;
#pragma unroll
        for (int ks = 0; ks < 2; ++ks) { const bf16x8 kb = *(const LAS bf16x8*)(Kt + (16 * (nt & 3) + cl) * TS + 32 * ks + 8 * q4); s[nt] = __builtin_amdgcn_mfma_f32_16x16x32_bf16(kb, qa[ks], s[nt], 0, 0, 0); } }
    const float o16 = slope2 * 16.f, bA = slope2 * (float)(64 * jA - (t0 + 31)), bB = slope2 * (float)(64 * jB - (t0 + 31));
    bool okA = true, okB = true; if (MODE == 0) { okA = ((tselA >> (16 * th + cl)) & 1ull) != 0ull; okB = ((tselB >> (16 * th + cl)) & 1ull) != 0ull; }
    const float refA = okA ? (mrow - bA) : INFINITY, refB = okB ? (mrow - bB) : INFINITY;
    float rs = 0.f;
#pragma unroll
    for (int nt = 0; nt < 8; ++nt) { float p[4]; const float refn = ((nt < 4) ? refA : refB) - (float)(nt & 3) * o16;
#pragma unroll
        for (int j = 0; j < 4; ++j) { p[j] = ex2(s[nt][j] - refn); rs += p[j]; }
        u32x2 w; w.x = pg8::cvt_pk_bf16(p[0], p[1]); w.y = pg8::cvt_pk_bf16(p[2], p[3]);
        *(LAS u32x2*)(Pw + cl * PP + 16 * nt + 4 * q4) = w; }
    rs += __shfl_xor(rs, 16); rs += __shfl_xor(rs, 32);
    lrow += rs;
    LDS_WAIT();
#pragma unroll
    for (int ks = 0; ks < 4; ++ks) { const bf16x8 pa = *(const LAS bf16x8*)(Pw + cl * PP + 32 * ks + 8 * q4); const LAS bf16_t* VTt = ((ks < 2) ? KtA : KtB) + 4608;
#pragma unroll
        for (int dt = 0; dt < 4; ++dt) { const bf16x8 vb = *(const LAS bf16x8*)(VTt + (16 * dt + cl) * TS + 32 * (ks & 1) + 8 * q4); O[dt] = __builtin_amdgcn_mfma_f32_16x16x32_bf16(vb, pa, O[dt], 0, 0, 0); } }
    LDS_WAIT();
}

template <int MODE>
__device__ __forceinline__ void attn_branch(LAS unsigned char* lds, LAS bf16_t* Pw, const bf16_t* KV, const bf16_t* VT2, const float* GATEB, const bf16x8 (&qa)[2], f32x4 (&outacc)[4],
                                            u64 uni, u64 tselv, int b, int bg, int h, int t0, int th, float slope2) {
    const int tid = threadIdx.x, lane = tid & 63; constexpr int TS = 72;
    const size_t PLANE = (size_t)8 * 4 * 4096 * 64;
    f32x4 O[4]; float mrow = -INFINITY, lrow = 0.f;
#pragma unroll
    for (int j = 0; j < 4; ++j) O[j] = (f32x4){0.f, 0.f, 0.f, 0.f};
    const float k0f = (float)(4 * (lane >> 4)); const f32x4 bv0 = (f32x4){slope2 * k0f, slope2 * (k0f + 1.f), slope2 * (k0f + 2.f), slope2 * (k0f + 3.f)};
    const int jhi = (t0 + 31) >> 6; int jlo = 0; if (MODE == 1) { jlo = t0 - 511; jlo = jlo < 0 ? 0 : (jlo >> 6); }
    u64 rem = (MODE == 0) ? uni : ((jhi >= 63 ? ~0ull : ((1ull << (jhi + 1)) - 1ull)) & ~((1ull << jlo) - 1ull));
    const bf16_t* Ksrc = KV + (size_t)(MODE == 0 ? 2 : 4) * PLANE + (size_t)bg * 4096 * 64;
    const bf16_t* Vsrc = VT2 + ((size_t)MODE * 32 + bg) * 4096 * 64;
    const size_t toff = (size_t)tid * 8;
    const int loff = (tid >> 3) * TS + 8 * (tid & 7);
    u32x4 pkA, pvA, pkB, pvB;
    int a0 = -1, b0_ = -1, a1 = -1, b1 = -1;
#define ATT_TAKE(x) do { if (rem) { x = 63 - __builtin_clzll(rem); rem &= ~(1ull << x); } else x = -1; } while (0)
#define ATT_LOAD(ja, jb_) do { if ((ja) >= 0) { pkA = *(const u32x4*)(Ksrc + (size_t)(ja) * 4096 + toff); pvA = *(const u32x4*)(Vsrc + (size_t)(ja) * 4096 + toff); } \
                               if ((jb_) >= 0) { pkB = *(const u32x4*)(Ksrc + (size_t)(jb_) * 4096 + toff); pvB = *(const u32x4*)(Vsrc + (size_t)(jb_) * 4096 + toff); } } while (0)
#define ATT_PUT(setp, ja, jb_) do { if ((ja) >= 0) { *(LAS u32x4*)((setp) + loff) = pkA; *(LAS u32x4*)((setp) + 4608 + loff) = pvA; } \
                                    if ((jb_) >= 0) { *(LAS u32x4*)((setp) + 9216 + loff) = pkB; *(LAS u32x4*)((setp) + 13824 + loff) = pvB; } } while (0)
    ATT_TAKE(a0); ATT_TAKE(b0_);
    ATT_LOAD(a0, b0_);
    { LAS bf16_t* set0 = (LAS bf16_t*)lds; ATT_PUT(set0, a0, b0_); }
    ATT_TAKE(a1); ATT_TAKE(b1);
    ATT_LOAD(a1, b1);
    LDS_BARRIER();
    int buf = 0;
#pragma unroll 1
    while (a0 >= 0) {
        LAS bf16_t* cur = (LAS bf16_t*)(lds + (buf ? 104448 : 0)); LAS bf16_t* nxt = (LAS bf16_t*)(lds + (buf ? 0 : 104448));
        int a2 = -1, b2 = -1;
        if (a1 >= 0) { ATT_PUT(nxt, a1, b1); ATT_TAKE(a2); ATT_TAKE(b2); ATT_LOAD(a2, b2); }
        u64 tsA = ~0ull, tsB = ~0ull;
        if (MODE == 0) { tsA = ((u64)(unsigned)__builtin_amdgcn_readlane((int)(tselv >> 32), a0) << 32) | (unsigned)__builtin_amdgcn_readlane((int)(unsigned)tselv, a0);
            if (b0_ >= 0) tsB = ((u64)(unsigned)__builtin_amdgcn_readlane((int)(tselv >> 32), b0_) << 32) | (unsigned)__builtin_amdgcn_readlane((int)(unsigned)tselv, b0_); }
        const bool useA = ((tsA >> (16 * th)) & 0xFFFFull) != 0ull, useB = b0_ >= 0 && ((tsB >> (16 * th)) & 0xFFFFull) != 0ull;
        const bool edgeA = (64 * a0 + 63 > t0) || (MODE == 1 && (t0 + 31 - 64 * a0 >= 512));
        const bool edgeB = b0_ >= 0 && ((64 * b0_ + 63 > t0) || (MODE == 1 && (t0 + 31 - 64 * b0_ >= 512)));
        if (useA && useB && !edgeA && !edgeB) {
            const bool rA = MODE == 1 || ((tsA >> (16 * th + (lane & 15))) & 1ull), rB = MODE == 1 || ((tsB >> (16 * th + (lane & 15))) & 1ull);
            if (__any((rA || rB) && mrow == -INFINITY)) attn_pair<MODE>(cur, cur + 9216, Pw, qa, bv0, a0, b0_, t0, th, slope2, tsA, tsB, O, mrow, lrow, lane);
            else attn_pair_fast<MODE>(cur, cur + 9216, Pw, qa, bv0, a0, b0_, t0, th, slope2, tsA, tsB, O, mrow, lrow, lane); }
        else {
            if (useA) { if (edgeA) attn_tile2<MODE, true>(cur, cur + 4608, Pw, qa, bv0, a0, t0, th, slope2, tsA, O, mrow, lrow, lane); else attn_tile2<MODE, false>(cur, cur + 4608, Pw, qa, bv0, a0, t0, th, slope2, tsA, O, mrow, lrow, lane); LDS_WAIT(); }
            if (useB) { if (edgeB) attn_tile2<MODE, true>(cur + 9216, cur + 13824, Pw, qa, bv0, b0_, t0, th, slope2, tsB, O, mrow, lrow, lane); else attn_tile2<MODE, false>(cur + 9216, cur + 13824, Pw, qa, bv0, b0_, t0, th, slope2, tsB, O, mrow, lrow, lane); }
        }
        LDS_BARRIER();
        a0 = a1; b0_ = b1; a1 = a2; b1 = b2; buf ^= 1;
    }
#undef ATT_TAKE
#undef ATT_LOAD
#undef ATT_PUT
    { const float gt = GATEB[((size_t)b * SEQ + t0 + 16 * th + (lane & 15)) * 48 + h * 3 + 1 + MODE];
      const float gsc = gt / (lrow > 0.f ? lrow : 1.0f);
#pragma unroll
      for (int dt = 0; dt < 4; ++dt) outacc[dt] = outacc[dt] + O[dt] * gsc; }
}

__device__ __forceinline__ void attn_phase(LAS unsigned char* lds, const bf16_t* KV, const bf16_t* VT2, const bf16_t* QB, const float* GATEB, const bf16_t* KC, const bf16_t* VCT, bf16_t* OB, int wgc, int G) {
    const int tid = threadIdx.x, wave = __builtin_amdgcn_readfirstlane(tid >> 6), lane = tid & 63, cl = lane & 15, q4 = lane >> 4;
    constexpr int TS = 72, PS = 264;
    LAS bf16_t* BUF0 = (LAS bf16_t*)(lds + 0);
    LAS bf16_t* Pw = (LAS bf16_t*)(lds + 36864 + wave * 8448);
    LAS float* IMP = (LAS float*)(lds + 104448);
    LAS u64* SEL = (LAS u64*)(lds + 137216);
    const float LOG2E = 1.4426950408889634f;
    for (int i = 0;; ++i) {
        const int L = i * G + wgc; if (L >= 4096) break;
        const int bg = L >> 7; int qt = L & 127; if ((bg >> 1) & 1) qt = 127 - qt;
        const int b = bg >> 2, g = bg & 3, t0 = qt * 32;
        const int r = wave >> 1, th = wave & 1, h = 4 * g + r;
        const float slope2 = exp2f(-0.5f * (float)(h + 1)) * LOG2E;
        bf16x8 qa[2];
        { const bf16_t* qp = QB + ((size_t)b * SEQ + t0 + 16 * th + cl) * 1024 + h * 64 + 8 * q4; qa[0] = *(const bf16x8*)qp; qa[1] = *(const bf16x8*)(qp + 32); }
        f32x4 outacc[4];
#pragma unroll
        for (int k = 0; k < 4; ++k) { const int id = tid + 512 * k, row = id >> 3, cc = id & 7; *(LAS u32x4*)(BUF0 + row * TS + 8 * cc) = *(const u32x4*)(KC + ((size_t)bg * 256 + row) * 64 + 8 * cc); }
        __syncthreads();
        u32x4 vct_pf[4];
#pragma unroll
        for (int k = 0; k < 4; ++k) { const int id = tid + 512 * k, d = id >> 5, cc = id & 31; vct_pf[k] = *(const u32x4*)(VCT + ((size_t)bg * 64 + d) * 256 + 8 * cc); }
        {
            LAS float* impw = IMP + wave * 1024;
            const int t = t0 + 16 * th + cl;
            f32x4 s[16]; float cm = -INFINITY;
#pragma unroll
            for (int nt = 0; nt < 16; ++nt) { s[nt] = (f32x4){0.f, 0.f, 0.f, 0.f};
#pragma unroll
                for (int ks = 0; ks < 2; ++ks) { const bf16x8 kb = *(const LAS bf16x8*)(BUF0 + (16 * nt + cl) * TS + 32 * ks + 8 * q4); s[nt] = __builtin_amdgcn_mfma_f32_16x16x32_bf16(kb, qa[ks], s[nt], 0, 0, 0); }
#pragma unroll
                for (int j = 0; j < 4; ++j) { const int c = 16 * nt + 4 * q4 + j; const int dist = t - (16 * c + 31); const bool ok = (c < 255) && dist >= 0;
                    const float v = ok ? (s[nt][j] - slope2 * (float)dist) : -INFINITY; s[nt][j] = v; cm = fmaxf(cm, v); } }
            cm = fmaxf(cm, __shfl_xor(cm, 16)); cm = fmaxf(cm, __shfl_xor(cm, 32));
            cm = (cm == -INFINITY) ? 0.f : cm;
            float cs = 0.f;
#pragma unroll
            for (int nt = 0; nt < 16; ++nt)
#pragma unroll
                for (int j = 0; j < 4; ++j) { const float e = ex2(s[nt][j] - cm); s[nt][j] = e; cs += e; }
            cs += __shfl_xor(cs, 16); cs += __shfl_xor(cs, 32);
            const float cinv = 1.0f / (cs > 0.f ? cs : 1.0f);
            float plast3 = 0.f;
#pragma unroll
            for (int nt = 0; nt < 16; ++nt) { float p[4];
#pragma unroll
                for (int j = 0; j < 4; ++j) p[j] = s[nt][j] * cinv;
                u32x2 w; w.x = pg8::cvt_pk_bf16(p[0], p[1]); w.y = pg8::cvt_pk_bf16(p[2], p[3]);
                *(LAS u32x2*)(Pw + cl * PS + 16 * nt + 4 * q4) = w;
                const float up = __shfl(p[3], (lane + 48) & 63);
                const float prevtile = __shfl(plast3, cl + 48);
                const float pm1 = (q4 == 0) ? prevtile : up;
                impw[cl * 64 + 4 * nt + q4] = ((p[0] + p[1]) + (p[2] + p[3])) + pm1;
                plast3 = p[3]; }
        }
        __syncthreads();
#pragma unroll
        for (int k = 0; k < 4; ++k) { const int id = tid + 512 * k, d = id >> 5, cc = id & 31; *(LAS u32x4*)(BUF0 + d * PS + 8 * cc) = vct_pf[k]; }
#pragma unroll 1
        for (int e = 0; e < 4; ++e) { const int tk = 4 * wave + e, tt = t0 + tk, cur = tt >> 6;
            float v = 0.f;
#pragma unroll
            for (int rr = 0; rr < 4; ++rr) v += IMP[((2 * rr + (tk >> 4)) * 16 + (tk & 15)) * 64 + lane];
            const bool forced = (lane == 0) || (lane == cur) || (lane == cur - 1);
            v = fmaxf(v, 0.f); if (forced) v = 1e4f;
            const bool valid = lane <= cur;
            const u64 key = valid ? (((u64)__builtin_bit_cast(unsigned, v) << 6) | (u64)(63 - lane)) + 1ull : 0ull;
            u64 msk;
            if (cur < 16) msk = __ballot(valid);
            else { u64 pre = 0ull;
#pragma unroll 1
                for (int bit = 38; bit >= 0; --bit) { const u64 cand = pre | (1ull << bit); const int cnt = __popcll(__ballot(key >= cand)); if (cnt >= 16) { pre = cand; if (cnt == 16) break; } }
                msk = __ballot(key >= pre); }
            if (lane == 0) SEL[tk] = msk; }
        __syncthreads();
        {
            f32x4 oc[4];
#pragma unroll
            for (int dt = 0; dt < 4; ++dt) oc[dt] = (f32x4){0.f, 0.f, 0.f, 0.f};
#pragma unroll
            for (int ks = 0; ks < 8; ++ks) { const bf16x8 pa = *(const LAS bf16x8*)(Pw + cl * PS + 32 * ks + 8 * q4);
#pragma unroll
                for (int dt = 0; dt < 4; ++dt) { const bf16x8 vb = *(const LAS bf16x8*)(BUF0 + (16 * dt + cl) * PS + 32 * ks + 8 * q4); oc[dt] = __builtin_amdgcn_mfma_f32_16x16x32_bf16(vb, pa, oc[dt], 0, 0, 0); } }
            const float gc = GATEB[((size_t)b * SEQ + t0 + 16 * th + cl) * 48 + h * 3];
#pragma unroll
            for (int dt = 0; dt < 4; ++dt) outacc[dt] = oc[dt] * gc;
        }
        u64 tselv = 0ull;
#pragma unroll 8
        for (int tk = 0; tk < 32; ++tk) { const u64 sv = SEL[tk]; tselv |= ((sv >> lane) & 1ull) << tk; }
        const u64 uni = __ballot(tselv != 0ull);
        __syncthreads();
        attn_branch<0>(lds, Pw, KV, VT2, GATEB, qa, outacc, uni, tselv, b, bg, h, t0, th, slope2);
        attn_branch<1>(lds, Pw, KV, VT2, GATEB, qa, outacc, uni, tselv, b, bg, h, t0, th, slope2);
        { bf16_t* op = OB + ((size_t)b * SEQ + t0 + 16 * th + cl) * 1024 + h * 64 + 4 * q4;
#pragma unroll
          for (int dt = 0; dt < 4; ++dt) { u32x2 w; w.x = pg8::cvt_pk_bf16(outacc[dt][0], outacc[dt][1]); w.y = pg8::cvt_pk_bf16(outacc[dt][2], outacc[dt][3]); *(u32x2*)(op + 16 * dt) = w; } }
    }
}

constexpr int NPHASE = 20;
__global__ void __launch_bounds__(NTHR, 2) yoco_fwd(Args args) {
    extern __shared__ __attribute__((aligned(16))) unsigned char lds_raw[];
    LAS unsigned char* lds = (LAS unsigned char*)lds_raw;
    volatile LAS unsigned* MISC = (volatile LAS unsigned*)(lds + MISC_OFF);
    const int tid = threadIdx.x, lane = tid & 63, wave = __builtin_amdgcn_readfirstlane(tid >> 6);
    const int G = gridDim.x, bx = blockIdx.x;
    const int vcu = (G % 8 == 0) ? (bx % 8) * (G / 8) + bx / 8 : bx;
    const int gw = vcu * NWAVES + wave, NGW = G * NWAVES;
    unsigned char* ws = args.ws;
    unsigned* ctl = (unsigned*)(ws + WS_CTL);
    if (tid < 64) MISC[tid] = 0u;
    __syncthreads();
    XcdBarrier bar; bar.bar = ctl + CW_BAR; bar.x = 0; bar.st = MISC + 60;
    if (!MK_PER_PHASE) bar = xcd_barrier_post(ctl + CW_BAR, MISC + 60);
    const int lo = args.ph_lo, hi = args.ph_hi;
#ifndef PHMASK
#define PHMASK 0xFFFFFFu
#endif
#ifndef PROBE_SKIP
#define PROBE_SKIP 0
#endif
constexpr unsigned PHSKIP = 0u;
#define IN(k) ((((PHMASK & ~PHSKIP) >> (k)) & 1u) && lo <= (k) && (k) < hi)
#ifndef P0REP
#define P0REP 0
#endif
#ifndef REPMASK
#define REPMASK 0x0u
#endif
#define PH(k) for (int _r = 0, _n = IN(k) ? ((((REPMASK) >> (k)) & 1u) ? 2 : 1) : 0; _r < _n; ++_r)
#define SEAM(k) do { if (lo <= (k) && (k) + 1 < hi) xcd_barrier(bar); } while (0)

    const float* x = A_IN(I_X);
    float* xs = args.out;
    bf16_t* XH = (bf16_t*)(ws + WS_XH);
    float* GA = (float*)(ws + WS_GA);
    float* bias1 = (float*)(ws + WS_SMALL);
    unsigned* EIDX = (unsigned*)(ws + WS_SMALL + 8192);
    float* EW = (float*)(ws + WS_SMALL + 8192 + 131072);
    u32x2* ROWINFO = (u32x2*)(ws + WS_ROWINFO);

    PH(0) {
        for (int _q = 0; _q < ((P0REP & 1) ? 2 : 1); ++_q) p0_weights(ws, lds, gw, NGW, wave, lane);
        __syncthreads();
        LAS float* Wg = (LAS float*)lds;
        for (int i = tid; i < 8192; i += NTHR) { const int k = i >> 3, e = i & 7; Wg[(e >> 2) * 4096 + ((((k >> 8) * 4 + (k & 3)) * 64 + ((k & 255) >> 2)) << 2) + (e & 3)] = A_IN(I_A_W_IN)[(size_t)k * NPROJ_SRC + 4096 + e] * A_IN(I_NORM_MIX)[k]; }
        __syncthreads();
        for (int _q = 0; _q < ((P0REP & 2) ? 2 : 1); ++_q) {
        f32x4 vn[4]; if (gw < M) load_row(x + (size_t)gw * D, lane, vn);
        for (int m = gw; m < M; m += NGW) {
            f32x4 v[4];
#pragma unroll
            for (int j = 0; j < 4; ++j) v[j] = vn[j];
            load_row(x + (size_t)(m + NGW < M ? m + NGW : m) * D, lane, vn);
            const float rstd = row_rstd(v);
            store_row_bf16(XH + (size_t)m * D, lane, v, rstd);
            float gsum[8];
#pragma unroll
            for (int e = 0; e < 8; ++e) gsum[e] = 0.f;
#pragma unroll
            for (int j = 0; j < 4; ++j)
#pragma unroll
                for (int c = 0; c < 4; ++c) { const f32x4 w0 = *(const LAS f32x4*)(Wg + (((j * 4 + c) * 64 + lane) << 2)), w1 = *(const LAS f32x4*)(Wg + 4096 + (((j * 4 + c) * 64 + lane) << 2)); const float xv = v[j][c];
                    gsum[0] += xv * w0.x; gsum[1] += xv * w0.y; gsum[2] += xv * w0.z; gsum[3] += xv * w0.w; gsum[4] += xv * w1.x; gsum[5] += xv * w1.y; gsum[6] += xv * w1.z; gsum[7] += xv * w1.w; }
#pragma unroll
            for (int e = 0; e < 8; ++e) gsum[e] = wave_sum(gsum[e]) * rstd + A_IN(I_A_B_GATE)[e];
            if (lane == 0) {
#pragma unroll
                for (int e = 0; e < 4; ++e) GA[(size_t)m * 8 + e] = gsum[e];
#pragma unroll
                for (int e = 4; e < 8; ++e) { const float g = gsum[e]; GA[(size_t)m * 8 + e] = fminf(g, 0.f) - log1pf(__expf(-fabsf(g))); } }
        }
        }
        __syncthreads();
        for (int it = bx; it < 256; it += G) { const int c = it >> 7, nb = (it >> 4) & 7, fc = it & 15, n = nb * 32 + (tid & 31), fs = tid >> 5; float s = 0.f;
#pragma unroll
            for (int k = 0; k < 8; ++k) { const int f = fc * 128 + fs * 8 + k; s += A_IN(I_B_CMP_POS)[((f >> 6) * 2 + c) * 64 + (f & 63)] * A_IN(I_B_CMP_W1)[((size_t)c * 2048 + f) * 256 + n]; }
            LAS float* red = (LAS float*)lds; __syncthreads(); red[tid] = s; __syncthreads();
            if (tid < 32) { float t = 0.f; for (int k = 0; k < 16; ++k) t += red[k * 32 + tid]; ((float*)(ws + WS_SMALL + 401408))[(c * 256 + n) * 16 + fc] = t; }
            __syncthreads(); }
    }
    SEAM(0);
    PH(1) { if (bx == 0) { const float* bp = (const float*)(ws + WS_SMALL + 401408) + tid * 16; float t = 0.f; for (int k = 0; k < 16; ++k) t += bp[k]; bias1[tid] = t; }
        pg8::PlainOrder S; S.init(XH, (const bf16_t*)(ws + WS_WIN), M, NPROJ, D, D, G, bx); pg8::EpiProjSplit E{(bf16_t*)(ws + WS_PROJ3), (bf16_t*)(ws + WS_OG)};
        pg8::gemm_phase(lds, pg8::Dims{D, D, D}, S, E); }
    SEAM(1);
    PH(2) scanprep_phase(lds, (const bf16_t*)(ws + WS_PROJ3), GA, A_IN(I_A_CONV), ws + WS_IMG, vcu, G);
    SEAM(2);
    PH(3) scan_phase(lds, ws + WS_IMG, (float*)(ws + WS_HS), (float*)(ws + WS_DN), vcu, G);
    SEAM(3);
    PH(4) {
        const float* HS = (const float*)(ws + WS_HS); const float* DN = (const float*)(ws + WS_DN); const bf16_t* OG = (const bf16_t*)(ws + WS_OG); bf16_t* HN = (bf16_t*)(ws + WS_HN);
        for (int m = gw; m < M; m += NGW) { f32x4 v[4]; load_row(HS + (size_t)m * D, lane, v); const f32x4 dn = *(const f32x4*)(DN + (size_t)m * 4);
            u64* o8 = (u64*)(HN + (size_t)m * D) + lane;
#pragma unroll
            for (int j = 0; j < 4; ++j) { v[j] = v[j] * (1.0f / dn[j]); float s = (v[j].x * v[j].x + v[j].y * v[j].y) + (v[j].z * v[j].z + v[j].w * v[j].w); s = wave_sum(s);
                const float rs = 1.0f / sqrtf(s * (1.f / 256.f) + EPS);
                const u32x2 oraw = *(const u32x2*)(OG + (size_t)m * D + 4 * lane + 256 * j); const f32x4 gv = *((const f32x4*)A_IN(I_A_NORM_H) + lane + 64 * j);
                const float o0 = v[j].x * rs * gv.x * sigmoidf_(bflo(oraw.x)), o1 = v[j].y * rs * gv.y * sigmoidf_(bfhi(oraw.x)), o2 = v[j].z * rs * gv.z * sigmoidf_(bflo(oraw.y)), o3 = v[j].w * rs * gv.w * sigmoidf_(bfhi(oraw.y));
                o8[64 * j] = (u64)pk2(o0, o1) | ((u64)pk2(o2, o3) << 32); } }
    }
    SEAM(4);
    PH(5) { pg8::PlainOrder S; S.init((const bf16_t*)(ws + WS_HN), (const bf16_t*)(ws + WS_WOUTA), M, D, D, D, G, bx); pg8::EpiResF32Stat E{x, xs, XH, (float*)(ws + WS_SSP), D};
        pg8::gemm_phase(lds, pg8::Dims{D, D, D}, S, E); }
    SEAM(5);
    PH(6) { const float* sp = (const float*)(ws + WS_SSP); float* rs = (float*)(ws + WS_RS);
        for (int r = bx * NTHR + tid; r < M; r += G * NTHR) rs[r] = pg8::row_rs16(sp, r); }
    SEAM(6);
    PH(7) { pg8::PlainOrder S; S.init(XH, (const bf16_t*)(ws + WS_WGU), M, 2 * FFD, D, D, G, bx); pg8::EpiSwiGLU E{(bf16_t*)(ws + WS_ACT), FFD, (const float*)(ws + WS_RS)};
        pg8::gemm_phase(lds, pg8::Dims{D, D, D}, S, E); }
    SEAM(7);
    PH(8) { pg8::PlainOrder S; S.init((const bf16_t*)(ws + WS_ACT), (const bf16_t*)(ws + WS_WDOWN), M, D, FFD, FFD, G, bx); pg8::EpiResF32Stat E{xs, xs, XH, (float*)(ws + WS_SSP), D};
        pg8::gemm_phase(lds, pg8::Dims{FFD, FFD, FFD}, S, E); }
    SEAM(8);
    PH(9) { const float* sp = (const float*)(ws + WS_SSP); float* rs = (float*)(ws + WS_RS);
        for (int r = bx * NTHR + tid; r < M; r += G * NTHR) rs[r] = pg8::row_rs16(sp, r); }
    SEAM(9);
    PH(10) { pg8::PlainOrder S; S.init(XH, (const bf16_t*)(ws + WS_WKVQ), M, NKVQ, D, D, G, bx); pg8::EpiKVQ E{(bf16_t*)(ws + WS_KV), (bf16_t*)(ws + WS_QB), (float*)(ws + WS_GATEB), A_IN(I_B_B_GATE), (const float*)(ws + WS_RS)};
        pg8::gemm_phase(lds, pg8::Dims{D, D, D}, S, E); }
    SEAM(10);
    PH(11) {
        struct CmpOrder { int G, c; const char* A; const char* B;
            __device__ __forceinline__ bool next(int i, pg8::Unit& u) const { const int L = i * G + c; if (L >= 64) return false; u.pm = L; u.pn = 0; u.a = A + (size_t)L * 256 * 1024 * 2; u.b = B + (size_t)(L >> 5) * 256 * 2048 * 2; return true; } };
        CmpOrder S{G, bx, (const char*)(ws + WS_KV), (const char*)(ws + WS_WCMP1)}; pg8::EpiCmp E{(bf16_t*)(ws + WS_HID), bias1};
        if (bx < 64 || G <= 64) pg8::gemm_phase(lds, pg8::Dims{2048, 1024, 2048}, S, E);
        if (bx >= 64 || G <= 64) {
        { LAS bf16_t* T = (LAS bf16_t*)lds; const size_t PLANE = (size_t)8 * 4 * 4096 * 64;
          for (int it = (G <= 64) ? bx : bx - 64; it < 4096; it += (G <= 64) ? G : G - 64) { const int mode = it >> 11, rest = it & 2047;
              const bf16_t* src = (const bf16_t*)(ws + WS_KV) + (size_t)(mode == 0 ? 3 : 5) * PLANE + (size_t)rest * 4096; bf16_t* dst = (bf16_t*)(ws + WS_VT2) + ((size_t)mode * 2048 + rest) * 4096;
              const int row = tid >> 3, cc = tid & 7; const u32x4 raw = *(const u32x4*)(src + (size_t)tid * 8);
              __syncthreads();
              T[(8 * cc + 0) * 72 + row] = (bf16_t)(raw.x & 0xffff); T[(8 * cc + 1) * 72 + row] = (bf16_t)(raw.x >> 16); T[(8 * cc + 2) * 72 + row] = (bf16_t)(raw.y & 0xffff); T[(8 * cc + 3) * 72 + row] = (bf16_t)(raw.y >> 16);
              T[(8 * cc + 4) * 72 + row] = (bf16_t)(raw.z & 0xffff); T[(8 * cc + 5) * 72 + row] = (bf16_t)(raw.z >> 16); T[(8 * cc + 6) * 72 + row] = (bf16_t)(raw.w & 0xffff); T[(8 * cc + 7) * 72 + row] = (bf16_t)(raw.w >> 16);
              __syncthreads();
              *(u32x4*)(dst + (size_t)tid * 8) = *(const LAS u32x4*)(T + row * 72 + 8 * cc); } }
        } }
    SEAM(11);
    PH(12) { const bf16_t* HID = (const bf16_t*)(ws + WS_HID);
        for (int gid = bx * NTHR + tid; gid < 2 * 8192 * 8; gid += G * NTHR) { const int dg = gid & 7, row = (gid >> 3) & 8191, c = gid >> 16;
            const float* w2 = A_IN(I_B_CMP_W2) + (size_t)c * 256 * 64 + 8 * dg; const bf16_t* hp = HID + ((size_t)c * 8192 + row) * 256;
            float o[8];
#pragma unroll
            for (int k = 0; k < 8; ++k) o[k] = 0.f;
            for (int hh = 0; hh < 256; hh += 8) { const u32x4 raw = *(const u32x4*)(hp + hh); const float hv[8] = {bflo(raw.x), bfhi(raw.x), bflo(raw.y), bfhi(raw.y), bflo(raw.z), bfhi(raw.z), bflo(raw.w), bfhi(raw.w)};
#pragma unroll
                for (int k8 = 0; k8 < 8; ++k8) { const f32x4 w0 = *(const f32x4*)(w2 + (size_t)(hh + k8) * 64), w1 = *(const f32x4*)(w2 + (size_t)(hh + k8) * 64 + 4);
                    o[0] += hv[k8] * w0.x; o[1] += hv[k8] * w0.y; o[2] += hv[k8] * w0.z; o[3] += hv[k8] * w0.w; o[4] += hv[k8] * w1.x; o[5] += hv[k8] * w1.y; o[6] += hv[k8] * w1.z; o[7] += hv[k8] * w1.w; } }
            u32x4 p; p.x = pk2(o[0], o[1]); p.y = pk2(o[2], o[3]); p.z = pk2(o[4], o[5]); p.w = pk2(o[6], o[7]);
            if (c == 0) *(u32x4*)((bf16_t*)(ws + WS_KC) + (size_t)row * 64 + 8 * dg) = p;
            else { bf16_t* vct = (bf16_t*)(ws + WS_VC) + ((size_t)(row >> 8) * 64 + 8 * dg) * 256 + (row & 255);
                vct[0] = (bf16_t)(p.x & 0xffff); vct[256] = (bf16_t)(p.x >> 16); vct[512] = (bf16_t)(p.y & 0xffff); vct[768] = (bf16_t)(p.y >> 16);
                vct[1024] = (bf16_t)(p.z & 0xffff); vct[1280] = (bf16_t)(p.z >> 16); vct[1536] = (bf16_t)(p.w & 0xffff); vct[1792] = (bf16_t)(p.w >> 16); } }
    }
    SEAM(12);
    PH(13) attn_phase(lds, (const bf16_t*)(ws + WS_KV), (const bf16_t*)(ws + WS_VT2), (const bf16_t*)(ws + WS_QB), (const float*)(ws + WS_GATEB), (const bf16_t*)(ws + WS_KC), (const bf16_t*)(ws + WS_VC), (bf16_t*)(ws + WS_OB), bx, G);
    SEAM(13);
    PH(14) { pg8::PlainOrder S; S.init((const bf16_t*)(ws + WS_OB), (const bf16_t*)(ws + WS_WOUTB), M, D, D, D, G, bx); pg8::EpiResF32 E{xs, xs, D};
        pg8::gemm_phase(lds, pg8::Dims{D, D, D}, S, E); }
    SEAM(14);
    PH(15) {
        LAS float* Wr = (LAS float*)lds;
        for (int i = tid; i < 8192; i += NTHR) Wr[i] = A_IN(I_M_ROUTER)[i] * A_IN(I_NORM_FFN)[1024 + (i >> 3)];
        __syncthreads();
        for (int m = gw; m < M; m += NGW) {
            f32x4 v[4]; load_row(xs + (size_t)m * D, lane, v); const float rstd = row_rstd(v);
            store_row_bf16(XH + (size_t)m * D, lane, v, rstd);
            float gsum[8];
#pragma unroll
            for (int e = 0; e < 8; ++e) gsum[e] = 0.f;
#pragma unroll
            for (int j = 0; j < 4; ++j)
#pragma unroll
                for (int c = 0; c < 4; ++c) { const int k = 4 * lane + 256 * j + c; const f32x4 w0 = *(const LAS f32x4*)(Wr + k * 8), w1 = *(const LAS f32x4*)(Wr + k * 8 + 4); const float xv = v[j][c];
                    gsum[0] += xv * w0.x; gsum[1] += xv * w0.y; gsum[2] += xv * w0.z; gsum[3] += xv * w0.w; gsum[4] += xv * w1.x; gsum[5] += xv * w1.y; gsum[6] += xv * w1.z; gsum[7] += xv * w1.w; }
#pragma unroll
            for (int e = 0; e < 8; ++e) gsum[e] = wave_sum(gsum[e]) * rstd;
            if (lane == 0) { int e1 = 0; float v1 = gsum[0];
#pragma unroll
                for (int e = 1; e < 8; ++e) if (gsum[e] > v1) { v1 = gsum[e]; e1 = e; }
                int e2 = -1; float v2 = -INFINITY;
#pragma unroll
                for (int e = 0; e < 8; ++e) if (e != e1 && gsum[e] > v2) { v2 = gsum[e]; e2 = e; }
                const float ex = __expf(v2 - v1), w1 = 1.0f / (1.0f + ex), w2 = ex * w1;
                EIDX[m] = (unsigned)e1 | ((unsigned)e2 << 8); EW[2 * (size_t)m] = w1; EW[2 * (size_t)m + 1] = w2;
                int* cc = (int*)(ws + WS_CTL + 524288) + (m >> 7) * 8; atomicAdd(cc + e1, 1); atomicAdd(cc + e2, 1); }
        }
    }
    SEAM(15);
    volatile LAS int* tb = (volatile LAS int*)(lds + MISC_OFF);
    PH(16) {
        LAS int* cnt_all = (LAS int*)lds;
        LAS int* posl = (LAS int*)(lds + 256);
        bf16_t* XG = (bf16_t*)(ws + WS_XG);
        for (int ch = bx; ch < M / 128; ch += G) {
            __syncthreads();
            if (tid < 16) cnt_all[tid] = 0;
            __syncthreads();
            int ct[8], cb[8];
#pragma unroll
            for (int e = 0; e < 8; ++e) { ct[e] = 0; cb[e] = 0; }
            if (tid < M / 128) { const int* cc = (const int*)(ws + WS_CTL + 524288) + tid * 8; const bool before = tid < ch;
#pragma unroll
                for (int e = 0; e < 8; ++e) { const int hit = cc[e]; ct[e] = hit; cb[e] = before ? hit : 0; } }
#pragma unroll
            for (int e = 0; e < 8; ++e) { int a = ct[e], b2 = cb[e];
#pragma unroll
                for (int o = 1; o < 64; o <<= 1) { a += __shfl_xor(a, o); b2 += __shfl_xor(b2, o); }
                if (lane == 0) { atomicAdd((int*)&cnt_all[e], a); atomicAdd((int*)&cnt_all[8 + e], b2); } }
            __syncthreads();
            if (wave == 0) {
                int base[8]; int run = 0;
#pragma unroll
                for (int e = 0; e < 8; ++e) { base[e] = run * 256 + cnt_all[8 + e]; run += (cnt_all[e] + 255) >> 8; }
#pragma unroll 1
                for (int half = 0; half < 2; ++half) { const int m = ch * 128 + half * 64 + lane; const unsigned ei = EIDX[m]; const int e1 = ei & 255, e2 = (ei >> 8) & 255;
                    int p1 = 0, p2 = 0;
#pragma unroll
                    for (int e = 0; e < 8; ++e) { const u64 mk = __ballot(e1 == e || e2 == e); const int rk = __popcll(mk & ((1ull << lane) - 1ull));
                        if (e1 == e) p1 = base[e] + rk; if (e2 == e) p2 = base[e] + rk; base[e] += __popcll(mk); }
                    posl[(half * 64 + lane) * 2] = p1; posl[(half * 64 + lane) * 2 + 1] = p2;
                    ROWINFO[p1] = (u32x2){(unsigned)m << 1, __builtin_bit_cast(unsigned, EW[2 * (size_t)m])};
                    ROWINFO[p2] = (u32x2){((unsigned)m << 1) | 1u, __builtin_bit_cast(unsigned, EW[2 * (size_t)m + 1])}; }
                if (ch == 0 && lane < 8) ((int*)(ws + WS_SMALL + 4096))[lane] = cnt_all[lane];
            }
            __syncthreads();
            for (int rr = wave; rr < 256; rr += NWAVES) { const int m = ch * 128 + (rr >> 1); const int p = posl[rr];
                const u32x4 a0 = ((const u32x4*)(XH + (size_t)m * D))[2 * lane], a1 = ((const u32x4*)(XH + (size_t)m * D))[2 * lane + 1];
                u32x4 o; o.x = pk_fp8x4(bflo(a0.x) * 16.f, bfhi(a0.x) * 16.f, bflo(a0.y) * 16.f, bfhi(a0.y) * 16.f); o.y = pk_fp8x4(bflo(a0.z) * 16.f, bfhi(a0.z) * 16.f, bflo(a0.w) * 16.f, bfhi(a0.w) * 16.f);
                o.z = pk_fp8x4(bflo(a1.x) * 16.f, bfhi(a1.x) * 16.f, bflo(a1.y) * 16.f, bfhi(a1.y) * 16.f); o.w = pk_fp8x4(bflo(a1.z) * 16.f, bfhi(a1.z) * 16.f, bflo(a1.w) * 16.f, bfhi(a1.w) * 16.f);
                ((u32x4*)((unsigned char*)XG + (size_t)p * D))[lane] = o; }
        }
    }
    SEAM(16);
    if (IN(17) || IN(18)) {
        __syncthreads();
        if (tid == 0) { const int* cg = (const int*)(ws + WS_SMALL + 4096); int run = 0;
            for (int e = 0; e < 8; ++e) { const int c = cg[e]; tb[e] = run; tb[16 + e] = c; run += (c + 255) >> 8; } tb[8] = run; }
        __syncthreads();
    }
    PH(17) { MoeOrder S{2 * FE / 256, G, bx, (const char*)(ws + WS_XG), (const char*)(ws + WS_MGU), (size_t)256 * D, (size_t)2 * FE * D, (size_t)256 * D, tb};
        pg8::EpiSwiGLU8 E{ws + WS_ACTS, FE, 8.f}; pg8::gemm_phase<pg8::EpiSwiGLU8, MoeOrder, true, true, true>(lds, pg8::Dims{D / 2, D / 2, D / 2, 127 - 4, 127 - 7}, S, E); }
    SEAM(17);
    PH(18) { MoeOrder S{D / 256, G, bx, (const char*)(ws + WS_ACTS), (const char*)(ws + WS_MDOWN), (size_t)256 * FE, (size_t)D * FE, (size_t)256 * FE, tb};
        EpiMoeDown E{xs, (float*)(ws + WS_Y1), ROWINFO, EW, tb}; pg8::gemm_phase<EpiMoeDown, MoeOrder, true, true, true>(lds, pg8::Dims{FE / 2, FE / 2, FE / 2, 127 - 3, 127 - 8}, S, E); }
    SEAM(18);
    PH(19) { const float* Y1 = (const float*)(ws + WS_Y1); const unsigned bad = xb_ld(ctl + CW_BAR + XB_TMO);
        for (int m = gw; m < M; m += NGW) { f32x4 v[4], y[4]; load_row(xs + (size_t)m * D, lane, v); load_row(Y1 + (size_t)m * D, lane, y);
#pragma unroll
            for (int j = 0; j < 4; ++j) v[j] = v[j] + y[j];
            const float rstd = bad ? __builtin_nanf("") : row_rstd(v); f32x4* o = (f32x4*)(xs + (size_t)m * D) + lane;
#pragma unroll
            for (int j = 0; j < 4; ++j) { const f32x4 gv = *((const f32x4*)A_IN(I_NORM_FINAL) + lane + 64 * j); o[64 * j] = v[j] * rstd * gv; } } }
#undef IN
#undef SEAM
}

extern "C" void kernel_launch(void* const* d_in, const int* in_sizes, int n_in, void* d_out, int out_size, void* d_ws, size_t ws_size, hipStream_t stream) {
    static int grid = 0;
    if (grid == 0) {
        if (n_in != 22 || out_size != M * D || ws_size < WS_END2) { fprintf(stderr, "kernel_launch: unexpected shapes (n_in %d, out %d, ws %zu < %zu)\n", n_in, out_size, ws_size, (size_t)WS_END); grid = -1; return; }
        int dev = 0, cus = 0, per_cu = 0;
        if (hipGetDevice(&dev) != hipSuccess || hipDeviceGetAttribute(&cus, hipDeviceAttributeMultiprocessorCount, dev) != hipSuccess) { grid = -1; return; }
        if (hipFuncSetAttribute((const void*)yoco_fwd, hipFuncAttributeMaxDynamicSharedMemorySize, LDS_BYTES) != hipSuccess) { fprintf(stderr, "kernel_launch: hipFuncSetAttribute failed\n"); grid = -1; return; }
        if (hipOccupancyMaxActiveBlocksPerMultiprocessor(&per_cu, (const void*)yoco_fwd, NTHR, LDS_BYTES) != hipSuccess || per_cu < 1) fprintf(stderr, "kernel_launch: occupancy query says %d\n", per_cu);
        (void)hipGetLastError();
        grid = cus;
    }
    if (grid < 0) return;
    (void)hipMemsetAsync((char*)d_ws + WS_CTL, 0, CTL_ZERO_BYTES, stream);
    Args a{};
    for (int i = 0; i < 22; ++i) a.in[i] = (const float*)d_in[i];
    a.out = (float*)d_out; a.ws = (unsigned char*)d_ws;
#if MK_PER_PHASE
    for (int p = 0; p < NPHASE; ++p) { a.ph_lo = p; a.ph_hi = p + 1; hipLaunchKernelGGL(yoco_fwd, dim3(grid), dim3(NTHR), LDS_BYTES, stream, a); }
#else
    a.ph_lo = 0; a.ph_hi = NPHASE; hipLaunchKernelGGL(yoco_fwd, dim3(grid), dim3(NTHR), LDS_BYTES, stream, a);
#endif
}
```

```cpp
#include <hip/hip_runtime.h>
#include <cstdio>
#include <cstdint>

#ifndef MK_PER_PHASE
#define MK_PER_PHASE 0
#endif

#define LAS __attribute__((address_space(3)))
#define GAS __attribute__((address_space(1)))
typedef unsigned short bf16_t;
typedef short bf16x8 __attribute__((ext_vector_type(8)));
typedef float f32x4 __attribute__((ext_vector_type(4)));
typedef float f32x2 __attribute__((ext_vector_type(2)));
typedef unsigned u32x4 __attribute__((ext_vector_type(4)));
typedef unsigned u32x2 __attribute__((ext_vector_type(2)));
typedef unsigned long long u64;

constexpr int BATCH = 8, SEQ = 4096, D = 1024, M = BATCH * SEQ;
constexpr int A_HEADS = 4, A_HD = 256, NPROJ = 4096, NPROJ_SRC = 4104;
constexpr int FFD = 2816, NE = 8, FE = 3584;
constexpr int KVG = 4, HD = 64, NH = 16, NKVQ = 2816, NQSRC = 1072;
constexpr float EPS = 1e-6f;
constexpr int MOE_MAXT = 264;
constexpr int MOE_ROWS = MOE_MAXT * 256;

constexpr size_t MiB = 1u << 20;
constexpr size_t WS_CTL = 0, CTL_ZERO_BYTES = 1 * MiB;
constexpr size_t WS_SMALL = 1 * MiB;
constexpr size_t WS_WIN = 2 * MiB, WS_WOUTA = 10 * MiB, WS_WGU = 12 * MiB, WS_WDOWN = 23 * MiB, WS_WKVQ = 29 * MiB, WS_WCMP1 = 35 * MiB, WS_WOUTB = 37 * MiB;
constexpr size_t WS_MGU = 40 * MiB, WS_MDOWN = 152 * MiB, WS_XH = 208 * MiB, WS_GA = 272 * MiB, WS_ROWINFO = 273 * MiB, WS_BIG = 274 * MiB;
constexpr size_t WS_PROJ3 = WS_BIG, WS_OG = WS_BIG + 192 * MiB, WS_IMG = WS_BIG + 256 * MiB, WS_DN = WS_BIG + 536 * MiB, WS_HS = WS_BIG, WS_HN = WS_BIG + 128 * MiB;
constexpr size_t IMG_Q = 0, IMG_K = 34816, IMG_KT = 67584, IMG_VT = 100352, IMG_G = 141312, IMG_STRIDE = 142080;
static_assert((size_t)2048 * IMG_STRIDE <= 280 * MiB, "scan images");
constexpr size_t WS_ACT = WS_BIG;
constexpr size_t WS_KV = WS_BIG, WS_QB = WS_BIG + 96 * MiB, WS_GATEB = WS_BIG + 160 * MiB, WS_HID = WS_BIG + 166 * MiB, WS_KC = WS_BIG + 174 * MiB, WS_VC = WS_BIG + 175 * MiB, WS_OB = WS_BIG + 176 * MiB, WS_VT2 = WS_BIG + 240 * MiB;
constexpr size_t WS_XG = WS_BIG, WS_ACTS = WS_BIG + 132 * MiB, WS_Y1 = WS_BIG;
constexpr size_t WS_END = WS_BIG + 594 * MiB;
constexpr size_t WS_W2T = WS_SMALL + 524288;
constexpr size_t WS_SSP = WS_END, WS_RS = WS_END + 2 * MiB, WS_END2 = WS_END + 3 * MiB;
static_assert((size_t)MOE_ROWS * 1024 * 2 <= 132 * MiB && (size_t)MOE_ROWS * FE * 2 <= 462 * MiB, "moe buffers");
constexpr int CW_BAR = 4096;

constexpr int NWAVES = 8, NTHR = 512;
constexpr int LDS_BYTES = 163840;
constexpr int MISC_OFF = 163840 - 256;

__device__ __forceinline__ unsigned f2bf(float f) { unsigned u = __builtin_bit_cast(unsigned, f); return (u + 0x7fffu + ((u >> 16) & 1u)) >> 16; }
__device__ __forceinline__ unsigned pk2(float lo, float hi) { return f2bf(lo) | (f2bf(hi) << 16); }
__device__ __forceinline__ float bf2f(unsigned short b) { return __builtin_bit_cast(float, ((unsigned)b) << 16); }
__device__ __forceinline__ float bflo(unsigned w) { return __builtin_bit_cast(float, w << 16); }
__device__ __forceinline__ float bfhi(unsigned w) { return __builtin_bit_cast(float, w & 0xffff0000u); }
__device__ __forceinline__ float wave_sum(float v) {
#pragma unroll
    for (int o = 1; o < 64; o <<= 1) v += __shfl_xor(v, o);
    return v;
}
__device__ __forceinline__ float sigmoidf_(float x) { return __builtin_amdgcn_rcpf(1.0f + __builtin_amdgcn_exp2f(-1.4426950408889634f * x)); }
__device__ __forceinline__ float siluf_(float x) { return x * __builtin_amdgcn_rcpf(1.0f + __builtin_amdgcn_exp2f(-1.4426950408889634f * x)); }
__device__ __forceinline__ float ex2(float x) { return __builtin_amdgcn_exp2f(x); }
__device__ __forceinline__ unsigned pk_fp8x4(float a, float b, float c, float d) { unsigned w = 0u; w = __builtin_amdgcn_cvt_pk_fp8_f32(a, b, w, false); w = __builtin_amdgcn_cvt_pk_fp8_f32(c, d, w, true); return w; }
#define LDS_WAIT() asm volatile("s_waitcnt lgkmcnt(0)" ::: "memory")
#define LDS_BARRIER() do { asm volatile("s_waitcnt lgkmcnt(0)" ::: "memory"); __builtin_amdgcn_s_barrier(); asm volatile("" ::: "memory"); } while (0)

#define XB_TMO      128
#define XB_XCNT(j)  (256  + 64 * (j))
#define XB_XSUB(j)  (1280 + 64 * (j))
#define XB_XGEN(j)  (2304 + 64 * (j))
#define XB_TOP      3328
#define XB_TOPGEN   3392
#define XCD_BAR_WORDS 3456
#define XB_SPIN_CAP (1u << 22)
__device__ __forceinline__ unsigned xb_ld(unsigned* p)              { return __hip_atomic_load(p, __ATOMIC_RELAXED, __HIP_MEMORY_SCOPE_AGENT); }
__device__ __forceinline__ unsigned xb_add(unsigned* p, unsigned v) { return __hip_atomic_fetch_add(p, v, __ATOMIC_RELAXED, __HIP_MEMORY_SCOPE_AGENT); }
__device__ __forceinline__ unsigned xb_xcc_id() { return (unsigned)__builtin_amdgcn_s_getreg((3 << 11) | 20) & 0xFu; }
#define XB_SPIN(cond, bar) do { unsigned _sp = 0; while (cond) { __builtin_amdgcn_s_sleep(1); \
    if ((++_sp & 255u) == 0u) { if (xb_ld(&(bar)[XB_TMO])) break; if (_sp > XB_SPIN_CAP) { atomicAdd(&(bar)[XB_TMO], 1u); break; } } } } while (0)
struct XcdBarrier { unsigned* bar; unsigned x; volatile LAS unsigned* st; };
__device__ __forceinline__ XcdBarrier xcd_barrier_post(unsigned* bar, volatile LAS unsigned* st) {
    XcdBarrier b; b.bar = bar; b.x = xb_xcc_id(); b.st = st;
    if (threadIdx.x == 0) (void)xb_add(&bar[XB_XCNT(b.x)], 1u);
    return b;
}
__device__ __forceinline__ void xcd_barrier_complete(unsigned* bar, unsigned x, unsigned& nloc, unsigned& nx) {
    const unsigned G = gridDim.x * gridDim.y * gridDim.z;
    unsigned sum, cnt, mine, sp = 0u;
    for (;;) {
        sum = 0u; cnt = 0u; mine = 0u;
#pragma unroll
        for (unsigned j = 0; j < 16; ++j) { const unsigned c = xb_ld(&bar[XB_XCNT(j)]); sum += c; cnt += (c > 0u) ? 1u : 0u; mine = (j == x) ? c : mine; }
        if (sum == G) break;
        __builtin_amdgcn_s_sleep(1);
        if ((++sp & 255u) == 0u) { if (xb_ld(&bar[XB_TMO])) break; if (sp > XB_SPIN_CAP) { atomicAdd(&bar[XB_TMO], 1u); break; } }
    }
    nloc = mine > 0u ? mine : 1u; nx = cnt > 0u ? cnt : 1u;
}
__device__ __forceinline__ void xcd_barrier(const XcdBarrier& b) {
    asm volatile("s_waitcnt vmcnt(0)" ::: "memory");
    __syncthreads();
    if (threadIdx.x == 0) {
        unsigned* bar = b.bar;
        __builtin_amdgcn_s_waitcnt(0);
        unsigned nloc = b.st[0], nx = b.st[1];
        if (nloc == 0u) { xcd_barrier_complete(bar, b.x, nloc, nx); b.st[0] = nloc; b.st[1] = nx; }
        const unsigned old = xb_add(&bar[XB_XSUB(b.x)], 1u);
        const unsigned gen = old / nloc;
        if (old + 1u == (gen + 1u) * nloc) {
            __builtin_amdgcn_fence(__ATOMIC_RELEASE, "agent");
            asm volatile("s_waitcnt vmcnt(0)" ::: "memory");
            const unsigned og = xb_add(&bar[XB_TOP], 1u);
            const unsigned tg = og / nx;
            if (og + 1u == (tg + 1u) * nx) xb_add(&bar[XB_TOPGEN], 1u);
            else XB_SPIN(xb_ld(&bar[XB_TOPGEN]) == tg, bar);
            __builtin_amdgcn_fence(__ATOMIC_ACQUIRE, "agent");
            xb_add(&bar[XB_XGEN(b.x)], 1u);
            asm volatile("s_waitcnt vmcnt(0)" ::: "memory");
        } else {
            XB_SPIN(xb_ld(&bar[XB_XGEN(b.x)]) == gen, bar);
            __builtin_amdgcn_fence(__ATOMIC_ACQUIRE, "agent");
            asm volatile("s_waitcnt vmcnt(0)" ::: "memory");
        }
    }
    __syncthreads();
}

#ifndef EXPT
#define EXPT 0
#endif
#ifndef TSEG
#define TSEG 0
#endif
#if TSEG
#define TS_B(k) do { if (TSEG & (1 << (k))) tseg_t = __builtin_amdgcn_s_memrealtime(); } while (0)
#define TS_E(k) do { if (TSEG & (1 << (k))) tseg_acc += __builtin_amdgcn_s_memrealtime() - tseg_t; } while (0)
#else
#define TS_B(k)
#define TS_E(k)
#endif
#ifndef TPROBE
#define TPROBE 0
#endif
namespace pg8 {
constexpr int BM = 256, BK = 64, HALF = 128, HTB = HALF * BK * 2, STAGE_BYTES = 8 * HTB, NXCD = 8, WGM = 8;
__host__ __device__ __forceinline__ int lds_byte(int r, int c) { const int st = (r >> 4) * 2 + (c >> 5), rr = r & 15, cc = c & 31, ob = rr * 64 + cc * 2; return st * 1024 + (ob ^ (((ob >> 9) & 1) << 5)); }
__host__ __device__ __forceinline__ void stage_rc(int b, int& R, int& C) { const int st = b / 1024, sb = b % 1024, swz = sb ^ (((sb >> 9) & 1) << 5); R = (st >> 1) * 16 + swz / 64; C = (st & 1) * 32 + (swz % 64) / 2; }
__host__ __device__ __forceinline__ int perm32(int rho) { const int n = rho >> 4, i = rho & 15; return 8 * (i >> 2) + 4 * n + (i & 3); }
struct Unit { int pm, pn; const char* a; const char* b; };
struct Dims { int K, lda, ldb; int sa = 127, sb = 127; float* tk = nullptr; };
typedef __bf16 bf16x2_t __attribute__((ext_vector_type(2)));
__device__ __forceinline__ unsigned cvt_pk_bf16(float lo, float hi) { const f32x2 v = {lo, hi}; const bf16x2_t b = __builtin_convertvector(v, bf16x2_t); return __builtin_bit_cast(unsigned, b); }

__device__ __forceinline__ bool tile_order(int i, int G, int c, int nM, int nN, int& pm, int& pn) {
    const int nwg = nM * nN; const long L = (long)i * G + c; if (L >= nwg) return false;
    int wgid = (int)L; { const int q = nwg / NXCD, r = nwg % NXCD, xcd = wgid % NXCD, off = wgid / NXCD; wgid = (xcd < r ? xcd * (q + 1) : r * (q + 1) + (xcd - r) * q) + off; }
    const int nig = WGM * nN, gid = wgid / nig, fm = gid * WGM, gsz = (nM - fm) < WGM ? (nM - fm) : WGM;
    pm = fm + ((wgid % nig) % gsz); pn = (wgid % nig) / gsz; return true;
}
struct PlainOrder {
    int nM, nN, G, c; const char* A; const char* B; size_t tA, tB; int same = 0;
    __device__ __forceinline__ void init(const bf16_t* A_, const bf16_t* B_, int M_, int N_, int lda, int ldb, int G_, int c_) { nM = M_ / BM; nN = N_ / BM; G = G_; c = c_; A = (const char*)A_; B = (const char*)B_; tA = (size_t)BM * lda * 2; tB = (size_t)BM * ldb * 2; }
    __device__ __forceinline__ bool next(int i, Unit& u) const { if (EXPT && same) { if (i >= same) return false; u.pm = 0; u.pn = i; u.a = A; u.b = B + (size_t)i * tB; return true; }
        if (!tile_order(i, G, c, nM, nN, u.pm, u.pn)) return false; u.a = A + (size_t)u.pm * tA; u.b = B + (size_t)u.pn * tB; return true; }
};

template <class Epi, class Sched, bool ALIGN_EPI = true, bool SP2 = true, bool FP8 = false>
__device__ __forceinline__ void gemm_phase(LAS unsigned char* lds, const Dims g, const Sched& S, const Epi& E) {
    const int tid = threadIdx.x, wid = __builtin_amdgcn_readfirstlane(tid >> 6), lane = tid & 63, wr = wid >> 2, wc = wid & 3, fr = lane & 15, fq = lane >> 4;
    const int K = g.K, nt = K / BK;
    unsigned voffA[2], voffB[2];
#pragma unroll
    for (int i = 0; i < 2; ++i) { int R, C; stage_rc(tid * 16 + i * 8192, R, C); const int Rb = Epi::PERM ? ((R & ~31) + perm32(R & 31)) : R;
        voffA[i] = (unsigned)(R * g.lda + C) * 2u; voffB[i] = (unsigned)(Rb * g.ldb + C) * 2u; }
    const size_t kstep = (size_t)(BK * 2);
    const size_t hstepA = (size_t)HALF * g.lda * 2, hstepB = (size_t)HALF * g.ldb * 2;
    const unsigned ldsw = (unsigned)wid * 1024u;
    const int aoff = lds_byte(wr * 64 + fr, fq * 8), boff = lds_byte(wc * 32 + fr, fq * 8);
#define PG8_SA(b, h) (((b) * 2 + (h)) * HTB)
#define PG8_SB(b, h) ((4 + (b) * 2 + (h)) * HTB)
#define PG8_STAGE(bufoff, gbase, voff) do { _Pragma("unroll") for (int _i = 0; _i < 2; ++_i) \
        __builtin_amdgcn_global_load_lds((const unsigned*)((const char*)(gbase) + (voff)[_i]), (LAS unsigned*)(lds + (bufoff) + ldsw + _i * 8192), 16, 0, 0); } while (0)
    typedef int v8i_t __attribute__((ext_vector_type(8))); typedef int v4i_t __attribute__((ext_vector_type(4)));
#define PG8_RD8(p) __builtin_shufflevector(*(const LAS v4i_t*)(p), *(const LAS v4i_t*)((p) + 1024), 0, 1, 2, 3, 4, 5, 6, 7)
#define PG8_LDA(dst, b, h) do { if constexpr (FP8) { _Pragma("unroll") for (int m = 0; m < 4; ++m) dst##8[m] = PG8_RD8(lds + PG8_SA(b, h) + aoff + m * 2048); } \
        else { _Pragma("unroll") for (int m = 0; m < 4; ++m) _Pragma("unroll") for (int k = 0; k < 2; ++k) dst[m][k] = *(const LAS bf16x8*)(lds + PG8_SA(b, h) + aoff + m * 2048 + k * 1024); } } while (0)
#define PG8_LDB(dst, b, h) do { if constexpr (FP8) { _Pragma("unroll") for (int n = 0; n < 2; ++n) dst##8[n] = PG8_RD8(lds + PG8_SB(b, h) + boff + n * 2048); } \
        else { _Pragma("unroll") for (int n = 0; n < 2; ++n) _Pragma("unroll") for (int k = 0; k < 2; ++k) dst[n][k] = *(const LAS bf16x8*)(lds + PG8_SB(b, h) + boff + n * 2048 + k * 1024); } } while (0)
#define PG8_MMA(ai, bj, At, Bt) do { __builtin_amdgcn_s_setprio(1); \
        if constexpr (FP8) { _Pragma("unroll") for (int m = 0; m < 4; ++m) _Pragma("unroll") for (int n = 0; n < 2; ++n) \
            asm volatile("v_mfma_scale_f32_16x16x128_f8f6f4 %0, %1, %2, %0, %3, %4 op_sel_hi:[0,0,0]" : "+v"(acc[ai][bj][m][n]) : "v"(Bt##8[n]), "v"(At##8[m]), "v"(sbv), "v"(sav)); } \
        else { _Pragma("unroll") for (int m = 0; m < 4; ++m) _Pragma("unroll") for (int n = 0; n < 2; ++n) _Pragma("unroll") for (int k = 0; k < 2; ++k) \
            acc[ai][bj][m][n] = __builtin_amdgcn_mfma_f32_16x16x32_bf16(Bt[n][k], At[m][k], acc[ai][bj][m][n], 0, 0, 0); } \
        __builtin_amdgcn_s_setprio(0); } while (0)
#define PG8_WAIT_V(n) asm volatile("s_waitcnt vmcnt(" #n ")" ::: "memory")
#define PG8_WAIT_L(n) asm volatile("s_waitcnt lgkmcnt(" #n ")" ::: "memory")
#define PG8_BAR __builtin_amdgcn_s_barrier()
#define PG8_SCHED __builtin_amdgcn_sched_barrier(0)
    Unit cur, nxt; int ui = 0;
    if (!S.next(0, cur)) return;
    f32x4 acc[2][2][4][2];
#pragma unroll
    for (int a = 0; a < 2; ++a)
#pragma unroll
        for (int b = 0; b < 2; ++b)
#pragma unroll
            for (int m = 0; m < 4; ++m)
#pragma unroll
                for (int n = 0; n < 2; ++n) acc[a][b][m][n] = (f32x4){0.f, 0.f, 0.f, 0.f};
    bf16x8 At[4][2], B0[2][2], B1[2][2]; v8i_t At8[4], B08[2], B18[2];
    const int sbv = g.sb, sav = g.sa;
    const char* cA = cur.a; const char* cB = cur.b;
    if constexpr (SP2) {
        PG8_STAGE(PG8_SB(0, 0), cB, voffB); PG8_STAGE(PG8_SB(0, 1), cB + hstepB, voffB); PG8_STAGE(PG8_SA(0, 0), cA, voffA); PG8_STAGE(PG8_SA(0, 1), cA + hstepA, voffA);
        if (wr == 1) PG8_BAR;
        PG8_WAIT_V(2); PG8_BAR;
        PG8_STAGE(PG8_SB(1, 0), cB + kstep, voffB); PG8_STAGE(PG8_SA(1, 0), cA + kstep, voffA); PG8_STAGE(PG8_SB(1, 1), cB + hstepB + kstep, voffB);
        PG8_WAIT_V(6); PG8_BAR;
    } else {
        PG8_STAGE(PG8_SB(0, 0), cB, voffB); PG8_STAGE(PG8_SA(0, 0), cA, voffA); PG8_STAGE(PG8_SB(0, 1), cB + hstepB, voffB); PG8_STAGE(PG8_SA(0, 1), cA + hstepA, voffA);
        if (wr == 1) PG8_BAR;
        PG8_WAIT_V(4); PG8_BAR;
        PG8_STAGE(PG8_SB(1, 0), cB + kstep, voffB); PG8_STAGE(PG8_SA(1, 0), cA + kstep, voffA); PG8_STAGE(PG8_SB(1, 1), cB + hstepB + kstep, voffB);
        PG8_WAIT_V(6); PG8_BAR;
    }
#if TPROBE
    unsigned long long tk_acc = 0, te_acc = 0;
#endif
    for (;;) {
        const bool has_next = S.next(ui + 1, nxt);
#if TPROBE
        const unsigned long long tk0 = __builtin_amdgcn_s_memrealtime();
#endif
        const char* nA = has_next ? nxt.a : cA; const char* nB = has_next ? nxt.b : cB;
#pragma unroll 1
        for (int t = 0; t < nt; t += 2) {
            const bool last = (t == nt - 2);
            const char* a1 = cA + (size_t)(t + 1) * kstep;
            const char* a2 = last ? nA : cA + (size_t)(t + 2) * kstep; const char* b2 = last ? nB : cB + (size_t)(t + 2) * kstep;
            const char* a3 = a2 + kstep; const char* b3 = b2 + kstep;
            if constexpr (SP2) {
            PG8_LDB(B0, 0, 0); PG8_LDB(B1, 0, 1); PG8_SCHED; PG8_LDA(At, 0, 0); PG8_STAGE(PG8_SA(1, 1), a1 + hstepA, voffA);
            PG8_WAIT_V(8); PG8_WAIT_L(0); PG8_BAR; PG8_MMA(0, 0, At, B0); PG8_MMA(0, 1, At, B1); PG8_BAR; PG8_SCHED;
            PG8_LDA(At, 0, 1); PG8_STAGE(PG8_SB(0, 0), b2, voffB); PG8_STAGE(PG8_SB(0, 1), b2 + hstepB, voffB); PG8_STAGE(PG8_SA(0, 0), a2, voffA);
            PG8_WAIT_V(8); PG8_WAIT_L(0); PG8_BAR; PG8_MMA(1, 0, At, B0); PG8_MMA(1, 1, At, B1); PG8_BAR; PG8_SCHED;
            PG8_LDB(B0, 1, 0); PG8_LDB(B1, 1, 1); PG8_SCHED; PG8_LDA(At, 1, 0); PG8_STAGE(PG8_SA(0, 1), a2 + hstepA, voffA);
            PG8_WAIT_V(8); PG8_WAIT_L(0); PG8_BAR; PG8_MMA(0, 0, At, B0); PG8_MMA(0, 1, At, B1); PG8_BAR; PG8_SCHED;
            PG8_LDA(At, 1, 1); PG8_STAGE(PG8_SB(1, 0), b3, voffB); PG8_STAGE(PG8_SB(1, 1), b3 + hstepB, voffB); PG8_STAGE(PG8_SA(1, 0), a3, voffA);
            PG8_WAIT_V(8); PG8_WAIT_L(0); PG8_BAR; PG8_MMA(1, 0, At, B0); PG8_MMA(1, 1, At, B1); PG8_BAR; PG8_SCHED;
            } else {
            PG8_LDB(B0, 0, 0); PG8_SCHED; PG8_LDA(At, 0, 0); PG8_STAGE(PG8_SA(1, 1), a1 + hstepA, voffA);
            PG8_WAIT_L(8); PG8_BAR; PG8_WAIT_L(0); PG8_MMA(0, 0, At, B0); PG8_BAR; PG8_SCHED;
            PG8_LDB(B1, 0, 1); PG8_STAGE(PG8_SB(0, 0), b2, voffB);
            PG8_BAR; PG8_WAIT_L(0); PG8_MMA(0, 1, At, B1); PG8_BAR;
            PG8_LDA(At, 0, 1); PG8_STAGE(PG8_SA(0, 0), a2, voffA);
            PG8_BAR; PG8_WAIT_L(0); PG8_MMA(1, 0, At, B0); PG8_BAR; PG8_SCHED;
            PG8_STAGE(PG8_SB(0, 1), b2 + hstepB, voffB);
            PG8_WAIT_V(6); PG8_BAR; PG8_MMA(1, 1, At, B1); PG8_BAR;
            PG8_LDB(B0, 1, 0); PG8_SCHED; PG8_LDA(At, 1, 0); PG8_STAGE(PG8_SA(0, 1), a2 + hstepA, voffA);
            PG8_WAIT_L(8); PG8_BAR; PG8_WAIT_L(0); PG8_MMA(0, 0, At, B0); PG8_BAR; PG8_SCHED;
            PG8_LDB(B1, 1, 1); PG8_STAGE(PG8_SB(1, 0), b3, voffB);
            PG8_BAR; PG8_WAIT_L(0); PG8_MMA(0, 1, At, B1); PG8_BAR;
            PG8_LDA(At, 1, 1); PG8_STAGE(PG8_SA(1, 0), a3, voffA);
            PG8_BAR; PG8_WAIT_L(0); PG8_MMA(1, 0, At, B0); PG8_BAR; PG8_SCHED;
            PG8_STAGE(PG8_SB(1, 1), b3 + hstepB, voffB);
            PG8_WAIT_V(6); PG8_BAR; PG8_MMA(1, 1, At, B1); PG8_BAR;
            }
        }
#if TPROBE
        const unsigned long long tk1 = __builtin_amdgcn_s_memrealtime(); tk_acc += tk1 - tk0;
#endif
        if constexpr (ALIGN_EPI) { if (wr == 0) PG8_BAR; }
        if constexpr (FP8) asm volatile("s_nop 15\n\ts_nop 15" ::: "memory");
        E(acc, cur, wr, wc, fr, fq);
#if TPROBE
        te_acc += __builtin_amdgcn_s_memrealtime() - tk1;
#endif
        if (!has_next) break;
#pragma unroll
        for (int a = 0; a < 2; ++a)
#pragma unroll
            for (int b = 0; b < 2; ++b)
#pragma unroll
                for (int m = 0; m < 4; ++m)
#pragma unroll
                    for (int n = 0; n < 2; ++n) acc[a][b][m][n] = (f32x4){0.f, 0.f, 0.f, 0.f};
        cur = nxt; cA = nA; cB = nB; ++ui;
        if constexpr (ALIGN_EPI) { if (wr == 1) PG8_BAR; }
    }
    PG8_WAIT_V(0);
    if constexpr (!ALIGN_EPI) { if (wr == 0) PG8_BAR; }
    PG8_BAR;
#if TPROBE
    if (g.tk && tid == 0) { g.tk[0] = (float)tk_acc; g.tk[1] = (float)te_acc; }
#endif
#undef PG8_SA
#undef PG8_SB
#undef PG8_STAGE
#undef PG8_LDA
#undef PG8_LDB
#undef PG8_MMA
#undef PG8_RD8
#undef PG8_WAIT_V
#undef PG8_WAIT_L
#undef PG8_BAR
#undef PG8_SCHED
}

typedef const f32x4 (&AccRef)[2][2][4][2];
struct EpiBf16Plain {
    static constexpr bool PERM = true;
    bf16_t* O; int ldc;
    __device__ __forceinline__ void operator()(AccRef acc, const Unit& u, int wr, int wc, int fr, int fq) const {
        const int row0 = u.pm * BM + wr * 64 + fr, col0 = u.pn * BM + wc * 32 + 8 * fq;
#pragma unroll
        for (int ai = 0; ai < 2; ++ai)
#pragma unroll
            for (int m = 0; m < 4; ++m) { bf16_t* rowp = O + (size_t)(row0 + ai * HALF + m * 16) * ldc + col0;
#pragma unroll
                for (int bj = 0; bj < 2; ++bj) { const f32x4 v0 = acc[ai][bj][m][0], v1 = acc[ai][bj][m][1];
                    u32x4 w; w.x = cvt_pk_bf16(v0[0], v0[1]); w.y = cvt_pk_bf16(v0[2], v0[3]); w.z = cvt_pk_bf16(v1[0], v1[1]); w.w = cvt_pk_bf16(v1[2], v1[3]);
                    *(u32x4*)(rowp + bj * HALF) = w; } }
    }
};
struct EpiProjSplit {
    static constexpr bool PERM = true;
    bf16_t* P3; bf16_t* OG;
    __device__ __forceinline__ void operator()(AccRef acc, const Unit& u, int wr, int wc, int fr, int fq) const {
        const int row0 = u.pm * BM + wr * 64 + fr; const bool og = u.pn >= 12; const int ldc = og ? 1024 : 3072; bf16_t* base = (og ? OG + (u.pn - 12) * BM : P3 + u.pn * BM) + wc * 32 + 8 * fq;
#pragma unroll
        for (int ai = 0; ai < 2; ++ai)
#pragma unroll
            for (int m = 0; m < 4; ++m) { bf16_t* rowp = base + (size_t)(row0 + ai * HALF + m * 16) * ldc;
#pragma unroll
                for (int bj = 0; bj < 2; ++bj) { const f32x4 v0 = acc[ai][bj][m][0], v1 = acc[ai][bj][m][1];
                    u32x4 w; w.x = cvt_pk_bf16(v0[0], v0[1]); w.y = cvt_pk_bf16(v0[2], v0[3]); w.z = cvt_pk_bf16(v1[0], v1[1]); w.w = cvt_pk_bf16(v1[2], v1[3]);
                    *(u32x4*)(rowp + bj * HALF) = w; } }
    }
};
struct EpiResF32 {
    static constexpr bool PERM = false;
    const float* base; float* out; int ldc;
    __device__ __forceinline__ void operator()(AccRef acc, const Unit& u, int wr, int wc, int fr, int fq) const {
        const int row0 = u.pm * BM + wr * 64 + fr, col0 = u.pn * BM + wc * 32 + 4 * fq;
#pragma unroll
        for (int ai = 0; ai < 2; ++ai)
#pragma unroll
            for (int m = 0; m < 4; ++m) { const size_t off = (size_t)(row0 + ai * HALF + m * 16) * ldc + col0;
#pragma unroll
                for (int bj = 0; bj < 2; ++bj)
#pragma unroll
                    for (int n = 0; n < 2; ++n) { const f32x4 bs = *(const f32x4*)(base + off + bj * HALF + n * 16); *(f32x4*)(out + off + bj * HALF + n * 16) = bs + acc[ai][bj][m][n]; } }
    }
};
__device__ __forceinline__ float row_rs16(const float* ss, int row) { const f32x4* p = (const f32x4*)(ss + (size_t)row * 16); const f32x4 a = p[0], b = p[1], c = p[2], d = p[3];
    const float t = (((a[0] + a[1]) + (a[2] + a[3])) + ((b[0] + b[1]) + (b[2] + b[3]))) + (((c[0] + c[1]) + (c[2] + c[3])) + ((d[0] + d[1]) + (d[2] + d[3]))); return 1.0f / sqrtf(t * (1.f / 1024.f) + EPS); }
struct EpiResF32Stat {
    static constexpr bool PERM = false;
    const float* base; float* out; bf16_t* XHo; float* SS; int ldc;
    __device__ __forceinline__ void operator()(AccRef acc, const Unit& u, int wr, int wc, int fr, int fq) const {
        const int row0 = u.pm * BM + wr * 64 + fr, col0 = u.pn * BM + wc * 32 + 4 * fq;
#pragma unroll
        for (int ai = 0; ai < 2; ++ai)
#pragma unroll
            for (int m = 0; m < 4; ++m) { const int row = row0 + ai * HALF + m * 16; const size_t off = (size_t)row * ldc + col0; float ss = 0.f;
#pragma unroll
                for (int bj = 0; bj < 2; ++bj)
#pragma unroll
                    for (int n = 0; n < 2; ++n) { const f32x4 o = *(const f32x4*)(base + off + bj * HALF + n * 16) + acc[ai][bj][m][n]; *(f32x4*)(out + off + bj * HALF + n * 16) = o;
                        ss += (o[0] * o[0] + o[1] * o[1]) + (o[2] * o[2] + o[3] * o[3]);
                        u32x2 w; w.x = cvt_pk_bf16(o[0], o[1]); w.y = cvt_pk_bf16(o[2], o[3]); *(u32x2*)(XHo + off + bj * HALF + n * 16) = w; }
                ss += __shfl_xor(ss, 16); ss += __shfl_xor(ss, 32);
                if (fq == 0) SS[(size_t)row * 16 + u.pn * 4 + wc] = ss; }
    }
};
template <bool BASE16, bool STAT>
struct EpiRes16 {
    static constexpr bool PERM = true;
    const float* base32; bf16_t* XHo; float* SS; int ldc;
    __device__ __forceinline__ void operator()(AccRef acc, const Unit& u, int wr, int wc, int fr, int fq) const {
        const int row0 = u.pm * BM + wr * 64 + fr, col0 = u.pn * BM + wc * 32 + 8 * fq;
#pragma unroll
        for (int ai = 0; ai < 2; ++ai)
#pragma unroll
            for (int m = 0; m < 4; ++m) { const int row = row0 + ai * HALF + m * 16; const size_t off = (size_t)row * ldc + col0; float ss = 0.f;
#pragma unroll
                for (int bj = 0; bj < 2; ++bj) { f32x4 b0, b1;
                    if constexpr (BASE16) { const u32x4 r = *(const u32x4*)(XHo + off + bj * HALF); b0 = (f32x4){bflo(r.x), bfhi(r.x), bflo(r.y), bfhi(r.y)}; b1 = (f32x4){bflo(r.z), bfhi(r.z), bflo(r.w), bfhi(r.w)}; }
                    else { b0 = *(const f32x4*)(base32 + off + bj * HALF); b1 = *(const f32x4*)(base32 + off + bj * HALF + 4); }
                    const f32x4 o0 = b0 + acc[ai][bj][m][0], o1 = b1 + acc[ai][bj][m][1];
                    if constexpr (STAT) ss += ((o0[0] * o0[0] + o0[1] * o0[1]) + (o0[2] * o0[2] + o0[3] * o0[3])) + ((o1[0] * o1[0] + o1[1] * o1[1]) + (o1[2] * o1[2] + o1[3] * o1[3]));
                    u32x4 w; w.x = cvt_pk_bf16(o0[0], o0[1]); w.y = cvt_pk_bf16(o0[2], o0[3]); w.z = cvt_pk_bf16(o1[0], o1[1]); w.w = cvt_pk_bf16(o1[2], o1[3]);
                    *(u32x4*)(XHo + off + bj * HALF) = w; }
                if constexpr (STAT) { ss += __shfl_xor(ss, 16); ss += __shfl_xor(ss, 32);
                    if (fq == 0) SS[(size_t)row * 16 + u.pn * 4 + wc] = ss; } }
    }
};
struct EpiSwiGLU {
    static constexpr bool PERM = true;
    bf16_t* O; int ldc; const float* rsv;
    __device__ __forceinline__ void operator()(AccRef acc, const Unit& u, int wr, int wc, int fr, int fq) const {
        const int row0 = u.pm * BM + wr * 64 + fr, col0 = u.pn * HALF + wc * 32 + 8 * fq;
#pragma unroll
        for (int ai = 0; ai < 2; ++ai)
#pragma unroll
            for (int m = 0; m < 4; ++m) { const int row = row0 + ai * HALF + m * 16; bf16_t* rowp = O + (size_t)row * ldc + col0; const float rs = rsv ? rsv[row] : 1.0f;
                float o[8];
#pragma unroll
                for (int n = 0; n < 2; ++n)
#pragma unroll
                    for (int j = 0; j < 4; ++j) { const float gv = acc[ai][0][m][n][j] * rs, uv = acc[ai][1][m][n][j] * rs; o[n * 4 + j] = siluf_(gv) * uv; }
                u32x4 w; w.x = cvt_pk_bf16(o[0], o[1]); w.y = cvt_pk_bf16(o[2], o[3]); w.z = cvt_pk_bf16(o[4], o[5]); w.w = cvt_pk_bf16(o[6], o[7]);
                *(u32x4*)rowp = w; }
    }
};
struct EpiSwiGLU8 {
    static constexpr bool PERM = true;
    unsigned char* O8; int ldc; float oscale;
    __device__ __forceinline__ void operator()(AccRef acc, const Unit& u, int wr, int wc, int fr, int fq) const {
        const int row0 = u.pm * BM + wr * 64 + fr, col0 = u.pn * HALF + wc * 32 + 8 * fq;
#pragma unroll
        for (int ai = 0; ai < 2; ++ai)
#pragma unroll
            for (int m = 0; m < 4; ++m) { unsigned char* rowp = O8 + (size_t)(row0 + ai * HALF + m * 16) * ldc + col0;
                float o[8];
#pragma unroll
                for (int n = 0; n < 2; ++n)
#pragma unroll
                    for (int j = 0; j < 4; ++j) { const float gv = acc[ai][0][m][n][j], uv = acc[ai][1][m][n][j]; o[n * 4 + j] = siluf_(gv) * uv * oscale; }
                u32x2 w; w.x = pk_fp8x4(o[0], o[1], o[2], o[3]); w.y = pk_fp8x4(o[4], o[5], o[6], o[7]);
                *(u32x2*)rowp = w; }
    }
};
struct EpiKVQ {
    static constexpr bool PERM = true;
    bf16_t* KV; bf16_t* Q; float* GATE; const float* bgate; const float* rsv;
    __device__ __forceinline__ void operator()(AccRef acc, const Unit& u, int wr, int wc, int fr, int fq) const {
        const int row0 = u.pm * BM + wr * 64 + fr, cin = wc * 32 + 8 * fq;
#pragma unroll
        for (int ai = 0; ai < 2; ++ai)
#pragma unroll
            for (int m = 0; m < 4; ++m) { const int row = row0 + ai * HALF + m * 16; const float rs = rsv[row];
#pragma unroll
                for (int bj = 0; bj < 2; ++bj) { const f32x4 v0 = acc[ai][bj][m][0] * rs, v1 = acc[ai][bj][m][1] * rs; const int col = cin + bj * HALF;
                    if (u.pn < 6) { const int b = row >> 12, t = row & 4095, g = col >> 6, d = col & 63;
                        u32x4 w; w.x = cvt_pk_bf16(v0[0], v0[1]); w.y = cvt_pk_bf16(v0[2], v0[3]); w.z = cvt_pk_bf16(v1[0], v1[1]); w.w = cvt_pk_bf16(v1[2], v1[3]);
                        *(u32x4*)(KV + ((((size_t)u.pn * 8 + b) * 4 + g) * 4096 + t) * 64 + d) = w;
                    } else if (u.pn < 10) { const float s = 0.125f * 1.4426950408889634f;
                        u32x4 w; w.x = cvt_pk_bf16(v0[0] * s, v0[1] * s); w.y = cvt_pk_bf16(v0[2] * s, v0[3] * s); w.z = cvt_pk_bf16(v1[0] * s, v1[1] * s); w.w = cvt_pk_bf16(v1[2] * s, v1[3] * s);
                        *(u32x4*)(Q + (size_t)row * 1024 + (u.pn - 6) * 256 + col) = w;
                    } else if (col < 48) { const f32x4 b0 = *(const f32x4*)(bgate + col), b1 = *(const f32x4*)(bgate + col + 4);
                        f32x4 o0, o1;
#pragma unroll
                        for (int j = 0; j < 4; ++j) { o0[j] = sigmoidf_(v0[j] + b0[j]); o1[j] = sigmoidf_(v1[j] + b1[j]); }
                        *(f32x4*)(GATE + (size_t)row * 48 + col) = o0; *(f32x4*)(GATE + (size_t)row * 48 + col + 4) = o1; } } }
    }
};
struct EpiCmp {
    static constexpr bool PERM = true;
    bf16_t* O; const float* bias;
    __device__ __forceinline__ void operator()(AccRef acc, const Unit& u, int wr, int wc, int fr, int fq) const {
        const int row0 = u.pm * BM + wr * 64 + fr, col0 = wc * 32 + 8 * fq; const float* bp = bias + (u.pm >> 5) * 256 + col0;
#pragma unroll
        for (int ai = 0; ai < 2; ++ai)
#pragma unroll
            for (int m = 0; m < 4; ++m) { bf16_t* rowp = O + (size_t)(row0 + ai * HALF + m * 16) * 256 + col0;
#pragma unroll
                for (int bj = 0; bj < 2; ++bj) { const f32x4 b0 = *(const f32x4*)(bp + bj * HALF), b1 = *(const f32x4*)(bp + bj * HALF + 4);
                    const f32x4 v0 = acc[ai][bj][m][0] + b0, v1 = acc[ai][bj][m][1] + b1;
                    u32x4 w; w.x = cvt_pk_bf16(siluf_(v0[0]), siluf_(v0[1])); w.y = cvt_pk_bf16(siluf_(v0[2]), siluf_(v0[3])); w.z = cvt_pk_bf16(siluf_(v1[0]), siluf_(v1[1])); w.w = cvt_pk_bf16(siluf_(v1[2]), siluf_(v1[3]));
                    *(u32x4*)(rowp + bj * HALF) = w; } }
    }
};
}

struct MoeOrder {
    int nN, G, c; const char* A; const char* B; size_t tA, tBe, tBn; volatile LAS int* tb;
    __device__ __forceinline__ int expert_of(int pm) const { int e = 0;
#pragma unroll
        for (int i = 1; i < 8; ++i) e += (pm >= __builtin_amdgcn_readfirstlane(tb[i])) ? 1 : 0;
        return e; }
    __device__ __forceinline__ bool next(int i, pg8::Unit& u) const {
        const int nM = __builtin_amdgcn_readfirstlane(tb[8]);
        if (!pg8::tile_order(i, G, c, nM, nN, u.pm, u.pn)) return false;
        u.a = A + (size_t)u.pm * tA; u.b = B + (size_t)expert_of(u.pm) * tBe + (size_t)u.pn * tBn; return true; }
};
struct EpiMoeDown {
    static constexpr bool PERM = true;
    bf16_t* Y; const u32x2* rowinfo; const float* ew; volatile LAS int* tb;
    __device__ __forceinline__ void operator()(pg8::AccRef acc, const pg8::Unit& u, int wr, int wc, int fr, int fq) const {
        int e = 0;
#pragma unroll
        for (int i = 1; i < 8; ++i) e += (u.pm >= __builtin_amdgcn_readfirstlane(tb[i])) ? 1 : 0;
        const int nvalid = __builtin_amdgcn_readfirstlane(tb[16 + e]) - (u.pm - __builtin_amdgcn_readfirstlane(tb[e])) * 256;
        int rin0 = wr * 64 + fr; const int col0 = u.pn * 256 + wc * 32 + 8 * fq;
        asm volatile("" : "+v"(rin0));
#pragma unroll
        for (int ai = 0; ai < 2; ++ai)
#pragma unroll
            for (int m = 0; m < 4; ++m) { const int rin = rin0 + ai * 128 + m * 16;
                if (rin < nvalid) { const unsigned info = ((const unsigned*)rowinfo)[2 * ((size_t)u.pm * 256 + rin)]; const float w = ew[info];
                    bf16_t* dst = Y + ((size_t)(info & 1u) * M + (info >> 1)) * 1024 + col0;
#pragma unroll
                    for (int bj = 0; bj < 2; ++bj) { const f32x4 v0 = acc[ai][bj][m][0] * w, v1 = acc[ai][bj][m][1] * w;
                        u32x4 o; o.x = pg8::cvt_pk_bf16(v0[0], v0[1]); o.y = pg8::cvt_pk_bf16(v0[2], v0[3]); o.z = pg8::cvt_pk_bf16(v1[0], v1[1]); o.w = pg8::cvt_pk_bf16(v1[2], v1[3]);
                        *(u32x4*)(dst + bj * 128) = o; } } }
    }
};

__device__ __forceinline__ void conv_item(const float* W, int ld, int srcc0, int nvalid, bf16_t* WT, int ldd, int dstr0, const float* gain, int k0, int lane) {
    const int n4 = lane & 7, c = lane >> 3;
    f32x4 v[8];
#pragma unroll
    for (int i = 0; i < 8; ++i) { v[i] = (f32x4){0.f, 0.f, 0.f, 0.f};
        if (4 * n4 < nvalid) { v[i] = *(const f32x4*)(W + (size_t)(k0 + 8 * c + i) * ld + srcc0 + 4 * n4); if (gain) v[i] = v[i] * gain[k0 + 8 * c + i]; } }
#pragma unroll
    for (int j = 0; j < 4; ++j) { u32x4 o; o.x = pk2(v[0][j], v[1][j]); o.y = pk2(v[2][j], v[3][j]); o.z = pk2(v[4][j], v[5][j]); o.w = pk2(v[6][j], v[7][j]);
        *(u32x4*)(WT + (size_t)(dstr0 + 4 * n4 + j) * ldd + k0 + 8 * c) = o; }
}

struct W8 { const float* src; const float* gain; unsigned char* dst; int ld, ldd; float scale, gm, ga; };
__device__ __forceinline__ void conv8_load(const W8& d, int lane, f32x4 (&v)[16], f32x4 (&g)[4]) {
    const int n4 = lane & 7, c = lane >> 3;
#pragma unroll
    for (int i = 0; i < 16; ++i) v[i] = *(const f32x4*)(d.src + (size_t)(16 * c + i) * d.ld + 4 * n4);
#pragma unroll
    for (int q = 0; q < 4; ++q) g[q] = *(const f32x4*)(d.gain + 16 * c + 4 * q);
}
__device__ __forceinline__ void conv8_store(const W8& d, int lane, const f32x4 (&v)[16], const f32x4 (&g)[4]) {
    const int n4 = lane & 7, c = lane >> 3;
    f32x4 gs[4];
#pragma unroll
    for (int q = 0; q < 4; ++q) gs[q] = (g[q] * d.gm + d.ga) * d.scale;
#pragma unroll
    for (int j = 0; j < 4; ++j) { u32x4 o;
        o.x = pk_fp8x4(v[0][j] * gs[0].x, v[1][j] * gs[0].y, v[2][j] * gs[0].z, v[3][j] * gs[0].w);
        o.y = pk_fp8x4(v[4][j] * gs[1].x, v[5][j] * gs[1].y, v[6][j] * gs[1].z, v[7][j] * gs[1].w);
        o.z = pk_fp8x4(v[8][j] * gs[2].x, v[9][j] * gs[2].y, v[10][j] * gs[2].z, v[11][j] * gs[2].w);
        o.w = pk_fp8x4(v[12][j] * gs[3].x, v[13][j] * gs[3].y, v[14][j] * gs[3].z, v[15][j] * gs[3].w);
        *(u32x4*)(d.dst + (size_t)(4 * n4 + j) * d.ldd + 16 * c) = o; }
}

struct Args { const float* in[22]; float* out; unsigned char* ws; int ph_lo, ph_hi; };
typedef const __attribute__((address_space(4))) Args* CArgsP;
__device__ __forceinline__ CArgsP argp() { CArgsP p = (CArgsP)__builtin_amdgcn_kernarg_segment_ptr(); asm volatile("" : "+s"(p)); return p; }
#define A_IN(i) ((const float*)argp()->in[i])
enum { I_X = 0, I_NORM_MIX, I_NORM_FFN, I_A_W_IN, I_A_B_GATE, I_A_CONV, I_A_NORM_H, I_A_W_OUT, I_NORM_KV, I_B_W_KV, I_B_CMP_POS, I_B_CMP_W1, I_B_CMP_W2,
       I_B_W_Q, I_B_B_GATE, I_B_W_OUT, I_F_W_GU, I_F_W_DOWN, I_M_ROUTER, I_M_W_GU, I_M_W_DOWN, I_NORM_FINAL };

__device__ __forceinline__ W8 w8_decode(unsigned char* ws, int r) {
    constexpr int N8 = 8 * 8 * 224;
    W8 d;
    if (r < N8) { const int e = r / (8 * 224), rr = r % (8 * 224), kb = rr / 224, db = rr % 224, tile = db >> 3, w = db & 7; const int sc = (w < 4) ? (128 * tile + 32 * w) : (FE + 128 * tile + 32 * (w - 4));
        d.src = A_IN(I_M_W_GU) + (size_t)e * 1024 * 2 * FE + (size_t)(128 * kb) * (2 * FE) + sc; d.ld = 2 * FE; d.gain = A_IN(I_NORM_FFN) + 1024 + 128 * kb; d.scale = 128.f; d.gm = 1.f; d.ga = 0.f;
        d.dst = ws + WS_MGU + (size_t)e * 2 * FE * 1024 + (size_t)(32 * db) * 1024 + 128 * kb; d.ldd = 1024; }
    else { r -= N8; const int e = r / (28 * 32), rr = r % (28 * 32), kb = rr / 32, db = rr % 32;
        d.src = A_IN(I_M_W_DOWN) + (size_t)e * FE * 1024 + (size_t)(128 * kb) * 1024 + 32 * db; d.ld = 1024; d.gain = A_IN(I_NORM_FFN); d.scale = 256.f; d.gm = 0.f; d.ga = 1.f;
        d.dst = ws + WS_MDOWN + (size_t)e * 1024 * FE + (size_t)(32 * db) * FE + 128 * kb; d.ldd = FE; }
    return d;
}
__device__ __forceinline__ void p0_item16(unsigned char* ws, int r, int lane) {
    constexpr int N1 = 16 * 128, N2 = 16 * 32, N3 = 16 * 176, N4 = 44 * 32, N5 = 16 * 88, N6 = 2 * 32 * 8;
    if (r < N1) { const int kb = r / 128, db = r % 128; conv_item(A_IN(I_A_W_IN), NPROJ_SRC, 32 * db, 32, (bf16_t*)(ws + WS_WIN), 1024, 32 * db, A_IN(I_NORM_MIX), 64 * kb, lane); return; } r -= N1;
    if (r < N2) { const int kb = r / 32, db = r % 32; conv_item(A_IN(I_A_W_OUT), 1024, 32 * db, 32, (bf16_t*)(ws + WS_WOUTA), 1024, 32 * db, nullptr, 64 * kb, lane); return; } r -= N2;
    if (r < N3) { const int kb = r / 176, db = r % 176, tile = db >> 3, w = db & 7; const int sc = (w < 4) ? (128 * tile + 32 * w) : (FFD + 128 * tile + 32 * (w - 4));
        conv_item(A_IN(I_F_W_GU), 2 * FFD, sc, 32, (bf16_t*)(ws + WS_WGU), 1024, 32 * db, A_IN(I_NORM_FFN), 64 * kb, lane); return; } r -= N3;
    if (r < N4) { const int kb = r / 32, db = r % 32; conv_item(A_IN(I_F_W_DOWN), 1024, 32 * db, 32, (bf16_t*)(ws + WS_WDOWN), FFD, 32 * db, nullptr, 64 * kb, lane); return; } r -= N4;
    if (r < N5) { const int kb = r / 88, db = r % 88;
        if (db < 48) conv_item(A_IN(I_B_W_KV), 1536, 32 * db, 32, (bf16_t*)(ws + WS_WKVQ), 1024, 32 * db, A_IN(I_NORM_KV), 64 * kb, lane);
        else { const int sc = 32 * (db - 48); int nv = NQSRC - sc; nv = nv < 0 ? 0 : (nv > 32 ? 32 : nv);
            conv_item(A_IN(I_B_W_Q), NQSRC, sc, nv, (bf16_t*)(ws + WS_WKVQ), 1024, 32 * db, A_IN(I_NORM_MIX) + 1024, 64 * kb, lane); }
        return; } r -= N5;
    if (r < N6) { const int c = r / 256, rr = r % 256, kb = rr / 8, db = rr % 8; conv_item(A_IN(I_B_CMP_W1) + (size_t)c * 2048 * 256, 256, 32 * db, 32, (bf16_t*)(ws + WS_WCMP1) + (size_t)c * 256 * 2048, 2048, 32 * db, nullptr, 64 * kb, lane); return; } r -= N6;
    if (r < 16 * 32) { const int kb = r / 32, db = r % 32; conv_item(A_IN(I_B_W_OUT), 1024, 32 * db, 32, (bf16_t*)(ws + WS_WOUTB), 1024, 32 * db, nullptr, 64 * kb, lane); return; } r -= 16 * 32;
    { const int c = r >> 3, kb = (r >> 1) & 3, db = r & 1;
        conv_item(A_IN(I_B_CMP_W2) + (size_t)c * 256 * 64, 64, 32 * db, 32, (bf16_t*)(ws + WS_W2T) + (size_t)c * 64 * 256, 256, 32 * db, nullptr, 64 * kb, lane); }
}
__device__ __forceinline__ void p0_weights(unsigned char* ws, LAS unsigned char* lds, int gw, int NGW, int wave, int lane) {
    constexpr int N1 = 16 * 128, N2 = 16 * 32, N3 = 16 * 176, N4 = 44 * 32, N5 = 16 * 88, N6 = 2 * 32 * 8, N7 = 16 * 32;
    constexpr int NB16 = N1 + N2 + N3 + N4 + N5 + N6 + N7 + 16, NT8 = 8 * 8 * 224 + 8 * 28 * 32;
    {   f32x4 va[16], ga[4], vb[16], gb[4]; W8 da, db;
        int it = gw;
        da = w8_decode(ws, it); conv8_load(da, lane, va, ga);
        for (;;) {
            int nx = it + NGW; db = w8_decode(ws, nx < NT8 ? nx : NT8 - 1); if (nx >= NT8) db.ld = 0;
            conv8_load(db, lane, vb, gb); __builtin_amdgcn_sched_barrier(0);
            conv8_store(da, lane, va, ga);
            if (nx >= NT8) break;
            it = nx; nx = it + NGW; da = w8_decode(ws, nx < NT8 ? nx : NT8 - 1); if (nx >= NT8) da.ld = 0;
            conv8_load(da, lane, va, ga); __builtin_amdgcn_sched_barrier(0);
            conv8_store(db, lane, vb, gb);
            if (nx >= NT8) break;
            it = nx; }
    }
    for (int it = gw; it < NB16; it += NGW) p0_item16(ws, it, lane);
}

__device__ __forceinline__ void load_row(const float* row, int lane, f32x4 (&v)[4]) {
    const f32x4* xr = (const f32x4*)row + lane;
#pragma unroll
    for (int j = 0; j < 4; ++j) v[j] = xr[64 * j];
}
__device__ __forceinline__ float row_rstd(const f32x4 (&v)[4]) {
    float s = 0.f;
#pragma unroll
    for (int j = 0; j < 4; ++j) s += (v[j].x * v[j].x + v[j].y * v[j].y) + (v[j].z * v[j].z + v[j].w * v[j].w);
    return 1.0f / sqrtf(wave_sum(s) * (1.f / 1024.f) + EPS);
}
__device__ __forceinline__ void store_row_bf16(bf16_t* orow, int lane, const f32x4 (&v)[4], float sc) {
    u64* o8 = (u64*)orow + lane;
#pragma unroll
    for (int j = 0; j < 4; ++j) o8[64 * j] = (u64)pk2(v[j].x * sc, v[j].y * sc) | ((u64)pk2(v[j].z * sc, v[j].w * sc) << 32);
}

__device__ __forceinline__ f32x4 mma_lds(const LAS bf16_t* A, int lda, const LAS bf16_t* Bt, int ldb, int K, f32x4 acc, int lane) {
    const int r = lane & 15, q = lane >> 4;
    const LAS bf16_t* ap = A + r * lda + 8 * q; const LAS bf16_t* bp = Bt + r * ldb + 8 * q;
    for (int k = 0; k < K; k += 32) { const bf16x8 a = *(const LAS bf16x8*)(ap + k), b = *(const LAS bf16x8*)(bp + k); acc = __builtin_amdgcn_mfma_f32_16x16x32_bf16(a, b, acc, 0, 0, 0); }
    return acc;
}

__device__ __forceinline__ void scanprep_phase(LAS unsigned char* lds, const bf16_t* P3, const float* GA, const float* conv_w, unsigned char* IMG, int vcu, int G) {
    const int tid = threadIdx.x, wave = __builtin_amdgcn_readfirstlane(tid >> 6), lane = tid & 63;
    constexpr int QS = 272, LDP = 3072;
    LAS bf16_t* Qs = (LAS bf16_t*)(lds + 0);
    LAS bf16_t* Kd = (LAS bf16_t*)(lds + 34816);
    LAS float* fg = (LAS float*)(lds + 67584);
    LAS float* cw = (LAS float*)(lds + 68352);
    const bool same_h = (G & 255) == 0; int h_loaded = -1;
    for (int item = vcu; item < 2048; item += G) {
        const int b = item >> 8, h = (item >> 6) & 3, ci = item & 63, t0 = ci * 64; const size_t rb = (size_t)b * SEQ + t0;
        unsigned char* img = IMG + (size_t)item * IMG_STRIDE;
        const int cg = tid & 31, rg = tid >> 5;
        u32x4 rawq[7], rawk[7];
#pragma unroll
        for (int r7 = 0; r7 < 7; ++r7) { const int tt = 4 * rg - 3 + r7; rawq[r7] = (u32x4){0u, 0u, 0u, 0u}; rawk[r7] = (u32x4){0u, 0u, 0u, 0u};
            if (t0 + tt >= 0) { const bf16_t* p = P3 + (rb + tt) * LDP + h * 256 + 8 * cg; rawq[r7] = *(const u32x4*)p; rawk[r7] = *(const u32x4*)(p + 1024); } }
        const int vv = tid & 255, hf = tid >> 8; unsigned short ev[32];
        { const bf16_t* vp = P3 + (rb + 32 * hf) * LDP + 2048 + h * 256 + vv;
#pragma unroll
          for (int i = 0; i < 32; ++i) ev[i] = vp[(size_t)i * LDP]; }
        float gli = 0.f, glf = 0.f; if (wave == 7) { gli = GA[(rb + lane) * 8 + h]; glf = GA[(rb + lane) * 8 + 4 + h]; }
        __syncthreads();
        if (h != h_loaded || !same_h) {
            for (int i = tid; i < 2048; i += NTHR) { const int j = i >> 8, kk = i & 255; cw[i] = conv_w[(j & 3) * 2048 + (j >> 2) * 1024 + h * 256 + kk]; }
            for (int i = tid; i < 64 * 16; i += NTHR) { const int r = i >> 4, c = i & 15; Qs[r * QS + 256 + c] = 0; }
            h_loaded = h; __syncthreads(); }
        { bf16_t* op = (bf16_t*)(img + IMG_VT) + vv * 80 + 32 * hf;
#pragma unroll
          for (int g8 = 0; g8 < 4; ++g8) { u32x4 w; w.x = ev[8 * g8] | ((unsigned)ev[8 * g8 + 1] << 16); w.y = ev[8 * g8 + 2] | ((unsigned)ev[8 * g8 + 3] << 16); w.z = ev[8 * g8 + 4] | ((unsigned)ev[8 * g8 + 5] << 16); w.w = ev[8 * g8 + 6] | ((unsigned)ev[8 * g8 + 7] << 16);
              *(u32x4*)(op + 8 * g8) = w; }
          *(u32x4*)((bf16_t*)(img + IMG_VT) + vv * 80 + 64 + 8 * hf) = (u32x4){0u, 0u, 0u, 0u}; }
        {
#pragma unroll
          for (int which = 0; which < 2; ++which) {
            float x[7][8];
#pragma unroll
            for (int r7 = 0; r7 < 7; ++r7) { const u32x4 raw = which ? rawk[r7] : rawq[r7];
                x[r7][0] = bflo(raw.x); x[r7][1] = bfhi(raw.x); x[r7][2] = bflo(raw.y); x[r7][3] = bfhi(raw.y); x[r7][4] = bflo(raw.z); x[r7][5] = bfhi(raw.z); x[r7][6] = bflo(raw.w); x[r7][7] = bfhi(raw.w); }
            float w[4][8];
#pragma unroll
            for (int tap = 0; tap < 4; ++tap) { const f32x4 w0 = *(const LAS f32x4*)(cw + (which * 4 + tap) * 256 + 8 * cg), w1 = *(const LAS f32x4*)(cw + (which * 4 + tap) * 256 + 8 * cg + 4);
                w[tap][0] = w0.x; w[tap][1] = w0.y; w[tap][2] = w0.z; w[tap][3] = w0.w; w[tap][4] = w1.x; w[tap][5] = w1.y; w[tap][6] = w1.z; w[tap][7] = w1.w; }
            const float sc = which ? 0.0625f : 1.0f;
#pragma unroll
            for (int j = 0; j < 4; ++j) { float o[8];
#pragma unroll
                for (int c = 0; c < 8; ++c) o[c] = (w[0][c] * x[j][c] + w[1][c] * x[j + 1][c] + w[2][c] * x[j + 2][c] + w[3][c] * x[j + 3][c]) * sc;
                u32x4 p; p.x = pg8::cvt_pk_bf16(o[0], o[1]); p.y = pg8::cvt_pk_bf16(o[2], o[3]); p.z = pg8::cvt_pk_bf16(o[4], o[5]); p.w = pg8::cvt_pk_bf16(o[6], o[7]);
                if (which) *(LAS u32x4*)(Kd + (4 * rg + j) * 256 + 8 * cg) = p; else *(LAS u32x4*)(Qs + (4 * rg + j) * QS + 8 * cg) = p; }
          }
          if (wave == 7) { const float li = gli, lf = glf;
              float bc = lf;
#pragma unroll
              for (int o = 1; o < 64; o <<= 1) { const float t = __shfl_up(bc, o); if (lane >= o) bc += t; }
              const float uu = li - bc; float pm = uu;
#pragma unroll
              for (int o = 1; o < 64; o <<= 1) { const float t = __shfl_up(pm, o); if (lane >= o) pm = fmaxf(pm, t); }
              fg[lane] = bc; fg[64 + lane] = uu; fg[128 + lane] = pm; }
        }
        __syncthreads();
        { const int k = tid & 255; bf16_t* op = (bf16_t*)(img + IMG_KT) + k * 64 + 32 * hf;
#pragma unroll
          for (int g8 = 0; g8 < 4; ++g8) { unsigned short e[8];
#pragma unroll
              for (int i = 0; i < 8; ++i) e[i] = Kd[(32 * hf + 8 * g8 + i) * 256 + k];
              u32x4 w; w.x = e[0] | ((unsigned)e[1] << 16); w.y = e[2] | ((unsigned)e[3] << 16); w.z = e[4] | ((unsigned)e[5] << 16); w.w = e[6] | ((unsigned)e[7] << 16);
              *(u32x4*)(op + 8 * g8) = w; } }
        for (int i = tid; i < 67584 / 16; i += NTHR) *(u32x4*)(img + (size_t)i * 16) = *(const LAS u32x4*)(lds + i * 16);
        if (tid < 48) *(u32x4*)(img + IMG_G + tid * 16) = *(const LAS u32x4*)(lds + 67584 + tid * 16);
    }
}

__device__ __forceinline__ void scan_phase(LAS unsigned char* lds, const unsigned char* IMG, float* HS, float* DN, int vcu, int G) {
    const int tid = threadIdx.x, wave = __builtin_amdgcn_readfirstlane(tid >> 6), lane = tid & 63, cl = lane & 15, q4 = lane >> 4;
    constexpr int QS = 272, TS = 80;
    LAS bf16_t* Qs = (LAS bf16_t*)(lds + 0);
    LAS bf16_t* Cbs = (LAS bf16_t*)(lds + 34816);
    LAS bf16_t* VTs = (LAS bf16_t*)(lds + 52768);
    LAS bf16_t* VaTs = (LAS bf16_t*)(lds + 58048);
    LAS bf16_t* Sws = (LAS bf16_t*)(lds + 63328);
    LAS float* fg = (LAS float*)(lds + 73568);
    const int r2 = cl ? 32 : 32;
    for (int u = vcu; u < 256; u += G) {
        const int b = u >> 5, h = (u >> 3) & 3, vs = u & 7;
        const unsigned char* img0 = IMG + (size_t)((b * 4 + h) * 64) * IMG_STRIDE;
        __syncthreads();
        for (int i = tid; i < 33 * QS; i += NTHR) Cbs[i] = 0;
        for (int i = tid; i < TS; i += NTHR) { VTs[32 * TS + i] = (i < 64) ? (bf16_t)0x3F80 : (bf16_t)0; VaTs[32 * TS + i] = 0; }
        f32x4 Cacc[2][3];
#pragma unroll
        for (int kk = 0; kk < 2; ++kk)
#pragma unroll
            for (int vt = 0; vt < 3; ++vt) Cacc[kk][vt] = (f32x4){0.f, 0.f, 0.f, 0.f};
        float mstate = 0.f;
        u32x4 pfq[5], pfv, pfg;
        bf16x8 kfr[8], ktf[2][2];
#define SCAN_LOAD(ci_) do { const unsigned char* ip = img0 + (size_t)(ci_) * IMG_STRIDE; \
            _Pragma("unroll") for (int k = 0; k < 5; ++k) { const int id = tid + 512 * k; if (id < 2176) pfq[k] = *(const u32x4*)(ip + (size_t)id * 16); } \
            if (tid < 320) pfv = *(const u32x4*)(ip + IMG_VT + vs * 5120 + tid * 16); \
            if (tid < 48) pfg = *(const u32x4*)(ip + IMG_G + tid * 16); } while (0)
#define SCAN_LOAD_K(ci_) do { if (wave >= 4) { const bf16_t* kp = (const bf16_t*)(img0 + (size_t)(ci_) * IMG_STRIDE + IMG_K) + (16 * (wave - 4) + cl) * 256 + 8 * q4; \
            _Pragma("unroll") for (int ks = 0; ks < 8; ++ks) kfr[ks] = *(const bf16x8*)(kp + 32 * ks); } } while (0)
#define SCAN_LOAD_KT(ci_) do { const bf16_t* kp = (const bf16_t*)(img0 + (size_t)(ci_) * IMG_STRIDE + IMG_KT) + (32 * wave + cl) * 64 + 8 * q4; \
            _Pragma("unroll") for (int kk = 0; kk < 2; ++kk) _Pragma("unroll") for (int ks = 0; ks < 2; ++ks) ktf[kk][ks] = *(const bf16x8*)(kp + kk * 1024 + 32 * ks); } while (0)
        SCAN_LOAD(0); SCAN_LOAD_K(0); SCAN_LOAD_KT(0);
        for (int ci = 0; ci < 64; ++ci) {
            const size_t rb = (size_t)b * SEQ + ci * 64;
#pragma unroll
            for (int k = 0; k < 5; ++k) { const int id = tid + 512 * k; if (id < 2176) *(LAS u32x4*)(lds + id * 16) = pfq[k]; }
            if (tid < 320) *(LAS u32x4*)((LAS unsigned char*)VTs + tid * 16) = pfv;
            if (tid < 48) *(LAS u32x4*)((LAS unsigned char*)fg + tid * 16) = pfg;
            if (ci + 1 < 64) SCAN_LOAD(ci + 1);
            LDS_BARRIER();
            const float pm63 = fg[128 + 63], bc63 = fg[63];
            const float M63 = fmaxf(mstate, pm63), aprev = ex2((mstate - M63) * 1.4426950408889634f);
            f32x4 hacc[3];
            if (wave < 4) {
                const int ti = wave;
#pragma unroll
                for (int vt = 0; vt < 3; ++vt) hacc[vt] = (f32x4){0.f, 0.f, 0.f, 0.f};
#pragma unroll
                for (int ks = 0; ks < 8; ++ks) { const bf16x8 a = *(const LAS bf16x8*)(Qs + (16 * ti + cl) * QS + 32 * ks + 8 * q4);
                    const bf16x8 b0 = *(const LAS bf16x8*)(Cbs + cl * QS + 32 * ks + 8 * q4), b1 = *(const LAS bf16x8*)(Cbs + (16 + cl) * QS + 32 * ks + 8 * q4), b2 = *(const LAS bf16x8*)(Cbs + r2 * QS + 32 * ks + 8 * q4);
                    hacc[0] = __builtin_amdgcn_mfma_f32_16x16x32_bf16(a, b0, hacc[0], 0, 0, 0); hacc[1] = __builtin_amdgcn_mfma_f32_16x16x32_bf16(a, b1, hacc[1], 0, 0, 0); hacc[2] = __builtin_amdgcn_mfma_f32_16x16x32_bf16(a, b2, hacc[2], 0, 0, 0); }
#pragma unroll
                for (int j = 0; j < 4; ++j) { const float wint = ex2((mstate - fmaxf(mstate, fg[128 + 16 * ti + 4 * q4 + j])) * 1.4426950408889634f); hacc[0][j] *= wint; hacc[1][j] *= wint; hacc[2][j] *= wint; }
            } else {
                const int si = wave - 4; f32x4 us4;
#pragma unroll
                for (int j = 0; j < 4; ++j) us4[j] = fg[64 + 16 * si + 4 * q4 + j];
#pragma unroll
                for (int ti = 0; ti < 4; ++ti) { u32x2 w = (u32x2){0u, 0u};
                    if (ti >= si) { f32x4 sacc = (f32x4){0.f, 0.f, 0.f, 0.f};
#pragma unroll
                        for (int ks = 0; ks < 8; ++ks) { const bf16x8 qb = *(const LAS bf16x8*)(Qs + (16 * ti + cl) * QS + 32 * ks + 8 * q4); sacc = __builtin_amdgcn_mfma_f32_16x16x32_bf16(kfr[ks], qb, sacc, 0, 0, 0); }
                        const int t = 16 * ti + cl; const float Mt = fmaxf(mstate, fg[128 + t]); float p[4];
#pragma unroll
                        for (int j = 0; j < 4; ++j) { const int s_ = 16 * si + 4 * q4 + j; p[j] = (s_ <= t) ? sacc[j] * ex2((us4[j] - Mt) * 1.4426950408889634f) : 0.f; }
                        w.x = pg8::cvt_pk_bf16(p[0], p[1]); w.y = pg8::cvt_pk_bf16(p[2], p[3]); }
                    *(LAS u32x2*)(Sws + (16 * ti + cl) * TS + 16 * si + 4 * q4) = w; }
                if (ci + 1 < 64) SCAN_LOAD_K(ci + 1);
            }
            if (tid < 264) { const int v = tid >> 3, s8 = (tid & 7) * 8; const u32x4 raw = *(const LAS u32x4*)(VTs + v * TS + s8); float a[8];
#pragma unroll
                for (int i = 0; i < 8; ++i) a[i] = ex2((fg[64 + s8 + i] - M63) * 1.4426950408889634f);
                u32x4 w; w.x = pg8::cvt_pk_bf16(bflo(raw.x) * a[0], bfhi(raw.x) * a[1]); w.y = pg8::cvt_pk_bf16(bflo(raw.y) * a[2], bfhi(raw.y) * a[3]); w.z = pg8::cvt_pk_bf16(bflo(raw.z) * a[4], bfhi(raw.z) * a[5]); w.w = pg8::cvt_pk_bf16(bflo(raw.w) * a[6], bfhi(raw.w) * a[7]);
                *(LAS u32x4*)(VaTs + v * TS + s8) = w; }
            LDS_BARRIER();
            if (wave < 4) {
                const int ti = wave;
#pragma unroll
                for (int ks = 0; ks < 2; ++ks) { const bf16x8 a = *(const LAS bf16x8*)(Sws + (16 * ti + cl) * TS + 32 * ks + 8 * q4);
                    const bf16x8 b0 = *(const LAS bf16x8*)(VTs + cl * TS + 32 * ks + 8 * q4), b1 = *(const LAS bf16x8*)(VTs + (16 + cl) * TS + 32 * ks + 8 * q4), b2 = *(const LAS bf16x8*)(VTs + r2 * TS + 32 * ks + 8 * q4);
                    hacc[0] = __builtin_amdgcn_mfma_f32_16x16x32_bf16(a, b0, hacc[0], 0, 0, 0); hacc[1] = __builtin_amdgcn_mfma_f32_16x16x32_bf16(a, b1, hacc[1], 0, 0, 0); hacc[2] = __builtin_amdgcn_mfma_f32_16x16x32_bf16(a, b2, hacc[2], 0, 0, 0); }
#pragma unroll
                for (int j = 0; j < 4; ++j) { const int t = 16 * ti + 4 * q4 + j; float* hp = HS + (rb + t) * 1024 + h * 256 + vs * 32 + cl; hp[0] = hacc[0][j]; hp[16] = hacc[1][j];
                    if (vs == 0 && cl == 0) { const float Mtt = fmaxf(mstate, fg[128 + t]); DN[(rb + t) * 4 + h] = fmaxf(fabsf(hacc[2][j]), ex2(-(fg[t] + Mtt) * 1.4426950408889634f)); } }
            }
#pragma unroll
            for (int kk = 0; kk < 2; ++kk)
#pragma unroll
                for (int vt = 0; vt < 3; ++vt) Cacc[kk][vt] = Cacc[kk][vt] * aprev;
#pragma unroll
            for (int ks = 0; ks < 2; ++ks) { const bf16x8 b0 = *(const LAS bf16x8*)(VaTs + cl * TS + 32 * ks + 8 * q4), b1 = *(const LAS bf16x8*)(VaTs + (16 + cl) * TS + 32 * ks + 8 * q4), b2 = *(const LAS bf16x8*)(VaTs + r2 * TS + 32 * ks + 8 * q4);
#pragma unroll
                for (int kk = 0; kk < 2; ++kk) { Cacc[kk][0] = __builtin_amdgcn_mfma_f32_16x16x32_bf16(ktf[kk][ks], b0, Cacc[kk][0], 0, 0, 0); Cacc[kk][1] = __builtin_amdgcn_mfma_f32_16x16x32_bf16(ktf[kk][ks], b1, Cacc[kk][1], 0, 0, 0);
                    Cacc[kk][2] = __builtin_amdgcn_mfma_f32_16x16x32_bf16(ktf[kk][ks], b2, Cacc[kk][2], 0, 0, 0); } }
#pragma unroll
            for (int kk = 0; kk < 2; ++kk)
#pragma unroll
                for (int vt = 0; vt < 3; ++vt) { if (vt < 2 || cl == 0) { u32x2 w; w.x = pg8::cvt_pk_bf16(Cacc[kk][vt][0], Cacc[kk][vt][1]); w.y = pg8::cvt_pk_bf16(Cacc[kk][vt][2], Cacc[kk][vt][3]);
                        *(LAS u32x2*)(Cbs + (16 * vt + cl) * QS + 32 * wave + 16 * kk + 4 * q4) = w; } }
            if (ci + 1 < 64) SCAN_LOAD_KT(ci + 1);
            mstate = bc63 + M63;
            LDS_BARRIER();
        }
#undef SCAN_LOAD
#undef SCAN_LOAD_K
#undef SCAN_LOAD_KT
    }
}

template <int MODE, bool EDGE>
__device__ __forceinline__ void attn_tile2(const LAS bf16_t* Kt, const LAS bf16_t* VTt, LAS bf16_t* Pw, const bf16x8 (&qa)[2], const f32x4 bv0, int jb, int t0, int th, float slope2,
                                           u64 tsel, f32x4 (&O)[4], float& mrow, float& lrow, int lane) {
    const int cl = lane & 15, q4 = lane >> 4; constexpr int TS = 72;
    f32x4 s[4];
#pragma unroll
    for (int nt = 0; nt < 4; ++nt) { s[nt] = bv0;
#pragma unroll
        for (int ks = 0; ks < 2; ++ks) { const bf16x8 kb = *(const LAS bf16x8*)(Kt + (16 * nt + cl) * TS + 32 * ks + 8 * q4); s[nt] = __builtin_amdgcn_mfma_f32_16x16x32_bf16(kb, qa[ks], s[nt], 0, 0, 0); } }
    const float b0 = slope2 * (float)(64 * jb - (t0 + 31)), o16 = slope2 * 16.f;
    bool rowok = true; if (MODE == 0) rowok = ((tsel >> (16 * th + cl)) & 1ull) != 0ull;
    if (EDGE) { const int dbase = t0 + 16 * th + cl - (64 * jb + 4 * q4);
#pragma unroll
        for (int nt = 0; nt < 4; ++nt)
#pragma unroll
            for (int j = 0; j < 4; ++j) { const int dist = dbase - (16 * nt + j); const bool ok = dist >= 0 && (MODE == 0 || dist < 512); s[nt][j] = ok ? s[nt][j] : -INFINITY; } }
    float mx = fmaxf(fmaxf(s[0][0], s[0][1]), fmaxf(s[0][2], s[0][3]));
#pragma unroll
    for (int n = 1; n < 4; ++n) mx = fmaxf(mx, fmaxf(fmaxf(s[n][0], s[n][1]), fmaxf(s[n][2], s[n][3])) + (float)n * o16);
    mx = rowok ? mx + b0 : -INFINITY;
    mx = fmaxf(mx, __shfl_xor(mx, 16)); mx = fmaxf(mx, __shfl_xor(mx, 32));
    const float mold = mrow, mnew = fmaxf(mold, mx), msafe = (mnew == -INFINITY) ? 0.f : mnew;
    const float alpha = (mold == -INFINITY) ? 0.f : ex2(mold - msafe);
    const float ref = rowok ? (msafe - b0) : INFINITY;
    float rs = 0.f;
    unsigned pw[4][2];
#pragma unroll
    for (int nt = 0; nt < 4; ++nt) { float p[4]; const float refn = ref - (float)nt * o16;
#pragma unroll
        for (int j = 0; j < 4; ++j) { p[j] = ex2(s[nt][j] - refn); rs += p[j]; }
        pw[nt][0] = pg8::cvt_pk_bf16(p[0], p[1]); pw[nt][1] = pg8::cvt_pk_bf16(p[2], p[3]); }
    rs += __shfl_xor(rs, 16); rs += __shfl_xor(rs, 32);
    lrow = lrow * alpha + rs; mrow = mnew;
#pragma unroll
    for (int dt = 0; dt < 4; ++dt) O[dt] = O[dt] * alpha;
#pragma unroll
    for (int ks = 0; ks < 2; ++ks) { const bf16x8 pa = __builtin_bit_cast(bf16x8, (u32x4){pw[2 * ks][0], pw[2 * ks][1], pw[2 * ks + 1][0], pw[2 * ks + 1][1]});
#pragma unroll
        for (int dt = 0; dt < 4; ++dt) { const bf16x8 vb = *(const LAS bf16x8*)(VTt + (16 * dt + cl) * TS + 32 * ks + 8 * q4); O[dt] = __builtin_amdgcn_mfma_f32_16x16x32_bf16(vb, pa, O[dt], 0, 0, 0); } }
}

template <int MODE>
__device__ __forceinline__ void attn_pair(const LAS bf16_t* KtA, const LAS bf16_t* KtB, LAS bf16_t* Pw, const bf16x8 (&qa)[2], const f32x4 bv0, int jA, int jB, int t0, int th, float slope2,
                                          u64 tselA, u64 tselB, f32x4 (&O)[4], float& mrow, float& lrow, int lane) {
    const int cl = lane & 15, q4 = lane >> 4; constexpr int TS = 72, PP = 136;
    f32x4 s[8];
#pragma unroll
    for (int nt = 0; nt < 8; ++nt) { const LAS bf16_t* Kt = (nt < 4) ? KtA : KtB; s[nt] = bv0;
#pragma unroll
        for (int ks = 0; ks < 2; ++ks) { const bf16x8 kb = *(const LAS bf16x8*)(Kt + (16 * (nt & 3) + cl) * TS + 32 * ks + 8 * q4); s[nt] = __builtin_amdgcn_mfma_f32_16x16x32_bf16(kb, qa[ks], s[nt], 0, 0, 0); } }
    const float o16 = slope2 * 16.f, bA = slope2 * (float)(64 * jA - (t0 + 31)), bB = slope2 * (float)(64 * jB - (t0 + 31));
    bool okA = true, okB = true; if (MODE == 0) { okA = ((tselA >> (16 * th + cl)) & 1ull) != 0ull; okB = ((tselB >> (16 * th + cl)) & 1ull) != 0ull; }
    float mA = fmaxf(fmaxf(s[0][0], s[0][1]), fmaxf(s[0][2], s[0][3])), mB = fmaxf(fmaxf(s[4][0], s[4][1]), fmaxf(s[4][2], s[4][3]));
#pragma unroll
    for (int n = 1; n < 4; ++n) { mA = fmaxf(mA, fmaxf(fmaxf(s[n][0], s[n][1]), fmaxf(s[n][2], s[n][3])) + (float)n * o16); mB = fmaxf(mB, fmaxf(fmaxf(s[4 + n][0], s[4 + n][1]), fmaxf(s[4 + n][2], s[4 + n][3])) + (float)n * o16); }
    float mx = fmaxf(okA ? mA + bA : -INFINITY, okB ? mB + bB : -INFINITY);
    mx = fmaxf(mx, __shfl_xor(mx, 16)); mx = fmaxf(mx, __shfl_xor(mx, 32));
    const float mold = mrow, mnew = fmaxf(mold, mx), msafe = (mnew == -INFINITY) ? 0.f : mnew;
    const float alpha = (mold == -INFINITY) ? 0.f : ex2(mold - msafe);
    const float refA = okA ? (msafe - bA) : INFINITY, refB = okB ? (msafe - bB) : INFINITY;
    float rs = 0.f;
    unsigned pw[8][2];
#pragma unroll
    for (int nt = 0; nt < 8; ++nt) { float p[4]; const float refn = ((nt < 4) ? refA : refB) - (float)(nt & 3) * o16;
#pragma unroll
        for (int j = 0; j < 4; ++j) { p[j] = ex2(s[nt][j] - refn); rs += p[j]; }
        pw[nt][0] = pg8::cvt_pk_bf16(p[0], p[1]); pw[nt][1] = pg8::cvt_pk_bf16(p[2], p[3]); }
    rs += __shfl_xor(rs, 16); rs += __shfl_xor(rs, 32);
    lrow = lrow * alpha + rs; mrow = mnew;
#pragma unroll
    for (int dt = 0; dt < 4; ++dt) O[dt] = O[dt] * alpha;
#pragma unroll
    for (int ks = 0; ks < 4; ++ks) { const bf16x8 pa = __builtin_bit_cast(bf16x8, (u32x4){pw[2 * ks][0], pw[2 * ks][1], pw[2 * ks + 1][0], pw[2 * ks + 1][1]}); const LAS bf16_t* VTt = ((ks < 2) ? KtA : KtB) + 4608;
#pragma unroll
        for (int dt = 0; dt < 4; ++dt) { const bf16x8 vb = *(const LAS bf16x8*)(VTt + (16 * dt + cl) * TS + 32 * (ks & 1) + 8 * q4); O[dt] = __builtin_amdgcn_mfma_f32_16x16x32_bf16(vb, pa, O[dt], 0, 0, 0); } }
    LDS_WAIT();
}

template <int MODE>
__device__ __forceinline__ void attn_pair_fast(const LAS bf16_t* KtA, const LAS bf16_t* KtB, LAS bf16_t* Pw, const bf16x8 (&qa)[2], const f32x4 bv0, int jA, int jB, int t0, int th, float slope2,
                                               u64 tselA, u64 tselB, f32x4 (&O)[4], float mrow, float& lrow, int lane) {
    const int cl = lane & 15, q4 = lane >> 4; constexpr int TS = 72, PP = 136;
    f32x4 s[8];
#pragma unroll
    for (int nt = 0; nt < 8; ++nt) { const LAS bf16_t* Kt = (nt < 4) ? KtA : KtB; s[nt] = bv0;
#pragma unroll
        for (int ks = 0; ks < 2; ++ks) { const bf16x8 kb = *(const LAS bf16x8*)(Kt + (16 * (nt & 3) + cl) * TS + 32 * ks + 8 * q4); s[nt] = __builtin_amdgcn_mfma_f32_16x16x32_bf16(kb, qa[ks], s[nt], 0, 0, 0); } }
    const float o16 = slope2 * 16.f, bA = slope2 * (float)(64 * jA - (t0 + 31)), bB = slope2 * (float)(64 * jB - (t0 + 31));
    bool okA = true, okB = true; if (MODE == 0) { okA = ((tselA >> (16 * th + cl)) & 1ull) != 0ull; okB = ((tselB >> (16 * th + cl)) & 1ull) != 0ull; }
    const float refA = okA ? (mrow - bA) : INFINITY, refB = okB ? (mrow - bB) : INFINITY;
    float rs = 0.f;
    unsigned pw[8][2];
#pragma unroll
    for (int nt = 0; nt < 8; ++nt) { float p[4]; const float refn = ((nt < 4) ? refA : refB) - (float)(nt & 3) * o16;
#pragma unroll
        for (int j = 0; j < 4; ++j) { p[j] = ex2(s[nt][j] - refn); rs += p[j]; }
        pw[nt][0] = pg8::cvt_pk_bf16(p[0], p[1]); pw[nt][1] = pg8::cvt_pk_bf16(p[2], p[3]); }
    rs += __shfl_xor(rs, 16); rs += __shfl_xor(rs, 32);
    lrow += rs;
#pragma unroll
    for (int ks = 0; ks < 4; ++ks) { const bf16x8 pa = __builtin_bit_cast(bf16x8, (u32x4){pw[2 * ks][0], pw[2 * ks][1], pw[2 * ks + 1][0], pw[2 * ks + 1][1]}); const LAS bf16_t* VTt = ((ks < 2) ? KtA : KtB) + 4608;
#pragma unroll
        for (int dt = 0; dt < 4; ++dt) { const bf16x8 vb = *(const LAS bf16x8*)(VTt + (16 * dt + cl) * TS + 32 * (ks & 1) + 8 * q4); O[dt] = __builtin_amdgcn_mfma_f32_16x16x32_bf16(vb, pa, O[dt], 0, 0, 0); } }
    LDS_WAIT();
}

constexpr int ATT_SET0 = 70656, ATT_SET1 = 107520, ATT_QL = 144384;
template <int MODE>
__device__ __forceinline__ void attn_branch(LAS unsigned char* lds, LAS bf16_t* Pw, const bf16_t* KV, const bf16_t* VT2, const float* GATEB, const bf16x8 (&qa)[2], f32x4 (&outacc)[4],
                                            u64 uni, u64 tselv, int b, int bg, int h, int t0, int th, float slope2
#if TSEG
                                            , unsigned long long& tseg_acc
#endif
                                            ) {
#if TSEG
    unsigned long long tseg_t = 0;
#endif
    const int tid = threadIdx.x, lane = tid & 63; constexpr int TS = 72;
    const size_t PLANE = (size_t)8 * 4 * 4096 * 64;
    f32x4 O[4]; float mrow = -INFINITY, lrow = 0.f;
#pragma unroll
    for (int j = 0; j < 4; ++j) O[j] = (f32x4){0.f, 0.f, 0.f, 0.f};
    const float k0f = (float)(4 * (lane >> 4)); const f32x4 bv0 = (f32x4){slope2 * k0f, slope2 * (k0f + 1.f), slope2 * (k0f + 2.f), slope2 * (k0f + 3.f)};
    const int jhi = (t0 + 31) >> 6; int jlo = 0; if (MODE == 1) { jlo = t0 - 511; jlo = jlo < 0 ? 0 : (jlo >> 6); }
    u64 rem = (MODE == 0) ? uni : ((jhi >= 63 ? ~0ull : ((1ull << (jhi + 1)) - 1ull)) & ~((1ull << jlo) - 1ull));
    const bf16_t* Ksrc = KV + (size_t)(MODE == 0 ? 2 : 4) * PLANE + (size_t)bg * 4096 * 64;
    const bf16_t* Vsrc = VT2 + ((size_t)MODE * 32 + bg) * 4096 * 64;
    const size_t toff = (size_t)tid * 8;
    const int loff = (tid >> 3) * TS + 8 * (tid & 7);
    u32x4 pkA, pvA, pkB, pvB;
    int a0 = -1, b0_ = -1, a1 = -1, b1 = -1;
#define ATT_TAKE(x) do { if (rem) { x = 63 - __builtin_clzll(rem); rem &= ~(1ull << x); } else x = -1; } while (0)
#define ATT_LOAD(ja, jb_) do { if ((ja) >= 0) { pkA = *(const u32x4*)(Ksrc + (size_t)(ja) * 4096 + toff); pvA = *(const u32x4*)(Vsrc + (size_t)(ja) * 4096 + toff); } \
                               if ((jb_) >= 0) { pkB = *(const u32x4*)(Ksrc + (size_t)(jb_) * 4096 + toff); pvB = *(const u32x4*)(Vsrc + (size_t)(jb_) * 4096 + toff); } } while (0)
#define ATT_PUT(setp, ja, jb_) do { if ((ja) >= 0) { *(LAS u32x4*)((setp) + loff) = pkA; *(LAS u32x4*)((setp) + 4608 + loff) = pvA; } \
                                    if ((jb_) >= 0) { *(LAS u32x4*)((setp) + 9216 + loff) = pkB; *(LAS u32x4*)((setp) + 13824 + loff) = pvB; } } while (0)
    ATT_TAKE(a0); ATT_TAKE(b0_);
    ATT_LOAD(a0, b0_);
    { LAS bf16_t* set0 = (LAS bf16_t*)(lds + ATT_SET0); ATT_PUT(set0, a0, b0_); }
    ATT_TAKE(a1); ATT_TAKE(b1);
    ATT_LOAD(a1, b1);
    LDS_BARRIER();
    int buf = 0;
#pragma unroll 1
    while (a0 >= 0) {
        LAS bf16_t* cur = (LAS bf16_t*)(lds + (buf ? ATT_SET1 : ATT_SET0)); LAS bf16_t* nxt = (LAS bf16_t*)(lds + (buf ? ATT_SET0 : ATT_SET1));
        int a2 = -1, b2 = -1;
        TS_B(10);
        if (a1 >= 0) { ATT_PUT(nxt, a1, b1); ATT_TAKE(a2); ATT_TAKE(b2); ATT_LOAD(a2, b2); }
        TS_E(10); TS_B(11);
        u64 tsA = ~0ull, tsB = ~0ull;
        if (MODE == 0) { tsA = ((u64)(unsigned)__builtin_amdgcn_readlane((int)(tselv >> 32), a0) << 32) | (unsigned)__builtin_amdgcn_readlane((int)(unsigned)tselv, a0);
            if (b0_ >= 0) tsB = ((u64)(unsigned)__builtin_amdgcn_readlane((int)(tselv >> 32), b0_) << 32) | (unsigned)__builtin_amdgcn_readlane((int)(unsigned)tselv, b0_); }
        const bool useA = ((tsA >> (16 * th)) & 0xFFFFull) != 0ull, useB = b0_ >= 0 && ((tsB >> (16 * th)) & 0xFFFFull) != 0ull;
        const bool edgeA = (64 * a0 + 63 > t0) || (MODE == 1 && (t0 + 31 - 64 * a0 >= 512));
        const bool edgeB = b0_ >= 0 && ((64 * b0_ + 63 > t0) || (MODE == 1 && (t0 + 31 - 64 * b0_ >= 512)));
        if (useA && useB && !edgeA && !edgeB) {
            const bool rA = MODE == 1 || ((tsA >> (16 * th + (lane & 15))) & 1ull), rB = MODE == 1 || ((tsB >> (16 * th + (lane & 15))) & 1ull);
            if (__any((rA || rB) && mrow == -INFINITY)) attn_pair<MODE>(cur, cur + 9216, Pw, qa, bv0, a0, b0_, t0, th, slope2, tsA, tsB, O, mrow, lrow, lane);
            else attn_pair_fast<MODE>(cur, cur + 9216, Pw, qa, bv0, a0, b0_, t0, th, slope2, tsA, tsB, O, mrow, lrow, lane); }
        else {
            if (useA) { if (edgeA) attn_tile2<MODE, true>(cur, cur + 4608, Pw, qa, bv0, a0, t0, th, slope2, tsA, O, mrow, lrow, lane); else attn_tile2<MODE, false>(cur, cur + 4608, Pw, qa, bv0, a0, t0, th, slope2, tsA, O, mrow, lrow, lane); LDS_WAIT(); }
            if (useB) { if (edgeB) attn_tile2<MODE, true>(cur + 9216, cur + 13824, Pw, qa, bv0, b0_, t0, th, slope2, tsB, O, mrow, lrow, lane); else attn_tile2<MODE, false>(cur + 9216, cur + 13824, Pw, qa, bv0, b0_, t0, th, slope2, tsB, O, mrow, lrow, lane); }
        }
        TS_E(11); TS_B(12);
        LDS_BARRIER();
        TS_E(12);
        a0 = a1; b0_ = b1; a1 = a2; b1 = b2; buf ^= 1;
    }
#undef ATT_TAKE
#undef ATT_LOAD
#undef ATT_PUT
    { const float gt = GATEB[((size_t)b * SEQ + t0 + 16 * th + (lane & 15)) * 48 + h * 3 + 1 + MODE];
      const float gsc = gt / (lrow > 0.f ? lrow : 1.0f);
#pragma unroll
      for (int dt = 0; dt < 4; ++dt) outacc[dt] = outacc[dt] + O[dt] * gsc; }
}

template <int NT>
__device__ __forceinline__ void cmp_scores(const LAS bf16_t* BUF0, unsigned (&pw)[16][2], LAS float* impw, const bf16x8 (&qa)[2], int t, float slope2, int lane) {
    constexpr int TS = 72, PS = 264, IP = 66;
    const int cl = lane & 15, q4 = lane >> 4;
    const int cmaxl = (t >= 31) ? (((t - 31) >> 4) < 254 ? ((t - 31) >> 4) : 254) : -1;
    f32x4 bq; { const float b0 = slope2 * (float)(16 * (4 * q4) + 31 - t); bq = (f32x4){b0, b0 + 16.f * slope2, b0 + 32.f * slope2, b0 + 48.f * slope2}; }
    const float o256 = 256.f * slope2;
    f32x4 s[NT]; float cm = -INFINITY;
#pragma unroll
    for (int nt = 0; nt < NT; ++nt) { s[nt] = bq + (float)nt * o256;
#pragma unroll
        for (int ks = 0; ks < 2; ++ks) { const bf16x8 kb = *(const LAS bf16x8*)(BUF0 + (16 * nt + cl) * TS + 32 * ks + 8 * q4); s[nt] = __builtin_amdgcn_mfma_f32_16x16x32_bf16(kb, qa[ks], s[nt], 0, 0, 0); } }
#pragma unroll
    for (int nt = 0; nt < NT; ++nt) {
        if (nt >= NT - 5) {
#pragma unroll
            for (int j = 0; j < 4; ++j) { const bool ok = (16 * nt + 4 * q4 + j) <= cmaxl; s[nt][j] = ok ? s[nt][j] : -INFINITY; } }
        cm = fmaxf(cm, fmaxf(fmaxf(s[nt][0], s[nt][1]), fmaxf(s[nt][2], s[nt][3]))); }
    cm = fmaxf(cm, __shfl_xor(cm, 16)); cm = fmaxf(cm, __shfl_xor(cm, 32));
    cm = (cm == -INFINITY) ? 0.f : cm;
    float cs = 0.f;
#pragma unroll
    for (int nt = 0; nt < NT; ++nt)
#pragma unroll
        for (int j = 0; j < 4; ++j) { const float e = ex2(s[nt][j] - cm); s[nt][j] = e; cs += e; }
    cs += __shfl_xor(cs, 16); cs += __shfl_xor(cs, 32);
    const float cinv = 1.0f / (cs > 0.f ? cs : 1.0f);
#pragma unroll
    for (int nt = 0; nt < NT; ++nt) { float p[4];
#pragma unroll
        for (int j = 0; j < 4; ++j) { p[j] = s[nt][j] * cinv; s[nt][j] = p[j]; }
        pw[nt][0] = pg8::cvt_pk_bf16(p[0], p[1]); pw[nt][1] = pg8::cvt_pk_bf16(p[2], p[3]);
        impw[cl * IP + 4 * nt + q4] = (p[0] + p[1]) + (p[2] + p[3]); }
#pragma unroll
    for (int nt = 0; nt < NT; ++nt) { if (nt < 15 || q4 < 3) __hip_atomic_fetch_add(impw + cl * IP + 4 * nt + q4 + 1, s[nt][3], __ATOMIC_RELAXED, __HIP_MEMORY_SCOPE_WORKGROUP); }
}
template <int NK>
__device__ __forceinline__ void cmp_pv(const LAS bf16_t* BUF0, const unsigned (&pw)[16][2], f32x4 (&oc)[4], int lane) {
    constexpr int PS = 264; const int cl = lane & 15, q4 = lane >> 4;
#pragma unroll
    for (int ks = 0; ks < NK; ++ks) { const bf16x8 pa = __builtin_bit_cast(bf16x8, (u32x4){pw[2 * ks][0], pw[2 * ks][1], pw[2 * ks + 1][0], pw[2 * ks + 1][1]});
#pragma unroll
        for (int dt = 0; dt < 4; ++dt) { const bf16x8 vb = *(const LAS bf16x8*)(BUF0 + (16 * dt + cl) * PS + 32 * ks + 8 * q4); oc[dt] = __builtin_amdgcn_mfma_f32_16x16x32_bf16(vb, pa, oc[dt], 0, 0, 0); } }
}

__device__ __forceinline__ void attn_phase(LAS unsigned char* lds, const bf16_t* KV, const bf16_t* VT2, const bf16_t* QB, const float* GATEB, const bf16_t* KC, const bf16_t* VCT, bf16_t* OB, int wgc, int G) {
    const int tid = threadIdx.x, wave = __builtin_amdgcn_readfirstlane(tid >> 6), lane = tid & 63, cl = lane & 15, q4 = lane >> 4;
    constexpr int TS = 72, PS = 264, IP = 66;
    LAS bf16_t* KCs = (LAS bf16_t*)(lds + 0);
    LAS bf16_t* VCTs = (LAS bf16_t*)(lds + 36864);
    LAS bf16_t* Pw = (LAS bf16_t*)(lds + ATT_SET0);
    LAS float* IMP = (LAS float*)(lds + ATT_SET1);
    LAS u64* SEL = (LAS u64*)(lds + ATT_SET1 + 33792);
    const float LOG2E = 1.4426950408889634f;
#if TSEG
    unsigned long long tseg_acc = 0, tseg_t = 0;
#endif
    const int nj = G < 8 ? G : 8, nslot = G / nj, js0 = wgc % nj, slot = wgc / nj, cb = (128 - js0 + nj - 1) / nj;
    int bg_loaded = -1;
    for (int it = 0; slot < nslot; ++it) {
        const int bg = slot + (it / cb) * nslot; if (bg >= 32) break;
        const int uu = js0 + (it % cb) * nj, i = uu >> 3, js = uu & 7;
        const int qt = 8 * i + ((i & 1) ? 7 - js : js);
        if (bg != bg_loaded) { bg_loaded = bg;
            __syncthreads();
#pragma unroll
            for (int k = 0; k < 4; ++k) { const int id = tid + 512 * k, row = id >> 3, cc = id & 7; *(LAS u32x4*)(KCs + row * TS + 8 * cc) = *(const u32x4*)(KC + ((size_t)bg * 256 + row) * 64 + 8 * cc); }
#pragma unroll
            for (int k = 0; k < 4; ++k) { const int id = tid + 512 * k, d = id >> 5, cc = id & 31; *(LAS u32x4*)(VCTs + d * PS + 8 * cc) = *(const u32x4*)(VCT + ((size_t)bg * 64 + d) * 256 + 8 * cc); }
            __syncthreads(); }
        const int b = bg >> 2, g = bg & 3, t0 = qt * 32;
        TS_B(1);
        const int r = wave >> 1, th = wave & 1, h = 4 * g + r;
        const float slope2 = exp2f(-0.5f * (float)(h + 1)) * LOG2E;
        LAS unsigned char* ql = lds + ATT_QL + wave * 2048;
#define ATT_QDMA(bg_, qt_) do { const bf16_t* qsrc = QB + ((size_t)((bg_) >> 2) * SEQ + (qt_) * 32 + 16 * th + (lane >> 3)) * 1024 + (4 * ((bg_) & 3) + r) * 64 + 8 * (lane & 7); \
            __builtin_amdgcn_global_load_lds((const unsigned*)qsrc, (LAS unsigned*)ql, 16, 0, 0); __builtin_amdgcn_global_load_lds((const unsigned*)(qsrc + 8 * 1024), (LAS unsigned*)(ql + 1024), 16, 0, 0); } while (0)
        if (it == 0) ATT_QDMA(bg, qt);
        asm volatile("s_waitcnt vmcnt(0)" ::: "memory");
        bf16x8 qa[2];
        qa[0] = *(const LAS bf16x8*)(ql + cl * 128 + 16 * q4); qa[1] = *(const LAS bf16x8*)(ql + cl * 128 + 64 + 16 * q4);
        LDS_WAIT();
        { const int it1 = it + 1, bgn = slot + (it1 / cb) * nslot, uun = js0 + (it1 % cb) * nj, in_ = uun >> 3, jsn = uun & 7;
          if (bgn < 32) ATT_QDMA(bgn, 8 * in_ + ((in_ & 1) ? 7 - jsn : jsn)); }
#undef ATT_QDMA
        f32x4 outacc[4];
        TS_E(1); TS_B(2);
        const int ng = (t0 >> 10) + 1;
        unsigned cpw[16][2];
        {   LAS float* impw = IMP + wave * (16 * IP);
            const int t = t0 + 16 * th + cl;
            if (ng == 1) cmp_scores<4>(KCs, cpw, impw, qa, t, slope2, lane);
            else if (ng == 2) cmp_scores<8>(KCs, cpw, impw, qa, t, slope2, lane);
            else if (ng == 3) cmp_scores<12>(KCs, cpw, impw, qa, t, slope2, lane);
            else cmp_scores<16>(KCs, cpw, impw, qa, t, slope2, lane);
        }
        TS_E(2); TS_B(3);
        __syncthreads();
        TS_E(3); TS_B(4);
        {   u64 key[4], pre[4];
#pragma unroll
            for (int e = 0; e < 4; ++e) { const int tk = 4 * wave + e, tt = t0 + tk, cur = tt >> 6;
                float v = 0.f;
#pragma unroll
                for (int rr = 0; rr < 4; ++rr) v += IMP[((2 * rr + (tk >> 4)) * 16 + (tk & 15)) * IP + lane];
                const bool forced = (lane == 0) || (lane == cur) || (lane == cur - 1);
                v = fmaxf(v, 0.f); if (forced) v = 1e4f;
                const bool valid = lane <= cur;
                key[e] = valid ? (((u64)__builtin_bit_cast(unsigned, v) << 6) | (u64)(63 - lane)) + 1ull : 0ull;
                pre[e] = 0ull; }
            int open = 0;
#pragma unroll
            for (int e = 0; e < 4; ++e) open |= (((t0 + 4 * wave + e) >> 6) >= 16) ? (1 << e) : 0;
#pragma unroll 1
            for (int bit = 36; bit >= 0 && open; --bit) { const u64 bm = 1ull << bit;
#pragma unroll
                for (int e = 0; e < 4; ++e) { const u64 cand = pre[e] | bm; const int cnt = __popcll(__ballot(key[e] >= cand)); pre[e] = (cnt >= 16) ? cand : pre[e]; if (cnt == 16) open &= ~(1 << e); } }
#pragma unroll
            for (int e = 0; e < 4; ++e) { const u64 msk = __ballot(key[e] >= (pre[e] ? pre[e] : 1ull)); if (lane == 0) SEL[4 * wave + e] = msk; }
        }
        TS_E(4); TS_B(6);
        {
            f32x4 oc[4];
#pragma unroll
            for (int dt = 0; dt < 4; ++dt) oc[dt] = (f32x4){0.f, 0.f, 0.f, 0.f};
            if (ng == 1) cmp_pv<2>(VCTs, cpw, oc, lane); else if (ng == 2) cmp_pv<4>(VCTs, cpw, oc, lane); else if (ng == 3) cmp_pv<6>(VCTs, cpw, oc, lane); else cmp_pv<8>(VCTs, cpw, oc, lane);
            const float gc = GATEB[((size_t)b * SEQ + t0 + 16 * th + cl) * 48 + h * 3];
#pragma unroll
            for (int dt = 0; dt < 4; ++dt) outacc[dt] = oc[dt] * gc;
        }
        TS_E(6); TS_B(5);
        __syncthreads();
        TS_E(5); TS_B(7);
        u64 tselv = 0ull;
#pragma unroll 8
        for (int tk = 0; tk < 32; ++tk) { const u64 sv = SEL[tk]; tselv |= ((sv >> lane) & 1ull) << tk; }
        const u64 uni = __ballot(tselv != 0ull);
        TS_E(7); TS_B(8);
#if TSEG
        attn_branch<0>(lds, Pw, KV, VT2, GATEB, qa, outacc, uni, tselv, b, bg, h, t0, th, slope2, tseg_acc);
#else
        attn_branch<0>(lds, Pw, KV, VT2, GATEB, qa, outacc, uni, tselv, b, bg, h, t0, th, slope2);
#endif
        TS_E(8); TS_B(9);
#if TSEG
        attn_branch<1>(lds, Pw, KV, VT2, GATEB, qa, outacc, uni, tselv, b, bg, h, t0, th, slope2, tseg_acc);
#else
        attn_branch<1>(lds, Pw, KV, VT2, GATEB, qa, outacc, uni, tselv, b, bg, h, t0, th, slope2);
#endif
        TS_E(9);
        { bf16_t* op = OB + ((size_t)b * SEQ + t0 + 16 * th + cl) * 1024 + h * 64 + 4 * q4;
#pragma unroll
          for (int dt = 0; dt < 4; ++dt) { u32x2 w; w.x = pg8::cvt_pk_bf16(outacc[dt][0], outacc[dt][1]); w.y = pg8::cvt_pk_bf16(outacc[dt][2], outacc[dt][3]); *(u32x2*)(op + 16 * dt) = w; } }
    }
#if TSEG
    { const unsigned long long w0 = __builtin_amdgcn_s_memrealtime(); while (__builtin_amdgcn_s_memrealtime() - w0 < 2 * tseg_acc) __builtin_amdgcn_s_sleep(8); }
#endif
}

constexpr int NPHASE = 20;
__global__ void __launch_bounds__(NTHR, 2) yoco_fwd(Args args) {
    extern __shared__ __attribute__((aligned(16))) unsigned char lds_raw[];
    LAS unsigned char* lds = (LAS unsigned char*)lds_raw;
    volatile LAS unsigned* MISC = (volatile LAS unsigned*)(lds + MISC_OFF);
    const int tid = threadIdx.x, lane = tid & 63, wave = __builtin_amdgcn_readfirstlane(tid >> 6);
    const int G = gridDim.x, bx = blockIdx.x;
    const int vcu = (G % 8 == 0) ? (bx % 8) * (G / 8) + bx / 8 : bx;
    const int gw = vcu * NWAVES + wave, NGW = G * NWAVES;
    unsigned char* ws = args.ws;
    unsigned* ctl = (unsigned*)(ws + WS_CTL);
    if (tid < 64) MISC[tid] = 0u;
    __syncthreads();
    XcdBarrier bar; bar.bar = ctl + CW_BAR; bar.x = 0; bar.st = MISC + 60;
    if (!MK_PER_PHASE) bar = xcd_barrier_post(ctl + CW_BAR, MISC + 60);
    const int lo = args.ph_lo, hi = args.ph_hi;
#ifndef PHMASK
#define PHMASK 0xFFFFFFu
#endif
#ifndef PROBE_SKIP
#define PROBE_SKIP 0
#endif
constexpr unsigned PHSKIP = 0u;
#define IN(k) ((((PHMASK & ~PHSKIP) >> (k)) & 1u) && lo <= (k) && (k) < hi)
#ifndef P0REP
#define P0REP 0
#endif
#ifndef REPMASK
#define REPMASK 0x0u
#endif
#define PH(k) for (int _r = 0, _n = IN(k) ? ((((REPMASK) >> (k)) & 1u) ? 2 : 1) : 0; _r < _n; ++_r)
#ifndef PHT
#define PHT -1
#endif
#if PHT >= 0
    unsigned long long pht_t = __builtin_amdgcn_s_memrealtime();
#define SEAM(k) do { if (PHT == (k)) { const unsigned long long d_ = __builtin_amdgcn_s_memrealtime() - pht_t, w0_ = __builtin_amdgcn_s_memrealtime(); while (__builtin_amdgcn_s_memrealtime() - w0_ < d_) __builtin_amdgcn_s_sleep(8); } \
        if (lo <= (k) && (k) + 1 < hi) xcd_barrier(bar); pht_t = __builtin_amdgcn_s_memrealtime(); } while (0)
#else
#define SEAM(k) do { if (lo <= (k) && (k) + 1 < hi) xcd_barrier(bar); } while (0)
#endif

    const float* x = A_IN(I_X);
    float* xs = args.out;
    bf16_t* XH = (bf16_t*)(ws + WS_XH);
    float* GA = (float*)(ws + WS_GA);
    float* bias1 = (float*)(ws + WS_SMALL);
    unsigned* EIDX = (unsigned*)(ws + WS_SMALL + 8192);
    float* EW = (float*)(ws + WS_SMALL + 8192 + 131072);
    u32x2* ROWINFO = (u32x2*)(ws + WS_ROWINFO);

    PH(0) {
        for (int _q = 0; _q < ((P0REP & 1) ? 2 : 1); ++_q) p0_weights(ws, lds, gw, NGW, wave, lane);
        __syncthreads();
        LAS float* Wg = (LAS float*)lds;
        for (int i = tid; i < 8192; i += NTHR) { const int k = i >> 3, e = i & 7; Wg[(e >> 2) * 4096 + ((((k >> 8) * 4 + (k & 3)) * 64 + ((k & 255) >> 2)) << 2) + (e & 3)] = A_IN(I_A_W_IN)[(size_t)k * NPROJ_SRC + 4096 + e] * A_IN(I_NORM_MIX)[k]; }
        __syncthreads();
        for (int _q = 0; _q < ((P0REP & 2) ? 2 : 1); ++_q) {
        f32x4 vn[4]; if (gw < M) load_row(x + (size_t)gw * D, lane, vn);
        for (int m = gw; m < M; m += NGW) {
            f32x4 v[4];
#pragma unroll
            for (int j = 0; j < 4; ++j) v[j] = vn[j];
            load_row(x + (size_t)(m + NGW < M ? m + NGW : m) * D, lane, vn);
            const float rstd = row_rstd(v);
            store_row_bf16(XH + (size_t)m * D, lane, v, rstd);
            float gsum[8];
#pragma unroll
            for (int e = 0; e < 8; ++e) gsum[e] = 0.f;
#pragma unroll
            for (int j = 0; j < 4; ++j)
#pragma unroll
                for (int c = 0; c < 4; ++c) { const f32x4 w0 = *(const LAS f32x4*)(Wg + (((j * 4 + c) * 64 + lane) << 2)), w1 = *(const LAS f32x4*)(Wg + 4096 + (((j * 4 + c) * 64 + lane) << 2)); const float xv = v[j][c];
                    gsum[0] += xv * w0.x; gsum[1] += xv * w0.y; gsum[2] += xv * w0.z; gsum[3] += xv * w0.w; gsum[4] += xv * w1.x; gsum[5] += xv * w1.y; gsum[6] += xv * w1.z; gsum[7] += xv * w1.w; }
#pragma unroll
            for (int e = 0; e < 8; ++e) gsum[e] = wave_sum(gsum[e]) * rstd + A_IN(I_A_B_GATE)[e];
            if (lane == 0) {
#pragma unroll
                for (int e = 0; e < 4; ++e) GA[(size_t)m * 8 + e] = gsum[e];
#pragma unroll
                for (int e = 4; e < 8; ++e) { const float g = gsum[e]; GA[(size_t)m * 8 + e] = fminf(g, 0.f) - log1pf(__expf(-fabsf(g))); } }
        }
        }
        __syncthreads();
        for (int it = bx; it < 256; it += G) { const int c = it >> 7, nb = (it >> 4) & 7, fc = it & 15, n = nb * 32 + (tid & 31), fs = tid >> 5; float s = 0.f;
#pragma unroll
            for (int k = 0; k < 8; ++k) { const int f = fc * 128 + fs * 8 + k; s += A_IN(I_B_CMP_POS)[((f >> 6) * 2 + c) * 64 + (f & 63)] * A_IN(I_B_CMP_W1)[((size_t)c * 2048 + f) * 256 + n]; }
            LAS float* red = (LAS float*)lds; __syncthreads(); red[tid] = s; __syncthreads();
            if (tid < 32) { float t = 0.f; for (int k = 0; k < 16; ++k) t += red[k * 32 + tid]; ((float*)(ws + WS_SMALL + 401408))[(c * 256 + n) * 16 + fc] = t; }
            __syncthreads(); }
    }
    SEAM(0);
    PH(1) { if (bx == 0) { const float* bp = (const float*)(ws + WS_SMALL + 401408) + tid * 16; float t = 0.f; for (int k = 0; k < 16; ++k) t += bp[k]; bias1[tid] = t; }
        pg8::PlainOrder S; S.init(XH, (const bf16_t*)(ws + WS_WIN), M, NPROJ, D, D, G, bx); pg8::EpiProjSplit E{(bf16_t*)(ws + WS_PROJ3), (bf16_t*)(ws + WS_OG)};
        pg8::gemm_phase(lds, pg8::Dims{D, D, D}, S, E); }
    SEAM(1);
    PH(2) scanprep_phase(lds, (const bf16_t*)(ws + WS_PROJ3), GA, A_IN(I_A_CONV), ws + WS_IMG, vcu, G);
    SEAM(2);
    PH(3) scan_phase(lds, ws + WS_IMG, (float*)(ws + WS_HS), (float*)(ws + WS_DN), vcu, G);
    SEAM(3);
    PH(4) {
        const float* HS = (const float*)(ws + WS_HS); const float* DN = (const float*)(ws + WS_DN); const bf16_t* OG = (const bf16_t*)(ws + WS_OG); bf16_t* HN = (bf16_t*)(ws + WS_HN);
        f32x4 vn[4], dnn; u32x2 ogn[4];
#define P4_LOAD(mm) do { load_row(HS + (size_t)(mm) * D, lane, vn); dnn = *(const f32x4*)(DN + (size_t)(mm) * 4); \
            _Pragma("unroll") for (int j = 0; j < 4; ++j) ogn[j] = *(const u32x2*)(OG + (size_t)(mm) * D + 4 * lane + 256 * j); } while (0)
        P4_LOAD(gw < M ? gw : 0);
        f32x4 gvv[4];
#pragma unroll
        for (int j = 0; j < 4; ++j) gvv[j] = *((const f32x4*)A_IN(I_A_NORM_H) + lane + 64 * j);
        for (int m = gw; m < M; m += NGW) { f32x4 v[4]; u32x2 og[4]; const f32x4 dn = dnn;
#pragma unroll
            for (int j = 0; j < 4; ++j) { v[j] = vn[j]; og[j] = ogn[j]; }
            P4_LOAD(m + NGW < M ? m + NGW : m);
            u64* o8 = (u64*)(HN + (size_t)m * D) + lane;
#pragma unroll
            for (int j = 0; j < 4; ++j) { v[j] = v[j] * (1.0f / dn[j]); float s = (v[j].x * v[j].x + v[j].y * v[j].y) + (v[j].z * v[j].z + v[j].w * v[j].w); s = wave_sum(s);
                const float rs = 1.0f / sqrtf(s * (1.f / 256.f) + EPS);
                const u32x2 oraw = og[j]; const f32x4 gv = gvv[j];
                const float o0 = v[j].x * rs * gv.x * sigmoidf_(bflo(oraw.x)), o1 = v[j].y * rs * gv.y * sigmoidf_(bfhi(oraw.x)), o2 = v[j].z * rs * gv.z * sigmoidf_(bflo(oraw.y)), o3 = v[j].w * rs * gv.w * sigmoidf_(bfhi(oraw.y));
                o8[64 * j] = (u64)pk2(o0, o1) | ((u64)pk2(o2, o3) << 32); } }
#undef P4_LOAD
    }
    SEAM(4);
    PH(5) { pg8::PlainOrder S; S.init((const bf16_t*)(ws + WS_HN), (const bf16_t*)(ws + WS_WOUTA), M, D, D, D, G, bx); pg8::EpiRes16<false, true> E{x, XH, (float*)(ws + WS_SSP), D};
        pg8::gemm_phase(lds, pg8::Dims{D, D, D}, S, E); }
    SEAM(5);
    PH(6) { const float* sp = (const float*)(ws + WS_SSP); float* rs = (float*)(ws + WS_RS);
        for (int r = bx * NTHR + tid; r < M; r += G * NTHR) rs[r] = pg8::row_rs16(sp, r); }
    SEAM(6);
    PH(7) { pg8::PlainOrder S; S.init(XH, (const bf16_t*)(ws + WS_WGU), M, 2 * FFD, D, D, G, bx); pg8::EpiSwiGLU E{(bf16_t*)(ws + WS_ACT), FFD, (const float*)(ws + WS_RS)};
        if (EXPT && _r == 1) { S.same = 11; E.O = (bf16_t*)(ws + WS_END2); }
#if TPROBE
        float* tkp = (float*)(ws + WS_END2 + 2 * MiB); const unsigned long long tp0 = __builtin_amdgcn_s_memrealtime();
        pg8::gemm_phase(lds, pg8::Dims{D, D, D, 127, 127, bx == 0 ? tkp : nullptr}, S, E);
        if (bx == 0 && tid == 0) tkp[2] = (float)(__builtin_amdgcn_s_memrealtime() - tp0);
#else
        pg8::gemm_phase(lds, pg8::Dims{D, D, D}, S, E);
#endif
    }
    SEAM(7);
    PH(8) { pg8::PlainOrder S; S.init((const bf16_t*)(ws + WS_ACT), (const bf16_t*)(ws + WS_WDOWN), M, D, FFD, FFD, G, bx); pg8::EpiRes16<true, true> E{nullptr, XH, (float*)(ws + WS_SSP), D};
        pg8::gemm_phase(lds, pg8::Dims{FFD, FFD, FFD}, S, E); }
    SEAM(8);
    PH(9) { const float* sp = (const float*)(ws + WS_SSP); float* rs = (float*)(ws + WS_RS);
        for (int r = bx * NTHR + tid; r < M; r += G * NTHR) rs[r] = pg8::row_rs16(sp, r); }
    SEAM(9);
    PH(10) { pg8::PlainOrder S; S.init(XH, (const bf16_t*)(ws + WS_WKVQ), M, NKVQ, D, D, G, bx); pg8::EpiKVQ E{(bf16_t*)(ws + WS_KV), (bf16_t*)(ws + WS_QB), (float*)(ws + WS_GATEB), A_IN(I_B_B_GATE), (const float*)(ws + WS_RS)};
        pg8::gemm_phase(lds, pg8::Dims{D, D, D}, S, E); }
    SEAM(10);
    PH(11) {
        struct CmpOrder { int G, c; const char* A; const char* B;
            __device__ __forceinline__ bool next(int i, pg8::Unit& u) const { const int L = i * G + c; if (L >= 64) return false; u.pm = L; u.pn = 0; u.a = A + (size_t)L * 256 * 1024 * 2; u.b = B + (size_t)(L >> 5) * 256 * 2048 * 2; return true; } };
        CmpOrder S{G, bx, (const char*)(ws + WS_KV), (const char*)(ws + WS_WCMP1)}; pg8::EpiCmp E{(bf16_t*)(ws + WS_HID), bias1};
        if (bx < 64 || G <= 64) pg8::gemm_phase(lds, pg8::Dims{2048, 1024, 2048}, S, E);
        if (bx >= 64 || G <= 64) {
        { LAS bf16_t* T = (LAS bf16_t*)lds; const size_t PLANE = (size_t)8 * 4 * 4096 * 64;
          for (int it = (G <= 64) ? bx : bx - 64; it < 4096; it += (G <= 64) ? G : G - 64) { const int mode = it >> 11, rest = it & 2047;
              const bf16_t* src = (const bf16_t*)(ws + WS_KV) + (size_t)(mode == 0 ? 3 : 5) * PLANE + (size_t)rest * 4096; bf16_t* dst = (bf16_t*)(ws + WS_VT2) + ((size_t)mode * 2048 + rest) * 4096;
              const int row = tid >> 3, cc = tid & 7; const u32x4 raw = *(const u32x4*)(src + (size_t)tid * 8);
              const int prow = (row & 32) | (((row >> 2) & 3) << 3) | (((row >> 4) & 1) << 2) | (row & 3);
              __syncthreads();
              T[(8 * cc + 0) * 72 + prow] = (bf16_t)(raw.x & 0xffff); T[(8 * cc + 1) * 72 + prow] = (bf16_t)(raw.x >> 16); T[(8 * cc + 2) * 72 + prow] = (bf16_t)(raw.y & 0xffff); T[(8 * cc + 3) * 72 + prow] = (bf16_t)(raw.y >> 16);
              T[(8 * cc + 4) * 72 + prow] = (bf16_t)(raw.z & 0xffff); T[(8 * cc + 5) * 72 + prow] = (bf16_t)(raw.z >> 16); T[(8 * cc + 6) * 72 + prow] = (bf16_t)(raw.w & 0xffff); T[(8 * cc + 7) * 72 + prow] = (bf16_t)(raw.w >> 16);
              __syncthreads();
              *(u32x4*)(dst + (size_t)tid * 8) = *(const LAS u32x4*)(T + row * 72 + 8 * cc); } }
        } }
    SEAM(11);
    PH(12) { const bf16_t* HID = (const bf16_t*)(ws + WS_HID); const bf16_t* W2T = (const bf16_t*)(ws + WS_W2T);
        if (gw < 512) { const int c = gw >> 8, r0 = 32 * (gw & 255); const int cl = lane & 15, q4 = lane >> 4;
            f32x4 acc[2][4];
#pragma unroll
            for (int rt = 0; rt < 2; ++rt)
#pragma unroll
                for (int dt = 0; dt < 4; ++dt) acc[rt][dt] = (f32x4){0.f, 0.f, 0.f, 0.f};
            const bf16_t* hp = HID + ((size_t)c * 8192 + r0 + cl) * 256 + 8 * q4; const bf16_t* wp = W2T + ((size_t)c * 64 + cl) * 256 + 8 * q4;
#pragma unroll 2
            for (int ks = 0; ks < 8; ++ks) { bf16x8 a[2], w[4];
#pragma unroll
                for (int rt = 0; rt < 2; ++rt) a[rt] = *(const bf16x8*)(hp + (size_t)rt * 16 * 256 + 32 * ks);
#pragma unroll
                for (int dt = 0; dt < 4; ++dt) w[dt] = *(const bf16x8*)(wp + (size_t)dt * 16 * 256 + 32 * ks);
#pragma unroll
                for (int rt = 0; rt < 2; ++rt)
#pragma unroll
                    for (int dt = 0; dt < 4; ++dt) acc[rt][dt] = (c == 0) ? __builtin_amdgcn_mfma_f32_16x16x32_bf16(w[dt], a[rt], acc[rt][dt], 0, 0, 0) : __builtin_amdgcn_mfma_f32_16x16x32_bf16(a[rt], w[dt], acc[rt][dt], 0, 0, 0); }
#pragma unroll
            for (int rt = 0; rt < 2; ++rt)
#pragma unroll
                for (int dt = 0; dt < 4; ++dt) { u32x2 p; p.x = pk2(acc[rt][dt][0], acc[rt][dt][1]); p.y = pk2(acc[rt][dt][2], acc[rt][dt][3]);
                    if (c == 0) *(u32x2*)((bf16_t*)(ws + WS_KC) + (size_t)(r0 + 16 * rt + cl) * 64 + 16 * dt + 4 * q4) = p;
                    else { const int R = r0 + 16 * rt + 4 * q4, cidx = R & 255, pc = (cidx & ~31) | (((cidx >> 2) & 3) << 3) | (((cidx >> 4) & 1) << 2);
                        *(u32x2*)((bf16_t*)(ws + WS_VC) + ((size_t)(R >> 8) * 64 + 16 * dt + cl) * 256 + pc) = p; } }
        }
    }
    SEAM(12);
    PH(13) attn_phase(lds, (const bf16_t*)(ws + WS_KV), (const bf16_t*)(ws + WS_VT2), (const bf16_t*)(ws + WS_QB), (const float*)(ws + WS_GATEB), (const bf16_t*)(ws + WS_KC), (const bf16_t*)(ws + WS_VC), (bf16_t*)(ws + WS_OB), bx, G);
    SEAM(13);
    PH(14) { pg8::PlainOrder S; S.init((const bf16_t*)(ws + WS_OB), (const bf16_t*)(ws + WS_WOUTB), M, D, D, D, G, bx); pg8::EpiRes16<true, false> E{nullptr, XH, nullptr, D};
        pg8::gemm_phase(lds, pg8::Dims{D, D, D}, S, E); }
    SEAM(14);
    PH(15) {
        LAS float* Wr = (LAS float*)lds;
        for (int i = tid; i < 8192; i += NTHR) { const int k = i >> 3, e = i & 7; Wr[(e >> 2) * 4096 + ((((k >> 8) * 4 + (k & 3)) * 64 + ((k & 255) >> 2)) << 2) + (e & 3)] = A_IN(I_M_ROUTER)[i] * A_IN(I_NORM_FFN)[1024 + k]; }
        __syncthreads();
        u32x2 rn[4];
#pragma unroll
        for (int j = 0; j < 4; ++j) rn[j] = *(const u32x2*)(XH + (size_t)(gw < M ? gw : 0) * D + 4 * lane + 256 * j);
        for (int m = gw; m < M; m += NGW) {
            f32x4 v[4];
#pragma unroll
            for (int j = 0; j < 4; ++j) v[j] = (f32x4){bflo(rn[j].x), bfhi(rn[j].x), bflo(rn[j].y), bfhi(rn[j].y)};
#pragma unroll
            for (int j = 0; j < 4; ++j) rn[j] = *(const u32x2*)(XH + (size_t)(m + NGW < M ? m + NGW : m) * D + 4 * lane + 256 * j);
            const float rstd = row_rstd(v);
            if (lane == 0) ((float*)(ws + WS_RS))[m] = rstd;
            float gsum[8];
#pragma unroll
            for (int e = 0; e < 8; ++e) gsum[e] = 0.f;
#pragma unroll
            for (int j = 0; j < 4; ++j)
#pragma unroll
                for (int c = 0; c < 4; ++c) { const f32x4 w0 = *(const LAS f32x4*)(Wr + (((j * 4 + c) * 64 + lane) << 2)), w1 = *(const LAS f32x4*)(Wr + 4096 + (((j * 4 + c) * 64 + lane) << 2)); const float xv = v[j][c];
                    gsum[0] += xv * w0.x; gsum[1] += xv * w0.y; gsum[2] += xv * w0.z; gsum[3] += xv * w0.w; gsum[4] += xv * w1.x; gsum[5] += xv * w1.y; gsum[6] += xv * w1.z; gsum[7] += xv * w1.w; }
#pragma unroll
            for (int e = 0; e < 8; ++e) gsum[e] = wave_sum(gsum[e]) * rstd;
            if (lane == 0) { int e1 = 0; float v1 = gsum[0];
#pragma unroll
                for (int e = 1; e < 8; ++e) if (gsum[e] > v1) { v1 = gsum[e]; e1 = e; }
                int e2 = -1; float v2 = -INFINITY;
#pragma unroll
                for (int e = 0; e < 8; ++e) if (e != e1 && gsum[e] > v2) { v2 = gsum[e]; e2 = e; }
                const float ex = __expf(v2 - v1), w1 = 1.0f / (1.0f + ex), w2 = ex * w1;
                EIDX[m] = (unsigned)e1 | ((unsigned)e2 << 8); EW[2 * (size_t)m] = w1; EW[2 * (size_t)m + 1] = w2;
                int* cc = (int*)(ws + WS_CTL + 524288) + (m >> 7) * 8; atomicAdd(cc + e1, 1); atomicAdd(cc + e2, 1); }
        }
    }
    SEAM(15);
    volatile LAS int* tb = (volatile LAS int*)(lds + MISC_OFF);
    PH(16) {
        LAS int* cnt_all = (LAS int*)lds;
        LAS int* posl = (LAS int*)(lds + 256);
        bf16_t* XG = (bf16_t*)(ws + WS_XG);
        for (int ch = bx; ch < M / 128; ch += G) {
            __syncthreads();
            if (tid < 16) cnt_all[tid] = 0;
            __syncthreads();
            int ct[8], cb[8];
#pragma unroll
            for (int e = 0; e < 8; ++e) { ct[e] = 0; cb[e] = 0; }
            if (tid < M / 128) { const int* cc = (const int*)(ws + WS_CTL + 524288) + tid * 8; const bool before = tid < ch;
#pragma unroll
                for (int e = 0; e < 8; ++e) { const int hit = cc[e]; ct[e] = hit; cb[e] = before ? hit : 0; } }
#pragma unroll
            for (int e = 0; e < 8; ++e) { int a = ct[e], b2 = cb[e];
#pragma unroll
                for (int o = 1; o < 64; o <<= 1) { a += __shfl_xor(a, o); b2 += __shfl_xor(b2, o); }
                if (lane == 0) { atomicAdd((int*)&cnt_all[e], a); atomicAdd((int*)&cnt_all[8 + e], b2); } }
            __syncthreads();
            if (wave == 0) {
                int base[8]; int run = 0;
#pragma unroll
                for (int e = 0; e < 8; ++e) { base[e] = run * 256 + cnt_all[8 + e]; run += (cnt_all[e] + 255) >> 8; }
#pragma unroll 1
                for (int half = 0; half < 2; ++half) { const int m = ch * 128 + half * 64 + lane; const unsigned ei = EIDX[m]; const int e1 = ei & 255, e2 = (ei >> 8) & 255;
                    int p1 = 0, p2 = 0;
#pragma unroll
                    for (int e = 0; e < 8; ++e) { const u64 mk = __ballot(e1 == e || e2 == e); const int rk = __popcll(mk & ((1ull << lane) - 1ull));
                        if (e1 == e) p1 = base[e] + rk; if (e2 == e) p2 = base[e] + rk; base[e] += __popcll(mk); }
                    posl[(half * 64 + lane) * 2] = p1; posl[(half * 64 + lane) * 2 + 1] = p2;
                    ROWINFO[p1] = (u32x2){(unsigned)m << 1, __builtin_bit_cast(unsigned, EW[2 * (size_t)m])};
                    ROWINFO[p2] = (u32x2){((unsigned)m << 1) | 1u, __builtin_bit_cast(unsigned, EW[2 * (size_t)m + 1])}; }
                if (ch == 0 && lane < 8) ((int*)(ws + WS_SMALL + 4096))[lane] = cnt_all[lane];
            }
            __syncthreads();
            for (int rr = wave; rr < 256; rr += NWAVES) { const int m = ch * 128 + (rr >> 1); const int p = posl[rr]; const float s16 = ((const float*)(ws + WS_RS))[m] * 16.f;
                const u32x4 a0 = ((const u32x4*)(XH + (size_t)m * D))[2 * lane], a1 = ((const u32x4*)(XH + (size_t)m * D))[2 * lane + 1];
                u32x4 o; o.x = pk_fp8x4(bflo(a0.x) * s16, bfhi(a0.x) * s16, bflo(a0.y) * s16, bfhi(a0.y) * s16); o.y = pk_fp8x4(bflo(a0.z) * s16, bfhi(a0.z) * s16, bflo(a0.w) * s16, bfhi(a0.w) * s16);
                o.z = pk_fp8x4(bflo(a1.x) * s16, bfhi(a1.x) * s16, bflo(a1.y) * s16, bfhi(a1.y) * s16); o.w = pk_fp8x4(bflo(a1.z) * s16, bfhi(a1.z) * s16, bflo(a1.w) * s16, bfhi(a1.w) * s16);
                ((u32x4*)((unsigned char*)XG + (size_t)p * D))[lane] = o; }
        }
    }
    SEAM(16);
    if (IN(17) || IN(18)) {
        __syncthreads();
        if (tid == 0) { const int* cg = (const int*)(ws + WS_SMALL + 4096); int run = 0;
            for (int e = 0; e < 8; ++e) { const int c = cg[e]; tb[e] = run; tb[16 + e] = c; run += (c + 255) >> 8; } tb[8] = run; }
        __syncthreads();
    }
    PH(17) { MoeOrder S{2 * FE / 256, G, bx, (const char*)(ws + WS_XG), (const char*)(ws + WS_MGU), (size_t)256 * D, (size_t)2 * FE * D, (size_t)256 * D, tb};
        pg8::EpiSwiGLU8 E{ws + WS_ACTS, FE, 8.f}; pg8::gemm_phase<pg8::EpiSwiGLU8, MoeOrder, true, true, true>(lds, pg8::Dims{D / 2, D / 2, D / 2, 127 - 4, 127 - 7}, S, E); }
    SEAM(17);
    PH(18) { MoeOrder S{D / 256, G, bx, (const char*)(ws + WS_ACTS), (const char*)(ws + WS_MDOWN), (size_t)256 * FE, (size_t)D * FE, (size_t)256 * FE, tb};
        EpiMoeDown E{(bf16_t*)(ws + WS_Y1), ROWINFO, EW, tb}; pg8::gemm_phase<EpiMoeDown, MoeOrder, true, true, true>(lds, pg8::Dims{FE / 2, FE / 2, FE / 2, 127 - 3, 127 - 8}, S, E); }
    SEAM(18);
    PH(19) { const bf16_t* Yb = (const bf16_t*)(ws + WS_Y1); const unsigned bad = xb_ld(ctl + CW_BAR + XB_TMO);
#if TPROBE
        const float* tkp = (const float*)(ws + WS_END2 + 2 * MiB); const float pfac = 1.0f + 0.25f * (tkp[TPROBE - 1] / tkp[2]);
#else
        const float pfac = 1.0f;
#endif
        u32x2 xn[4], y0n[4], y1n[4]; f32x4 gfin[4];
#define P19_LOAD(mm) do { _Pragma("unroll") for (int j = 0; j < 4; ++j) { xn[j] = *(const u32x2*)(XH + (size_t)(mm) * D + 4 * lane + 256 * j); \
            y0n[j] = *(const u32x2*)(Yb + (size_t)(mm) * D + 4 * lane + 256 * j); y1n[j] = *(const u32x2*)(Yb + ((size_t)M + (mm)) * D + 4 * lane + 256 * j); } } while (0)
        P19_LOAD(gw < M ? gw : 0);
#pragma unroll
        for (int j = 0; j < 4; ++j) gfin[j] = *((const f32x4*)A_IN(I_NORM_FINAL) + lane + 64 * j);
        for (int m = gw; m < M; m += NGW) { f32x4 v[4]; u32x2 y0[4], y1[4];
#pragma unroll
            for (int j = 0; j < 4; ++j) { v[j] = (f32x4){bflo(xn[j].x), bfhi(xn[j].x), bflo(xn[j].y), bfhi(xn[j].y)}; y0[j] = y0n[j]; y1[j] = y1n[j]; }
            P19_LOAD(m + NGW < M ? m + NGW : m);
#pragma unroll
            for (int j = 0; j < 4; ++j) v[j] = v[j] + ((f32x4){bflo(y0[j].x), bfhi(y0[j].x), bflo(y0[j].y), bfhi(y0[j].y)} + (f32x4){bflo(y1[j].x), bfhi(y1[j].x), bflo(y1[j].y), bfhi(y1[j].y)});
            const float rstd = bad ? __builtin_nanf("") : row_rstd(v); f32x4* o = (f32x4*)(xs + (size_t)m * D) + lane;
#pragma unroll
            for (int j = 0; j < 4; ++j) o[64 * j] = v[j] * (rstd * pfac) * gfin[j]; }
#undef P19_LOAD
    }
#undef IN
#undef SEAM
}

extern "C" void kernel_launch(void* const* d_in, const int* in_sizes, int n_in, void* d_out, int out_size, void* d_ws, size_t ws_size, hipStream_t stream) {
    static int grid = 0;
    if (grid == 0) {
        if (n_in != 22 || out_size != M * D || ws_size < WS_END2) { fprintf(stderr, "kernel_launch: unexpected shapes (n_in %d, out %d, ws %zu < %zu)\n", n_in, out_size, ws_size, (size_t)WS_END); grid = -1; return; }
        int dev = 0, cus = 0, per_cu = 0;
        if (hipGetDevice(&dev) != hipSuccess || hipDeviceGetAttribute(&cus, hipDeviceAttributeMultiprocessorCount, dev) != hipSuccess) { grid = -1; return; }
        if (hipFuncSetAttribute((const void*)yoco_fwd, hipFuncAttributeMaxDynamicSharedMemorySize, LDS_BYTES) != hipSuccess) { fprintf(stderr, "kernel_launch: hipFuncSetAttribute failed\n"); grid = -1; return; }
        if (hipOccupancyMaxActiveBlocksPerMultiprocessor(&per_cu, (const void*)yoco_fwd, NTHR, LDS_BYTES) != hipSuccess || per_cu < 1) fprintf(stderr, "kernel_launch: occupancy query says %d\n", per_cu);
        (void)hipGetLastError();
        grid = cus;
    }
    if (grid < 0) return;
    (void)hipMemsetAsync((char*)d_ws + WS_CTL, 0, CTL_ZERO_BYTES, stream);
    Args a{};
    for (int i = 0; i < 22; ++i) a.in[i] = (const float*)d_in[i];
    a.out = (float*)d_out; a.ws = (unsigned char*)d_ws;
#if MK_PER_PHASE
    for (int p = 0; p < NPHASE; ++p) { a.ph_lo = p; a.ph_hi = p + 1; hipLaunchKernelGGL(yoco_fwd, dim3(grid), dim3(NTHR), LDS_BYTES, stream, a); }
#else
    a.ph_lo = 0; a.ph_hi = NPHASE; hipLaunchKernelGGL(yoco_fwd, dim3(grid), dim3(NTHR), LDS_BYTES, stream, a);
#endif
}
```

```cpp
#include <hip/hip_runtime.h>
#include <cstdio>
#include <cstdint>

#ifndef MK_PER_PHASE
#define MK_PER_PHASE 0
#endif

#define LAS __attribute__((address_space(3)))
#define GAS __attribute__((address_space(1)))
typedef unsigned short bf16_t;
typedef short bf16x8 __attribute__((ext_vector_type(8)));
typedef float f32x4 __attribute__((ext_vector_type(4)));
typedef float f32x2 __attribute__((ext_vector_type(2)));
typedef unsigned u32x4 __attribute__((ext_vector_type(4)));
typedef unsigned u32x2 __attribute__((ext_vector_type(2)));
typedef unsigned long long u64;

constexpr int BATCH = 8, SEQ = 4096, D = 1024, M = BATCH * SEQ;
constexpr int A_HEADS = 4, A_HD = 256, NPROJ = 4096, NPROJ_SRC = 4104;
constexpr int FFD = 2816, NE = 8, FE = 3584;
constexpr int KVG = 4, HD = 64, NH = 16, NKVQ = 2816, NQSRC = 1072;
constexpr float EPS = 1e-6f;
constexpr int MOE_MAXT = 264;
constexpr int MOE_ROWS = MOE_MAXT * 256;

constexpr size_t MiB = 1u << 20;
constexpr size_t WS_CTL = 0, CTL_ZERO_BYTES = 1 * MiB;
constexpr size_t WS_SMALL = 1 * MiB;
constexpr size_t WS_WIN = 2 * MiB, WS_WOUTA = 10 * MiB, WS_WGU = 12 * MiB, WS_WDOWN = 23 * MiB, WS_WKVQ = 29 * MiB, WS_WCMP1 = 35 * MiB, WS_WOUTB = 37 * MiB;
constexpr size_t WS_MGU = 40 * MiB, WS_MDOWN = 152 * MiB, WS_XH = 208 * MiB, WS_GA = 272 * MiB, WS_ROWINFO = 273 * MiB, WS_BIG = 274 * MiB;
constexpr size_t WS_PROJ3 = WS_BIG, WS_OG = WS_BIG + 192 * MiB, WS_IMG = WS_BIG + 256 * MiB, WS_DN = WS_BIG + 536 * MiB, WS_HS = WS_BIG, WS_HN = WS_BIG + 128 * MiB;
constexpr size_t IMG_Q = 0, IMG_K = 34816, IMG_KT = 67584, IMG_VT = 100352, IMG_G = 141312, IMG_STRIDE = 142080;
static_assert((size_t)2048 * IMG_STRIDE <= 280 * MiB, "scan images");
constexpr size_t WS_ACT = WS_BIG;
constexpr size_t WS_KV = WS_BIG, WS_QB = WS_BIG + 96 * MiB, WS_GATEB = WS_BIG + 160 * MiB, WS_HID = WS_BIG + 166 * MiB, WS_KC = WS_BIG + 174 * MiB, WS_VC = WS_BIG + 175 * MiB, WS_OB = WS_BIG + 176 * MiB, WS_VT2 = WS_BIG + 240 * MiB;
constexpr size_t WS_XG = WS_BIG, WS_ACTS = WS_BIG + 132 * MiB, WS_Y1 = WS_BIG;
constexpr size_t WS_END = WS_BIG + 594 * MiB;
constexpr size_t WS_W2T = WS_SMALL + 524288;
constexpr size_t WS_SSP = WS_END, WS_RS = WS_END + 2 * MiB, WS_END2 = WS_END + 3 * MiB;
static_assert((size_t)MOE_ROWS * 1024 * 2 <= 132 * MiB && (size_t)MOE_ROWS * FE * 2 <= 462 * MiB, "moe buffers");
constexpr int CW_BAR = 4096;

constexpr int NWAVES = 8, NTHR = 512;
constexpr int LDS_BYTES = 163840;
constexpr int MISC_OFF = 163840 - 256;

__device__ __forceinline__ unsigned f2bf(float f) { unsigned u = __builtin_bit_cast(unsigned, f); return (u + 0x7fffu + ((u >> 16) & 1u)) >> 16; }
__device__ __forceinline__ unsigned pk2(float lo, float hi) { return f2bf(lo) | (f2bf(hi) << 16); }
__device__ __forceinline__ float bf2f(unsigned short b) { return __builtin_bit_cast(float, ((unsigned)b) << 16); }
__device__ __forceinline__ float bflo(unsigned w) { return __builtin_bit_cast(float, w << 16); }
__device__ __forceinline__ float bfhi(unsigned w) { return __builtin_bit_cast(float, w & 0xffff0000u); }
__device__ __forceinline__ float wave_sum(float v) {
#pragma unroll
    for (int o = 1; o < 64; o <<= 1) v += __shfl_xor(v, o);
    return v;
}
__device__ __forceinline__ float sigmoidf_(float x) { return __builtin_amdgcn_rcpf(1.0f + __builtin_amdgcn_exp2f(-1.4426950408889634f * x)); }
__device__ __forceinline__ float siluf_(float x) { return x * __builtin_amdgcn_rcpf(1.0f + __builtin_amdgcn_exp2f(-1.4426950408889634f * x)); }
__device__ __forceinline__ float ex2(float x) { return __builtin_amdgcn_exp2f(x); }
__device__ __forceinline__ unsigned pk_fp8x4(float a, float b, float c, float d) { unsigned w = 0u; w = __builtin_amdgcn_cvt_pk_fp8_f32(a, b, w, false); w = __builtin_amdgcn_cvt_pk_fp8_f32(c, d, w, true); return w; }
#define LDS_WAIT() asm volatile("s_waitcnt lgkmcnt(0)" ::: "memory")
#define LDS_BARRIER() do { asm volatile("s_waitcnt lgkmcnt(0)" ::: "memory"); __builtin_amdgcn_s_barrier(); asm volatile("" ::: "memory"); } while (0)

#define XB_TMO      128
#define XB_XCNT(j)  (256  + 64 * (j))
#define XB_XSUB(j)  (1280 + 64 * (j))
#define XB_XGEN(j)  (2304 + 64 * (j))
#define XB_TOP      3328
#define XB_TOPGEN   3392
#define XCD_BAR_WORDS 3456
#define XB_SPIN_CAP (1u << 22)
__device__ __forceinline__ unsigned xb_ld(unsigned* p)              { return __hip_atomic_load(p, __ATOMIC_RELAXED, __HIP_MEMORY_SCOPE_AGENT); }
__device__ __forceinline__ unsigned xb_add(unsigned* p, unsigned v) { return __hip_atomic_fetch_add(p, v, __ATOMIC_RELAXED, __HIP_MEMORY_SCOPE_AGENT); }
__device__ __forceinline__ unsigned xb_xcc_id() { return (unsigned)__builtin_amdgcn_s_getreg((3 << 11) | 20) & 0xFu; }
#define XB_SPIN(cond, bar) do { unsigned _sp = 0; while (cond) { __builtin_amdgcn_s_sleep(1); \
    if ((++_sp & 255u) == 0u) { if (xb_ld(&(bar)[XB_TMO])) break; if (_sp > XB_SPIN_CAP) { atomicAdd(&(bar)[XB_TMO], 1u); break; } } } } while (0)
struct XcdBarrier { unsigned* bar; unsigned x; volatile LAS unsigned* st; };
__device__ __forceinline__ XcdBarrier xcd_barrier_post(unsigned* bar, volatile LAS unsigned* st) {
    XcdBarrier b; b.bar = bar; b.x = xb_xcc_id(); b.st = st;
    if (threadIdx.x == 0) (void)xb_add(&bar[XB_XCNT(b.x)], 1u);
    return b;
}
__device__ __forceinline__ void xcd_barrier_complete(unsigned* bar, unsigned x, unsigned& nloc, unsigned& nx) {
    const unsigned G = gridDim.x * gridDim.y * gridDim.z;
    unsigned sum, cnt, mine, sp = 0u;
    for (;;) {
        sum = 0u; cnt = 0u; mine = 0u;
#pragma unroll
        for (unsigned j = 0; j < 16; ++j) { const unsigned c = xb_ld(&bar[XB_XCNT(j)]); sum += c; cnt += (c > 0u) ? 1u : 0u; mine = (j == x) ? c : mine; }
        if (sum == G) break;
        __builtin_amdgcn_s_sleep(1);
        if ((++sp & 255u) == 0u) { if (xb_ld(&bar[XB_TMO])) break; if (sp > XB_SPIN_CAP) { atomicAdd(&bar[XB_TMO], 1u); break; } }
    }
    nloc = mine > 0u ? mine : 1u; nx = cnt > 0u ? cnt : 1u;
}
__device__ __forceinline__ void xcd_barrier(const XcdBarrier& b) {
    asm volatile("s_waitcnt vmcnt(0)" ::: "memory");
    __syncthreads();
    if (threadIdx.x == 0) {
        unsigned* bar = b.bar;
        __builtin_amdgcn_s_waitcnt(0);
        unsigned nloc = b.st[0], nx = b.st[1];
        if (nloc == 0u) { xcd_barrier_complete(bar, b.x, nloc, nx); b.st[0] = nloc; b.st[1] = nx; }
        const unsigned old = xb_add(&bar[XB_XSUB(b.x)], 1u);
        const unsigned gen = old / nloc;
        if (old + 1u == (gen + 1u) * nloc) {
            __builtin_amdgcn_fence(__ATOMIC_RELEASE, "agent");
            asm volatile("s_waitcnt vmcnt(0)" ::: "memory");
            const unsigned og = xb_add(&bar[XB_TOP], 1u);
            const unsigned tg = og / nx;
            if (og + 1u == (tg + 1u) * nx) xb_add(&bar[XB_TOPGEN], 1u);
            else XB_SPIN(xb_ld(&bar[XB_TOPGEN]) == tg, bar);
            __builtin_amdgcn_fence(__ATOMIC_ACQUIRE, "agent");
            xb_add(&bar[XB_XGEN(b.x)], 1u);
            asm volatile("s_waitcnt vmcnt(0)" ::: "memory");
        } else {
            XB_SPIN(xb_ld(&bar[XB_XGEN(b.x)]) == gen, bar);
            __builtin_amdgcn_fence(__ATOMIC_ACQUIRE, "agent");
            asm volatile("s_waitcnt vmcnt(0)" ::: "memory");
        }
    }
    __syncthreads();
}

#ifndef EXPT
#define EXPT 0
#endif
#ifndef TSEG
#define TSEG 0
#endif
#if TSEG
#define TS_B(k) do { if (TSEG & (1 << (k))) tseg_t = __builtin_amdgcn_s_memrealtime(); } while (0)
#define TS_E(k) do { if (TSEG & (1 << (k))) tseg_acc += __builtin_amdgcn_s_memrealtime() - tseg_t; } while (0)
#else
#define TS_B(k)
#define TS_E(k)
#endif
#ifndef TPROBE
#define TPROBE 0
#endif
namespace pg8 {
constexpr int BM = 256, BK = 64, HALF = 128, HTB = HALF * BK * 2, STAGE_BYTES = 8 * HTB, NXCD = 8, WGM = 8;
__host__ __device__ __forceinline__ int lds_byte(int r, int c) { const int st = (r >> 4) * 2 + (c >> 5), rr = r & 15, cc = c & 31, ob = rr * 64 + cc * 2; return st * 1024 + (ob ^ (((ob >> 9) & 1) << 5)); }
__host__ __device__ __forceinline__ void stage_rc(int b, int& R, int& C) { const int st = b / 1024, sb = b % 1024, swz = sb ^ (((sb >> 9) & 1) << 5); R = (st >> 1) * 16 + swz / 64; C = (st & 1) * 32 + (swz % 64) / 2; }
__host__ __device__ __forceinline__ int perm32(int rho) { const int n = rho >> 4, i = rho & 15; return 8 * (i >> 2) + 4 * n + (i & 3); }
struct Unit { int pm, pn; const char* a; const char* b; };
struct Dims { int K, lda, ldb; int sa = 127, sb = 127; float* tk = nullptr; };
typedef __bf16 bf16x2_t __attribute__((ext_vector_type(2)));
__device__ __forceinline__ unsigned cvt_pk_bf16(float lo, float hi) { const f32x2 v = {lo, hi}; const bf16x2_t b = __builtin_convertvector(v, bf16x2_t); return __builtin_bit_cast(unsigned, b); }

__device__ __forceinline__ bool tile_order(int i, int G, int c, int nM, int nN, int& pm, int& pn) {
    const int nwg = nM * nN; const long L = (long)i * G + c; if (L >= nwg) return false;
    int wgid = (int)L; { const int q = nwg / NXCD, r = nwg % NXCD, xcd = wgid % NXCD, off = wgid / NXCD; wgid = (xcd < r ? xcd * (q + 1) : r * (q + 1) + (xcd - r) * q) + off; }
    const int nig = WGM * nN, gid = wgid / nig, fm = gid * WGM, gsz = (nM - fm) < WGM ? (nM - fm) : WGM;
    pm = fm + ((wgid % nig) % gsz); pn = (wgid % nig) / gsz; return true;
}
struct PlainOrder {
    int nM, nN, G, c; const char* A; const char* B; size_t tA, tB; int same = 0;
    __device__ __forceinline__ void init(const bf16_t* A_, const bf16_t* B_, int M_, int N_, int lda, int ldb, int G_, int c_) { nM = M_ / BM; nN = N_ / BM; G = G_; c = c_; A = (const char*)A_; B = (const char*)B_; tA = (size_t)BM * lda * 2; tB = (size_t)BM * ldb * 2; }
    __device__ __forceinline__ bool next(int i, Unit& u) const { if (EXPT && same) { if (i >= same) return false; u.pm = 0; u.pn = i; u.a = A; u.b = B + (size_t)i * tB; return true; }
        if (!tile_order(i, G, c, nM, nN, u.pm, u.pn)) return false; u.a = A + (size_t)u.pm * tA; u.b = B + (size_t)u.pn * tB; return true; }
};

template <class Epi, class Sched, bool ALIGN_EPI = true, bool SP2 = true, bool FP8 = false>
__device__ __forceinline__ void gemm_phase(LAS unsigned char* lds, const Dims g, const Sched& S, const Epi& E) {
    const int tid = threadIdx.x, wid = __builtin_amdgcn_readfirstlane(tid >> 6), lane = tid & 63, wr = wid >> 2, wc = wid & 3, fr = lane & 15, fq = lane >> 4;
    const int K = g.K, nt = K / BK;
    unsigned voffA[2], voffB[2];
#pragma unroll
    for (int i = 0; i < 2; ++i) { int R, C; stage_rc(tid * 16 + i * 8192, R, C); const int Rb = Epi::PERM ? ((R & ~31) + perm32(R & 31)) : R;
        voffA[i] = (unsigned)(R * g.lda + C) * 2u; voffB[i] = (unsigned)(Rb * g.ldb + C) * 2u; }
    const size_t kstep = (size_t)(BK * 2);
    const size_t hstepA = (size_t)HALF * g.lda * 2, hstepB = (size_t)HALF * g.ldb * 2;
    const unsigned ldsw = (unsigned)wid * 1024u;
    const int aoff = lds_byte(wr * 64 + fr, fq * 8), boff = lds_byte(wc * 32 + fr, fq * 8);
#define PG8_SA(b, h) (((b) * 2 + (h)) * HTB)
#define PG8_SB(b, h) ((4 + (b) * 2 + (h)) * HTB)
#define PG8_STAGE(bufoff, gbase, voff) do { _Pragma("unroll") for (int _i = 0; _i < 2; ++_i) \
        __builtin_amdgcn_global_load_lds((const unsigned*)((const char*)(gbase) + (voff)[_i]), (LAS unsigned*)(lds + (bufoff) + ldsw + _i * 8192), 16, 0, 0); } while (0)
    typedef int v8i_t __attribute__((ext_vector_type(8))); typedef int v4i_t __attribute__((ext_vector_type(4)));
#define PG8_RD8(p) __builtin_shufflevector(*(const LAS v4i_t*)(p), *(const LAS v4i_t*)((p) + 1024), 0, 1, 2, 3, 4, 5, 6, 7)
#define PG8_LDA(dst, b, h) do { if constexpr (FP8) { _Pragma("unroll") for (int m = 0; m < 4; ++m) dst##8[m] = PG8_RD8(lds + PG8_SA(b, h) + aoff + m * 2048); } \
        else { _Pragma("unroll") for (int m = 0; m < 4; ++m) _Pragma("unroll") for (int k = 0; k < 2; ++k) dst[m][k] = *(const LAS bf16x8*)(lds + PG8_SA(b, h) + aoff + m * 2048 + k * 1024); } } while (0)
#define PG8_LDB(dst, b, h) do { if constexpr (FP8) { _Pragma("unroll") for (int n = 0; n < 2; ++n) dst##8[n] = PG8_RD8(lds + PG8_SB(b, h) + boff + n * 2048); } \
        else { _Pragma("unroll") for (int n = 0; n < 2; ++n) _Pragma("unroll") for (int k = 0; k < 2; ++k) dst[n][k] = *(const LAS bf16x8*)(lds + PG8_SB(b, h) + boff + n * 2048 + k * 1024); } } while (0)
#define PG8_MMA(ai, bj, At, Bt) do { __builtin_amdgcn_s_setprio(1); \
        if constexpr (FP8) { _Pragma("unroll") for (int m = 0; m < 4; ++m) _Pragma("unroll") for (int n = 0; n < 2; ++n) \
            asm volatile("v_mfma_scale_f32_16x16x128_f8f6f4 %0, %1, %2, %0, %3, %4 op_sel_hi:[0,0,0]" : "+v"(acc[ai][bj][m][n]) : "v"(Bt##8[n]), "v"(At##8[m]), "v"(sbv), "v"(sav)); } \
        else { _Pragma("unroll") for (int m = 0; m < 4; ++m) _Pragma("unroll") for (int n = 0; n < 2; ++n) _Pragma("unroll") for (int k = 0; k < 2; ++k) \
            acc[ai][bj][m][n] = __builtin_amdgcn_mfma_f32_16x16x32_bf16(Bt[n][k], At[m][k], acc[ai][bj][m][n], 0, 0, 0); } \
        __builtin_amdgcn_s_setprio(0); } while (0)
#define PG8_WAIT_V(n) asm volatile("s_waitcnt vmcnt(" #n ")" ::: "memory")
#define PG8_WAIT_L(n) asm volatile("s_waitcnt lgkmcnt(" #n ")" ::: "memory")
#define PG8_BAR __builtin_amdgcn_s_barrier()
#define PG8_SCHED __builtin_amdgcn_sched_barrier(0)
    Unit cur, nxt; int ui = 0;
    if (!S.next(0, cur)) return;
    f32x4 acc[2][2][4][2];
#pragma unroll
    for (int a = 0; a < 2; ++a)
#pragma unroll
        for (int b = 0; b < 2; ++b)
#pragma unroll
            for (int m = 0; m < 4; ++m)
#pragma unroll
                for (int n = 0; n < 2; ++n) acc[a][b][m][n] = (f32x4){0.f, 0.f, 0.f, 0.f};
    bf16x8 At[4][2], B0[2][2], B1[2][2]; v8i_t At8[4], B08[2], B18[2];
    const int sbv = g.sb, sav = g.sa;
    const char* cA = cur.a; const char* cB = cur.b;
    if constexpr (SP2) {
        PG8_STAGE(PG8_SB(0, 0), cB, voffB); PG8_STAGE(PG8_SB(0, 1), cB + hstepB, voffB); PG8_STAGE(PG8_SA(0, 0), cA, voffA); PG8_STAGE(PG8_SA(0, 1), cA + hstepA, voffA);
        if (wr == 1) PG8_BAR;
        PG8_WAIT_V(2); PG8_BAR;
        PG8_STAGE(PG8_SB(1, 0), cB + kstep, voffB); PG8_STAGE(PG8_SA(1, 0), cA + kstep, voffA); PG8_STAGE(PG8_SB(1, 1), cB + hstepB + kstep, voffB);
        PG8_WAIT_V(6); PG8_BAR;
    } else {
        PG8_STAGE(PG8_SB(0, 0), cB, voffB); PG8_STAGE(PG8_SA(0, 0), cA, voffA); PG8_STAGE(PG8_SB(0, 1), cB + hstepB, voffB); PG8_STAGE(PG8_SA(0, 1), cA + hstepA, voffA);
        if (wr == 1) PG8_BAR;
        PG8_WAIT_V(4); PG8_BAR;
        PG8_STAGE(PG8_SB(1, 0), cB + kstep, voffB); PG8_STAGE(PG8_SA(1, 0), cA + kstep, voffA); PG8_STAGE(PG8_SB(1, 1), cB + hstepB + kstep, voffB);
        PG8_WAIT_V(6); PG8_BAR;
    }
#if TPROBE
    unsigned long long tk_acc = 0, te_acc = 0;
#endif
    for (;;) {
        const bool has_next = S.next(ui + 1, nxt);
#if TPROBE
        const unsigned long long tk0 = __builtin_amdgcn_s_memrealtime();
#endif
        const char* nA = has_next ? nxt.a : cA; const char* nB = has_next ? nxt.b : cB;
#pragma unroll 1
        for (int t = 0; t < nt; t += 2) {
            const bool last = (t == nt - 2);
            const char* a1 = cA + (size_t)(t + 1) * kstep;
            const char* a2 = last ? nA : cA + (size_t)(t + 2) * kstep; const char* b2 = last ? nB : cB + (size_t)(t + 2) * kstep;
            const char* a3 = a2 + kstep; const char* b3 = b2 + kstep;
            if constexpr (SP2) {
            PG8_LDB(B0, 0, 0); PG8_LDB(B1, 0, 1); PG8_SCHED; PG8_LDA(At, 0, 0); PG8_STAGE(PG8_SA(1, 1), a1 + hstepA, voffA);
            PG8_WAIT_V(8); PG8_WAIT_L(0); PG8_BAR; PG8_MMA(0, 0, At, B0); PG8_MMA(0, 1, At, B1); PG8_BAR; PG8_SCHED;
            PG8_LDA(At, 0, 1); PG8_STAGE(PG8_SB(0, 0), b2, voffB); PG8_STAGE(PG8_SB(0, 1), b2 + hstepB, voffB); PG8_STAGE(PG8_SA(0, 0), a2, voffA);
            PG8_WAIT_V(8); PG8_WAIT_L(0); PG8_BAR; PG8_MMA(1, 0, At, B0); PG8_MMA(1, 1, At, B1); PG8_BAR; PG8_SCHED;
            PG8_LDB(B0, 1, 0); PG8_LDB(B1, 1, 1); PG8_SCHED; PG8_LDA(At, 1, 0); PG8_STAGE(PG8_SA(0, 1), a2 + hstepA, voffA);
            PG8_WAIT_V(8); PG8_WAIT_L(0); PG8_BAR; PG8_MMA(0, 0, At, B0); PG8_MMA(0, 1, At, B1); PG8_BAR; PG8_SCHED;
            PG8_LDA(At, 1, 1); PG8_STAGE(PG8_SB(1, 0), b3, voffB); PG8_STAGE(PG8_SB(1, 1), b3 + hstepB, voffB); PG8_STAGE(PG8_SA(1, 0), a3, voffA);
            PG8_WAIT_V(8); PG8_WAIT_L(0); PG8_BAR; PG8_MMA(1, 0, At, B0); PG8_MMA(1, 1, At, B1); PG8_BAR; PG8_SCHED;
            } else {
            PG8_LDB(B0, 0, 0); PG8_SCHED; PG8_LDA(At, 0, 0); PG8_STAGE(PG8_SA(1, 1), a1 + hstepA, voffA);
            PG8_WAIT_L(8); PG8_BAR; PG8_WAIT_L(0); PG8_MMA(0, 0, At, B0); PG8_BAR; PG8_SCHED;
            PG8_LDB(B1, 0, 1); PG8_STAGE(PG8_SB(0, 0), b2, voffB);
            PG8_BAR; PG8_WAIT_L(0); PG8_MMA(0, 1, At, B1); PG8_BAR;
            PG8_LDA(At, 0, 1); PG8_STAGE(PG8_SA(0, 0), a2, voffA);
            PG8_BAR; PG8_WAIT_L(0); PG8_MMA(1, 0, At, B0); PG8_BAR; PG8_SCHED;
            PG8_STAGE(PG8_SB(0, 1), b2 + hstepB, voffB);
            PG8_WAIT_V(6); PG8_BAR; PG8_MMA(1, 1, At, B1); PG8_BAR;
            PG8_LDB(B0, 1, 0); PG8_SCHED; PG8_LDA(At, 1, 0); PG8_STAGE(PG8_SA(0, 1), a2 + hstepA, voffA);
            PG8_WAIT_L(8); PG8_BAR; PG8_WAIT_L(0); PG8_MMA(0, 0, At, B0); PG8_BAR; PG8_SCHED;
            PG8_LDB(B1, 1, 1); PG8_STAGE(PG8_SB(1, 0), b3, voffB);
            PG8_BAR; PG8_WAIT_L(0); PG8_MMA(0, 1, At, B1); PG8_BAR;
            PG8_LDA(At, 1, 1); PG8_STAGE(PG8_SA(1, 0), a3, voffA);
            PG8_BAR; PG8_WAIT_L(0); PG8_MMA(1, 0, At, B0); PG8_BAR; PG8_SCHED;
            PG8_STAGE(PG8_SB(1, 1), b3 + hstepB, voffB);
            PG8_WAIT_V(6); PG8_BAR; PG8_MMA(1, 1, At, B1); PG8_BAR;
            }
        }
#if TPROBE
        const unsigned long long tk1 = __builtin_amdgcn_s_memrealtime(); tk_acc += tk1 - tk0;
#endif
        if constexpr (ALIGN_EPI) { if (wr == 0) PG8_BAR; }
        if constexpr (FP8) asm volatile("s_nop 15\n\ts_nop 15" ::: "memory");
        E(acc, cur, wr, wc, fr, fq);
#if TPROBE
        te_acc += __builtin_amdgcn_s_memrealtime() - tk1;
#endif
        if (!has_next) break;
#pragma unroll
        for (int a = 0; a < 2; ++a)
#pragma unroll
            for (int b = 0; b < 2; ++b)
#pragma unroll
                for (int m = 0; m < 4; ++m)
#pragma unroll
                    for (int n = 0; n < 2; ++n) acc[a][b][m][n] = (f32x4){0.f, 0.f, 0.f, 0.f};
        cur = nxt; cA = nA; cB = nB; ++ui;
        if constexpr (ALIGN_EPI) { if (wr == 1) PG8_BAR; }
    }
    PG8_WAIT_V(0);
    if constexpr (!ALIGN_EPI) { if (wr == 0) PG8_BAR; }
    PG8_BAR;
#if TPROBE
    if (g.tk && tid == 0) { g.tk[0] = (float)tk_acc; g.tk[1] = (float)te_acc; }
#endif
#undef PG8_SA
#undef PG8_SB
#undef PG8_STAGE
#undef PG8_LDA
#undef PG8_LDB
#undef PG8_MMA
#undef PG8_RD8
#undef PG8_WAIT_V
#undef PG8_WAIT_L
#undef PG8_BAR
#undef PG8_SCHED
}

typedef const f32x4 (&AccRef)[2][2][4][2];
struct EpiBf16Plain {
    static constexpr bool PERM = true;
    bf16_t* O; int ldc;
    __device__ __forceinline__ void operator()(AccRef acc, const Unit& u, int wr, int wc, int fr, int fq) const {
        const int row0 = u.pm * BM + wr * 64 + fr, col0 = u.pn * BM + wc * 32 + 8 * fq;
#pragma unroll
        for (int ai = 0; ai < 2; ++ai)
#pragma unroll
            for (int m = 0; m < 4; ++m) { bf16_t* rowp = O + (size_t)(row0 + ai * HALF + m * 16) * ldc + col0;
#pragma unroll
                for (int bj = 0; bj < 2; ++bj) { const f32x4 v0 = acc[ai][bj][m][0], v1 = acc[ai][bj][m][1];
                    u32x4 w; w.x = cvt_pk_bf16(v0[0], v0[1]); w.y = cvt_pk_bf16(v0[2], v0[3]); w.z = cvt_pk_bf16(v1[0], v1[1]); w.w = cvt_pk_bf16(v1[2], v1[3]);
                    *(u32x4*)(rowp + bj * HALF) = w; } }
    }
};
struct EpiProjSplit {
    static constexpr bool PERM = true;
    bf16_t* P3; bf16_t* OG;
    __device__ __forceinline__ void operator()(AccRef acc, const Unit& u, int wr, int wc, int fr, int fq) const {
        const int row0 = u.pm * BM + wr * 64 + fr; const bool og = u.pn >= 12; const int ldc = og ? 1024 : 3072; bf16_t* base = (og ? OG + (u.pn - 12) * BM : P3 + u.pn * BM) + wc * 32 + 8 * fq;
#pragma unroll
        for (int ai = 0; ai < 2; ++ai)
#pragma unroll
            for (int m = 0; m < 4; ++m) { bf16_t* rowp = base + (size_t)(row0 + ai * HALF + m * 16) * ldc;
#pragma unroll
                for (int bj = 0; bj < 2; ++bj) { const f32x4 v0 = acc[ai][bj][m][0], v1 = acc[ai][bj][m][1];
                    u32x4 w; w.x = cvt_pk_bf16(v0[0], v0[1]); w.y = cvt_pk_bf16(v0[2], v0[3]); w.z = cvt_pk_bf16(v1[0], v1[1]); w.w = cvt_pk_bf16(v1[2], v1[3]);
                    *(u32x4*)(rowp + bj * HALF) = w; } }
    }
};
struct EpiResF32 {
    static constexpr bool PERM = false;
    const float* base; float* out; int ldc;
    __device__ __forceinline__ void operator()(AccRef acc, const Unit& u, int wr, int wc, int fr, int fq) const {
        const int row0 = u.pm * BM + wr * 64 + fr, col0 = u.pn * BM + wc * 32 + 4 * fq;
#pragma unroll
        for (int ai = 0; ai < 2; ++ai)
#pragma unroll
            for (int m = 0; m < 4; ++m) { const size_t off = (size_t)(row0 + ai * HALF + m * 16) * ldc + col0;
#pragma unroll
                for (int bj = 0; bj < 2; ++bj)
#pragma unroll
                    for (int n = 0; n < 2; ++n) { const f32x4 bs = *(const f32x4*)(base + off + bj * HALF + n * 16); *(f32x4*)(out + off + bj * HALF + n * 16) = bs + acc[ai][bj][m][n]; } }
    }
};
__device__ __forceinline__ float row_rs16(const float* ss, int row) { const f32x4* p = (const f32x4*)(ss + (size_t)row * 16); const f32x4 a = p[0], b = p[1], c = p[2], d = p[3];
    const float t = (((a[0] + a[1]) + (a[2] + a[3])) + ((b[0] + b[1]) + (b[2] + b[3]))) + (((c[0] + c[1]) + (c[2] + c[3])) + ((d[0] + d[1]) + (d[2] + d[3]))); return 1.0f / sqrtf(t * (1.f / 1024.f) + EPS); }
struct EpiResF32Stat {
    static constexpr bool PERM = false;
    const float* base; float* out; bf16_t* XHo; float* SS; int ldc;
    __device__ __forceinline__ void operator()(AccRef acc, const Unit& u, int wr, int wc, int fr, int fq) const {
        const int row0 = u.pm * BM + wr * 64 + fr, col0 = u.pn * BM + wc * 32 + 4 * fq;
#pragma unroll
        for (int ai = 0; ai < 2; ++ai)
#pragma unroll
            for (int m = 0; m < 4; ++m) { const int row = row0 + ai * HALF + m * 16; const size_t off = (size_t)row * ldc + col0; float ss = 0.f;
#pragma unroll
                for (int bj = 0; bj < 2; ++bj)
#pragma unroll
                    for (int n = 0; n < 2; ++n) { const f32x4 o = *(const f32x4*)(base + off + bj * HALF + n * 16) + acc[ai][bj][m][n]; *(f32x4*)(out + off + bj * HALF + n * 16) = o;
                        ss += (o[0] * o[0] + o[1] * o[1]) + (o[2] * o[2] + o[3] * o[3]);
                        u32x2 w; w.x = cvt_pk_bf16(o[0], o[1]); w.y = cvt_pk_bf16(o[2], o[3]); *(u32x2*)(XHo + off + bj * HALF + n * 16) = w; }
                ss += __shfl_xor(ss, 16); ss += __shfl_xor(ss, 32);
                if (fq == 0) SS[(size_t)row * 16 + u.pn * 4 + wc] = ss; }
    }
};
template <bool BASE16, bool STAT>
struct EpiRes16 {
    static constexpr bool PERM = true;
    const float* base32; bf16_t* XHo; float* SS; int ldc;
    __device__ __forceinline__ void operator()(AccRef acc, const Unit& u, int wr, int wc, int fr, int fq) const {
        const int row0 = u.pm * BM + wr * 64 + fr, col0 = u.pn * BM + wc * 32 + 8 * fq;
#pragma unroll
        for (int ai = 0; ai < 2; ++ai)
#pragma unroll
            for (int m = 0; m < 4; ++m) { const int row = row0 + ai * HALF + m * 16; const size_t off = (size_t)row * ldc + col0; float ss = 0.f;
#pragma unroll
                for (int bj = 0; bj < 2; ++bj) { f32x4 b0, b1;
                    if constexpr (BASE16) { const u32x4 r = *(const u32x4*)(XHo + off + bj * HALF); b0 = (f32x4){bflo(r.x), bfhi(r.x), bflo(r.y), bfhi(r.y)}; b1 = (f32x4){bflo(r.z), bfhi(r.z), bflo(r.w), bfhi(r.w)}; }
                    else { b0 = *(const f32x4*)(base32 + off + bj * HALF); b1 = *(const f32x4*)(base32 + off + bj * HALF + 4); }
                    const f32x4 o0 = b0 + acc[ai][bj][m][0], o1 = b1 + acc[ai][bj][m][1];
                    if constexpr (STAT) ss += ((o0[0] * o0[0] + o0[1] * o0[1]) + (o0[2] * o0[2] + o0[3] * o0[3])) + ((o1[0] * o1[0] + o1[1] * o1[1]) + (o1[2] * o1[2] + o1[3] * o1[3]));
                    u32x4 w; w.x = cvt_pk_bf16(o0[0], o0[1]); w.y = cvt_pk_bf16(o0[2], o0[3]); w.z = cvt_pk_bf16(o1[0], o1[1]); w.w = cvt_pk_bf16(o1[2], o1[3]);
                    *(u32x4*)(XHo + off + bj * HALF) = w; }
                if constexpr (STAT) { ss += __shfl_xor(ss, 16); ss += __shfl_xor(ss, 32);
                    if (fq == 0) SS[(size_t)row * 16 + u.pn * 4 + wc] = ss; } }
    }
};
struct EpiSwiGLU {
    static constexpr bool PERM = true;
    bf16_t* O; int ldc; const float* rsv;
    __device__ __forceinline__ void operator()(AccRef acc, const Unit& u, int wr, int wc, int fr, int fq) const {
        const int row0 = u.pm * BM + wr * 64 + fr, col0 = u.pn * HALF + wc * 32 + 8 * fq;
#pragma unroll
        for (int ai = 0; ai < 2; ++ai)
#pragma unroll
            for (int m = 0; m < 4; ++m) { const int row = row0 + ai * HALF + m * 16; bf16_t* rowp = O + (size_t)row * ldc + col0; const float rs = rsv ? rsv[row] : 1.0f;
                float o[8];
#pragma unroll
                for (int n = 0; n < 2; ++n)
#pragma unroll
                    for (int j = 0; j < 4; ++j) { const float gv = acc[ai][0][m][n][j] * rs, uv = acc[ai][1][m][n][j] * rs; o[n * 4 + j] = siluf_(gv) * uv; }
                u32x4 w; w.x = cvt_pk_bf16(o[0], o[1]); w.y = cvt_pk_bf16(o[2], o[3]); w.z = cvt_pk_bf16(o[4], o[5]); w.w = cvt_pk_bf16(o[6], o[7]);
                *(u32x4*)rowp = w; }
    }
};
struct EpiSwiGLU8 {
    static constexpr bool PERM = true;
    unsigned char* O8; int ldc; float oscale;
    __device__ __forceinline__ void operator()(AccRef acc, const Unit& u, int wr, int wc, int fr, int fq) const {
        const int row0 = u.pm * BM + wr * 64 + fr, col0 = u.pn * HALF + wc * 32 + 8 * fq;
#pragma unroll
        for (int ai = 0; ai < 2; ++ai)
#pragma unroll
            for (int m = 0; m < 4; ++m) { unsigned char* rowp = O8 + (size_t)(row0 + ai * HALF + m * 16) * ldc + col0;
                float o[8];
#pragma unroll
                for (int n = 0; n < 2; ++n)
#pragma unroll
                    for (int j = 0; j < 4; ++j) { const float gv = acc[ai][0][m][n][j], uv = acc[ai][1][m][n][j]; o[n * 4 + j] = siluf_(gv) * uv * oscale; }
                u32x2 w; w.x = pk_fp8x4(o[0], o[1], o[2], o[3]); w.y = pk_fp8x4(o[4], o[5], o[6], o[7]);
                *(u32x2*)rowp = w; }
    }
};
struct EpiKVQ {
    static constexpr bool PERM = true;
    bf16_t* KV; bf16_t* Q; float* GATE; const float* bgate; const float* rsv;
    __device__ __forceinline__ void operator()(AccRef acc, const Unit& u, int wr, int wc, int fr, int fq) const {
        const int row0 = u.pm * BM + wr * 64 + fr, cin = wc * 32 + 8 * fq;
#pragma unroll
        for (int ai = 0; ai < 2; ++ai)
#pragma unroll
            for (int m = 0; m < 4; ++m) { const int row = row0 + ai * HALF + m * 16; const float rs = rsv[row];
#pragma unroll
                for (int bj = 0; bj < 2; ++bj) { const f32x4 v0 = acc[ai][bj][m][0] * rs, v1 = acc[ai][bj][m][1] * rs; const int col = cin + bj * HALF;
                    if (u.pn < 6) { const int b = row >> 12, t = row & 4095, g = col >> 6, d = col & 63;
                        u32x4 w; w.x = cvt_pk_bf16(v0[0], v0[1]); w.y = cvt_pk_bf16(v0[2], v0[3]); w.z = cvt_pk_bf16(v1[0], v1[1]); w.w = cvt_pk_bf16(v1[2], v1[3]);
                        *(u32x4*)(KV + ((((size_t)u.pn * 8 + b) * 4 + g) * 4096 + t) * 64 + d) = w;
                    } else if (u.pn < 10) { const float s = 0.125f * 1.4426950408889634f;
                        u32x4 w; w.x = cvt_pk_bf16(v0[0] * s, v0[1] * s); w.y = cvt_pk_bf16(v0[2] * s, v0[3] * s); w.z = cvt_pk_bf16(v1[0] * s, v1[1] * s); w.w = cvt_pk_bf16(v1[2] * s, v1[3] * s);
                        *(u32x4*)(Q + (size_t)row * 1024 + (u.pn - 6) * 256 + col) = w;
                    } else if (col < 48) { const f32x4 b0 = *(const f32x4*)(bgate + col), b1 = *(const f32x4*)(bgate + col + 4);
                        f32x4 o0, o1;
#pragma unroll
                        for (int j = 0; j < 4; ++j) { o0[j] = sigmoidf_(v0[j] + b0[j]); o1[j] = sigmoidf_(v1[j] + b1[j]); }
                        *(f32x4*)(GATE + (size_t)row * 48 + col) = o0; *(f32x4*)(GATE + (size_t)row * 48 + col + 4) = o1; } } }
    }
};
struct EpiCmp {
    static constexpr bool PERM = true;
    bf16_t* O; const float* bias;
    __device__ __forceinline__ void operator()(AccRef acc, const Unit& u, int wr, int wc, int fr, int fq) const {
        const int row0 = u.pm * BM + wr * 64 + fr, col0 = wc * 32 + 8 * fq; const float* bp = bias + (u.pm >> 5) * 256 + col0;
#pragma unroll
        for (int ai = 0; ai < 2; ++ai)
#pragma unroll
            for (int m = 0; m < 4; ++m) { bf16_t* rowp = O + (size_t)(row0 + ai * HALF + m * 16) * 256 + col0;
#pragma unroll
                for (int bj = 0; bj < 2; ++bj) { const f32x4 b0 = *(const f32x4*)(bp + bj * HALF), b1 = *(const f32x4*)(bp + bj * HALF + 4);
                    const f32x4 v0 = acc[ai][bj][m][0] + b0, v1 = acc[ai][bj][m][1] + b1;
                    u32x4 w; w.x = cvt_pk_bf16(siluf_(v0[0]), siluf_(v0[1])); w.y = cvt_pk_bf16(siluf_(v0[2]), siluf_(v0[3])); w.z = cvt_pk_bf16(siluf_(v1[0]), siluf_(v1[1])); w.w = cvt_pk_bf16(siluf_(v1[2]), siluf_(v1[3]));
                    *(u32x4*)(rowp + bj * HALF) = w; } }
    }
};
}

struct MoeOrder {
    int nN, G, c; const char* A; const char* B; size_t tA, tBe, tBn; volatile LAS int* tb;
    __device__ __forceinline__ int expert_of(int pm) const { int e = 0;
#pragma unroll
        for (int i = 1; i < 8; ++i) e += (pm >= __builtin_amdgcn_readfirstlane(tb[i])) ? 1 : 0;
        return e; }
    __device__ __forceinline__ bool next(int i, pg8::Unit& u) const {
        const int nM = __builtin_amdgcn_readfirstlane(tb[8]);
        if (!pg8::tile_order(i, G, c, nM, nN, u.pm, u.pn)) return false;
        u.a = A + (size_t)u.pm * tA; u.b = B + (size_t)expert_of(u.pm) * tBe + (size_t)u.pn * tBn; return true; }
};
struct EpiMoeDown {
    static constexpr bool PERM = true;
    bf16_t* Y; const u32x2* rowinfo; const float* ew; volatile LAS int* tb;
    __device__ __forceinline__ void operator()(pg8::AccRef acc, const pg8::Unit& u, int wr, int wc, int fr, int fq) const {
        int e = 0;
#pragma unroll
        for (int i = 1; i < 8; ++i) e += (u.pm >= __builtin_amdgcn_readfirstlane(tb[i])) ? 1 : 0;
        const int nvalid = __builtin_amdgcn_readfirstlane(tb[16 + e]) - (u.pm - __builtin_amdgcn_readfirstlane(tb[e])) * 256;
        int rin0 = wr * 64 + fr; const int col0 = u.pn * 256 + wc * 32 + 8 * fq;
        asm volatile("" : "+v"(rin0));
#pragma unroll
        for (int ai = 0; ai < 2; ++ai)
#pragma unroll
            for (int m = 0; m < 4; ++m) { const int rin = rin0 + ai * 128 + m * 16;
                if (rin < nvalid) { const unsigned info = ((const unsigned*)rowinfo)[2 * ((size_t)u.pm * 256 + rin)]; const float w = ew[info];
                    bf16_t* dst = Y + ((size_t)(info & 1u) * M + (info >> 1)) * 1024 + col0;
#pragma unroll
                    for (int bj = 0; bj < 2; ++bj) { const f32x4 v0 = acc[ai][bj][m][0] * w, v1 = acc[ai][bj][m][1] * w;
                        u32x4 o; o.x = pg8::cvt_pk_bf16(v0[0], v0[1]); o.y = pg8::cvt_pk_bf16(v0[2], v0[3]); o.z = pg8::cvt_pk_bf16(v1[0], v1[1]); o.w = pg8::cvt_pk_bf16(v1[2], v1[3]);
                        *(u32x4*)(dst + bj * 128) = o; } } }
    }
};

__device__ __forceinline__ void conv_item(const float* W, int ld, int srcc0, int nvalid, bf16_t* WT, int ldd, int dstr0, const float* gain, int k0, int lane) {
    const int n4 = lane & 7, c = lane >> 3;
    f32x4 v[8];
#pragma unroll
    for (int i = 0; i < 8; ++i) { v[i] = (f32x4){0.f, 0.f, 0.f, 0.f};
        if (4 * n4 < nvalid) { v[i] = *(const f32x4*)(W + (size_t)(k0 + 8 * c + i) * ld + srcc0 + 4 * n4); if (gain) v[i] = v[i] * gain[k0 + 8 * c + i]; } }
#pragma unroll
    for (int j = 0; j < 4; ++j) { u32x4 o; o.x = pk2(v[0][j], v[1][j]); o.y = pk2(v[2][j], v[3][j]); o.z = pk2(v[4][j], v[5][j]); o.w = pk2(v[6][j], v[7][j]);
        *(u32x4*)(WT + (size_t)(dstr0 + 4 * n4 + j) * ldd + k0 + 8 * c) = o; }
}

struct W8 { const float* src; const float* gain; unsigned char* dst; int ld, ldd; float scale, gm, ga; };
__device__ __forceinline__ void conv8_load(const W8& d, int lane, f32x4 (&v)[16], f32x4 (&g)[4]) {
    const int n4 = lane & 7, c = lane >> 3;
#pragma unroll
    for (int i = 0; i < 16; ++i) v[i] = *(const f32x4*)(d.src + (size_t)(16 * c + i) * d.ld + 4 * n4);
#pragma unroll
    for (int q = 0; q < 4; ++q) g[q] = *(const f32x4*)(d.gain + 16 * c + 4 * q);
}
__device__ __forceinline__ void conv8_store(const W8& d, int lane, const f32x4 (&v)[16], const f32x4 (&g)[4]) {
    const int n4 = lane & 7, c = lane >> 3;
    f32x4 gs[4];
#pragma unroll
    for (int q = 0; q < 4; ++q) gs[q] = (g[q] * d.gm + d.ga) * d.scale;
#pragma unroll
    for (int j = 0; j < 4; ++j) { u32x4 o;
        o.x = pk_fp8x4(v[0][j] * gs[0].x, v[1][j] * gs[0].y, v[2][j] * gs[0].z, v[3][j] * gs[0].w);
        o.y = pk_fp8x4(v[4][j] * gs[1].x, v[5][j] * gs[1].y, v[6][j] * gs[1].z, v[7][j] * gs[1].w);
        o.z = pk_fp8x4(v[8][j] * gs[2].x, v[9][j] * gs[2].y, v[10][j] * gs[2].z, v[11][j] * gs[2].w);
        o.w = pk_fp8x4(v[12][j] * gs[3].x, v[13][j] * gs[3].y, v[14][j] * gs[3].z, v[15][j] * gs[3].w);
        *(u32x4*)(d.dst + (size_t)(4 * n4 + j) * d.ldd + 16 * c) = o; }
}

struct Args { const float* in[22]; float* out; unsigned char* ws; int ph_lo, ph_hi; };
typedef const __attribute__((address_space(4))) Args* CArgsP;
__device__ __forceinline__ CArgsP argp() { CArgsP p = (CArgsP)__builtin_amdgcn_kernarg_segment_ptr(); asm volatile("" : "+s"(p)); return p; }
#define A_IN(i) ((const float*)argp()->in[i])
enum { I_X = 0, I_NORM_MIX, I_NORM_FFN, I_A_W_IN, I_A_B_GATE, I_A_CONV, I_A_NORM_H, I_A_W_OUT, I_NORM_KV, I_B_W_KV, I_B_CMP_POS, I_B_CMP_W1, I_B_CMP_W2,
       I_B_W_Q, I_B_B_GATE, I_B_W_OUT, I_F_W_GU, I_F_W_DOWN, I_M_ROUTER, I_M_W_GU, I_M_W_DOWN, I_NORM_FINAL };

__device__ __forceinline__ W8 w8_decode(unsigned char* ws, int r) {
    constexpr int N8 = 8 * 8 * 224;
    W8 d;
    if (r < N8) { const int e = r / (8 * 224), rr = r % (8 * 224), kb = rr / 224, db = rr % 224, tile = db >> 3, w = db & 7; const int sc = (w < 4) ? (128 * tile + 32 * w) : (FE + 128 * tile + 32 * (w - 4));
        d.src = A_IN(I_M_W_GU) + (size_t)e * 1024 * 2 * FE + (size_t)(128 * kb) * (2 * FE) + sc; d.ld = 2 * FE; d.gain = A_IN(I_NORM_FFN) + 1024 + 128 * kb; d.scale = 128.f; d.gm = 1.f; d.ga = 0.f;
        d.dst = ws + WS_MGU + (size_t)e * 2 * FE * 1024 + (size_t)(32 * db) * 1024 + 128 * kb; d.ldd = 1024; }
    else { r -= N8; const int e = r / (28 * 32), rr = r % (28 * 32), kb = rr / 32, db = rr % 32;
        d.src = A_IN(I_M_W_DOWN) + (size_t)e * FE * 1024 + (size_t)(128 * kb) * 1024 + 32 * db; d.ld = 1024; d.gain = A_IN(I_NORM_FFN); d.scale = 256.f; d.gm = 0.f; d.ga = 1.f;
        d.dst = ws + WS_MDOWN + (size_t)e * 1024 * FE + (size_t)(32 * db) * FE + 128 * kb; d.ldd = FE; }
    return d;
}
__device__ __forceinline__ void p0_item16(unsigned char* ws, int r, int lane) {
    constexpr int N1 = 16 * 128, N2 = 16 * 32, N3 = 16 * 176, N4 = 44 * 32, N5 = 16 * 88, N6 = 2 * 32 * 8;
    if (r < N1) { const int kb = r / 128, db = r % 128; conv_item(A_IN(I_A_W_IN), NPROJ_SRC, 32 * db, 32, (bf16_t*)(ws + WS_WIN), 1024, 32 * db, A_IN(I_NORM_MIX), 64 * kb, lane); return; } r -= N1;
    if (r < N2) { const int kb = r / 32, db = r % 32; conv_item(A_IN(I_A_W_OUT), 1024, 32 * db, 32, (bf16_t*)(ws + WS_WOUTA), 1024, 32 * db, nullptr, 64 * kb, lane); return; } r -= N2;
    if (r < N3) { const int kb = r / 176, db = r % 176, tile = db >> 3, w = db & 7; const int sc = (w < 4) ? (128 * tile + 32 * w) : (FFD + 128 * tile + 32 * (w - 4));
        conv_item(A_IN(I_F_W_GU), 2 * FFD, sc, 32, (bf16_t*)(ws + WS_WGU), 1024, 32 * db, A_IN(I_NORM_FFN), 64 * kb, lane); return; } r -= N3;
    if (r < N4) { const int kb = r / 32, db = r % 32; conv_item(A_IN(I_F_W_DOWN), 1024, 32 * db, 32, (bf16_t*)(ws + WS_WDOWN), FFD, 32 * db, nullptr, 64 * kb, lane); return; } r -= N4;
    if (r < N5) { const int kb = r / 88, db = r % 88;
        if (db < 48) conv_item(A_IN(I_B_W_KV), 1536, 32 * db, 32, (bf16_t*)(ws + WS_WKVQ), 1024, 32 * db, A_IN(I_NORM_KV), 64 * kb, lane);
        else { const int sc = 32 * (db - 48); int nv = NQSRC - sc; nv = nv < 0 ? 0 : (nv > 32 ? 32 : nv);
            conv_item(A_IN(I_B_W_Q), NQSRC, sc, nv, (bf16_t*)(ws + WS_WKVQ), 1024, 32 * db, A_IN(I_NORM_MIX) + 1024, 64 * kb, lane); }
        return; } r -= N5;
    if (r < N6) { const int c = r / 256, rr = r % 256, kb = rr / 8, db = rr % 8; conv_item(A_IN(I_B_CMP_W1) + (size_t)c * 2048 * 256, 256, 32 * db, 32, (bf16_t*)(ws + WS_WCMP1) + (size_t)c * 256 * 2048, 2048, 32 * db, nullptr, 64 * kb, lane); return; } r -= N6;
    if (r < 16 * 32) { const int kb = r / 32, db = r % 32; conv_item(A_IN(I_B_W_OUT), 1024, 32 * db, 32, (bf16_t*)(ws + WS_WOUTB), 1024, 32 * db, nullptr, 64 * kb, lane); return; } r -= 16 * 32;
    { const int c = r >> 3, kb = (r >> 1) & 3, db = r & 1;
        conv_item(A_IN(I_B_CMP_W2) + (size_t)c * 256 * 64, 64, 32 * db, 32, (bf16_t*)(ws + WS_W2T) + (size_t)c * 64 * 256, 256, 32 * db, nullptr, 64 * kb, lane); }
}
__device__ __forceinline__ void p0_weights(unsigned char* ws, LAS unsigned char* lds, int gw, int NGW, int wave, int lane) {
    constexpr int N1 = 16 * 128, N2 = 16 * 32, N3 = 16 * 176, N4 = 44 * 32, N5 = 16 * 88, N6 = 2 * 32 * 8, N7 = 16 * 32;
    constexpr int NB16 = N1 + N2 + N3 + N4 + N5 + N6 + N7 + 16, NT8 = 8 * 8 * 224 + 8 * 28 * 32;
    {   f32x4 va[16], ga[4], vb[16], gb[4]; W8 da, db;
        int it = gw;
        da = w8_decode(ws, it); conv8_load(da, lane, va, ga);
        for (;;) {
            int nx = it + NGW; db = w8_decode(ws, nx < NT8 ? nx : NT8 - 1); if (nx >= NT8) db.ld = 0;
            conv8_load(db, lane, vb, gb); __builtin_amdgcn_sched_barrier(0);
            conv8_store(da, lane, va, ga);
            if (nx >= NT8) break;
            it = nx; nx = it + NGW; da = w8_decode(ws, nx < NT8 ? nx : NT8 - 1); if (nx >= NT8) da.ld = 0;
            conv8_load(da, lane, va, ga); __builtin_amdgcn_sched_barrier(0);
            conv8_store(db, lane, vb, gb);
            if (nx >= NT8) break;
            it = nx; }
    }
    for (int it = gw; it < NB16; it += NGW) p0_item16(ws, it, lane);
}

__device__ __forceinline__ void load_row(const float* row, int lane, f32x4 (&v)[4]) {
    const f32x4* xr = (const f32x4*)row + lane;
#pragma unroll
    for (int j = 0; j < 4; ++j) v[j] = xr[64 * j];
}
__device__ __forceinline__ float row_rstd(const f32x4 (&v)[4]) {
    float s = 0.f;
#pragma unroll
    for (int j = 0; j < 4; ++j) s += (v[j].x * v[j].x + v[j].y * v[j].y) + (v[j].z * v[j].z + v[j].w * v[j].w);
    return 1.0f / sqrtf(wave_sum(s) * (1.f / 1024.f) + EPS);
}
__device__ __forceinline__ void store_row_bf16(bf16_t* orow, int lane, const f32x4 (&v)[4], float sc) {
    u64* o8 = (u64*)orow + lane;
#pragma unroll
    for (int j = 0; j < 4; ++j) o8[64 * j] = (u64)pk2(v[j].x * sc, v[j].y * sc) | ((u64)pk2(v[j].z * sc, v[j].w * sc) << 32);
}

__device__ __forceinline__ f32x4 mma_lds(const LAS bf16_t* A, int lda, const LAS bf16_t* Bt, int ldb, int K, f32x4 acc, int lane) {
    const int r = lane & 15, q = lane >> 4;
    const LAS bf16_t* ap = A + r * lda + 8 * q; const LAS bf16_t* bp = Bt + r * ldb + 8 * q;
    for (int k = 0; k < K; k += 32) { const bf16x8 a = *(const LAS bf16x8*)(ap + k), b = *(const LAS bf16x8*)(bp + k); acc = __builtin_amdgcn_mfma_f32_16x16x32_bf16(a, b, acc, 0, 0, 0); }
    return acc;
}

__device__ __forceinline__ void scanprep_phase(LAS unsigned char* lds, const bf16_t* P3, const float* GA, const float* conv_w, unsigned char* IMG, int vcu, int G) {
    const int tid = threadIdx.x, wave = __builtin_amdgcn_readfirstlane(tid >> 6), lane = tid & 63;
    constexpr int QS = 272, LDP = 3072;
    LAS bf16_t* Qs = (LAS bf16_t*)(lds + 0);
    LAS bf16_t* Kd = (LAS bf16_t*)(lds + 34816);
    LAS float* fg = (LAS float*)(lds + 67584);
    LAS float* cw = (LAS float*)(lds + 68352);
    const bool same_h = (G & 255) == 0; int h_loaded = -1;
    for (int item = vcu; item < 2048; item += G) {
        const int b = item >> 8, h = (item >> 6) & 3, ci = item & 63, t0 = ci * 64; const size_t rb = (size_t)b * SEQ + t0;
        unsigned char* img = IMG + (size_t)item * IMG_STRIDE;
        const int cg = tid & 31, rg = tid >> 5;
        u32x4 rawq[7], rawk[7];
#pragma unroll
        for (int r7 = 0; r7 < 7; ++r7) { const int tt = 4 * rg - 3 + r7; rawq[r7] = (u32x4){0u, 0u, 0u, 0u}; rawk[r7] = (u32x4){0u, 0u, 0u, 0u};
            if (t0 + tt >= 0) { const bf16_t* p = P3 + (rb + tt) * LDP + h * 256 + 8 * cg; rawq[r7] = *(const u32x4*)p; rawk[r7] = *(const u32x4*)(p + 1024); } }
        const int vv = tid & 255, hf = tid >> 8; unsigned short ev[32];
        { const bf16_t* vp = P3 + (rb + 32 * hf) * LDP + 2048 + h * 256 + vv;
#pragma unroll
          for (int i = 0; i < 32; ++i) ev[i] = vp[(size_t)i * LDP]; }
        float gli = 0.f, glf = 0.f; if (wave == 7) { gli = GA[(rb + lane) * 8 + h]; glf = GA[(rb + lane) * 8 + 4 + h]; }
        __syncthreads();
        if (h != h_loaded || !same_h) {
            for (int i = tid; i < 2048; i += NTHR) { const int j = i >> 8, kk = i & 255; cw[i] = conv_w[(j & 3) * 2048 + (j >> 2) * 1024 + h * 256 + kk]; }
            for (int i = tid; i < 64 * 16; i += NTHR) { const int r = i >> 4, c = i & 15; Qs[r * QS + 256 + c] = 0; }
            h_loaded = h; __syncthreads(); }
        { bf16_t* op = (bf16_t*)(img + IMG_VT) + vv * 80 + 32 * hf;
#pragma unroll
          for (int g8 = 0; g8 < 4; ++g8) { u32x4 w; w.x = ev[8 * g8] | ((unsigned)ev[8 * g8 + 1] << 16); w.y = ev[8 * g8 + 2] | ((unsigned)ev[8 * g8 + 3] << 16); w.z = ev[8 * g8 + 4] | ((unsigned)ev[8 * g8 + 5] << 16); w.w = ev[8 * g8 + 6] | ((unsigned)ev[8 * g8 + 7] << 16);
              *(u32x4*)(op + 8 * g8) = w; }
          *(u32x4*)((bf16_t*)(img + IMG_VT) + vv * 80 + 64 + 8 * hf) = (u32x4){0u, 0u, 0u, 0u}; }
        {
#pragma unroll
          for (int which = 0; which < 2; ++which) {
            float x[7][8];
#pragma unroll
            for (int r7 = 0; r7 < 7; ++r7) { const u32x4 raw = which ? rawk[r7] : rawq[r7];
                x[r7][0] = bflo(raw.x); x[r7][1] = bfhi(raw.x); x[r7][2] = bflo(raw.y); x[r7][3] = bfhi(raw.y); x[r7][4] = bflo(raw.z); x[r7][5] = bfhi(raw.z); x[r7][6] = bflo(raw.w); x[r7][7] = bfhi(raw.w); }
            float w[4][8];
#pragma unroll
            for (int tap = 0; tap < 4; ++tap) { const f32x4 w0 = *(const LAS f32x4*)(cw + (which * 4 + tap) * 256 + 8 * cg), w1 = *(const LAS f32x4*)(cw + (which * 4 + tap) * 256 + 8 * cg + 4);
                w[tap][0] = w0.x; w[tap][1] = w0.y; w[tap][2] = w0.z; w[tap][3] = w0.w; w[tap][4] = w1.x; w[tap][5] = w1.y; w[tap][6] = w1.z; w[tap][7] = w1.w; }
            const float sc = which ? 0.0625f : 1.0f;
#pragma unroll
            for (int j = 0; j < 4; ++j) { float o[8];
#pragma unroll
                for (int c = 0; c < 8; ++c) o[c] = (w[0][c] * x[j][c] + w[1][c] * x[j + 1][c] + w[2][c] * x[j + 2][c] + w[3][c] * x[j + 3][c]) * sc;
                u32x4 p; p.x = pg8::cvt_pk_bf16(o[0], o[1]); p.y = pg8::cvt_pk_bf16(o[2], o[3]); p.z = pg8::cvt_pk_bf16(o[4], o[5]); p.w = pg8::cvt_pk_bf16(o[6], o[7]);
                if (which) *(LAS u32x4*)(Kd + (4 * rg + j) * 256 + 8 * cg) = p; else *(LAS u32x4*)(Qs + (4 * rg + j) * QS + 8 * cg) = p; }
          }
          if (wave == 7) { const float li = gli, lf = glf;
              float bc = lf;
#pragma unroll
              for (int o = 1; o < 64; o <<= 1) { const float t = __shfl_up(bc, o); if (lane >= o) bc += t; }
              const float uu = li - bc; float pm = uu;
#pragma unroll
              for (int o = 1; o < 64; o <<= 1) { const float t = __shfl_up(pm, o); if (lane >= o) pm = fmaxf(pm, t); }
              fg[lane] = bc; fg[64 + lane] = uu; fg[128 + lane] = pm; }
        }
        __syncthreads();
        { const int k = tid & 255; bf16_t* op = (bf16_t*)(img + IMG_KT) + k * 64 + 32 * hf;
#pragma unroll
          for (int g8 = 0; g8 < 4; ++g8) { unsigned short e[8];
#pragma unroll
              for (int i = 0; i < 8; ++i) e[i] = Kd[(32 * hf + 8 * g8 + i) * 256 + k];
              u32x4 w; w.x = e[0] | ((unsigned)e[1] << 16); w.y = e[2] | ((unsigned)e[3] << 16); w.z = e[4] | ((unsigned)e[5] << 16); w.w = e[6] | ((unsigned)e[7] << 16);
              *(u32x4*)(op + 8 * g8) = w; } }
        for (int i = tid; i < 67584 / 16; i += NTHR) *(u32x4*)(img + (size_t)i * 16) = *(const LAS u32x4*)(lds + i * 16);
        if (tid < 48) *(u32x4*)(img + IMG_G + tid * 16) = *(const LAS u32x4*)(lds + 67584 + tid * 16);
    }
}

__device__ __forceinline__ void scan_phase(LAS unsigned char* lds, const unsigned char* IMG, float* HS, float* DN, int vcu, int G) {
    const int tid = threadIdx.x, wave = __builtin_amdgcn_readfirstlane(tid >> 6), lane = tid & 63, cl = lane & 15, q4 = lane >> 4;
    constexpr int QS = 272, TS = 80;
    LAS bf16_t* Qs = (LAS bf16_t*)(lds + 0);
    LAS bf16_t* Cbs = (LAS bf16_t*)(lds + 34816);
    LAS bf16_t* VTs = (LAS bf16_t*)(lds + 52768);
    LAS bf16_t* VaTs = (LAS bf16_t*)(lds + 58048);
    LAS bf16_t* Sws = (LAS bf16_t*)(lds + 63328);
    LAS float* fg = (LAS float*)(lds + 73568);
    const int r2 = cl ? 32 : 32;
    for (int u = vcu; u < 256; u += G) {
        const int b = u >> 5, h = (u >> 3) & 3, vs = u & 7;
        const unsigned char* img0 = IMG + (size_t)((b * 4 + h) * 64) * IMG_STRIDE;
        __syncthreads();
        for (int i = tid; i < 33 * QS; i += NTHR) Cbs[i] = 0;
        for (int i = tid; i < TS; i += NTHR) { VTs[32 * TS + i] = (i < 64) ? (bf16_t)0x3F80 : (bf16_t)0; VaTs[32 * TS + i] = 0; }
        f32x4 Cacc[2][3];
#pragma unroll
        for (int kk = 0; kk < 2; ++kk)
#pragma unroll
            for (int vt = 0; vt < 3; ++vt) Cacc[kk][vt] = (f32x4){0.f, 0.f, 0.f, 0.f};
        float mstate = 0.f;
        u32x4 pfq[5], pfv, pfg;
        bf16x8 kfr[8], ktf[2][2];
#define SCAN_LOAD(ci_) do { const unsigned char* ip = img0 + (size_t)(ci_) * IMG_STRIDE; \
            _Pragma("unroll") for (int k = 0; k < 5; ++k) { const int id = tid + 512 * k; if (id < 2176) pfq[k] = *(const u32x4*)(ip + (size_t)id * 16); } \
            if (tid < 320) pfv = *(const u32x4*)(ip + IMG_VT + vs * 5120 + tid * 16); \
            if (tid < 48) pfg = *(const u32x4*)(ip + IMG_G + tid * 16); } while (0)
#define SCAN_LOAD_K(ci_) do { if (wave >= 4) { const bf16_t* kp = (const bf16_t*)(img0 + (size_t)(ci_) * IMG_STRIDE + IMG_K) + (16 * (wave - 4) + cl) * 256 + 8 * q4; \
            _Pragma("unroll") for (int ks = 0; ks < 8; ++ks) kfr[ks] = *(const bf16x8*)(kp + 32 * ks); } } while (0)
#define SCAN_LOAD_KT(ci_) do { const bf16_t* kp = (const bf16_t*)(img0 + (size_t)(ci_) * IMG_STRIDE + IMG_KT) + (32 * wave + cl) * 64 + 8 * q4; \
            _Pragma("unroll") for (int kk = 0; kk < 2; ++kk) _Pragma("unroll") for (int ks = 0; ks < 2; ++ks) ktf[kk][ks] = *(const bf16x8*)(kp + kk * 1024 + 32 * ks); } while (0)
        SCAN_LOAD(0); SCAN_LOAD_K(0); SCAN_LOAD_KT(0);
        for (int ci = 0; ci < 64; ++ci) {
            const size_t rb = (size_t)b * SEQ + ci * 64;
#pragma unroll
            for (int k = 0; k < 5; ++k) { const int id = tid + 512 * k; if (id < 2176) *(LAS u32x4*)(lds + id * 16) = pfq[k]; }
            if (tid < 320) *(LAS u32x4*)((LAS unsigned char*)VTs + tid * 16) = pfv;
            if (tid < 48) *(LAS u32x4*)((LAS unsigned char*)fg + tid * 16) = pfg;
            if (ci + 1 < 64) SCAN_LOAD(ci + 1);
            LDS_BARRIER();
            const float pm63 = fg[128 + 63], bc63 = fg[63];
            const float M63 = fmaxf(mstate, pm63), aprev = ex2((mstate - M63) * 1.4426950408889634f);
            f32x4 hacc[3];
            if (wave < 4) {
                const int ti = wave;
#pragma unroll
                for (int vt = 0; vt < 3; ++vt) hacc[vt] = (f32x4){0.f, 0.f, 0.f, 0.f};
#pragma unroll
                for (int ks = 0; ks < 8; ++ks) { const bf16x8 a = *(const LAS bf16x8*)(Qs + (16 * ti + cl) * QS + 32 * ks + 8 * q4);
                    const bf16x8 b0 = *(const LAS bf16x8*)(Cbs + cl * QS + 32 * ks + 8 * q4), b1 = *(const LAS bf16x8*)(Cbs + (16 + cl) * QS + 32 * ks + 8 * q4), b2 = *(const LAS bf16x8*)(Cbs + r2 * QS + 32 * ks + 8 * q4);
                    hacc[0] = __builtin_amdgcn_mfma_f32_16x16x32_bf16(a, b0, hacc[0], 0, 0, 0); hacc[1] = __builtin_amdgcn_mfma_f32_16x16x32_bf16(a, b1, hacc[1], 0, 0, 0); hacc[2] = __builtin_amdgcn_mfma_f32_16x16x32_bf16(a, b2, hacc[2], 0, 0, 0); }
#pragma unroll
                for (int j = 0; j < 4; ++j) { const float wint = ex2((mstate - fmaxf(mstate, fg[128 + 16 * ti + 4 * q4 + j])) * 1.4426950408889634f); hacc[0][j] *= wint; hacc[1][j] *= wint; hacc[2][j] *= wint; }
            } else {
                const int si = wave - 4; f32x4 us4;
#pragma unroll
                for (int j = 0; j < 4; ++j) us4[j] = fg[64 + 16 * si + 4 * q4 + j];
#pragma unroll
                for (int ti = 0; ti < 4; ++ti) { u32x2 w = (u32x2){0u, 0u};
                    if (ti >= si) { f32x4 sacc = (f32x4){0.f, 0.f, 0.f, 0.f};
#pragma unroll
                        for (int ks = 0; ks < 8; ++ks) { const bf16x8 qb = *(const LAS bf16x8*)(Qs + (16 * ti + cl) * QS + 32 * ks + 8 * q4); sacc = __builtin_amdgcn_mfma_f32_16x16x32_bf16(kfr[ks], qb, sacc, 0, 0, 0); }
                        const int t = 16 * ti + cl; const float Mt = fmaxf(mstate, fg[128 + t]); float p[4];
#pragma unroll
                        for (int j = 0; j < 4; ++j) { const int s_ = 16 * si + 4 * q4 + j; p[j] = (s_ <= t) ? sacc[j] * ex2((us4[j] - Mt) * 1.4426950408889634f) : 0.f; }
                        w.x = pg8::cvt_pk_bf16(p[0], p[1]); w.y = pg8::cvt_pk_bf16(p[2], p[3]); }
                    *(LAS u32x2*)(Sws + (16 * ti + cl) * TS + 16 * si + 4 * q4) = w; }
                if (ci + 1 < 64) SCAN_LOAD_K(ci + 1);
            }
            if (tid < 264) { const int v = tid >> 3, s8 = (tid & 7) * 8; const u32x4 raw = *(const LAS u32x4*)(VTs + v * TS + s8); float a[8];
#pragma unroll
                for (int i = 0; i < 8; ++i) a[i] = ex2((fg[64 + s8 + i] - M63) * 1.4426950408889634f);
                u32x4 w; w.x = pg8::cvt_pk_bf16(bflo(raw.x) * a[0], bfhi(raw.x) * a[1]); w.y = pg8::cvt_pk_bf16(bflo(raw.y) * a[2], bfhi(raw.y) * a[3]); w.z = pg8::cvt_pk_bf16(bflo(raw.z) * a[4], bfhi(raw.z) * a[5]); w.w = pg8::cvt_pk_bf16(bflo(raw.w) * a[6], bfhi(raw.w) * a[7]);
                *(LAS u32x4*)(VaTs + v * TS + s8) = w; }
            LDS_BARRIER();
            if (wave < 4) {
                const int ti = wave;
#pragma unroll
                for (int ks = 0; ks < 2; ++ks) { const bf16x8 a = *(const LAS bf16x8*)(Sws + (16 * ti + cl) * TS + 32 * ks + 8 * q4);
                    const bf16x8 b0 = *(const LAS bf16x8*)(VTs + cl * TS + 32 * ks + 8 * q4), b1 = *(const LAS bf16x8*)(VTs + (16 + cl) * TS + 32 * ks + 8 * q4), b2 = *(const LAS bf16x8*)(VTs + r2 * TS + 32 * ks + 8 * q4);
                    hacc[0] = __builtin_amdgcn_mfma_f32_16x16x32_bf16(a, b0, hacc[0], 0, 0, 0); hacc[1] = __builtin_amdgcn_mfma_f32_16x16x32_bf16(a, b1, hacc[1], 0, 0, 0); hacc[2] = __builtin_amdgcn_mfma_f32_16x16x32_bf16(a, b2, hacc[2], 0, 0, 0); }
#pragma unroll
                for (int j = 0; j < 4; ++j) { const int t = 16 * ti + 4 * q4 + j; float* hp = HS + (rb + t) * 1024 + h * 256 + vs * 32 + cl; hp[0] = hacc[0][j]; hp[16] = hacc[1][j];
                    if (vs == 0 && cl == 0) { const float Mtt = fmaxf(mstate, fg[128 + t]); DN[(rb + t) * 4 + h] = fmaxf(fabsf(hacc[2][j]), ex2(-(fg[t] + Mtt) * 1.4426950408889634f)); } }
            }
#pragma unroll
            for (int kk = 0; kk < 2; ++kk)
#pragma unroll
                for (int vt = 0; vt < 3; ++vt) Cacc[kk][vt] = Cacc[kk][vt] * aprev;
#pragma unroll
            for (int ks = 0; ks < 2; ++ks) { const bf16x8 b0 = *(const LAS bf16x8*)(VaTs + cl * TS + 32 * ks + 8 * q4), b1 = *(const LAS bf16x8*)(VaTs + (16 + cl) * TS + 32 * ks + 8 * q4), b2 = *(const LAS bf16x8*)(VaTs + r2 * TS + 32 * ks + 8 * q4);
#pragma unroll
                for (int kk = 0; kk < 2; ++kk) { Cacc[kk][0] = __builtin_amdgcn_mfma_f32_16x16x32_bf16(ktf[kk][ks], b0, Cacc[kk][0], 0, 0, 0); Cacc[kk][1] = __builtin_amdgcn_mfma_f32_16x16x32_bf16(ktf[kk][ks], b1, Cacc[kk][1], 0, 0, 0);
                    Cacc[kk][2] = __builtin_amdgcn_mfma_f32_16x16x32_bf16(ktf[kk][ks], b2, Cacc[kk][2], 0, 0, 0); } }
#pragma unroll
            for (int kk = 0; kk < 2; ++kk)
#pragma unroll
                for (int vt = 0; vt < 3; ++vt) { if (vt < 2 || cl == 0) { u32x2 w; w.x = pg8::cvt_pk_bf16(Cacc[kk][vt][0], Cacc[kk][vt][1]); w.y = pg8::cvt_pk_bf16(Cacc[kk][vt][2], Cacc[kk][vt][3]);
                        *(LAS u32x2*)(Cbs + (16 * vt + cl) * QS + 32 * wave + 16 * kk + 4 * q4) = w; } }
            if (ci + 1 < 64) SCAN_LOAD_KT(ci + 1);
            mstate = bc63 + M63;
            LDS_BARRIER();
        }
#undef SCAN_LOAD
#undef SCAN_LOAD_K
#undef SCAN_LOAD_KT
    }
}

template <int MODE, bool EDGE>
__device__ __forceinline__ void attn_tile2(const LAS bf16_t* Kt, const LAS bf16_t* VTt, LAS bf16_t* Pw, const bf16x8 (&qa)[2], const f32x4 bv0, int jb, int t0, int th, float slope2,
                                           u64 tsel, f32x4 (&O)[4], float& mrow, float& lrow, int lane) {
    const int cl = lane & 15, q4 = lane >> 4; constexpr int TS = 72;
    f32x4 s[4];
#pragma unroll
    for (int nt = 0; nt < 4; ++nt) { s[nt] = bv0;
#pragma unroll
        for (int ks = 0; ks < 2; ++ks) { const bf16x8 kb = *(const LAS bf16x8*)(Kt + (16 * nt + cl) * TS + 32 * ks + 8 * q4); s[nt] = __builtin_amdgcn_mfma_f32_16x16x32_bf16(kb, qa[ks], s[nt], 0, 0, 0); } }
    const float b0 = slope2 * (float)(64 * jb - (t0 + 31)), o16 = slope2 * 16.f;
    bool rowok = true; if (MODE == 0) rowok = ((tsel >> (16 * th + cl)) & 1ull) != 0ull;
    if (EDGE) { const int dbase = t0 + 16 * th + cl - (64 * jb + 4 * q4);
#pragma unroll
        for (int nt = 0; nt < 4; ++nt)
#pragma unroll
            for (int j = 0; j < 4; ++j) { const int dist = dbase - (16 * nt + j); const bool ok = dist >= 0 && (MODE == 0 || dist < 512); s[nt][j] = ok ? s[nt][j] : -INFINITY; } }
    float mx = fmaxf(fmaxf(s[0][0], s[0][1]), fmaxf(s[0][2], s[0][3]));
#pragma unroll
    for (int n = 1; n < 4; ++n) mx = fmaxf(mx, fmaxf(fmaxf(s[n][0], s[n][1]), fmaxf(s[n][2], s[n][3])) + (float)n * o16);
    mx = rowok ? mx + b0 : -INFINITY;
    mx = fmaxf(mx, __shfl_xor(mx, 16)); mx = fmaxf(mx, __shfl_xor(mx, 32));
    const float mold = mrow, mnew = fmaxf(mold, mx), msafe = (mnew == -INFINITY) ? 0.f : mnew;
    const float alpha = (mold == -INFINITY) ? 0.f : ex2(mold - msafe);
    const float ref = rowok ? (msafe - b0) : INFINITY;
    float rs = 0.f;
    unsigned pw[4][2];
#pragma unroll
    for (int nt = 0; nt < 4; ++nt) { float p[4]; const float refn = ref - (float)nt * o16;
#pragma unroll
        for (int j = 0; j < 4; ++j) { p[j] = ex2(s[nt][j] - refn); rs += p[j]; }
        pw[nt][0] = pg8::cvt_pk_bf16(p[0], p[1]); pw[nt][1] = pg8::cvt_pk_bf16(p[2], p[3]); }
    rs += __shfl_xor(rs, 16); rs += __shfl_xor(rs, 32);
    lrow = lrow * alpha + rs; mrow = mnew;
#pragma unroll
    for (int dt = 0; dt < 4; ++dt) O[dt] = O[dt] * alpha;
#pragma unroll
    for (int ks = 0; ks < 2; ++ks) { const bf16x8 pa = __builtin_bit_cast(bf16x8, (u32x4){pw[2 * ks][0], pw[2 * ks][1], pw[2 * ks + 1][0], pw[2 * ks + 1][1]});
#pragma unroll
        for (int dt = 0; dt < 4; ++dt) { const bf16x8 vb = *(const LAS bf16x8*)(VTt + (16 * dt + cl) * TS + 32 * ks + 8 * q4); O[dt] = __builtin_amdgcn_mfma_f32_16x16x32_bf16(vb, pa, O[dt], 0, 0, 0); } }
}

template <int MODE>
__device__ __forceinline__ void attn_pair(const LAS bf16_t* KtA, const LAS bf16_t* KtB, LAS bf16_t* Pw, const bf16x8 (&qa)[2], const f32x4 bv0, int jA, int jB, int t0, int th, float slope2,
                                          u64 tselA, u64 tselB, f32x4 (&O)[4], float& mrow, float& lrow, int lane) {
    const int cl = lane & 15, q4 = lane >> 4; constexpr int TS = 72, PP = 136;
    f32x4 s[8];
#pragma unroll
    for (int nt = 0; nt < 8; ++nt) { const LAS bf16_t* Kt = (nt < 4) ? KtA : KtB; s[nt] = bv0;
#pragma unroll
        for (int ks = 0; ks < 2; ++ks) { const bf16x8 kb = *(const LAS bf16x8*)(Kt + (16 * (nt & 3) + cl) * TS + 32 * ks + 8 * q4); s[nt] = __builtin_amdgcn_mfma_f32_16x16x32_bf16(kb, qa[ks], s[nt], 0, 0, 0); } }
    const float o16 = slope2 * 16.f, bA = slope2 * (float)(64 * jA - (t0 + 31)), bB = slope2 * (float)(64 * jB - (t0 + 31));
    bool okA = true, okB = true; if (MODE == 0) { okA = ((tselA >> (16 * th + cl)) & 1ull) != 0ull; okB = ((tselB >> (16 * th + cl)) & 1ull) != 0ull; }
    float mA = fmaxf(fmaxf(s[0][0], s[0][1]), fmaxf(s[0][2], s[0][3])), mB = fmaxf(fmaxf(s[4][0], s[4][1]), fmaxf(s[4][2], s[4][3]));
#pragma unroll
    for (int n = 1; n < 4; ++n) { mA = fmaxf(mA, fmaxf(fmaxf(s[n][0], s[n][1]), fmaxf(s[n][2], s[n][3])) + (float)n * o16); mB = fmaxf(mB, fmaxf(fmaxf(s[4 + n][0], s[4 + n][1]), fmaxf(s[4 + n][2], s[4 + n][3])) + (float)n * o16); }
    float mx = fmaxf(okA ? mA + bA : -INFINITY, okB ? mB + bB : -INFINITY);
    mx = fmaxf(mx, __shfl_xor(mx, 16)); mx = fmaxf(mx, __shfl_xor(mx, 32));
    const float mold = mrow, mnew = fmaxf(mold, mx), msafe = (mnew == -INFINITY) ? 0.f : mnew;
    const float alpha = (mold == -INFINITY) ? 0.f : ex2(mold - msafe);
    const float refA = okA ? (msafe - bA) : INFINITY, refB = okB ? (msafe - bB) : INFINITY;
    float rs = 0.f;
    unsigned pw[8][2];
#pragma unroll
    for (int nt = 0; nt < 8; ++nt) { float p[4]; const float refn = ((nt < 4) ? refA : refB) - (float)(nt & 3) * o16;
#pragma unroll
        for (int j = 0; j < 4; ++j) { p[j] = ex2(s[nt][j] - refn); rs += p[j]; }
        pw[nt][0] = pg8::cvt_pk_bf16(p[0], p[1]); pw[nt][1] = pg8::cvt_pk_bf16(p[2], p[3]); }
    rs += __shfl_xor(rs, 16); rs += __shfl_xor(rs, 32);
    lrow = lrow * alpha + rs; mrow = mnew;
#pragma unroll
    for (int dt = 0; dt < 4; ++dt) O[dt] = O[dt] * alpha;
#pragma unroll
    for (int ks = 0; ks < 4; ++ks) { const bf16x8 pa = __builtin_bit_cast(bf16x8, (u32x4){pw[2 * ks][0], pw[2 * ks][1], pw[2 * ks + 1][0], pw[2 * ks + 1][1]}); const LAS bf16_t* VTt = ((ks < 2) ? KtA : KtB) + 4608;
#pragma unroll
        for (int dt = 0; dt < 4; ++dt) { const bf16x8 vb = *(const LAS bf16x8*)(VTt + (16 * dt + cl) * TS + 32 * (ks & 1) + 8 * q4); O[dt] = __builtin_amdgcn_mfma_f32_16x16x32_bf16(vb, pa, O[dt], 0, 0, 0); } }
    LDS_WAIT();
}

template <int MODE>
__device__ __forceinline__ void attn_pair_fast(const LAS bf16_t* KtA, const LAS bf16_t* KtB, LAS bf16_t* Pw, const bf16x8 (&qa)[2], const f32x4 bv0, int jA, int jB, int t0, int th, float slope2,
                                               u64 tselA, u64 tselB, f32x4 (&O)[4], float mrow, float& lrow, int lane) {
    const int cl = lane & 15, q4 = lane >> 4; constexpr int TS = 72, PP = 136;
    f32x4 s[8];
#pragma unroll
    for (int nt = 0; nt < 8; ++nt) { const LAS bf16_t* Kt = (nt < 4) ? KtA : KtB; s[nt] = bv0;
#pragma unroll
        for (int ks = 0; ks < 2; ++ks) { const bf16x8 kb = *(const LAS bf16x8*)(Kt + (16 * (nt & 3) + cl) * TS + 32 * ks + 8 * q4); s[nt] = __builtin_amdgcn_mfma_f32_16x16x32_bf16(kb, qa[ks], s[nt], 0, 0, 0); } }
    const float o16 = slope2 * 16.f, bA = slope2 * (float)(64 * jA - (t0 + 31)), bB = slope2 * (float)(64 * jB - (t0 + 31));
    bool okA = true, okB = true; if (MODE == 0) { okA = ((tselA >> (16 * th + cl)) & 1ull) != 0ull; okB = ((tselB >> (16 * th + cl)) & 1ull) != 0ull; }
    const float refA = okA ? (mrow - bA) : INFINITY, refB = okB ? (mrow - bB) : INFINITY;
    float rs = 0.f;
    unsigned pw[8][2];
#pragma unroll
    for (int nt = 0; nt < 8; ++nt) { float p[4]; const float refn = ((nt < 4) ? refA : refB) - (float)(nt & 3) * o16;
#pragma unroll
        for (int j = 0; j < 4; ++j) { p[j] = ex2(s[nt][j] - refn); rs += p[j]; }
        pw[nt][0] = pg8::cvt_pk_bf16(p[0], p[1]); pw[nt][1] = pg8::cvt_pk_bf16(p[2], p[3]); }
    rs += __shfl_xor(rs, 16); rs += __shfl_xor(rs, 32);
    lrow += rs;
#pragma unroll
    for (int ks = 0; ks < 4; ++ks) { const bf16x8 pa = __builtin_bit_cast(bf16x8, (u32x4){pw[2 * ks][0], pw[2 * ks][1], pw[2 * ks + 1][0], pw[2 * ks + 1][1]}); const LAS bf16_t* VTt = ((ks < 2) ? KtA : KtB) + 4608;
#pragma unroll
        for (int dt = 0; dt < 4; ++dt) { const bf16x8 vb = *(const LAS bf16x8*)(VTt + (16 * dt + cl) * TS + 32 * (ks & 1) + 8 * q4); O[dt] = __builtin_amdgcn_mfma_f32_16x16x32_bf16(vb, pa, O[dt], 0, 0, 0); } }
    LDS_WAIT();
}

constexpr int ATT_SET0 = 70656, ATT_SET1 = 107520, ATT_QL = 144384;
template <int MODE>
__device__ __forceinline__ void attn_branch(LAS unsigned char* lds, LAS bf16_t* Pw, const bf16_t* KV, const bf16_t* VT2, const float* GATEB, const bf16x8 (&qa)[2], f32x4 (&outacc)[4],
                                            u64 uni, u64 tselv, int b, int bg, int h, int t0, int th, float slope2
#if TSEG
                                            , unsigned long long& tseg_acc
#endif
                                            ) {
#if TSEG
    unsigned long long tseg_t = 0;
#endif
    const int tid = threadIdx.x, lane = tid & 63; constexpr int TS = 72;
    const size_t PLANE = (size_t)8 * 4 * 4096 * 64;
    f32x4 O[4]; float mrow = -INFINITY, lrow = 0.f;
#pragma unroll
    for (int j = 0; j < 4; ++j) O[j] = (f32x4){0.f, 0.f, 0.f, 0.f};
    const float k0f = (float)(4 * (lane >> 4)); const f32x4 bv0 = (f32x4){slope2 * k0f, slope2 * (k0f + 1.f), slope2 * (k0f + 2.f), slope2 * (k0f + 3.f)};
    const int jhi = (t0 + 31) >> 6; int jlo = 0; if (MODE == 1) { jlo = t0 - 511; jlo = jlo < 0 ? 0 : (jlo >> 6); }
    u64 rem = (MODE == 0) ? uni : ((jhi >= 63 ? ~0ull : ((1ull << (jhi + 1)) - 1ull)) & ~((1ull << jlo) - 1ull));
    const bf16_t* Ksrc = KV + (size_t)(MODE == 0 ? 2 : 4) * PLANE + (size_t)bg * 4096 * 64;
    const bf16_t* Vsrc = VT2 + ((size_t)MODE * 32 + bg) * 4096 * 64;
    const size_t toff = (size_t)tid * 8;
    const int loff = (tid >> 3) * TS + 8 * (tid & 7);
    u32x4 pkA, pvA, pkB, pvB;
    int a0 = -1, b0_ = -1, a1 = -1, b1 = -1;
#define ATT_TAKE(x) do { if (rem) { x = 63 - __builtin_clzll(rem); rem &= ~(1ull << x); } else x = -1; } while (0)
#define ATT_LOAD(ja, jb_) do { if ((ja) >= 0) { pkA = *(const u32x4*)(Ksrc + (size_t)(ja) * 4096 + toff); pvA = *(const u32x4*)(Vsrc + (size_t)(ja) * 4096 + toff); } \
                               if ((jb_) >= 0) { pkB = *(const u32x4*)(Ksrc + (size_t)(jb_) * 4096 + toff); pvB = *(const u32x4*)(Vsrc + (size_t)(jb_) * 4096 + toff); } } while (0)
#define ATT_PUT(setp, ja, jb_) do { if ((ja) >= 0) { *(LAS u32x4*)((setp) + loff) = pkA; *(LAS u32x4*)((setp) + 4608 + loff) = pvA; } \
                                    if ((jb_) >= 0) { *(LAS u32x4*)((setp) + 9216 + loff) = pkB; *(LAS u32x4*)((setp) + 13824 + loff) = pvB; } } while (0)
    ATT_TAKE(a0); ATT_TAKE(b0_);
    ATT_LOAD(a0, b0_);
    { LAS bf16_t* set0 = (LAS bf16_t*)(lds + ATT_SET0); ATT_PUT(set0, a0, b0_); }
    ATT_TAKE(a1); ATT_TAKE(b1);
    ATT_LOAD(a1, b1);
    LDS_BARRIER();
    int buf = 0;
#pragma unroll 1
    while (a0 >= 0) {
        LAS bf16_t* cur = (LAS bf16_t*)(lds + (buf ? ATT_SET1 : ATT_SET0)); LAS bf16_t* nxt = (LAS bf16_t*)(lds + (buf ? ATT_SET0 : ATT_SET1));
        int a2 = -1, b2 = -1;
        TS_B(10);
        if (a1 >= 0) { ATT_PUT(nxt, a1, b1); ATT_TAKE(a2); ATT_TAKE(b2); ATT_LOAD(a2, b2); }
        TS_E(10); TS_B(11);
        u64 tsA = ~0ull, tsB = ~0ull;
        if (MODE == 0) { tsA = ((u64)(unsigned)__builtin_amdgcn_readlane((int)(tselv >> 32), a0) << 32) | (unsigned)__builtin_amdgcn_readlane((int)(unsigned)tselv, a0);
            if (b0_ >= 0) tsB = ((u64)(unsigned)__builtin_amdgcn_readlane((int)(tselv >> 32), b0_) << 32) | (unsigned)__builtin_amdgcn_readlane((int)(unsigned)tselv, b0_); }
        const bool useA = ((tsA >> (16 * th)) & 0xFFFFull) != 0ull, useB = b0_ >= 0 && ((tsB >> (16 * th)) & 0xFFFFull) != 0ull;
        const bool edgeA = (64 * a0 + 63 > t0) || (MODE == 1 && (t0 + 31 - 64 * a0 >= 512));
        const bool edgeB = b0_ >= 0 && ((64 * b0_ + 63 > t0) || (MODE == 1 && (t0 + 31 - 64 * b0_ >= 512)));
        if (useA && useB && !edgeA && !edgeB) {
            const bool rA = MODE == 1 || ((tsA >> (16 * th + (lane & 15))) & 1ull), rB = MODE == 1 || ((tsB >> (16 * th + (lane & 15))) & 1ull);
            if (__any((rA || rB) && mrow == -INFINITY)) attn_pair<MODE>(cur, cur + 9216, Pw, qa, bv0, a0, b0_, t0, th, slope2, tsA, tsB, O, mrow, lrow, lane);
            else attn_pair_fast<MODE>(cur, cur + 9216, Pw, qa, bv0, a0, b0_, t0, th, slope2, tsA, tsB, O, mrow, lrow, lane); }
        else {
            if (useA) { if (edgeA) attn_tile2<MODE, true>(cur, cur + 4608, Pw, qa, bv0, a0, t0, th, slope2, tsA, O, mrow, lrow, lane); else attn_tile2<MODE, false>(cur, cur + 4608, Pw, qa, bv0, a0, t0, th, slope2, tsA, O, mrow, lrow, lane); LDS_WAIT(); }
            if (useB) { if (edgeB) attn_tile2<MODE, true>(cur + 9216, cur + 13824, Pw, qa, bv0, b0_, t0, th, slope2, tsB, O, mrow, lrow, lane); else attn_tile2<MODE, false>(cur + 9216, cur + 13824, Pw, qa, bv0, b0_, t0, th, slope2, tsB, O, mrow, lrow, lane); }
        }
        TS_E(11); TS_B(12);
        LDS_BARRIER();
        TS_E(12);
        a0 = a1; b0_ = b1; a1 = a2; b1 = b2; buf ^= 1;
    }
#undef ATT_TAKE
#undef ATT_LOAD
#undef ATT_PUT
    { const float gt = GATEB[((size_t)b * SEQ + t0 + 16 * th + (lane & 15)) * 48 + h * 3 + 1 + MODE];
      const float gsc = gt / (lrow > 0.f ? lrow : 1.0f);
#pragma unroll
      for (int dt = 0; dt < 4; ++dt) outacc[dt] = outacc[dt] + O[dt] * gsc; }
}

template <int NT>
__device__ __forceinline__ void cmp_scores(const LAS bf16_t* BUF0, unsigned (&pw)[16][2], LAS float* impw, const bf16x8 (&qa)[2], int t, float slope2, int lane) {
    constexpr int TS = 72, PS = 264, IP = 66;
    const int cl = lane & 15, q4 = lane >> 4;
    const int cmaxl = (t >= 31) ? (((t - 31) >> 4) < 254 ? ((t - 31) >> 4) : 254) : -1;
    f32x4 bq; { const float b0 = slope2 * (float)(16 * (4 * q4) + 31 - t); bq = (f32x4){b0, b0 + 16.f * slope2, b0 + 32.f * slope2, b0 + 48.f * slope2}; }
    const float o256 = 256.f * slope2;
    f32x4 s[NT]; float cm = -INFINITY;
#pragma unroll
    for (int nt = 0; nt < NT; ++nt) { s[nt] = bq + (float)nt * o256;
#pragma unroll
        for (int ks = 0; ks < 2; ++ks) { const bf16x8 kb = *(const LAS bf16x8*)(BUF0 + (16 * nt + cl) * TS + 32 * ks + 8 * q4); s[nt] = __builtin_amdgcn_mfma_f32_16x16x32_bf16(kb, qa[ks], s[nt], 0, 0, 0); } }
#pragma unroll
    for (int nt = 0; nt < NT; ++nt) {
        if (nt >= NT - 5) {
#pragma unroll
            for (int j = 0; j < 4; ++j) { const bool ok = (16 * nt + 4 * q4 + j) <= cmaxl; s[nt][j] = ok ? s[nt][j] : -INFINITY; } }
        cm = fmaxf(cm, fmaxf(fmaxf(s[nt][0], s[nt][1]), fmaxf(s[nt][2], s[nt][3]))); }
    cm = fmaxf(cm, __shfl_xor(cm, 16)); cm = fmaxf(cm, __shfl_xor(cm, 32));
    cm = (cm == -INFINITY) ? 0.f : cm;
    float cs = 0.f;
#pragma unroll
    for (int nt = 0; nt < NT; ++nt)
#pragma unroll
        for (int j = 0; j < 4; ++j) { const float e = ex2(s[nt][j] - cm); s[nt][j] = e; cs += e; }
    cs += __shfl_xor(cs, 16); cs += __shfl_xor(cs, 32);
    const float cinv = 1.0f / (cs > 0.f ? cs : 1.0f);
#pragma unroll
    for (int nt = 0; nt < NT; ++nt) { float p[4];
#pragma unroll
        for (int j = 0; j < 4; ++j) { p[j] = s[nt][j] * cinv; s[nt][j] = p[j]; }
        pw[nt][0] = pg8::cvt_pk_bf16(p[0], p[1]); pw[nt][1] = pg8::cvt_pk_bf16(p[2], p[3]);
        impw[cl * IP + 4 * nt + q4] = (p[0] + p[1]) + (p[2] + p[3]); }
#pragma unroll
    for (int nt = 0; nt < NT; ++nt) { if (nt < 15 || q4 < 3) __hip_atomic_fetch_add(impw + cl * IP + 4 * nt + q4 + 1, s[nt][3], __ATOMIC_RELAXED, __HIP_MEMORY_SCOPE_WORKGROUP); }
}
template <int NK>
__device__ __forceinline__ void cmp_pv(const LAS bf16_t* BUF0, const unsigned (&pw)[16][2], f32x4 (&oc)[4], int lane) {
    constexpr int PS = 264; const int cl = lane & 15, q4 = lane >> 4;
#pragma unroll
    for (int ks = 0; ks < NK; ++ks) { const bf16x8 pa = __builtin_bit_cast(bf16x8, (u32x4){pw[2 * ks][0], pw[2 * ks][1], pw[2 * ks + 1][0], pw[2 * ks + 1][1]});
#pragma unroll
        for (int dt = 0; dt < 4; ++dt) { const bf16x8 vb = *(const LAS bf16x8*)(BUF0 + (16 * dt + cl) * PS + 32 * ks + 8 * q4); oc[dt] = __builtin_amdgcn_mfma_f32_16x16x32_bf16(vb, pa, oc[dt], 0, 0, 0); } }
}

__device__ __forceinline__ void attn_phase(LAS unsigned char* lds, const bf16_t* KV, const bf16_t* VT2, const bf16_t* QB, const float* GATEB, const bf16_t* KC, const bf16_t* VCT, bf16_t* OB, int wgc, int G) {
    const int tid = threadIdx.x, wave = __builtin_amdgcn_readfirstlane(tid >> 6), lane = tid & 63, cl = lane & 15, q4 = lane >> 4;
    constexpr int TS = 72, PS = 264, IP = 66;
    LAS bf16_t* KCs = (LAS bf16_t*)(lds + 0);
    LAS bf16_t* VCTs = (LAS bf16_t*)(lds + 36864);
    LAS bf16_t* Pw = (LAS bf16_t*)(lds + ATT_SET0);
    LAS float* IMP = (LAS float*)(lds + ATT_SET1);
    LAS u64* SEL = (LAS u64*)(lds + ATT_SET1 + 33792);
    const float LOG2E = 1.4426950408889634f;
#if TSEG
    unsigned long long tseg_acc = 0, tseg_t = 0;
#endif
    const int nj = G < 8 ? G : 8, nslot = G / nj, js0 = wgc % nj, slot = wgc / nj, cb = (128 - js0 + nj - 1) / nj;
    int bg_loaded = -1;
    for (int it = 0; slot < nslot; ++it) {
        const int bg = slot + (it / cb) * nslot; if (bg >= 32) break;
        const int uu = js0 + (it % cb) * nj, i = uu >> 3, js = uu & 7;
        const int qt = 8 * i + ((i & 1) ? 7 - js : js);
        if (bg != bg_loaded) { bg_loaded = bg;
            __syncthreads();
#pragma unroll
            for (int k = 0; k < 4; ++k) { const int id = tid + 512 * k, row = id >> 3, cc = id & 7; *(LAS u32x4*)(KCs + row * TS + 8 * cc) = *(const u32x4*)(KC + ((size_t)bg * 256 + row) * 64 + 8 * cc); }
#pragma unroll
            for (int k = 0; k < 4; ++k) { const int id = tid + 512 * k, d = id >> 5, cc = id & 31; *(LAS u32x4*)(VCTs + d * PS + 8 * cc) = *(const u32x4*)(VCT + ((size_t)bg * 64 + d) * 256 + 8 * cc); }
            __syncthreads(); }
        const int b = bg >> 2, g = bg & 3, t0 = qt * 32;
        TS_B(1);
        const int r = wave >> 1, th = wave & 1, h = 4 * g + r;
        const float slope2 = exp2f(-0.5f * (float)(h + 1)) * LOG2E;
        LAS unsigned char* ql = lds + ATT_QL + wave * 2048;
#define ATT_QDMA(bg_, qt_) do { const bf16_t* qsrc = QB + ((size_t)((bg_) >> 2) * SEQ + (qt_) * 32 + 16 * th + (lane >> 3)) * 1024 + (4 * ((bg_) & 3) + r) * 64 + 8 * (lane & 7); \
            __builtin_amdgcn_global_load_lds((const unsigned*)qsrc, (LAS unsigned*)ql, 16, 0, 0); __builtin_amdgcn_global_load_lds((const unsigned*)(qsrc + 8 * 1024), (LAS unsigned*)(ql + 1024), 16, 0, 0); } while (0)
        if (it == 0) ATT_QDMA(bg, qt);
        asm volatile("s_waitcnt vmcnt(0)" ::: "memory");
        bf16x8 qa[2];
        qa[0] = *(const LAS bf16x8*)(ql + cl * 128 + 16 * q4); qa[1] = *(const LAS bf16x8*)(ql + cl * 128 + 64 + 16 * q4);
        LDS_WAIT();
        { const int it1 = it + 1, bgn = slot + (it1 / cb) * nslot, uun = js0 + (it1 % cb) * nj, in_ = uun >> 3, jsn = uun & 7;
          if (bgn < 32) ATT_QDMA(bgn, 8 * in_ + ((in_ & 1) ? 7 - jsn : jsn)); }
#undef ATT_QDMA
        f32x4 outacc[4];
        TS_E(1); TS_B(2);
        const int ng = (t0 >> 10) + 1;
        unsigned cpw[16][2];
        {   LAS float* impw = IMP + wave * (16 * IP);
            const int t = t0 + 16 * th + cl;
            if (ng == 1) cmp_scores<4>(KCs, cpw, impw, qa, t, slope2, lane);
            else if (ng == 2) cmp_scores<8>(KCs, cpw, impw, qa, t, slope2, lane);
            else if (ng == 3) cmp_scores<12>(KCs, cpw, impw, qa, t, slope2, lane);
            else cmp_scores<16>(KCs, cpw, impw, qa, t, slope2, lane);
        }
        TS_E(2); TS_B(3);
        __syncthreads();
        TS_E(3); TS_B(4);
        {   u64 key[4], pre[4];
#pragma unroll
            for (int e = 0; e < 4; ++e) { const int tk = 4 * wave + e, tt = t0 + tk, cur = tt >> 6;
                float v = 0.f;
#pragma unroll
                for (int rr = 0; rr < 4; ++rr) v += IMP[((2 * rr + (tk >> 4)) * 16 + (tk & 15)) * IP + lane];
                const bool forced = (lane == 0) || (lane == cur) || (lane == cur - 1);
                v = fmaxf(v, 0.f); if (forced) v = 1e4f;
                const bool valid = lane <= cur;
                key[e] = valid ? (((u64)__builtin_bit_cast(unsigned, v) << 6) | (u64)(63 - lane)) + 1ull : 0ull;
                pre[e] = 0ull; }
            int open = 0;
#pragma unroll
            for (int e = 0; e < 4; ++e) open |= (((t0 + 4 * wave + e) >> 6) >= 16) ? (1 << e) : 0;
#pragma unroll 1
            for (int bit = 36; bit >= 0 && open; --bit) { const u64 bm = 1ull << bit;
#pragma unroll
                for (int e = 0; e < 4; ++e) { const u64 cand = pre[e] | bm; const int cnt = __popcll(__ballot(key[e] >= cand)); pre[e] = (cnt >= 16) ? cand : pre[e]; if (cnt == 16) open &= ~(1 << e); } }
#pragma unroll
            for (int e = 0; e < 4; ++e) { const u64 msk = __ballot(key[e] >= (pre[e] ? pre[e] : 1ull)); if (lane == 0) SEL[4 * wave + e] = msk; }
        }
        TS_E(4); TS_B(6);
        {
            f32x4 oc[4];
#pragma unroll
            for (int dt = 0; dt < 4; ++dt) oc[dt] = (f32x4){0.f, 0.f, 0.f, 0.f};
            if (ng == 1) cmp_pv<2>(VCTs, cpw, oc, lane); else if (ng == 2) cmp_pv<4>(VCTs, cpw, oc, lane); else if (ng == 3) cmp_pv<6>(VCTs, cpw, oc, lane); else cmp_pv<8>(VCTs, cpw, oc, lane);
            const float gc = GATEB[((size_t)b * SEQ + t0 + 16 * th + cl) * 48 + h * 3];
#pragma unroll
            for (int dt = 0; dt < 4; ++dt) outacc[dt] = oc[dt] * gc;
        }
        TS_E(6); TS_B(5);
        __syncthreads();
        TS_E(5); TS_B(7);
        u64 tselv = 0ull;
#pragma unroll 8
        for (int tk = 0; tk < 32; ++tk) { const u64 sv = SEL[tk]; tselv |= ((sv >> lane) & 1ull) << tk; }
        const u64 uni = __ballot(tselv != 0ull);
        TS_E(7); TS_B(8);
#if TSEG
        attn_branch<0>(lds, Pw, KV, VT2, GATEB, qa, outacc, uni, tselv, b, bg, h, t0, th, slope2, tseg_acc);
#else
        attn_branch<0>(lds, Pw, KV, VT2, GATEB, qa, outacc, uni, tselv, b, bg, h, t0, th, slope2);
#endif
        TS_E(8); TS_B(9);
#if TSEG
        attn_branch<1>(lds, Pw, KV, VT2, GATEB, qa, outacc, uni, tselv, b, bg, h, t0, th, slope2, tseg_acc);
#else
        attn_branch<1>(lds, Pw, KV, VT2, GATEB, qa, outacc, uni, tselv, b, bg, h, t0, th, slope2);
#endif
        TS_E(9);
        { bf16_t* op = OB + ((size_t)b * SEQ + t0 + 16 * th + cl) * 1024 + h * 64 + 4 * q4;
#pragma unroll
          for (int dt = 0; dt < 4; ++dt) { u32x2 w; w.x = pg8::cvt_pk_bf16(outacc[dt][0], outacc[dt][1]); w.y = pg8::cvt_pk_bf16(outacc[dt][2], outacc[dt][3]); *(u32x2*)(op + 16 * dt) = w; } }
    }
#if TSEG
    { const unsigned long long w0 = __builtin_amdgcn_s_memrealtime(); while (__builtin_amdgcn_s_memrealtime() - w0 < 2 * tseg_acc) __builtin_amdgcn_s_sleep(8); }
#endif
}

constexpr int NPHASE = 20;
__global__ void __launch_bounds__(NTHR, 2) yoco_fwd(Args args) {
    extern __shared__ __attribute__((aligned(16))) unsigned char lds_raw[];
    LAS unsigned char* lds = (LAS unsigned char*)lds_raw;
    volatile LAS unsigned* MISC = (volatile LAS unsigned*)(lds + MISC_OFF);
    const int tid = threadIdx.x, lane = tid & 63, wave = __builtin_amdgcn_readfirstlane(tid >> 6);
    const int G = gridDim.x, bx = blockIdx.x;
    const int vcu = (G % 8 == 0) ? (bx % 8) * (G / 8) + bx / 8 : bx;
    const int gw = vcu * NWAVES + wave, NGW = G * NWAVES;
    unsigned char* ws = args.ws;
    unsigned* ctl = (unsigned*)(ws + WS_CTL);
    if (tid < 64) MISC[tid] = 0u;
    __syncthreads();
    XcdBarrier bar; bar.bar = ctl + CW_BAR; bar.x = 0; bar.st = MISC + 60;
    if (!MK_PER_PHASE) bar = xcd_barrier_post(ctl + CW_BAR, MISC + 60);
    const int lo = args.ph_lo, hi = args.ph_hi;
#ifndef PHMASK
#define PHMASK 0xFFFFFFu
#endif
#ifndef PROBE_SKIP
#define PROBE_SKIP 0
#endif
constexpr unsigned PHSKIP = 0u;
#define IN(k) ((((PHMASK & ~PHSKIP) >> (k)) & 1u) && lo <= (k) && (k) < hi)
#ifndef P0REP
#define P0REP 0
#endif
#ifndef REPMASK
#define REPMASK 0x0u
#endif
#define PH(k) for (int _r = 0, _n = IN(k) ? ((((REPMASK) >> (k)) & 1u) ? 2 : 1) : 0; _r < _n; ++_r)
#ifndef PHT
#define PHT -1
#endif
#if PHT >= 0
    unsigned long long pht_t = __builtin_amdgcn_s_memrealtime();
#define SEAM(k) do { if (PHT == (k)) { const unsigned long long d_ = __builtin_amdgcn_s_memrealtime() - pht_t, w0_ = __builtin_amdgcn_s_memrealtime(); while (__builtin_amdgcn_s_memrealtime() - w0_ < d_) __builtin_amdgcn_s_sleep(8); } \
        if (lo <= (k) && (k) + 1 < hi) xcd_barrier(bar); pht_t = __builtin_amdgcn_s_memrealtime(); } while (0)
#else
#define SEAM(k) do { if (lo <= (k) && (k) + 1 < hi) xcd_barrier(bar); } while (0)
#endif

    const float* x = A_IN(I_X);
    float* xs = args.out;
    bf16_t* XH = (bf16_t*)(ws + WS_XH);
    float* GA = (float*)(ws + WS_GA);
    float* bias1 = (float*)(ws + WS_SMALL);
    unsigned* EIDX = (unsigned*)(ws + WS_SMALL + 8192);
    float* EW = (float*)(ws + WS_SMALL + 8192 + 131072);
    u32x2* ROWINFO = (u32x2*)(ws + WS_ROWINFO);

    PH(0) {
        for (int _q = 0; _q < ((P0REP & 1) ? 2 : 1); ++_q) p0_weights(ws, lds, gw, NGW, wave, lane);
        __syncthreads();
        LAS float* Wg = (LAS float*)lds;
        for (int i = tid; i < 8192; i += NTHR) { const int k = i >> 3, e = i & 7; Wg[(e >> 2) * 4096 + ((((k >> 8) * 4 + (k & 3)) * 64 + ((k & 255) >> 2)) << 2) + (e & 3)] = A_IN(I_A_W_IN)[(size_t)k * NPROJ_SRC + 4096 + e] * A_IN(I_NORM_MIX)[k]; }
        __syncthreads();
        for (int _q = 0; _q < ((P0REP & 2) ? 2 : 1); ++_q) {
        f32x4 vn[4]; if (gw < M) load_row(x + (size_t)gw * D, lane, vn);
        for (int m = gw; m < M; m += NGW) {
            f32x4 v[4];
#pragma unroll
            for (int j = 0; j < 4; ++j) v[j] = vn[j];
            load_row(x + (size_t)(m + NGW < M ? m + NGW : m) * D, lane, vn);
            const float rstd = row_rstd(v);
            store_row_bf16(XH + (size_t)m * D, lane, v, rstd);
            float gsum[8];
#pragma unroll
            for (int e = 0; e < 8; ++e) gsum[e] = 0.f;
#pragma unroll
            for (int j = 0; j < 4; ++j)
#pragma unroll
                for (int c = 0; c < 4; ++c) { const f32x4 w0 = *(const LAS f32x4*)(Wg + (((j * 4 + c) * 64 + lane) << 2)), w1 = *(const LAS f32x4*)(Wg + 4096 + (((j * 4 + c) * 64 + lane) << 2)); const float xv = v[j][c];
                    gsum[0] += xv * w0.x; gsum[1] += xv * w0.y; gsum[2] += xv * w0.z; gsum[3] += xv * w0.w; gsum[4] += xv * w1.x; gsum[5] += xv * w1.y; gsum[6] += xv * w1.z; gsum[7] += xv * w1.w; }
#pragma unroll
            for (int e = 0; e < 8; ++e) gsum[e] = wave_sum(gsum[e]) * rstd + A_IN(I_A_B_GATE)[e];
            if (lane == 0) {
#pragma unroll
                for (int e = 0; e < 4; ++e) GA[(size_t)m * 8 + e] = gsum[e];
#pragma unroll
                for (int e = 4; e < 8; ++e) { const float g = gsum[e]; GA[(size_t)m * 8 + e] = fminf(g, 0.f) - log1pf(__expf(-fabsf(g))); } }
        }
        }
        __syncthreads();
        for (int it = bx; it < 256; it += G) { const int c = it >> 7, nb = (it >> 4) & 7, fc = it & 15, n = nb * 32 + (tid & 31), fs = tid >> 5; float s = 0.f;
#pragma unroll
            for (int k = 0; k < 8; ++k) { const int f = fc * 128 + fs * 8 + k; s += A_IN(I_B_CMP_POS)[((f >> 6) * 2 + c) * 64 + (f & 63)] * A_IN(I_B_CMP_W1)[((size_t)c * 2048 + f) * 256 + n]; }
            LAS float* red = (LAS float*)lds; __syncthreads(); red[tid] = s; __syncthreads();
            if (tid < 32) { float t = 0.f; for (int k = 0; k < 16; ++k) t += red[k * 32 + tid]; ((float*)(ws + WS_SMALL + 401408))[(c * 256 + n) * 16 + fc] = t; }
            __syncthreads(); }
    }
    SEAM(0);
    PH(1) { if (bx == 0) { const float* bp = (const float*)(ws + WS_SMALL + 401408) + tid * 16; float t = 0.f; for (int k = 0; k < 16; ++k) t += bp[k]; bias1[tid] = t; }
        pg8::PlainOrder S; S.init(XH, (const bf16_t*)(ws + WS_WIN), M, NPROJ, D, D, G, bx); pg8::EpiProjSplit E{(bf16_t*)(ws + WS_PROJ3), (bf16_t*)(ws + WS_OG)};
        pg8::gemm_phase(lds, pg8::Dims{D, D, D}, S, E); }
    SEAM(1);
    PH(2) scanprep_phase(lds, (const bf16_t*)(ws + WS_PROJ3), GA, A_IN(I_A_CONV), ws + WS_IMG, vcu, G);
    SEAM(2);
    PH(3) scan_phase(lds, ws + WS_IMG, (float*)(ws + WS_HS), (float*)(ws + WS_DN), vcu, G);
    SEAM(3);
    PH(4) {
        const float* HS = (const float*)(ws + WS_HS); const float* DN = (const float*)(ws + WS_DN); const bf16_t* OG = (const bf16_t*)(ws + WS_OG); bf16_t* HN = (bf16_t*)(ws + WS_HN);
        f32x4 vn[4], dnn; u32x2 ogn[4];
#define P4_LOAD(mm) do { load_row(HS + (size_t)(mm) * D, lane, vn); dnn = *(const f32x4*)(DN + (size_t)(mm) * 4); \
            _Pragma("unroll") for (int j = 0; j < 4; ++j) ogn[j] = *(const u32x2*)(OG + (size_t)(mm) * D + 4 * lane + 256 * j); } while (0)
        P4_LOAD(gw < M ? gw : 0);
        f32x4 gvv[4];
#pragma unroll
        for (int j = 0; j < 4; ++j) gvv[j] = *((const f32x4*)A_IN(I_A_NORM_H) + lane + 64 * j);
        for (int m = gw; m < M; m += NGW) { f32x4 v[4]; u32x2 og[4]; const f32x4 dn = dnn;
#pragma unroll
            for (int j = 0; j < 4; ++j) { v[j] = vn[j]; og[j] = ogn[j]; }
            P4_LOAD(m + NGW < M ? m + NGW : m);
            u64* o8 = (u64*)(HN + (size_t)m * D) + lane;
#pragma unroll
            for (int j = 0; j < 4; ++j) { v[j] = v[j] * (1.0f / dn[j]); float s = (v[j].x * v[j].x + v[j].y * v[j].y) + (v[j].z * v[j].z + v[j].w * v[j].w); s = wave_sum(s);
                const float rs = 1.0f / sqrtf(s * (1.f / 256.f) + EPS);
                const u32x2 oraw = og[j]; const f32x4 gv = gvv[j];
                const float o0 = v[j].x * rs * gv.x * sigmoidf_(bflo(oraw.x)), o1 = v[j].y * rs * gv.y * sigmoidf_(bfhi(oraw.x)), o2 = v[j].z * rs * gv.z * sigmoidf_(bflo(oraw.y)), o3 = v[j].w * rs * gv.w * sigmoidf_(bfhi(oraw.y));
                o8[64 * j] = (u64)pk2(o0, o1) | ((u64)pk2(o2, o3) << 32); } }
#undef P4_LOAD
    }
    SEAM(4);
    PH(5) { pg8::PlainOrder S; S.init((const bf16_t*)(ws + WS_HN), (const bf16_t*)(ws + WS_WOUTA), M, D, D, D, G, bx); pg8::EpiRes16<false, true> E{x, XH, (float*)(ws + WS_SSP), D};
        pg8::gemm_phase(lds, pg8::Dims{D, D, D}, S, E); }
    SEAM(5);
    PH(6) { const float* sp = (const float*)(ws + WS_SSP); float* rs = (float*)(ws + WS_RS);
        for (int r = bx * NTHR + tid; r < M; r += G * NTHR) rs[r] = pg8::row_rs16(sp, r); }
    SEAM(6);
    PH(7) { pg8::PlainOrder S; S.init(XH, (const bf16_t*)(ws + WS_WGU), M, 2 * FFD, D, D, G, bx); pg8::EpiSwiGLU E{(bf16_t*)(ws + WS_ACT), FFD, (const float*)(ws + WS_RS)};
        if (EXPT && _r == 1) { S.same = 11; E.O = (bf16_t*)(ws + WS_END2); }
#if TPROBE
        float* tkp = (float*)(ws + WS_END2 + 2 * MiB); const unsigned long long tp0 = __builtin_amdgcn_s_memrealtime();
        pg8::gemm_phase(lds, pg8::Dims{D, D, D, 127, 127, bx == 0 ? tkp : nullptr}, S, E);
        if (bx == 0 && tid == 0) tkp[2] = (float)(__builtin_amdgcn_s_memrealtime() - tp0);
#else
        pg8::gemm_phase(lds, pg8::Dims{D, D, D}, S, E);
#endif
    }
    SEAM(7);
    PH(8) { pg8::PlainOrder S; S.init((const bf16_t*)(ws + WS_ACT), (const bf16_t*)(ws + WS_WDOWN), M, D, FFD, FFD, G, bx); pg8::EpiRes16<true, true> E{nullptr, XH, (float*)(ws + WS_SSP), D};
        pg8::gemm_phase(lds, pg8::Dims{FFD, FFD, FFD}, S, E); }
    SEAM(8);
    PH(9) { const float* sp = (const float*)(ws + WS_SSP); float* rs = (float*)(ws + WS_RS);
        for (int r = bx * NTHR + tid; r < M; r += G * NTHR) rs[r] = pg8::row_rs16(sp, r); }
    SEAM(9);
    PH(10) { pg8::PlainOrder S; S.init(XH, (const bf16_t*)(ws + WS_WKVQ), M, NKVQ, D, D, G, bx); pg8::EpiKVQ E{(bf16_t*)(ws + WS_KV), (bf16_t*)(ws + WS_QB), (float*)(ws + WS_GATEB), A_IN(I_B_B_GATE), (const float*)(ws + WS_RS)};
        pg8::gemm_phase(lds, pg8::Dims{D, D, D}, S, E); }
    SEAM(10);
    PH(11) {
        struct CmpOrder { int G, c; const char* A; const char* B;
            __device__ __forceinline__ bool next(int i, pg8::Unit& u) const { const int L = i * G + c; if (L >= 64) return false; u.pm = L; u.pn = 0; u.a = A + (size_t)L * 256 * 1024 * 2; u.b = B + (size_t)(L >> 5) * 256 * 2048 * 2; return true; } };
        CmpOrder S{G, bx, (const char*)(ws + WS_KV), (const char*)(ws + WS_WCMP1)}; pg8::EpiCmp E{(bf16_t*)(ws + WS_HID), bias1};
        if (bx < 64 || G <= 64) pg8::gemm_phase(lds, pg8::Dims{2048, 1024, 2048}, S, E);
        if (bx >= 64 || G <= 64) {
        { LAS bf16_t* T = (LAS bf16_t*)lds; const size_t PLANE = (size_t)8 * 4 * 4096 * 64;
          for (int it = (G <= 64) ? bx : bx - 64; it < 4096; it += (G <= 64) ? G : G - 64) { const int mode = it >> 11, rest = it & 2047;
              const bf16_t* src = (const bf16_t*)(ws + WS_KV) + (size_t)(mode == 0 ? 3 : 5) * PLANE + (size_t)rest * 4096; bf16_t* dst = (bf16_t*)(ws + WS_VT2) + ((size_t)mode * 2048 + rest) * 4096;
              const int row = tid >> 3, cc = tid & 7; const u32x4 raw = *(const u32x4*)(src + (size_t)tid * 8);
              const int prow = (row & 32) | (((row >> 2) & 3) << 3) | (((row >> 4) & 1) << 2) | (row & 3);
              __syncthreads();
              T[(8 * cc + 0) * 72 + prow] = (bf16_t)(raw.x & 0xffff); T[(8 * cc + 1) * 72 + prow] = (bf16_t)(raw.x >> 16); T[(8 * cc + 2) * 72 + prow] = (bf16_t)(raw.y & 0xffff); T[(8 * cc + 3) * 72 + prow] = (bf16_t)(raw.y >> 16);
              T[(8 * cc + 4) * 72 + prow] = (bf16_t)(raw.z & 0xffff); T[(8 * cc + 5) * 72 + prow] = (bf16_t)(raw.z >> 16); T[(8 * cc + 6) * 72 + prow] = (bf16_t)(raw.w & 0xffff); T[(8 * cc + 7) * 72 + prow] = (bf16_t)(raw.w >> 16);
              __syncthreads();
              *(u32x4*)(dst + (size_t)tid * 8) = *(const LAS u32x4*)(T + row * 72 + 8 * cc); } }
        } }
    SEAM(11);
    PH(12) { const bf16_t* HID = (const bf16_t*)(ws + WS_HID); const bf16_t* W2T = (const bf16_t*)(ws + WS_W2T);
        if (gw < 512) { const int c = gw >> 8, r0 = 32 * (gw & 255); const int cl = lane & 15, q4 = lane >> 4;
            f32x4 acc[2][4];
#pragma unroll
            for (int rt = 0; rt < 2; ++rt)
#pragma unroll
                for (int dt = 0; dt < 4; ++dt) acc[rt][dt] = (f32x4){0.f, 0.f, 0.f, 0.f};
            const bf16_t* hp = HID + ((size_t)c * 8192 + r0 + cl) * 256 + 8 * q4; const bf16_t* wp = W2T + ((size_t)c * 64 + cl) * 256 + 8 * q4;
#pragma unroll 2
            for (int ks = 0; ks < 8; ++ks) { bf16x8 a[2], w[4];
#pragma unroll
                for (int rt = 0; rt < 2; ++rt) a[rt] = *(const bf16x8*)(hp + (size_t)rt * 16 * 256 + 32 * ks);
#pragma unroll
                for (int dt = 0; dt < 4; ++dt) w[dt] = *(const bf16x8*)(wp + (size_t)dt * 16 * 256 + 32 * ks);
#pragma unroll
                for (int rt = 0; rt < 2; ++rt)
#pragma unroll
                    for (int dt = 0; dt < 4; ++dt) acc[rt][dt] = (c == 0) ? __builtin_amdgcn_mfma_f32_16x16x32_bf16(w[dt], a[rt], acc[rt][dt], 0, 0, 0) : __builtin_amdgcn_mfma_f32_16x16x32_bf16(a[rt], w[dt], acc[rt][dt], 0, 0, 0); }
#pragma unroll
            for (int rt = 0; rt < 2; ++rt)
#pragma unroll
                for (int dt = 0; dt < 4; ++dt) { u32x2 p; p.x = pk2(acc[rt][dt][0], acc[rt][dt][1]); p.y = pk2(acc[rt][dt][2], acc[rt][dt][3]);
                    if (c == 0) *(u32x2*)((bf16_t*)(ws + WS_KC) + (size_t)(r0 + 16 * rt + cl) * 64 + 16 * dt + 4 * q4) = p;
                    else { const int R = r0 + 16 * rt + 4 * q4, cidx = R & 255, pc = (cidx & ~31) | (((cidx >> 2) & 3) << 3) | (((cidx >> 4) & 1) << 2);
                        *(u32x2*)((bf16_t*)(ws + WS_VC) + ((size_t)(R >> 8) * 64 + 16 * dt + cl) * 256 + pc) = p; } }
        }
    }
    SEAM(12);
    PH(13) attn_phase(lds, (const bf16_t*)(ws + WS_KV), (const bf16_t*)(ws + WS_VT2), (const bf16_t*)(ws + WS_QB), (const float*)(ws + WS_GATEB), (const bf16_t*)(ws + WS_KC), (const bf16_t*)(ws + WS_VC), (bf16_t*)(ws + WS_OB), vcu, G);
    SEAM(13);
    PH(14) { pg8::PlainOrder S; S.init((const bf16_t*)(ws + WS_OB), (const bf16_t*)(ws + WS_WOUTB), M, D, D, D, G, bx); pg8::EpiRes16<true, false> E{nullptr, XH, nullptr, D};
        pg8::gemm_phase(lds, pg8::Dims{D, D, D}, S, E); }
    SEAM(14);
    PH(15) {
        LAS float* Wr = (LAS float*)lds;
        for (int i = tid; i < 8192; i += NTHR) { const int k = i >> 3, e = i & 7; Wr[(e >> 2) * 4096 + ((((k >> 8) * 4 + (k & 3)) * 64 + ((k & 255) >> 2)) << 2) + (e & 3)] = A_IN(I_M_ROUTER)[i] * A_IN(I_NORM_FFN)[1024 + k]; }
        __syncthreads();
        u32x2 rn[4];
#pragma unroll
        for (int j = 0; j < 4; ++j) rn[j] = *(const u32x2*)(XH + (size_t)(gw < M ? gw : 0) * D + 4 * lane + 256 * j);
        for (int m = gw; m < M; m += NGW) {
            f32x4 v[4];
#pragma unroll
            for (int j = 0; j < 4; ++j) v[j] = (f32x4){bflo(rn[j].x), bfhi(rn[j].x), bflo(rn[j].y), bfhi(rn[j].y)};
#pragma unroll
            for (int j = 0; j < 4; ++j) rn[j] = *(const u32x2*)(XH + (size_t)(m + NGW < M ? m + NGW : m) * D + 4 * lane + 256 * j);
            const float rstd = row_rstd(v);
            if (lane == 0) ((float*)(ws + WS_RS))[m] = rstd;
            float gsum[8];
#pragma unroll
            for (int e = 0; e < 8; ++e) gsum[e] = 0.f;
#pragma unroll
            for (int j = 0; j < 4; ++j)
#pragma unroll
                for (int c = 0; c < 4; ++c) { const f32x4 w0 = *(const LAS f32x4*)(Wr + (((j * 4 + c) * 64 + lane) << 2)), w1 = *(const LAS f32x4*)(Wr + 4096 + (((j * 4 + c) * 64 + lane) << 2)); const float xv = v[j][c];
                    gsum[0] += xv * w0.x; gsum[1] += xv * w0.y; gsum[2] += xv * w0.z; gsum[3] += xv * w0.w; gsum[4] += xv * w1.x; gsum[5] += xv * w1.y; gsum[6] += xv * w1.z; gsum[7] += xv * w1.w; }
#pragma unroll
            for (int e = 0; e < 8; ++e) gsum[e] = wave_sum(gsum[e]) * rstd;
            if (lane == 0) { int e1 = 0; float v1 = gsum[0];
#pragma unroll
                for (int e = 1; e < 8; ++e) if (gsum[e] > v1) { v1 = gsum[e]; e1 = e; }
                int e2 = -1; float v2 = -INFINITY;
#pragma unroll
                for (int e = 0; e < 8; ++e) if (e != e1 && gsum[e] > v2) { v2 = gsum[e]; e2 = e; }
                const float ex = __expf(v2 - v1), w1 = 1.0f / (1.0f + ex), w2 = ex * w1;
                EIDX[m] = (unsigned)e1 | ((unsigned)e2 << 8); EW[2 * (size_t)m] = w1; EW[2 * (size_t)m + 1] = w2;
                int* cc = (int*)(ws + WS_CTL + 524288) + (m >> 7) * 8; atomicAdd(cc + e1, 1); atomicAdd(cc + e2, 1); }
        }
    }
    SEAM(15);
    volatile LAS int* tb = (volatile LAS int*)(lds + MISC_OFF);
    PH(16) {
        LAS int* cnt_all = (LAS int*)lds;
        LAS int* posl = (LAS int*)(lds + 256);
        bf16_t* XG = (bf16_t*)(ws + WS_XG);
        for (int ch = bx; ch < M / 128; ch += G) {
            __syncthreads();
            if (tid < 16) cnt_all[tid] = 0;
            __syncthreads();
            int ct[8], cb[8];
#pragma unroll
            for (int e = 0; e < 8; ++e) { ct[e] = 0; cb[e] = 0; }
            if (tid < M / 128) { const int* cc = (const int*)(ws + WS_CTL + 524288) + tid * 8; const bool before = tid < ch;
#pragma unroll
                for (int e = 0; e < 8; ++e) { const int hit = cc[e]; ct[e] = hit; cb[e] = before ? hit : 0; } }
#pragma unroll
            for (int e = 0; e < 8; ++e) { int a = ct[e], b2 = cb[e];
#pragma unroll
                for (int o = 1; o < 64; o <<= 1) { a += __shfl_xor(a, o); b2 += __shfl_xor(b2, o); }
                if (lane == 0) { atomicAdd((int*)&cnt_all[e], a); atomicAdd((int*)&cnt_all[8 + e], b2); } }
            __syncthreads();
            if (wave == 0) {
                int base[8]; int run = 0;
#pragma unroll
                for (int e = 0; e < 8; ++e) { base[e] = run * 256 + cnt_all[8 + e]; run += (cnt_all[e] + 255) >> 8; }
#pragma unroll 1
                for (int half = 0; half < 2; ++half) { const int m = ch * 128 + half * 64 + lane; const unsigned ei = EIDX[m]; const int e1 = ei & 255, e2 = (ei >> 8) & 255;
                    int p1 = 0, p2 = 0;
#pragma unroll
                    for (int e = 0; e < 8; ++e) { const u64 mk = __ballot(e1 == e || e2 == e); const int rk = __popcll(mk & ((1ull << lane) - 1ull));
                        if (e1 == e) p1 = base[e] + rk; if (e2 == e) p2 = base[e] + rk; base[e] += __popcll(mk); }
                    posl[(half * 64 + lane) * 2] = p1; posl[(half * 64 + lane) * 2 + 1] = p2;
                    ROWINFO[p1] = (u32x2){(unsigned)m << 1, __builtin_bit_cast(unsigned, EW[2 * (size_t)m])};
                    ROWINFO[p2] = (u32x2){((unsigned)m << 1) | 1u, __builtin_bit_cast(unsigned, EW[2 * (size_t)m + 1])}; }
                if (ch == 0 && lane < 8) ((int*)(ws + WS_SMALL + 4096))[lane] = cnt_all[lane];
            }
            __syncthreads();
            for (int rr = wave; rr < 256; rr += NWAVES) { const int m = ch * 128 + (rr >> 1); const int p = posl[rr]; const float s16 = ((const float*)(ws + WS_RS))[m] * 16.f;
                const u32x4 a0 = ((const u32x4*)(XH + (size_t)m * D))[2 * lane], a1 = ((const u32x4*)(XH + (size_t)m * D))[2 * lane + 1];
                u32x4 o; o.x = pk_fp8x4(bflo(a0.x) * s16, bfhi(a0.x) * s16, bflo(a0.y) * s16, bfhi(a0.y) * s16); o.y = pk_fp8x4(bflo(a0.z) * s16, bfhi(a0.z) * s16, bflo(a0.w) * s16, bfhi(a0.w) * s16);
                o.z = pk_fp8x4(bflo(a1.x) * s16, bfhi(a1.x) * s16, bflo(a1.y) * s16, bfhi(a1.y) * s16); o.w = pk_fp8x4(bflo(a1.z) * s16, bfhi(a1.z) * s16, bflo(a1.w) * s16, bfhi(a1.w) * s16);
                ((u32x4*)((unsigned char*)XG + (size_t)p * D))[lane] = o; }
        }
    }
    SEAM(16);
    if (IN(17) || IN(18)) {
        __syncthreads();
        if (tid == 0) { const int* cg = (const int*)(ws + WS_SMALL + 4096); int run = 0;
            for (int e = 0; e < 8; ++e) { const int c = cg[e]; tb[e] = run; tb[16 + e] = c; run += (c + 255) >> 8; } tb[8] = run; }
        __syncthreads();
    }
    PH(17) { MoeOrder S{2 * FE / 256, G, bx, (const char*)(ws + WS_XG), (const char*)(ws + WS_MGU), (size_t)256 * D, (size_t)2 * FE * D, (size_t)256 * D, tb};
        pg8::EpiSwiGLU8 E{ws + WS_ACTS, FE, 8.f}; pg8::gemm_phase<pg8::EpiSwiGLU8, MoeOrder, true, true, true>(lds, pg8::Dims{D / 2, D / 2, D / 2, 127 - 4, 127 - 7}, S, E); }
    SEAM(17);
    PH(18) { MoeOrder S{D / 256, G, bx, (const char*)(ws + WS_ACTS), (const char*)(ws + WS_MDOWN), (size_t)256 * FE, (size_t)D * FE, (size_t)256 * FE, tb};
        EpiMoeDown E{(bf16_t*)(ws + WS_Y1), ROWINFO, EW, tb}; pg8::gemm_phase<EpiMoeDown, MoeOrder, true, true, true>(lds, pg8::Dims{FE / 2, FE / 2, FE / 2, 127 - 3, 127 - 8}, S, E); }
    SEAM(18);
    PH(19) { const bf16_t* Yb = (const bf16_t*)(ws + WS_Y1); const unsigned bad = xb_ld(ctl + CW_BAR + XB_TMO);
#if TPROBE
        const float* tkp = (const float*)(ws + WS_END2 + 2 * MiB); const float pfac = 1.0f + 0.25f * (tkp[TPROBE - 1] / tkp[2]);
#else
        const float pfac = 1.0f;
#endif
        u32x2 xn[4], y0n[4], y1n[4]; f32x4 gfin[4];
#define P19_LOAD(mm) do { _Pragma("unroll") for (int j = 0; j < 4; ++j) { xn[j] = *(const u32x2*)(XH + (size_t)(mm) * D + 4 * lane + 256 * j); \
            y0n[j] = *(const u32x2*)(Yb + (size_t)(mm) * D + 4 * lane + 256 * j); y1n[j] = *(const u32x2*)(Yb + ((size_t)M + (mm)) * D + 4 * lane + 256 * j); } } while (0)
        P19_LOAD(gw < M ? gw : 0);
#pragma unroll
        for (int j = 0; j < 4; ++j) gfin[j] = *((const f32x4*)A_IN(I_NORM_FINAL) + lane + 64 * j);
        for (int m = gw; m < M; m += NGW) { f32x4 v[4]; u32x2 y0[4], y1[4];
#pragma unroll
            for (int j = 0; j < 4; ++j) { v[j] = (f32x4){bflo(xn[j].x), bfhi(xn[j].x), bflo(xn[j].y), bfhi(xn[j].y)}; y0[j] = y0n[j]; y1[j] = y1n[j]; }
            P19_LOAD(m + NGW < M ? m + NGW : m);
#pragma unroll
            for (int j = 0; j < 4; ++j) v[j] = v[j] + ((f32x4){bflo(y0[j].x), bfhi(y0[j].x), bflo(y0[j].y), bfhi(y0[j].y)} + (f32x4){bflo(y1[j].x), bfhi(y1[j].x), bflo(y1[j].y), bfhi(y1[j].y)});
            const float rstd = bad ? __builtin_nanf("") : row_rstd(v); f32x4* o = (f32x4*)(xs + (size_t)m * D) + lane;
#pragma unroll
            for (int j = 0; j < 4; ++j) o[64 * j] = v[j] * (rstd * pfac) * gfin[j]; }
#undef P19_LOAD
    }
#undef IN
#undef SEAM
}

extern "C" void kernel_launch(void* const* d_in, const int* in_sizes, int n_in, void* d_out, int out_size, void* d_ws, size_t ws_size, hipStream_t stream) {
    static int grid = 0;
    if (grid == 0) {
        if (n_in != 22 || out_size != M * D || ws_size < WS_END2) { fprintf(stderr, "kernel_launch: unexpected shapes (n_in %d, out %d, ws %zu < %zu)\n", n_in, out_size, ws_size, (size_t)WS_END); grid = -1; return; }
        int dev = 0, cus = 0, per_cu = 0;
        if (hipGetDevice(&dev) != hipSuccess || hipDeviceGetAttribute(&cus, hipDeviceAttributeMultiprocessorCount, dev) != hipSuccess) { grid = -1; return; }
        if (hipFuncSetAttribute((const void*)yoco_fwd, hipFuncAttributeMaxDynamicSharedMemorySize, LDS_BYTES) != hipSuccess) { fprintf(stderr, "kernel_launch: hipFuncSetAttribute failed\n"); grid = -1; return; }
        if (hipOccupancyMaxActiveBlocksPerMultiprocessor(&per_cu, (const void*)yoco_fwd, NTHR, LDS_BYTES) != hipSuccess || per_cu < 1) fprintf(stderr, "kernel_launch: occupancy query says %d\n", per_cu);
        (void)hipGetLastError();
        grid = cus;
    }
    if (grid < 0) return;
    (void)hipMemsetAsync((char*)d_ws + WS_CTL, 0, CTL_ZERO_BYTES, stream);
    Args a{};
    for (int i = 0; i < 22; ++i) a.in[i] = (const float*)d_in[i];
    a.out = (float*)d_out; a.ws = (unsigned char*)d_ws;
#if MK_PER_PHASE
    for (int p = 0; p < NPHASE; ++p) { a.ph_lo = p; a.ph_hi = p + 1; hipLaunchKernelGGL(yoco_fwd, dim3(grid), dim3(NTHR), LDS_BYTES, stream, a); }
#else
    a.ph_lo = 0; a.ph_hi = NPHASE; hipLaunchKernelGGL(yoco_fwd, dim3(grid), dim3(NTHR), LDS_BYTES, stream, a);
#endif
}
```

```cpp
#include <hip/hip_runtime.h>
#include <cstdio>
#include <cstdint>

#ifndef MK_PER_PHASE
#define MK_PER_PHASE 0
#endif

#define LAS __attribute__((address_space(3)))
#define GAS __attribute__((address_space(1)))
typedef unsigned short bf16_t;
typedef short bf16x8 __attribute__((ext_vector_type(8)));
typedef float f32x4 __attribute__((ext_vector_type(4)));
typedef float f32x2 __attribute__((ext_vector_type(2)));
typedef unsigned u32x4 __attribute__((ext_vector_type(4)));
typedef unsigned u32x2 __attribute__((ext_vector_type(2)));
typedef unsigned long long u64;

constexpr int BATCH = 8, SEQ = 4096, D = 1024, M = BATCH * SEQ;
constexpr int A_HEADS = 4, A_HD = 256, NPROJ = 4096, NPROJ_SRC = 4104;
constexpr int FFD = 2816, NE = 8, FE = 3584;
constexpr int KVG = 4, HD = 64, NH = 16, NKVQ = 2816, NQSRC = 1072;
constexpr float EPS = 1e-6f;
constexpr int MOE_MAXT = 264;
constexpr int MOE_ROWS = MOE_MAXT * 256;

constexpr size_t MiB = 1u << 20;
constexpr size_t WS_CTL = 0, CTL_ZERO_BYTES = 1 * MiB;
constexpr size_t WS_SMALL = 1 * MiB;
constexpr size_t WS_WIN = 2 * MiB, WS_WOUTA = 10 * MiB, WS_WGU = 12 * MiB, WS_WDOWN = 23 * MiB, WS_WKVQ = 29 * MiB, WS_WCMP1 = 35 * MiB, WS_WOUTB = 37 * MiB;
constexpr size_t WS_MGU = 40 * MiB, WS_MDOWN = 152 * MiB, WS_XH = 208 * MiB, WS_GA = 272 * MiB, WS_ROWINFO = 273 * MiB, WS_BIG = 274 * MiB;
constexpr size_t WS_PROJ3 = WS_BIG, WS_OG = WS_BIG + 192 * MiB, WS_IMG = WS_BIG + 256 * MiB, WS_DN = WS_BIG + 536 * MiB, WS_HS = WS_BIG, WS_HN = WS_BIG + 128 * MiB;
constexpr size_t IMG_Q = 0, IMG_K = 34816, IMG_KT = 67584, IMG_VT = 100352, IMG_G = 141312, IMG_STRIDE = 142080;
static_assert((size_t)2048 * IMG_STRIDE <= 280 * MiB, "scan images");
constexpr size_t WS_ACT = WS_BIG;
constexpr size_t WS_KV = WS_BIG, WS_QB = WS_BIG + 96 * MiB, WS_GATEB = WS_BIG + 160 * MiB, WS_HID = WS_BIG + 166 * MiB, WS_KC = WS_BIG + 174 * MiB, WS_VC = WS_BIG + 175 * MiB, WS_OB = WS_BIG + 176 * MiB, WS_VT2 = WS_BIG + 240 * MiB;
constexpr size_t WS_XG = WS_BIG, WS_ACTS = WS_BIG + 132 * MiB, WS_Y1 = WS_BIG;
constexpr size_t WS_END = WS_BIG + 594 * MiB;
constexpr size_t WS_W2T = WS_SMALL + 524288;
constexpr size_t WS_SSP = WS_END, WS_RS = WS_END + 2 * MiB, WS_END2 = WS_END + 3 * MiB;
static_assert((size_t)MOE_ROWS * 1024 * 2 <= 132 * MiB && (size_t)MOE_ROWS * FE * 2 <= 462 * MiB, "moe buffers");
constexpr int CW_BAR = 4096;

constexpr int NWAVES = 8, NTHR = 512;
constexpr int LDS_BYTES = 163840;
constexpr int MISC_OFF = 163840 - 256;

__device__ __forceinline__ unsigned f2bf(float f) { unsigned u = __builtin_bit_cast(unsigned, f); return (u + 0x7fffu + ((u >> 16) & 1u)) >> 16; }
__device__ __forceinline__ unsigned pk2(float lo, float hi) { return f2bf(lo) | (f2bf(hi) << 16); }
__device__ __forceinline__ float bf2f(unsigned short b) { return __builtin_bit_cast(float, ((unsigned)b) << 16); }
__device__ __forceinline__ float bflo(unsigned w) { return __builtin_bit_cast(float, w << 16); }
__device__ __forceinline__ float bfhi(unsigned w) { return __builtin_bit_cast(float, w & 0xffff0000u); }
__device__ __forceinline__ float wave_sum(float v) {
#pragma unroll
    for (int o = 1; o < 64; o <<= 1) v += __shfl_xor(v, o);
    return v;
}
__device__ __forceinline__ float sigmoidf_(float x) { return __builtin_amdgcn_rcpf(1.0f + __builtin_amdgcn_exp2f(-1.4426950408889634f * x)); }
__device__ __forceinline__ float siluf_(float x) { return x * __builtin_amdgcn_rcpf(1.0f + __builtin_amdgcn_exp2f(-1.4426950408889634f * x)); }
__device__ __forceinline__ float ex2(float x) { return __builtin_amdgcn_exp2f(x); }
__device__ __forceinline__ unsigned pk_fp8x4(float a, float b, float c, float d) { unsigned w = 0u; w = __builtin_amdgcn_cvt_pk_fp8_f32(a, b, w, false); w = __builtin_amdgcn_cvt_pk_fp8_f32(c, d, w, true); return w; }
#define LDS_WAIT() asm volatile("s_waitcnt lgkmcnt(0)" ::: "memory")
#define LDS_BARRIER() do { asm volatile("s_waitcnt lgkmcnt(0)" ::: "memory"); __builtin_amdgcn_s_barrier(); asm volatile("" ::: "memory"); } while (0)

#define XB_TMO      128
#define XB_XCNT(j)  (256  + 64 * (j))
#define XB_XSUB(j)  (1280 + 64 * (j))
#define XB_XGEN(j)  (2304 + 64 * (j))
#define XB_TOP      3328
#define XB_TOPGEN   3392
#define XCD_BAR_WORDS 3456
#define XB_SPIN_CAP (1u << 22)
__device__ __forceinline__ unsigned xb_ld(unsigned* p)              { return __hip_atomic_load(p, __ATOMIC_RELAXED, __HIP_MEMORY_SCOPE_AGENT); }
__device__ __forceinline__ unsigned xb_add(unsigned* p, unsigned v) { return __hip_atomic_fetch_add(p, v, __ATOMIC_RELAXED, __HIP_MEMORY_SCOPE_AGENT); }
__device__ __forceinline__ unsigned xb_xcc_id() { return (unsigned)__builtin_amdgcn_s_getreg((3 << 11) | 20) & 0xFu; }
#define XB_SPIN(cond, bar) do { unsigned _sp = 0; while (cond) { __builtin_amdgcn_s_sleep(1); \
    if ((++_sp & 255u) == 0u) { if (xb_ld(&(bar)[XB_TMO])) break; if (_sp > XB_SPIN_CAP) { atomicAdd(&(bar)[XB_TMO], 1u); break; } } } } while (0)
struct XcdBarrier { unsigned* bar; unsigned x; volatile LAS unsigned* st; };
__device__ __forceinline__ XcdBarrier xcd_barrier_post(unsigned* bar, volatile LAS unsigned* st) {
    XcdBarrier b; b.bar = bar; b.x = xb_xcc_id(); b.st = st;
    if (threadIdx.x == 0) (void)xb_add(&bar[XB_XCNT(b.x)], 1u);
    return b;
}
__device__ __forceinline__ void xcd_barrier_complete(unsigned* bar, unsigned x, unsigned& nloc, unsigned& nx) {
    const unsigned G = gridDim.x * gridDim.y * gridDim.z;
    unsigned sum, cnt, mine, sp = 0u;
    for (;;) {
        sum = 0u; cnt = 0u; mine = 0u;
#pragma unroll
        for (unsigned j = 0; j < 16; ++j) { const unsigned c = xb_ld(&bar[XB_XCNT(j)]); sum += c; cnt += (c > 0u) ? 1u : 0u; mine = (j == x) ? c : mine; }
        if (sum == G) break;
        __builtin_amdgcn_s_sleep(1);
        if ((++sp & 255u) == 0u) { if (xb_ld(&bar[XB_TMO])) break; if (sp > XB_SPIN_CAP) { atomicAdd(&bar[XB_TMO], 1u); break; } }
    }
    nloc = mine > 0u ? mine : 1u; nx = cnt > 0u ? cnt : 1u;
}
__device__ __forceinline__ void xcd_barrier(const XcdBarrier& b) {
    asm volatile("s_waitcnt vmcnt(0)" ::: "memory");
    __syncthreads();
    if (threadIdx.x == 0) {
        unsigned* bar = b.bar;
        __builtin_amdgcn_s_waitcnt(0);
        unsigned nloc = b.st[0], nx = b.st[1];
        if (nloc == 0u) { xcd_barrier_complete(bar, b.x, nloc, nx); b.st[0] = nloc; b.st[1] = nx; }
        const unsigned old = xb_add(&bar[XB_XSUB(b.x)], 1u);
        const unsigned gen = old / nloc;
        if (old + 1u == (gen + 1u) * nloc) {
            __builtin_amdgcn_fence(__ATOMIC_RELEASE, "agent");
            asm volatile("s_waitcnt vmcnt(0)" ::: "memory");
            const unsigned og = xb_add(&bar[XB_TOP], 1u);
            const unsigned tg = og / nx;
            if (og + 1u == (tg + 1u) * nx) xb_add(&bar[XB_TOPGEN], 1u);
            else XB_SPIN(xb_ld(&bar[XB_TOPGEN]) == tg, bar);
            __builtin_amdgcn_fence(__ATOMIC_ACQUIRE, "agent");
            xb_add(&bar[XB_XGEN(b.x)], 1u);
            asm volatile("s_waitcnt vmcnt(0)" ::: "memory");
        } else {
            XB_SPIN(xb_ld(&bar[XB_XGEN(b.x)]) == gen, bar);
            __builtin_amdgcn_fence(__ATOMIC_ACQUIRE, "agent");
            asm volatile("s_waitcnt vmcnt(0)" ::: "memory");
        }
    }
    __syncthreads();
}

#ifndef EXPT
#define EXPT 0
#endif
#ifndef TSEG
#define TSEG 0
#endif
#if TSEG
#define TS_B(k) do { if (TSEG & (1 << (k))) tseg_t = __builtin_amdgcn_s_memrealtime(); } while (0)
#define TS_E(k) do { if (TSEG & (1 << (k))) tseg_acc += __builtin_amdgcn_s_memrealtime() - tseg_t; } while (0)
#else
#define TS_B(k)
#define TS_E(k)
#endif
#ifndef TPROBE
#define TPROBE 0
#endif
namespace pg8 {
constexpr int BM = 256, BK = 64, HALF = 128, HTB = HALF * BK * 2, STAGE_BYTES = 8 * HTB, NXCD = 8, WGM = 8;
__host__ __device__ __forceinline__ int lds_byte(int r, int c) { const int st = (r >> 4) * 2 + (c >> 5), rr = r & 15, cc = c & 31, ob = rr * 64 + cc * 2; return st * 1024 + (ob ^ (((ob >> 9) & 1) << 5)); }
__host__ __device__ __forceinline__ void stage_rc(int b, int& R, int& C) { const int st = b / 1024, sb = b % 1024, swz = sb ^ (((sb >> 9) & 1) << 5); R = (st >> 1) * 16 + swz / 64; C = (st & 1) * 32 + (swz % 64) / 2; }
__host__ __device__ __forceinline__ int perm32(int rho) { const int n = rho >> 4, i = rho & 15; return 8 * (i >> 2) + 4 * n + (i & 3); }
struct Unit { int pm, pn; const char* a; const char* b; };
struct Dims { int K, lda, ldb; int sa = 127, sb = 127; float* tk = nullptr; };
typedef __bf16 bf16x2_t __attribute__((ext_vector_type(2)));
__device__ __forceinline__ unsigned cvt_pk_bf16(float lo, float hi) { const f32x2 v = {lo, hi}; const bf16x2_t b = __builtin_convertvector(v, bf16x2_t); return __builtin_bit_cast(unsigned, b); }

__device__ __forceinline__ bool tile_order(int i, int G, int c, int nM, int nN, int& pm, int& pn) {
    const int nwg = nM * nN; const long L = (long)i * G + c; if (L >= nwg) return false;
    int wgid = (int)L; { const int q = nwg / NXCD, r = nwg % NXCD, xcd = wgid % NXCD, off = wgid / NXCD; wgid = (xcd < r ? xcd * (q + 1) : r * (q + 1) + (xcd - r) * q) + off; }
    const int nig = WGM * nN, gid = wgid / nig, fm = gid * WGM, gsz = (nM - fm) < WGM ? (nM - fm) : WGM;
    pm = fm + ((wgid % nig) % gsz); pn = (wgid % nig) / gsz; return true;
}
struct PlainOrder {
    int nM, nN, G, c; const char* A; const char* B; size_t tA, tB; int same = 0;
    __device__ __forceinline__ void init(const bf16_t* A_, const bf16_t* B_, int M_, int N_, int lda, int ldb, int G_, int c_) { nM = M_ / BM; nN = N_ / BM; G = G_; c = c_; A = (const char*)A_; B = (const char*)B_; tA = (size_t)BM * lda * 2; tB = (size_t)BM * ldb * 2; }
    __device__ __forceinline__ bool next(int i, Unit& u) const { if (EXPT && same) { if (i >= same) return false; u.pm = 0; u.pn = i; u.a = A; u.b = B + (size_t)i * tB; return true; }
        if (!tile_order(i, G, c, nM, nN, u.pm, u.pn)) return false; u.a = A + (size_t)u.pm * tA; u.b = B + (size_t)u.pn * tB; return true; }
};

template <class Epi, class Sched, bool ALIGN_EPI = true, bool SP2 = true, bool FP8 = false>
__device__ __forceinline__ void gemm_phase(LAS unsigned char* lds, const Dims g, const Sched& S, const Epi& E) {
    const int tid = threadIdx.x, wid = __builtin_amdgcn_readfirstlane(tid >> 6), lane = tid & 63, wr = wid >> 2, wc = wid & 3, fr = lane & 15, fq = lane >> 4;
    const int K = g.K, nt = K / BK;
    unsigned voffA[2], voffB[2];
#pragma unroll
    for (int i = 0; i < 2; ++i) { int R, C; stage_rc(tid * 16 + i * 8192, R, C); const int Rb = Epi::PERM ? ((R & ~31) + perm32(R & 31)) : R;
        voffA[i] = (unsigned)(R * g.lda + C) * 2u; voffB[i] = (unsigned)(Rb * g.ldb + C) * 2u; }
    const size_t kstep = (size_t)(BK * 2);
    const size_t hstepA = (size_t)HALF * g.lda * 2, hstepB = (size_t)HALF * g.ldb * 2;
    const unsigned ldsw = (unsigned)wid * 1024u;
    const int aoff = lds_byte(wr * 64 + fr, fq * 8), boff = lds_byte(wc * 32 + fr, fq * 8);
#define PG8_SA(b, h) (((b) * 2 + (h)) * HTB)
#define PG8_SB(b, h) ((4 + (b) * 2 + (h)) * HTB)
#define PG8_STAGE(bufoff, gbase, voff) do { _Pragma("unroll") for (int _i = 0; _i < 2; ++_i) \
        __builtin_amdgcn_global_load_lds((const unsigned*)((const char*)(gbase) + (voff)[_i]), (LAS unsigned*)(lds + (bufoff) + ldsw + _i * 8192), 16, 0, 0); } while (0)
    typedef int v8i_t __attribute__((ext_vector_type(8))); typedef int v4i_t __attribute__((ext_vector_type(4)));
#define PG8_RD8(p) __builtin_shufflevector(*(const LAS v4i_t*)(p), *(const LAS v4i_t*)((p) + 1024), 0, 1, 2, 3, 4, 5, 6, 7)
#define PG8_LDA(dst, b, h) do { if constexpr (FP8) { _Pragma("unroll") for (int m = 0; m < 4; ++m) dst##8[m] = PG8_RD8(lds + PG8_SA(b, h) + aoff + m * 2048); } \
        else { _Pragma("unroll") for (int m = 0; m < 4; ++m) _Pragma("unroll") for (int k = 0; k < 2; ++k) dst[m][k] = *(const LAS bf16x8*)(lds + PG8_SA(b, h) + aoff + m * 2048 + k * 1024); } } while (0)
#define PG8_LDB(dst, b, h) do { if constexpr (FP8) { _Pragma("unroll") for (int n = 0; n < 2; ++n) dst##8[n] = PG8_RD8(lds + PG8_SB(b, h) + boff + n * 2048); } \
        else { _Pragma("unroll") for (int n = 0; n < 2; ++n) _Pragma("unroll") for (int k = 0; k < 2; ++k) dst[n][k] = *(const LAS bf16x8*)(lds + PG8_SB(b, h) + boff + n * 2048 + k * 1024); } } while (0)
#define PG8_MMA(ai, bj, At, Bt) do { __builtin_amdgcn_s_setprio(1); \
        if constexpr (FP8) { _Pragma("unroll") for (int m = 0; m < 4; ++m) _Pragma("unroll") for (int n = 0; n < 2; ++n) \
            asm volatile("v_mfma_scale_f32_16x16x128_f8f6f4 %0, %1, %2, %0, %3, %4 op_sel_hi:[0,0,0]" : "+v"(acc[ai][bj][m][n]) : "v"(Bt##8[n]), "v"(At##8[m]), "v"(sbv), "v"(sav)); } \
        else { _Pragma("unroll") for (int m = 0; m < 4; ++m) _Pragma("unroll") for (int n = 0; n < 2; ++n) _Pragma("unroll") for (int k = 0; k < 2; ++k) \
            acc[ai][bj][m][n] = __builtin_amdgcn_mfma_f32_16x16x32_bf16(Bt[n][k], At[m][k], acc[ai][bj][m][n], 0, 0, 0); } \
        __builtin_amdgcn_s_setprio(0); } while (0)
#define PG8_WAIT_V(n) asm volatile("s_waitcnt vmcnt(" #n ")" ::: "memory")
#define PG8_WAIT_L(n) asm volatile("s_waitcnt lgkmcnt(" #n ")" ::: "memory")
#define PG8_BAR __builtin_amdgcn_s_barrier()
#define PG8_SCHED __builtin_amdgcn_sched_barrier(0)
    Unit cur, nxt; int ui = 0;
    if (!S.next(0, cur)) return;
    f32x4 acc[2][2][4][2];
#pragma unroll
    for (int a = 0; a < 2; ++a)
#pragma unroll
        for (int b = 0; b < 2; ++b)
#pragma unroll
            for (int m = 0; m < 4; ++m)
#pragma unroll
                for (int n = 0; n < 2; ++n) acc[a][b][m][n] = (f32x4){0.f, 0.f, 0.f, 0.f};
    bf16x8 At[4][2], B0[2][2], B1[2][2]; v8i_t At8[4], B08[2], B18[2];
    const int sbv = g.sb, sav = g.sa;
    const char* cA = cur.a; const char* cB = cur.b;
    if constexpr (SP2) {
        PG8_STAGE(PG8_SB(0, 0), cB, voffB); PG8_STAGE(PG8_SB(0, 1), cB + hstepB, voffB); PG8_STAGE(PG8_SA(0, 0), cA, voffA); PG8_STAGE(PG8_SA(0, 1), cA + hstepA, voffA);
        if (wr == 1) PG8_BAR;
        PG8_WAIT_V(2); PG8_BAR;
        PG8_STAGE(PG8_SB(1, 0), cB + kstep, voffB); PG8_STAGE(PG8_SA(1, 0), cA + kstep, voffA); PG8_STAGE(PG8_SB(1, 1), cB + hstepB + kstep, voffB);
        PG8_WAIT_V(6); PG8_BAR;
    } else {
        PG8_STAGE(PG8_SB(0, 0), cB, voffB); PG8_STAGE(PG8_SA(0, 0), cA, voffA); PG8_STAGE(PG8_SB(0, 1), cB + hstepB, voffB); PG8_STAGE(PG8_SA(0, 1), cA + hstepA, voffA);
        if (wr == 1) PG8_BAR;
        PG8_WAIT_V(4); PG8_BAR;
        PG8_STAGE(PG8_SB(1, 0), cB + kstep, voffB); PG8_STAGE(PG8_SA(1, 0), cA + kstep, voffA); PG8_STAGE(PG8_SB(1, 1), cB + hstepB + kstep, voffB);
        PG8_WAIT_V(6); PG8_BAR;
    }
#if TPROBE
    unsigned long long tk_acc = 0, te_acc = 0;
#endif
    for (;;) {
        const bool has_next = S.next(ui + 1, nxt);
#if TPROBE
        const unsigned long long tk0 = __builtin_amdgcn_s_memrealtime();
#endif
        const char* nA = has_next ? nxt.a : cA; const char* nB = has_next ? nxt.b : cB;
#pragma unroll 1
        for (int t = 0; t < nt; t += 2) {
            const bool last = (t == nt - 2);
            const char* a1 = cA + (size_t)(t + 1) * kstep;
            const char* a2 = last ? nA : cA + (size_t)(t + 2) * kstep; const char* b2 = last ? nB : cB + (size_t)(t + 2) * kstep;
            const char* a3 = a2 + kstep; const char* b3 = b2 + kstep;
            if constexpr (SP2) {
            PG8_LDB(B0, 0, 0); PG8_LDB(B1, 0, 1); PG8_SCHED; PG8_LDA(At, 0, 0); PG8_STAGE(PG8_SA(1, 1), a1 + hstepA, voffA);
            PG8_WAIT_V(8); PG8_WAIT_L(0); PG8_BAR; PG8_MMA(0, 0, At, B0); PG8_MMA(0, 1, At, B1); PG8_BAR; PG8_SCHED;
            PG8_LDA(At, 0, 1); PG8_STAGE(PG8_SB(0, 0), b2, voffB); PG8_STAGE(PG8_SB(0, 1), b2 + hstepB, voffB); PG8_STAGE(PG8_SA(0, 0), a2, voffA);
            PG8_WAIT_V(8); PG8_WAIT_L(0); PG8_BAR; PG8_MMA(1, 0, At, B0); PG8_MMA(1, 1, At, B1); PG8_BAR; PG8_SCHED;
            PG8_LDB(B0, 1, 0); PG8_LDB(B1, 1, 1); PG8_SCHED; PG8_LDA(At, 1, 0); PG8_STAGE(PG8_SA(0, 1), a2 + hstepA, voffA);
            PG8_WAIT_V(8); PG8_WAIT_L(0); PG8_BAR; PG8_MMA(0, 0, At, B0); PG8_MMA(0, 1, At, B1); PG8_BAR; PG8_SCHED;
            PG8_LDA(At, 1, 1); PG8_STAGE(PG8_SB(1, 0), b3, voffB); PG8_STAGE(PG8_SB(1, 1), b3 + hstepB, voffB); PG8_STAGE(PG8_SA(1, 0), a3, voffA);
            PG8_WAIT_V(8); PG8_WAIT_L(0); PG8_BAR; PG8_MMA(1, 0, At, B0); PG8_MMA(1, 1, At, B1); PG8_BAR; PG8_SCHED;
            } else {
            PG8_LDB(B0, 0, 0); PG8_SCHED; PG8_LDA(At, 0, 0); PG8_STAGE(PG8_SA(1, 1), a1 + hstepA, voffA);
            PG8_WAIT_L(8); PG8_BAR; PG8_WAIT_L(0); PG8_MMA(0, 0, At, B0); PG8_BAR; PG8_SCHED;
            PG8_LDB(B1, 0, 1); PG8_STAGE(PG8_SB(0, 0), b2, voffB);
            PG8_BAR; PG8_WAIT_L(0); PG8_MMA(0, 1, At, B1); PG8_BAR;
            PG8_LDA(At, 0, 1); PG8_STAGE(PG8_SA(0, 0), a2, voffA);
            PG8_BAR; PG8_WAIT_L(0); PG8_MMA(1, 0, At, B0); PG8_BAR; PG8_SCHED;
            PG8_STAGE(PG8_SB(0, 1), b2 + hstepB, voffB);
            PG8_WAIT_V(6); PG8_BAR; PG8_MMA(1, 1, At, B1); PG8_BAR;
            PG8_LDB(B0, 1, 0); PG8_SCHED; PG8_LDA(At, 1, 0); PG8_STAGE(PG8_SA(0, 1), a2 + hstepA, voffA);
            PG8_WAIT_L(8); PG8_BAR; PG8_WAIT_L(0); PG8_MMA(0, 0, At, B0); PG8_BAR; PG8_SCHED;
            PG8_LDB(B1, 1, 1); PG8_STAGE(PG8_SB(1, 0), b3, voffB);
            PG8_BAR; PG8_WAIT_L(0); PG8_MMA(0, 1, At, B1); PG8_BAR;
            PG8_LDA(At, 1, 1); PG8_STAGE(PG8_SA(1, 0), a3, voffA);
            PG8_BAR; PG8_WAIT_L(0); PG8_MMA(1, 0, At, B0); PG8_BAR; PG8_SCHED;
            PG8_STAGE(PG8_SB(1, 1), b3 + hstepB, voffB);
            PG8_WAIT_V(6); PG8_BAR; PG8_MMA(1, 1, At, B1); PG8_BAR;
            }
        }
#if TPROBE
        const unsigned long long tk1 = __builtin_amdgcn_s_memrealtime(); tk_acc += tk1 - tk0;
#endif
        if constexpr (ALIGN_EPI) { if (wr == 0) PG8_BAR; }
        if constexpr (FP8) asm volatile("s_nop 15\n\ts_nop 15" ::: "memory");
        E(acc, cur, wr, wc, fr, fq);
#if TPROBE
        te_acc += __builtin_amdgcn_s_memrealtime() - tk1;
#endif
        if (!has_next) break;
#pragma unroll
        for (int a = 0; a < 2; ++a)
#pragma unroll
            for (int b = 0; b < 2; ++b)
#pragma unroll
                for (int m = 0; m < 4; ++m)
#pragma unroll
                    for (int n = 0; n < 2; ++n) acc[a][b][m][n] = (f32x4){0.f, 0.f, 0.f, 0.f};
        cur = nxt; cA = nA; cB = nB; ++ui;
        if constexpr (ALIGN_EPI) { if (wr == 1) PG8_BAR; }
    }
    PG8_WAIT_V(0);
    if constexpr (!ALIGN_EPI) { if (wr == 0) PG8_BAR; }
    PG8_BAR;
#if TPROBE
    if (g.tk && tid == 0) { g.tk[0] = (float)tk_acc; g.tk[1] = (float)te_acc; }
#endif
#undef PG8_SA
#undef PG8_SB
#undef PG8_STAGE
#undef PG8_LDA
#undef PG8_LDB
#undef PG8_MMA
#undef PG8_RD8
#undef PG8_WAIT_V
#undef PG8_WAIT_L
#undef PG8_BAR
#undef PG8_SCHED
}

typedef const f32x4 (&AccRef)[2][2][4][2];
struct EpiBf16Plain {
    static constexpr bool PERM = true;
    bf16_t* O; int ldc;
    __device__ __forceinline__ void operator()(AccRef acc, const Unit& u, int wr, int wc, int fr, int fq) const {
        const int row0 = u.pm * BM + wr * 64 + fr, col0 = u.pn * BM + wc * 32 + 8 * fq;
#pragma unroll
        for (int ai = 0; ai < 2; ++ai)
#pragma unroll
            for (int m = 0; m < 4; ++m) { bf16_t* rowp = O + (size_t)(row0 + ai * HALF + m * 16) * ldc + col0;
#pragma unroll
                for (int bj = 0; bj < 2; ++bj) { const f32x4 v0 = acc[ai][bj][m][0], v1 = acc[ai][bj][m][1];
                    u32x4 w; w.x = cvt_pk_bf16(v0[0], v0[1]); w.y = cvt_pk_bf16(v0[2], v0[3]); w.z = cvt_pk_bf16(v1[0], v1[1]); w.w = cvt_pk_bf16(v1[2], v1[3]);
                    *(u32x4*)(rowp + bj * HALF) = w; } }
    }
};
struct EpiProjSplit {
    static constexpr bool PERM = true;
    bf16_t* P3; bf16_t* OG;
    __device__ __forceinline__ void operator()(AccRef acc, const Unit& u, int wr, int wc, int fr, int fq) const {
        const int row0 = u.pm * BM + wr * 64 + fr; const bool og = u.pn >= 12; const int ldc = og ? 1024 : 3072; bf16_t* base = (og ? OG + (u.pn - 12) * BM : P3 + u.pn * BM) + wc * 32 + 8 * fq;
#pragma unroll
        for (int ai = 0; ai < 2; ++ai)
#pragma unroll
            for (int m = 0; m < 4; ++m) { bf16_t* rowp = base + (size_t)(row0 + ai * HALF + m * 16) * ldc;
#pragma unroll
                for (int bj = 0; bj < 2; ++bj) { const f32x4 v0 = acc[ai][bj][m][0], v1 = acc[ai][bj][m][1];
                    u32x4 w; w.x = cvt_pk_bf16(v0[0], v0[1]); w.y = cvt_pk_bf16(v0[2], v0[3]); w.z = cvt_pk_bf16(v1[0], v1[1]); w.w = cvt_pk_bf16(v1[2], v1[3]);
                    *(u32x4*)(rowp + bj * HALF) = w; } }
    }
};
struct EpiResF32 {
    static constexpr bool PERM = false;
    const float* base; float* out; int ldc;
    __device__ __forceinline__ void operator()(AccRef acc, const Unit& u, int wr, int wc, int fr, int fq) const {
        const int row0 = u.pm * BM + wr * 64 + fr, col0 = u.pn * BM + wc * 32 + 4 * fq;
#pragma unroll
        for (int ai = 0; ai < 2; ++ai)
#pragma unroll
            for (int m = 0; m < 4; ++m) { const size_t off = (size_t)(row0 + ai * HALF + m * 16) * ldc + col0;
#pragma unroll
                for (int bj = 0; bj < 2; ++bj)
#pragma unroll
                    for (int n = 0; n < 2; ++n) { const f32x4 bs = *(const f32x4*)(base + off + bj * HALF + n * 16); *(f32x4*)(out + off + bj * HALF + n * 16) = bs + acc[ai][bj][m][n]; } }
    }
};
__device__ __forceinline__ float row_rs16(const float* ss, int row) { const f32x4* p = (const f32x4*)(ss + (size_t)row * 16); const f32x4 a = p[0], b = p[1], c = p[2], d = p[3];
    const float t = (((a[0] + a[1]) + (a[2] + a[3])) + ((b[0] + b[1]) + (b[2] + b[3]))) + (((c[0] + c[1]) + (c[2] + c[3])) + ((d[0] + d[1]) + (d[2] + d[3]))); return 1.0f / sqrtf(t * (1.f / 1024.f) + EPS); }
struct EpiResF32Stat {
    static constexpr bool PERM = false;
    const float* base; float* out; bf16_t* XHo; float* SS; int ldc;
    __device__ __forceinline__ void operator()(AccRef acc, const Unit& u, int wr, int wc, int fr, int fq) const {
        const int row0 = u.pm * BM + wr * 64 + fr, col0 = u.pn * BM + wc * 32 + 4 * fq;
#pragma unroll
        for (int ai = 0; ai < 2; ++ai)
#pragma unroll
            for (int m = 0; m < 4; ++m) { const int row = row0 + ai * HALF + m * 16; const size_t off = (size_t)row * ldc + col0; float ss = 0.f;
#pragma unroll
                for (int bj = 0; bj < 2; ++bj)
#pragma unroll
                    for (int n = 0; n < 2; ++n) { const f32x4 o = *(const f32x4*)(base + off + bj * HALF + n * 16) + acc[ai][bj][m][n]; *(f32x4*)(out + off + bj * HALF + n * 16) = o;
                        ss += (o[0] * o[0] + o[1] * o[1]) + (o[2] * o[2] + o[3] * o[3]);
                        u32x2 w; w.x = cvt_pk_bf16(o[0], o[1]); w.y = cvt_pk_bf16(o[2], o[3]); *(u32x2*)(XHo + off + bj * HALF + n * 16) = w; }
                ss += __shfl_xor(ss, 16); ss += __shfl_xor(ss, 32);
                if (fq == 0) SS[(size_t)row * 16 + u.pn * 4 + wc] = ss; }
    }
};
template <bool BASE16, bool STAT>
struct EpiRes16 {
    static constexpr bool PERM = true;
    const float* base32; bf16_t* XHo; float* SS; int ldc;
    __device__ __forceinline__ void operator()(AccRef acc, const Unit& u, int wr, int wc, int fr, int fq) const {
        const int row0 = u.pm * BM + wr * 64 + fr, col0 = u.pn * BM + wc * 32 + 8 * fq;
#pragma unroll
        for (int ai = 0; ai < 2; ++ai)
#pragma unroll
            for (int m = 0; m < 4; ++m) { const int row = row0 + ai * HALF + m * 16; const size_t off = (size_t)row * ldc + col0; float ss = 0.f;
#pragma unroll
                for (int bj = 0; bj < 2; ++bj) { f32x4 b0, b1;
                    if constexpr (BASE16) { const u32x4 r = *(const u32x4*)(XHo + off + bj * HALF); b0 = (f32x4){bflo(r.x), bfhi(r.x), bflo(r.y), bfhi(r.y)}; b1 = (f32x4){bflo(r.z), bfhi(r.z), bflo(r.w), bfhi(r.w)}; }
                    else { b0 = *(const f32x4*)(base32 + off + bj * HALF); b1 = *(const f32x4*)(base32 + off + bj * HALF + 4); }
                    const f32x4 o0 = b0 + acc[ai][bj][m][0], o1 = b1 + acc[ai][bj][m][1];
                    if constexpr (STAT) ss += ((o0[0] * o0[0] + o0[1] * o0[1]) + (o0[2] * o0[2] + o0[3] * o0[3])) + ((o1[0] * o1[0] + o1[1] * o1[1]) + (o1[2] * o1[2] + o1[3] * o1[3]));
                    u32x4 w; w.x = cvt_pk_bf16(o0[0], o0[1]); w.y = cvt_pk_bf16(o0[2], o0[3]); w.z = cvt_pk_bf16(o1[0], o1[1]); w.w = cvt_pk_bf16(o1[2], o1[3]);
                    *(u32x4*)(XHo + off + bj * HALF) = w; }
                if constexpr (STAT) { ss += __shfl_xor(ss, 16); ss += __shfl_xor(ss, 32);
                    if (fq == 0) SS[(size_t)row * 16 + u.pn * 4 + wc] = ss; } }
    }
};
struct EpiSwiGLU {
    static constexpr bool PERM = true;
    bf16_t* O; int ldc; const float* rsv;
    __device__ __forceinline__ void operator()(AccRef acc, const Unit& u, int wr, int wc, int fr, int fq) const {
        const int row0 = u.pm * BM + wr * 64 + fr, col0 = u.pn * HALF + wc * 32 + 8 * fq;
#pragma unroll
        for (int ai = 0; ai < 2; ++ai)
#pragma unroll
            for (int m = 0; m < 4; ++m) { const int row = row0 + ai * HALF + m * 16; bf16_t* rowp = O + (size_t)row * ldc + col0; const float rs = rsv ? rsv[row] : 1.0f;
                float o[8];
#pragma unroll
                for (int n = 0; n < 2; ++n)
#pragma unroll
                    for (int j = 0; j < 4; ++j) { const float gv = acc[ai][0][m][n][j] * rs, uv = acc[ai][1][m][n][j] * rs; o[n * 4 + j] = siluf_(gv) * uv; }
                u32x4 w; w.x = cvt_pk_bf16(o[0], o[1]); w.y = cvt_pk_bf16(o[2], o[3]); w.z = cvt_pk_bf16(o[4], o[5]); w.w = cvt_pk_bf16(o[6], o[7]);
                *(u32x4*)rowp = w; }
    }
};
struct EpiSwiGLU8 {
    static constexpr bool PERM = true;
    unsigned char* O8; int ldc; float oscale;
    __device__ __forceinline__ void operator()(AccRef acc, const Unit& u, int wr, int wc, int fr, int fq) const {
        const int row0 = u.pm * BM + wr * 64 + fr, col0 = u.pn * HALF + wc * 32 + 8 * fq;
#pragma unroll
        for (int ai = 0; ai < 2; ++ai)
#pragma unroll
            for (int m = 0; m < 4; ++m) { unsigned char* rowp = O8 + (size_t)(row0 + ai * HALF + m * 16) * ldc + col0;
                float o[8];
#pragma unroll
                for (int n = 0; n < 2; ++n)
#pragma unroll
                    for (int j = 0; j < 4; ++j) { const float gv = acc[ai][0][m][n][j], uv = acc[ai][1][m][n][j]; o[n * 4 + j] = siluf_(gv) * uv * oscale; }
                u32x2 w; w.x = pk_fp8x4(o[0], o[1], o[2], o[3]); w.y = pk_fp8x4(o[4], o[5], o[6], o[7]);
                *(u32x2*)rowp = w; }
    }
};
struct EpiKVQ {
    static constexpr bool PERM = true;
    bf16_t* KV; bf16_t* Q; float* GATE; const float* bgate; const float* rsv;
    __device__ __forceinline__ void operator()(AccRef acc, const Unit& u, int wr, int wc, int fr, int fq) const {
        const int row0 = u.pm * BM + wr * 64 + fr, cin = wc * 32 + 8 * fq;
#pragma unroll
        for (int ai = 0; ai < 2; ++ai)
#pragma unroll
            for (int m = 0; m < 4; ++m) { const int row = row0 + ai * HALF + m * 16; const float rs = rsv[row];
#pragma unroll
                for (int bj = 0; bj < 2; ++bj) { const f32x4 v0 = acc[ai][bj][m][0] * rs, v1 = acc[ai][bj][m][1] * rs; const int col = cin + bj * HALF;
                    if (u.pn < 6) { const int b = row >> 12, t = row & 4095, g = col >> 6, d = col & 63;
                        u32x4 w; w.x = cvt_pk_bf16(v0[0], v0[1]); w.y = cvt_pk_bf16(v0[2], v0[3]); w.z = cvt_pk_bf16(v1[0], v1[1]); w.w = cvt_pk_bf16(v1[2], v1[3]);
                        *(u32x4*)(KV + ((((size_t)u.pn * 8 + b) * 4 + g) * 4096 + t) * 64 + d) = w;
                    } else if (u.pn < 10) { const float s = 0.125f * 1.4426950408889634f;
                        u32x4 w; w.x = cvt_pk_bf16(v0[0] * s, v0[1] * s); w.y = cvt_pk_bf16(v0[2] * s, v0[3] * s); w.z = cvt_pk_bf16(v1[0] * s, v1[1] * s); w.w = cvt_pk_bf16(v1[2] * s, v1[3] * s);
                        *(u32x4*)(Q + (size_t)row * 1024 + (u.pn - 6) * 256 + col) = w;
                    } else if (col < 48) { const f32x4 b0 = *(const f32x4*)(bgate + col), b1 = *(const f32x4*)(bgate + col + 4);
                        f32x4 o0, o1;
#pragma unroll
                        for (int j = 0; j < 4; ++j) { o0[j] = sigmoidf_(v0[j] + b0[j]); o1[j] = sigmoidf_(v1[j] + b1[j]); }
                        *(f32x4*)(GATE + (size_t)row * 48 + col) = o0; *(f32x4*)(GATE + (size_t)row * 48 + col + 4) = o1; } } }
    }
};
struct EpiCmp {
    static constexpr bool PERM = true;
    bf16_t* O; const float* bias;
    __device__ __forceinline__ void operator()(AccRef acc, const Unit& u, int wr, int wc, int fr, int fq) const {
        const int row0 = u.pm * BM + wr * 64 + fr, col0 = wc * 32 + 8 * fq; const float* bp = bias + (u.pm >> 5) * 256 + col0;
#pragma unroll
        for (int ai = 0; ai < 2; ++ai)
#pragma unroll
            for (int m = 0; m < 4; ++m) { bf16_t* rowp = O + (size_t)(row0 + ai * HALF + m * 16) * 256 + col0;
#pragma unroll
                for (int bj = 0; bj < 2; ++bj) { const f32x4 b0 = *(const f32x4*)(bp + bj * HALF), b1 = *(const f32x4*)(bp + bj * HALF + 4);
                    const f32x4 v0 = acc[ai][bj][m][0] + b0, v1 = acc[ai][bj][m][1] + b1;
                    u32x4 w; w.x = cvt_pk_bf16(siluf_(v0[0]), siluf_(v0[1])); w.y = cvt_pk_bf16(siluf_(v0[2]), siluf_(v0[3])); w.z = cvt_pk_bf16(siluf_(v1[0]), siluf_(v1[1])); w.w = cvt_pk_bf16(siluf_(v1[2]), siluf_(v1[3]));
                    *(u32x4*)(rowp + bj * HALF) = w; } }
    }
};
}

struct MoeOrder {
    int nN, G, c; const char* A; const char* B; size_t tA, tBe, tBn; volatile LAS int* tb;
    __device__ __forceinline__ int expert_of(int pm) const { int e = 0;
#pragma unroll
        for (int i = 1; i < 8; ++i) e += (pm >= __builtin_amdgcn_readfirstlane(tb[i])) ? 1 : 0;
        return e; }
    __device__ __forceinline__ bool next(int i, pg8::Unit& u) const {
        const int nM = __builtin_amdgcn_readfirstlane(tb[8]);
        if (!pg8::tile_order(i, G, c, nM, nN, u.pm, u.pn)) return false;
        u.a = A + (size_t)u.pm * tA; u.b = B + (size_t)expert_of(u.pm) * tBe + (size_t)u.pn * tBn; return true; }
};
struct EpiMoeDown {
    static constexpr bool PERM = true;
    bf16_t* Y; const u32x2* rowinfo; const float* ew; volatile LAS int* tb;
    __device__ __forceinline__ void operator()(pg8::AccRef acc, const pg8::Unit& u, int wr, int wc, int fr, int fq) const {
        int e = 0;
#pragma unroll
        for (int i = 1; i < 8; ++i) e += (u.pm >= __builtin_amdgcn_readfirstlane(tb[i])) ? 1 : 0;
        const int nvalid = __builtin_amdgcn_readfirstlane(tb[16 + e]) - (u.pm - __builtin_amdgcn_readfirstlane(tb[e])) * 256;
        int rin0 = wr * 64 + fr; const int col0 = u.pn * 256 + wc * 32 + 8 * fq;
        asm volatile("" : "+v"(rin0));
#pragma unroll
        for (int ai = 0; ai < 2; ++ai)
#pragma unroll
            for (int m = 0; m < 4; ++m) { const int rin = rin0 + ai * 128 + m * 16;
                if (rin < nvalid) { const unsigned info = ((const unsigned*)rowinfo)[2 * ((size_t)u.pm * 256 + rin)]; const float w = ew[info];
                    bf16_t* dst = Y + ((size_t)(info & 1u) * M + (info >> 1)) * 1024 + col0;
#pragma unroll
                    for (int bj = 0; bj < 2; ++bj) { const f32x4 v0 = acc[ai][bj][m][0] * w, v1 = acc[ai][bj][m][1] * w;
                        u32x4 o; o.x = pg8::cvt_pk_bf16(v0[0], v0[1]); o.y = pg8::cvt_pk_bf16(v0[2], v0[3]); o.z = pg8::cvt_pk_bf16(v1[0], v1[1]); o.w = pg8::cvt_pk_bf16(v1[2], v1[3]);
                        *(u32x4*)(dst + bj * 128) = o; } } }
    }
};

__device__ __forceinline__ void conv_item(const float* W, int ld, int srcc0, int nvalid, bf16_t* WT, int ldd, int dstr0, const float* gain, int k0, int lane) {
    const int n4 = lane & 7, c = lane >> 3;
    f32x4 v[8];
#pragma unroll
    for (int i = 0; i < 8; ++i) { v[i] = (f32x4){0.f, 0.f, 0.f, 0.f};
        if (4 * n4 < nvalid) { v[i] = *(const f32x4*)(W + (size_t)(k0 + 8 * c + i) * ld + srcc0 + 4 * n4); if (gain) v[i] = v[i] * gain[k0 + 8 * c + i]; } }
#pragma unroll
    for (int j = 0; j < 4; ++j) { u32x4 o; o.x = pk2(v[0][j], v[1][j]); o.y = pk2(v[2][j], v[3][j]); o.z = pk2(v[4][j], v[5][j]); o.w = pk2(v[6][j], v[7][j]);
        *(u32x4*)(WT + (size_t)(dstr0 + 4 * n4 + j) * ldd + k0 + 8 * c) = o; }
}

struct W8 { const float* src; const float* gain; unsigned char* dst; int ld, ldd; float scale, gm, ga; };
__device__ __forceinline__ void conv8_load(const W8& d, int lane, f32x4 (&v)[16], f32x4 (&g)[4]) {
    const int n4 = lane & 7, c = lane >> 3;
#pragma unroll
    for (int i = 0; i < 16; ++i) v[i] = *(const f32x4*)(d.src + (size_t)(16 * c + i) * d.ld + 4 * n4);
#pragma unroll
    for (int q = 0; q < 4; ++q) g[q] = *(const f32x4*)(d.gain + 16 * c + 4 * q);
}
__device__ __forceinline__ void conv8_store(const W8& d, int lane, const f32x4 (&v)[16], const f32x4 (&g)[4]) {
    const int n4 = lane & 7, c = lane >> 3;
    f32x4 gs[4];
#pragma unroll
    for (int q = 0; q < 4; ++q) gs[q] = (g[q] * d.gm + d.ga) * d.scale;
#pragma unroll
    for (int j = 0; j < 4; ++j) { u32x4 o;
        o.x = pk_fp8x4(v[0][j] * gs[0].x, v[1][j] * gs[0].y, v[2][j] * gs[0].z, v[3][j] * gs[0].w);
        o.y = pk_fp8x4(v[4][j] * gs[1].x, v[5][j] * gs[1].y, v[6][j] * gs[1].z, v[7][j] * gs[1].w);
        o.z = pk_fp8x4(v[8][j] * gs[2].x, v[9][j] * gs[2].y, v[10][j] * gs[2].z, v[11][j] * gs[2].w);
        o.w = pk_fp8x4(v[12][j] * gs[3].x, v[13][j] * gs[3].y, v[14][j] * gs[3].z, v[15][j] * gs[3].w);
        *(u32x4*)(d.dst + (size_t)(4 * n4 + j) * d.ldd + 16 * c) = o; }
}

struct Args { const float* in[22]; float* out; unsigned char* ws; int ph_lo, ph_hi; };
typedef const __attribute__((address_space(4))) Args* CArgsP;
__device__ __forceinline__ CArgsP argp() { CArgsP p = (CArgsP)__builtin_amdgcn_kernarg_segment_ptr(); asm volatile("" : "+s"(p)); return p; }
#define A_IN(i) ((const float*)argp()->in[i])
enum { I_X = 0, I_NORM_MIX, I_NORM_FFN, I_A_W_IN, I_A_B_GATE, I_A_CONV, I_A_NORM_H, I_A_W_OUT, I_NORM_KV, I_B_W_KV, I_B_CMP_POS, I_B_CMP_W1, I_B_CMP_W2,
       I_B_W_Q, I_B_B_GATE, I_B_W_OUT, I_F_W_GU, I_F_W_DOWN, I_M_ROUTER, I_M_W_GU, I_M_W_DOWN, I_NORM_FINAL };

__device__ __forceinline__ W8 w8_decode(unsigned char* ws, int r) {
    constexpr int N8 = 8 * 8 * 224;
    W8 d;
    if (r < N8) { const int e = r / (8 * 224), rr = r % (8 * 224), kb = rr / 224, db = rr % 224, tile = db >> 3, w = db & 7; const int sc = (w < 4) ? (128 * tile + 32 * w) : (FE + 128 * tile + 32 * (w - 4));
        d.src = A_IN(I_M_W_GU) + (size_t)e * 1024 * 2 * FE + (size_t)(128 * kb) * (2 * FE) + sc; d.ld = 2 * FE; d.gain = A_IN(I_NORM_FFN) + 1024 + 128 * kb; d.scale = 128.f; d.gm = 1.f; d.ga = 0.f;
        d.dst = ws + WS_MGU + (size_t)e * 2 * FE * 1024 + (size_t)(32 * db) * 1024 + 128 * kb; d.ldd = 1024; }
    else { r -= N8; const int e = r / (28 * 32), rr = r % (28 * 32), kb = rr / 32, db = rr % 32;
        d.src = A_IN(I_M_W_DOWN) + (size_t)e * FE * 1024 + (size_t)(128 * kb) * 1024 + 32 * db; d.ld = 1024; d.gain = A_IN(I_NORM_FFN); d.scale = 256.f; d.gm = 0.f; d.ga = 1.f;
        d.dst = ws + WS_MDOWN + (size_t)e * 1024 * FE + (size_t)(32 * db) * FE + 128 * kb; d.ldd = FE; }
    return d;
}
__device__ __forceinline__ void p0_item16(unsigned char* ws, int r, int lane) {
    constexpr int N1 = 16 * 128, N2 = 16 * 32, N3 = 16 * 176, N4 = 44 * 32, N5 = 16 * 88, N6 = 2 * 32 * 8;
    if (r < N1) { const int kb = r / 128, db = r % 128; conv_item(A_IN(I_A_W_IN), NPROJ_SRC, 32 * db, 32, (bf16_t*)(ws + WS_WIN), 1024, 32 * db, A_IN(I_NORM_MIX), 64 * kb, lane); return; } r -= N1;
    if (r < N2) { const int kb = r / 32, db = r % 32; conv_item(A_IN(I_A_W_OUT), 1024, 32 * db, 32, (bf16_t*)(ws + WS_WOUTA), 1024, 32 * db, nullptr, 64 * kb, lane); return; } r -= N2;
    if (r < N3) { const int kb = r / 176, db = r % 176, tile = db >> 3, w = db & 7; const int sc = (w < 4) ? (128 * tile + 32 * w) : (FFD + 128 * tile + 32 * (w - 4));
        conv_item(A_IN(I_F_W_GU), 2 * FFD, sc, 32, (bf16_t*)(ws + WS_WGU), 1024, 32 * db, A_IN(I_NORM_FFN), 64 * kb, lane); return; } r -= N3;
    if (r < N4) { const int kb = r / 32, db = r % 32; conv_item(A_IN(I_F_W_DOWN), 1024, 32 * db, 32, (bf16_t*)(ws + WS_WDOWN), FFD, 32 * db, nullptr, 64 * kb, lane); return; } r -= N4;
    if (r < N5) { const int kb = r / 88, db = r % 88;
        if (db < 48) conv_item(A_IN(I_B_W_KV), 1536, 32 * db, 32, (bf16_t*)(ws + WS_WKVQ), 1024, 32 * db, A_IN(I_NORM_KV), 64 * kb, lane);
        else { const int sc = 32 * (db - 48); int nv = NQSRC - sc; nv = nv < 0 ? 0 : (nv > 32 ? 32 : nv);
            conv_item(A_IN(I_B_W_Q), NQSRC, sc, nv, (bf16_t*)(ws + WS_WKVQ), 1024, 32 * db, A_IN(I_NORM_MIX) + 1024, 64 * kb, lane); }
        return; } r -= N5;
    if (r < N6) { const int c = r / 256, rr = r % 256, kb = rr / 8, db = rr % 8; conv_item(A_IN(I_B_CMP_W1) + (size_t)c * 2048 * 256, 256, 32 * db, 32, (bf16_t*)(ws + WS_WCMP1) + (size_t)c * 256 * 2048, 2048, 32 * db, nullptr, 64 * kb, lane); return; } r -= N6;
    if (r < 16 * 32) { const int kb = r / 32, db = r % 32; conv_item(A_IN(I_B_W_OUT), 1024, 32 * db, 32, (bf16_t*)(ws + WS_WOUTB), 1024, 32 * db, nullptr, 64 * kb, lane); return; } r -= 16 * 32;
    { const int c = r >> 3, kb = (r >> 1) & 3, db = r & 1;
        conv_item(A_IN(I_B_CMP_W2) + (size_t)c * 256 * 64, 64, 32 * db, 32, (bf16_t*)(ws + WS_W2T) + (size_t)c * 64 * 256, 256, 32 * db, nullptr, 64 * kb, lane); }
}
__device__ __forceinline__ void p0_weights(unsigned char* ws, LAS unsigned char* lds, int gw, int NGW, int wave, int lane, bool moe) {
    constexpr int N1 = 16 * 128, N2 = 16 * 32, N3 = 16 * 176, N4 = 44 * 32, N5 = 16 * 88, N6 = 2 * 32 * 8, N7 = 16 * 32;
    constexpr int NB16 = N1 + N2 + N3 + N4 + N5 + N6 + N7 + 16, NT8 = 8 * 8 * 224 + 8 * 28 * 32;
    if (moe) {   f32x4 va[16], ga[4], vb[16], gb[4]; W8 da, db;
        int it = gw;
        da = w8_decode(ws, it); conv8_load(da, lane, va, ga);
        for (;;) {
            int nx = it + NGW; db = w8_decode(ws, nx < NT8 ? nx : NT8 - 1); if (nx >= NT8) db.ld = 0;
            conv8_load(db, lane, vb, gb); __builtin_amdgcn_sched_barrier(0);
            conv8_store(da, lane, va, ga);
            if (nx >= NT8) break;
            it = nx; nx = it + NGW; da = w8_decode(ws, nx < NT8 ? nx : NT8 - 1); if (nx >= NT8) da.ld = 0;
            conv8_load(da, lane, va, ga); __builtin_amdgcn_sched_barrier(0);
            conv8_store(db, lane, vb, gb);
            if (nx >= NT8) break;
            it = nx; }
    }
    for (int it = gw; it < NB16; it += NGW) p0_item16(ws, it, lane);
}

constexpr int NMINI = 8 * 32 * 224 + 8 * 112 * 32;
__device__ __forceinline__ W8 mini_decode(unsigned char* ws, int r) {
    W8 d;
    if (r < 8 * 32 * 224) { const int e = r / (32 * 224), rr = r % (32 * 224), kb = rr / 224, db = rr % 224, tile = db >> 3, w = db & 7; const int sc = (w < 4) ? (128 * tile + 32 * w) : (FE + 128 * tile + 32 * (w - 4));
        d.src = A_IN(I_M_W_GU) + (size_t)e * 1024 * 2 * FE + (size_t)(32 * kb) * (2 * FE) + sc; d.ld = 2 * FE; d.gain = A_IN(I_NORM_FFN) + 1024 + 32 * kb; d.scale = 128.f; d.gm = 1.f; d.ga = 0.f;
        d.dst = ws + WS_MGU + (size_t)e * 2 * FE * 1024 + (size_t)(32 * db) * 1024 + 32 * kb; d.ldd = 1024; }
    else { r -= 8 * 32 * 224; const int e = r / (112 * 32), rr = r % (112 * 32), kb = rr / 32, db = rr % 32;
        d.src = A_IN(I_M_W_DOWN) + (size_t)e * FE * 1024 + (size_t)(32 * kb) * 1024 + 32 * db; d.ld = 1024; d.gain = A_IN(I_NORM_FFN); d.scale = 256.f; d.gm = 0.f; d.ga = 1.f;
        d.dst = ws + WS_MDOWN + (size_t)e * 1024 * FE + (size_t)(32 * db) * FE + 32 * kb; d.ldd = FE; }
    return d;
}
__device__ __forceinline__ void mini_load(const W8& d, int lane, f32x4 (&v)[4], f32x4& g) {
    const int n4 = lane & 7, c = lane >> 3;
#pragma unroll
    for (int i = 0; i < 4; ++i) v[i] = *(const f32x4*)(d.src + (size_t)(4 * c + i) * d.ld + 4 * n4);
    g = *(const f32x4*)(d.gain + 4 * c);
}
__device__ __forceinline__ void mini_store(const W8& d, int lane, const f32x4 (&v)[4], const f32x4 g) {
    const int n4 = lane & 7, c = lane >> 3; const f32x4 gs = (g * d.gm + d.ga) * d.scale;
#pragma unroll
    for (int j = 0; j < 4; ++j) *(unsigned*)(d.dst + (size_t)(4 * n4 + j) * d.ldd + 4 * c) = pk_fp8x4(v[0][j] * gs.x, v[1][j] * gs.y, v[2][j] * gs.z, v[3][j] * gs.w);
}

__device__ __forceinline__ void load_row(const float* row, int lane, f32x4 (&v)[4]) {
    const f32x4* xr = (const f32x4*)row + lane;
#pragma unroll
    for (int j = 0; j < 4; ++j) v[j] = xr[64 * j];
}
__device__ __forceinline__ float row_rstd(const f32x4 (&v)[4]) {
    float s = 0.f;
#pragma unroll
    for (int j = 0; j < 4; ++j) s += (v[j].x * v[j].x + v[j].y * v[j].y) + (v[j].z * v[j].z + v[j].w * v[j].w);
    return 1.0f / sqrtf(wave_sum(s) * (1.f / 1024.f) + EPS);
}
__device__ __forceinline__ void store_row_bf16(bf16_t* orow, int lane, const f32x4 (&v)[4], float sc) {
    u64* o8 = (u64*)orow + lane;
#pragma unroll
    for (int j = 0; j < 4; ++j) o8[64 * j] = (u64)pk2(v[j].x * sc, v[j].y * sc) | ((u64)pk2(v[j].z * sc, v[j].w * sc) << 32);
}

__device__ __forceinline__ f32x4 mma_lds(const LAS bf16_t* A, int lda, const LAS bf16_t* Bt, int ldb, int K, f32x4 acc, int lane) {
    const int r = lane & 15, q = lane >> 4;
    const LAS bf16_t* ap = A + r * lda + 8 * q; const LAS bf16_t* bp = Bt + r * ldb + 8 * q;
    for (int k = 0; k < K; k += 32) { const bf16x8 a = *(const LAS bf16x8*)(ap + k), b = *(const LAS bf16x8*)(bp + k); acc = __builtin_amdgcn_mfma_f32_16x16x32_bf16(a, b, acc, 0, 0, 0); }
    return acc;
}

__device__ __forceinline__ void scanprep_phase(LAS unsigned char* lds, const bf16_t* P3, const float* GA, const float* conv_w, unsigned char* IMG, int vcu, int G) {
    const int tid = threadIdx.x, wave = __builtin_amdgcn_readfirstlane(tid >> 6), lane = tid & 63;
    constexpr int QS = 272, LDP = 3072;
    LAS bf16_t* Qs = (LAS bf16_t*)(lds + 0);
    LAS bf16_t* Kd = (LAS bf16_t*)(lds + 34816);
    LAS float* fg = (LAS float*)(lds + 67584);
    LAS float* cw = (LAS float*)(lds + 68352);
    const bool same_h = (G & 255) == 0; int h_loaded = -1;
    for (int item = vcu; item < 2048; item += G) {
        const int b = item >> 8, h = (item >> 6) & 3, ci = item & 63, t0 = ci * 64; const size_t rb = (size_t)b * SEQ + t0;
        unsigned char* img = IMG + (size_t)item * IMG_STRIDE;
        const int cg = tid & 31, rg = tid >> 5;
        u32x4 rawq[7], rawk[7];
#pragma unroll
        for (int r7 = 0; r7 < 7; ++r7) { const int tt = 4 * rg - 3 + r7; rawq[r7] = (u32x4){0u, 0u, 0u, 0u}; rawk[r7] = (u32x4){0u, 0u, 0u, 0u};
            if (t0 + tt >= 0) { const bf16_t* p = P3 + (rb + tt) * LDP + h * 256 + 8 * cg; rawq[r7] = *(const u32x4*)p; rawk[r7] = *(const u32x4*)(p + 1024); } }
        const int vv = tid & 255, hf = tid >> 8; unsigned short ev[32];
        { const bf16_t* vp = P3 + (rb + 32 * hf) * LDP + 2048 + h * 256 + vv;
#pragma unroll
          for (int i = 0; i < 32; ++i) ev[i] = vp[(size_t)i * LDP]; }
        float gli = 0.f, glf = 0.f; if (wave == 7) { gli = GA[(rb + lane) * 8 + h]; glf = GA[(rb + lane) * 8 + 4 + h]; }
        __syncthreads();
        if (h != h_loaded || !same_h) {
            for (int i = tid; i < 2048; i += NTHR) { const int j = i >> 8, kk = i & 255; cw[i] = conv_w[(j & 3) * 2048 + (j >> 2) * 1024 + h * 256 + kk]; }
            for (int i = tid; i < 64 * 16; i += NTHR) { const int r = i >> 4, c = i & 15; Qs[r * QS + 256 + c] = 0; }
            h_loaded = h; __syncthreads(); }
        { bf16_t* op = (bf16_t*)(img + IMG_VT) + vv * 80 + 32 * hf;
#pragma unroll
          for (int g8 = 0; g8 < 4; ++g8) { u32x4 w; w.x = ev[8 * g8] | ((unsigned)ev[8 * g8 + 1] << 16); w.y = ev[8 * g8 + 2] | ((unsigned)ev[8 * g8 + 3] << 16); w.z = ev[8 * g8 + 4] | ((unsigned)ev[8 * g8 + 5] << 16); w.w = ev[8 * g8 + 6] | ((unsigned)ev[8 * g8 + 7] << 16);
              *(u32x4*)(op + 8 * g8) = w; }
          *(u32x4*)((bf16_t*)(img + IMG_VT) + vv * 80 + 64 + 8 * hf) = (u32x4){0u, 0u, 0u, 0u}; }
        {
#pragma unroll
          for (int which = 0; which < 2; ++which) {
            float x[7][8];
#pragma unroll
            for (int r7 = 0; r7 < 7; ++r7) { const u32x4 raw = which ? rawk[r7] : rawq[r7];
                x[r7][0] = bflo(raw.x); x[r7][1] = bfhi(raw.x); x[r7][2] = bflo(raw.y); x[r7][3] = bfhi(raw.y); x[r7][4] = bflo(raw.z); x[r7][5] = bfhi(raw.z); x[r7][6] = bflo(raw.w); x[r7][7] = bfhi(raw.w); }
            float w[4][8];
#pragma unroll
            for (int tap = 0; tap < 4; ++tap) { const f32x4 w0 = *(const LAS f32x4*)(cw + (which * 4 + tap) * 256 + 8 * cg), w1 = *(const LAS f32x4*)(cw + (which * 4 + tap) * 256 + 8 * cg + 4);
                w[tap][0] = w0.x; w[tap][1] = w0.y; w[tap][2] = w0.z; w[tap][3] = w0.w; w[tap][4] = w1.x; w[tap][5] = w1.y; w[tap][6] = w1.z; w[tap][7] = w1.w; }
            const float sc = which ? 0.0625f : 1.0f;
#pragma unroll
            for (int j = 0; j < 4; ++j) { float o[8];
#pragma unroll
                for (int c = 0; c < 8; ++c) o[c] = (w[0][c] * x[j][c] + w[1][c] * x[j + 1][c] + w[2][c] * x[j + 2][c] + w[3][c] * x[j + 3][c]) * sc;
                u32x4 p; p.x = pg8::cvt_pk_bf16(o[0], o[1]); p.y = pg8::cvt_pk_bf16(o[2], o[3]); p.z = pg8::cvt_pk_bf16(o[4], o[5]); p.w = pg8::cvt_pk_bf16(o[6], o[7]);
                if (which) *(LAS u32x4*)(Kd + (4 * rg + j) * 256 + 8 * cg) = p; else *(LAS u32x4*)(Qs + (4 * rg + j) * QS + 8 * cg) = p; }
          }
          if (wave == 7) { const float li = gli, lf = glf;
              float bc = lf;
#pragma unroll
              for (int o = 1; o < 64; o <<= 1) { const float t = __shfl_up(bc, o); if (lane >= o) bc += t; }
              const float uu = li - bc; float pm = uu;
#pragma unroll
              for (int o = 1; o < 64; o <<= 1) { const float t = __shfl_up(pm, o); if (lane >= o) pm = fmaxf(pm, t); }
              fg[lane] = bc; fg[64 + lane] = uu; fg[128 + lane] = pm; }
        }
        __syncthreads();
        { const int k = tid & 255; bf16_t* op = (bf16_t*)(img + IMG_KT) + k * 64 + 32 * hf;
#pragma unroll
          for (int g8 = 0; g8 < 4; ++g8) { unsigned short e[8];
#pragma unroll
              for (int i = 0; i < 8; ++i) e[i] = Kd[(32 * hf + 8 * g8 + i) * 256 + k];
              u32x4 w; w.x = e[0] | ((unsigned)e[1] << 16); w.y = e[2] | ((unsigned)e[3] << 16); w.z = e[4] | ((unsigned)e[5] << 16); w.w = e[6] | ((unsigned)e[7] << 16);
              *(u32x4*)(op + 8 * g8) = w; } }
        for (int i = tid; i < 67584 / 16; i += NTHR) *(u32x4*)(img + (size_t)i * 16) = *(const LAS u32x4*)(lds + i * 16);
        if (tid < 48) *(u32x4*)(img + IMG_G + tid * 16) = *(const LAS u32x4*)(lds + 67584 + tid * 16);
    }
}

__device__ __forceinline__ void scan_phase(LAS unsigned char* lds, const unsigned char* IMG, float* HS, float* DN, int vcu, int G, unsigned char* ws) {
    const int tid = threadIdx.x, wave = __builtin_amdgcn_readfirstlane(tid >> 6), lane = tid & 63, cl = lane & 15, q4 = lane >> 4;
    constexpr int QS = 272, TS = 80;
    LAS bf16_t* Qs = (LAS bf16_t*)(lds + 0);
    LAS bf16_t* Cbs = (LAS bf16_t*)(lds + 34816);
    LAS bf16_t* VTs = (LAS bf16_t*)(lds + 52768);
    LAS bf16_t* VaTs = (LAS bf16_t*)(lds + 58048);
    LAS bf16_t* Sws = (LAS bf16_t*)(lds + 63328);
    LAS float* fg = (LAS float*)(lds + 73568);
    const int r2 = cl ? 32 : 32;
    for (int u = vcu; u < 256; u += G) {
        const int b = u >> 5, h = (u >> 3) & 3, vs = u & 7;
        const unsigned char* img0 = IMG + (size_t)((b * 4 + h) * 64) * IMG_STRIDE;
        __syncthreads();
        for (int i = tid; i < 33 * QS; i += NTHR) Cbs[i] = 0;
        for (int i = tid; i < TS; i += NTHR) { VTs[32 * TS + i] = (i < 64) ? (bf16_t)0x3F80 : (bf16_t)0; VaTs[32 * TS + i] = 0; }
        f32x4 Cacc[2][3];
#pragma unroll
        for (int kk = 0; kk < 2; ++kk)
#pragma unroll
            for (int vt = 0; vt < 3; ++vt) Cacc[kk][vt] = (f32x4){0.f, 0.f, 0.f, 0.f};
        float mstate = 0.f;
        u32x4 pfq[5], pfv, pfg;
        bf16x8 kfr[8], ktf[2][2];
#define SCAN_LOAD(ci_) do { const unsigned char* ip = img0 + (size_t)(ci_) * IMG_STRIDE; \
            _Pragma("unroll") for (int k = 0; k < 5; ++k) { const int id = tid + 512 * k; if (id < 2176) pfq[k] = *(const u32x4*)(ip + (size_t)id * 16); } \
            if (tid < 320) pfv = *(const u32x4*)(ip + IMG_VT + vs * 5120 + tid * 16); \
            if (tid < 48) pfg = *(const u32x4*)(ip + IMG_G + tid * 16); } while (0)
#define SCAN_LOAD_K(ci_) do { if (wave >= 4) { const bf16_t* kp = (const bf16_t*)(img0 + (size_t)(ci_) * IMG_STRIDE + IMG_K) + (16 * (wave - 4) + cl) * 256 + 8 * q4; \
            _Pragma("unroll") for (int ks = 0; ks < 8; ++ks) kfr[ks] = *(const bf16x8*)(kp + 32 * ks); } } while (0)
#define SCAN_LOAD_KT(ci_) do { const bf16_t* kp = (const bf16_t*)(img0 + (size_t)(ci_) * IMG_STRIDE + IMG_KT) + (32 * wave + cl) * 64 + 8 * q4; \
            _Pragma("unroll") for (int kk = 0; kk < 2; ++kk) _Pragma("unroll") for (int ks = 0; ks < 2; ++ks) ktf[kk][ks] = *(const bf16x8*)(kp + kk * 1024 + 32 * ks); } while (0)
        SCAN_LOAD(0); SCAN_LOAD_K(0); SCAN_LOAD_KT(0);
        W8 cvd = mini_decode(ws, 0); f32x4 cvv[4], cvg;
#pragma unroll
        for (int i = 0; i < 4; ++i) cvv[i] = (f32x4){0.f, 0.f, 0.f, 0.f};
        cvg = (f32x4){0.f, 0.f, 0.f, 0.f};
        for (int ci = 0; ci < 64; ++ci) {
            const size_t rb = (size_t)b * SEQ + ci * 64;
#pragma unroll
            for (int k = 0; k < 5; ++k) { const int id = tid + 512 * k; if (id < 2176) *(LAS u32x4*)(lds + id * 16) = pfq[k]; }
            if (tid < 320) *(LAS u32x4*)((LAS unsigned char*)VTs + tid * 16) = pfv;
            if (tid < 48) *(LAS u32x4*)((LAS unsigned char*)fg + tid * 16) = pfg;
            if (ci + 1 < 64) SCAN_LOAD(ci + 1);
            if (G == 256 && ci >= 1 && ci <= 42) mini_store(cvd, lane, cvv, cvg);
            cvd = mini_decode(ws, (ci < 42 ? ci : 41) * 2048 + vcu * 8 + wave); if (!(G == 256 && ci < 42)) cvd.ld = 0;
            mini_load(cvd, lane, cvv, cvg);
            LDS_BARRIER();
            const float pm63 = fg[128 + 63], bc63 = fg[63];
            const float M63 = fmaxf(mstate, pm63), aprev = ex2((mstate - M63) * 1.4426950408889634f);
            f32x4 hacc[3];
            if (wave < 4) {
                const int ti = wave;
#pragma unroll
                for (int vt = 0; vt < 3; ++vt) hacc[vt] = (f32x4){0.f, 0.f, 0.f, 0.f};
#pragma unroll
                for (int ks = 0; ks < 8; ++ks) { const bf16x8 a = *(const LAS bf16x8*)(Qs + (16 * ti + cl) * QS + 32 * ks + 8 * q4);
                    const bf16x8 b0 = *(const LAS bf16x8*)(Cbs + cl * QS + 32 * ks + 8 * q4), b1 = *(const LAS bf16x8*)(Cbs + (16 + cl) * QS + 32 * ks + 8 * q4), b2 = *(const LAS bf16x8*)(Cbs + r2 * QS + 32 * ks + 8 * q4);
                    hacc[0] = __builtin_amdgcn_mfma_f32_16x16x32_bf16(a, b0, hacc[0], 0, 0, 0); hacc[1] = __builtin_amdgcn_mfma_f32_16x16x32_bf16(a, b1, hacc[1], 0, 0, 0); hacc[2] = __builtin_amdgcn_mfma_f32_16x16x32_bf16(a, b2, hacc[2], 0, 0, 0); }
#pragma unroll
                for (int j = 0; j < 4; ++j) { const float wint = ex2((mstate - fmaxf(mstate, fg[128 + 16 * ti + 4 * q4 + j])) * 1.4426950408889634f); hacc[0][j] *= wint; hacc[1][j] *= wint; hacc[2][j] *= wint; }
            } else {
                const int si = wave - 4; f32x4 us4;
#pragma unroll
                for (int j = 0; j < 4; ++j) us4[j] = fg[64 + 16 * si + 4 * q4 + j];
#pragma unroll
                for (int ti = 0; ti < 4; ++ti) { u32x2 w = (u32x2){0u, 0u};
                    if (ti >= si) { f32x4 sacc = (f32x4){0.f, 0.f, 0.f, 0.f};
#pragma unroll
                        for (int ks = 0; ks < 8; ++ks) { const bf16x8 qb = *(const LAS bf16x8*)(Qs + (16 * ti + cl) * QS + 32 * ks + 8 * q4); sacc = __builtin_amdgcn_mfma_f32_16x16x32_bf16(kfr[ks], qb, sacc, 0, 0, 0); }
                        const int t = 16 * ti + cl; const float Mt = fmaxf(mstate, fg[128 + t]); float p[4];
#pragma unroll
                        for (int j = 0; j < 4; ++j) { const int s_ = 16 * si + 4 * q4 + j; p[j] = (s_ <= t) ? sacc[j] * ex2((us4[j] - Mt) * 1.4426950408889634f) : 0.f; }
                        w.x = pg8::cvt_pk_bf16(p[0], p[1]); w.y = pg8::cvt_pk_bf16(p[2], p[3]); }
                    *(LAS u32x2*)(Sws + (16 * ti + cl) * TS + 16 * si + 4 * q4) = w; }
                if (ci + 1 < 64) SCAN_LOAD_K(ci + 1);
            }
            if (tid < 264) { const int v = tid >> 3, s8 = (tid & 7) * 8; const u32x4 raw = *(const LAS u32x4*)(VTs + v * TS + s8); float a[8];
#pragma unroll
                for (int i = 0; i < 8; ++i) a[i] = ex2((fg[64 + s8 + i] - M63) * 1.4426950408889634f);
                u32x4 w; w.x = pg8::cvt_pk_bf16(bflo(raw.x) * a[0], bfhi(raw.x) * a[1]); w.y = pg8::cvt_pk_bf16(bflo(raw.y) * a[2], bfhi(raw.y) * a[3]); w.z = pg8::cvt_pk_bf16(bflo(raw.z) * a[4], bfhi(raw.z) * a[5]); w.w = pg8::cvt_pk_bf16(bflo(raw.w) * a[6], bfhi(raw.w) * a[7]);
                *(LAS u32x4*)(VaTs + v * TS + s8) = w; }
            LDS_BARRIER();
            if (wave < 4) {
                const int ti = wave;
#pragma unroll
                for (int ks = 0; ks < 2; ++ks) { const bf16x8 a = *(const LAS bf16x8*)(Sws + (16 * ti + cl) * TS + 32 * ks + 8 * q4);
                    const bf16x8 b0 = *(const LAS bf16x8*)(VTs + cl * TS + 32 * ks + 8 * q4), b1 = *(const LAS bf16x8*)(VTs + (16 + cl) * TS + 32 * ks + 8 * q4), b2 = *(const LAS bf16x8*)(VTs + r2 * TS + 32 * ks + 8 * q4);
                    hacc[0] = __builtin_amdgcn_mfma_f32_16x16x32_bf16(a, b0, hacc[0], 0, 0, 0); hacc[1] = __builtin_amdgcn_mfma_f32_16x16x32_bf16(a, b1, hacc[1], 0, 0, 0); hacc[2] = __builtin_amdgcn_mfma_f32_16x16x32_bf16(a, b2, hacc[2], 0, 0, 0); }
#pragma unroll
                for (int j = 0; j < 4; ++j) { const int t = 16 * ti + 4 * q4 + j; float* hp = HS + (rb + t) * 1024 + h * 256 + vs * 32 + cl; hp[0] = hacc[0][j]; hp[16] = hacc[1][j];
                    if (vs == 0 && cl == 0) { const float Mtt = fmaxf(mstate, fg[128 + t]); DN[(rb + t) * 4 + h] = fmaxf(fabsf(hacc[2][j]), ex2(-(fg[t] + Mtt) * 1.4426950408889634f)); } }
            }
#pragma unroll
            for (int kk = 0; kk < 2; ++kk)
#pragma unroll
                for (int vt = 0; vt < 3; ++vt) Cacc[kk][vt] = Cacc[kk][vt] * aprev;
#pragma unroll
            for (int ks = 0; ks < 2; ++ks) { const bf16x8 b0 = *(const LAS bf16x8*)(VaTs + cl * TS + 32 * ks + 8 * q4), b1 = *(const LAS bf16x8*)(VaTs + (16 + cl) * TS + 32 * ks + 8 * q4), b2 = *(const LAS bf16x8*)(VaTs + r2 * TS + 32 * ks + 8 * q4);
#pragma unroll
                for (int kk = 0; kk < 2; ++kk) { Cacc[kk][0] = __builtin_amdgcn_mfma_f32_16x16x32_bf16(ktf[kk][ks], b0, Cacc[kk][0], 0, 0, 0); Cacc[kk][1] = __builtin_amdgcn_mfma_f32_16x16x32_bf16(ktf[kk][ks], b1, Cacc[kk][1], 0, 0, 0);
                    Cacc[kk][2] = __builtin_amdgcn_mfma_f32_16x16x32_bf16(ktf[kk][ks], b2, Cacc[kk][2], 0, 0, 0); } }
#pragma unroll
            for (int kk = 0; kk < 2; ++kk)
#pragma unroll
                for (int vt = 0; vt < 3; ++vt) { if (vt < 2 || cl == 0) { u32x2 w; w.x = pg8::cvt_pk_bf16(Cacc[kk][vt][0], Cacc[kk][vt][1]); w.y = pg8::cvt_pk_bf16(Cacc[kk][vt][2], Cacc[kk][vt][3]);
                        *(LAS u32x2*)(Cbs + (16 * vt + cl) * QS + 32 * wave + 16 * kk + 4 * q4) = w; } }
            if (ci + 1 < 64) SCAN_LOAD_KT(ci + 1);
            mstate = bc63 + M63;
            LDS_BARRIER();
        }
#undef SCAN_LOAD
#undef SCAN_LOAD_K
#undef SCAN_LOAD_KT
    }
}

template <int MODE, bool EDGE>
__device__ __forceinline__ void attn_tile2(const LAS bf16_t* Kt, const LAS bf16_t* VTt, LAS bf16_t* Pw, const bf16x8 (&qa)[2], const f32x4 bv0, int jb, int t0, int th, float slope2,
                                           u64 tsel, f32x4 (&O)[4], float& mrow, float& lrow, int lane) {
    const int cl = lane & 15, q4 = lane >> 4; constexpr int TS = 72;
    f32x4 s[4];
#pragma unroll
    for (int nt = 0; nt < 4; ++nt) { s[nt] = bv0;
#pragma unroll
        for (int ks = 0; ks < 2; ++ks) { const bf16x8 kb = *(const LAS bf16x8*)(Kt + (16 * nt + cl) * TS + 32 * ks + 8 * q4); s[nt] = __builtin_amdgcn_mfma_f32_16x16x32_bf16(kb, qa[ks], s[nt], 0, 0, 0); } }
    const float b0 = slope2 * (float)(64 * jb - (t0 + 31)), o16 = slope2 * 16.f;
    bool rowok = true; if (MODE == 0) rowok = ((tsel >> (16 * th + cl)) & 1ull) != 0ull;
    if (EDGE) { const int dbase = t0 + 16 * th + cl - (64 * jb + 4 * q4);
#pragma unroll
        for (int nt = 0; nt < 4; ++nt)
#pragma unroll
            for (int j = 0; j < 4; ++j) { const int dist = dbase - (16 * nt + j); const bool ok = dist >= 0 && (MODE == 0 || dist < 512); s[nt][j] = ok ? s[nt][j] : -INFINITY; } }
    float mx = fmaxf(fmaxf(s[0][0], s[0][1]), fmaxf(s[0][2], s[0][3]));
#pragma unroll
    for (int n = 1; n < 4; ++n) mx = fmaxf(mx, fmaxf(fmaxf(s[n][0], s[n][1]), fmaxf(s[n][2], s[n][3])) + (float)n * o16);
    mx = rowok ? mx + b0 : -INFINITY;
    mx = fmaxf(mx, __shfl_xor(mx, 16)); mx = fmaxf(mx, __shfl_xor(mx, 32));
    const float mold = mrow, mnew = fmaxf(mold, mx), msafe = (mnew == -INFINITY) ? 0.f : mnew;
    const float alpha = (mold == -INFINITY) ? 0.f : ex2(mold - msafe);
    const float ref = rowok ? (msafe - b0) : INFINITY;
    float rs = 0.f;
    unsigned pw[4][2];
#pragma unroll
    for (int nt = 0; nt < 4; ++nt) { float p[4]; const float refn = ref - (float)nt * o16;
#pragma unroll
        for (int j = 0; j < 4; ++j) { p[j] = ex2(s[nt][j] - refn); rs += p[j]; }
        pw[nt][0] = pg8::cvt_pk_bf16(p[0], p[1]); pw[nt][1] = pg8::cvt_pk_bf16(p[2], p[3]); }
    rs += __shfl_xor(rs, 16); rs += __shfl_xor(rs, 32);
    lrow = lrow * alpha + rs; mrow = mnew;
#pragma unroll
    for (int dt = 0; dt < 4; ++dt) O[dt] = O[dt] * alpha;
#pragma unroll
    for (int ks = 0; ks < 2; ++ks) { const bf16x8 pa = __builtin_bit_cast(bf16x8, (u32x4){pw[2 * ks][0], pw[2 * ks][1], pw[2 * ks + 1][0], pw[2 * ks + 1][1]});
#pragma unroll
        for (int dt = 0; dt < 4; ++dt) { const bf16x8 vb = *(const LAS bf16x8*)(VTt + (16 * dt + cl) * TS + 32 * ks + 8 * q4); O[dt] = __builtin_amdgcn_mfma_f32_16x16x32_bf16(vb, pa, O[dt], 0, 0, 0); } }
}

template <int MODE>
__device__ __forceinline__ void attn_pair(const LAS bf16_t* KtA, const LAS bf16_t* KtB, LAS bf16_t* Pw, const bf16x8 (&qa)[2], const f32x4 bv0, int jA, int jB, int t0, int th, float slope2,
                                          u64 tselA, u64 tselB, f32x4 (&O)[4], float& mrow, float& lrow, int lane) {
    const int cl = lane & 15, q4 = lane >> 4; constexpr int TS = 72, PP = 136;
    f32x4 s[8];
#pragma unroll
    for (int nt = 0; nt < 8; ++nt) { const LAS bf16_t* Kt = (nt < 4) ? KtA : KtB; s[nt] = bv0;
#pragma unroll
        for (int ks = 0; ks < 2; ++ks) { const bf16x8 kb = *(const LAS bf16x8*)(Kt + (16 * (nt & 3) + cl) * TS + 32 * ks + 8 * q4); s[nt] = __builtin_amdgcn_mfma_f32_16x16x32_bf16(kb, qa[ks], s[nt], 0, 0, 0); } }
    const float o16 = slope2 * 16.f, bA = slope2 * (float)(64 * jA - (t0 + 31)), bB = slope2 * (float)(64 * jB - (t0 + 31));
    bool okA = true, okB = true; if (MODE == 0) { okA = ((tselA >> (16 * th + cl)) & 1ull) != 0ull; okB = ((tselB >> (16 * th + cl)) & 1ull) != 0ull; }
    float mA = fmaxf(fmaxf(s[0][0], s[0][1]), fmaxf(s[0][2], s[0][3])), mB = fmaxf(fmaxf(s[4][0], s[4][1]), fmaxf(s[4][2], s[4][3]));
#pragma unroll
    for (int n = 1; n < 4; ++n) { mA = fmaxf(mA, fmaxf(fmaxf(s[n][0], s[n][1]), fmaxf(s[n][2], s[n][3])) + (float)n * o16); mB = fmaxf(mB, fmaxf(fmaxf(s[4 + n][0], s[4 + n][1]), fmaxf(s[4 + n][2], s[4 + n][3])) + (float)n * o16); }
    float mx = fmaxf(okA ? mA + bA : -INFINITY, okB ? mB + bB : -INFINITY);
    mx = fmaxf(mx, __shfl_xor(mx, 16)); mx = fmaxf(mx, __shfl_xor(mx, 32));
    const float mold = mrow, mnew = fmaxf(mold, mx), msafe = (mnew == -INFINITY) ? 0.f : mnew;
    const float alpha = (mold == -INFINITY) ? 0.f : ex2(mold - msafe);
    const float refA = okA ? (msafe - bA) : INFINITY, refB = okB ? (msafe - bB) : INFINITY;
    float rs = 0.f;
    unsigned pw[8][2];
#pragma unroll
    for (int nt = 0; nt < 8; ++nt) { float p[4]; const float refn = ((nt < 4) ? refA : refB) - (float)(nt & 3) * o16;
#pragma unroll
        for (int j = 0; j < 4; ++j) { p[j] = ex2(s[nt][j] - refn); rs += p[j]; }
        pw[nt][0] = pg8::cvt_pk_bf16(p[0], p[1]); pw[nt][1] = pg8::cvt_pk_bf16(p[2], p[3]); }
    rs += __shfl_xor(rs, 16); rs += __shfl_xor(rs, 32);
    lrow = lrow * alpha + rs; mrow = mnew;
#pragma unroll
    for (int dt = 0; dt < 4; ++dt) O[dt] = O[dt] * alpha;
#pragma unroll
    for (int ks = 0; ks < 4; ++ks) { const bf16x8 pa = __builtin_bit_cast(bf16x8, (u32x4){pw[2 * ks][0], pw[2 * ks][1], pw[2 * ks + 1][0], pw[2 * ks + 1][1]}); const LAS bf16_t* VTt = ((ks < 2) ? KtA : KtB) + 4608;
#pragma unroll
        for (int dt = 0; dt < 4; ++dt) { const bf16x8 vb = *(const LAS bf16x8*)(VTt + (16 * dt + cl) * TS + 32 * (ks & 1) + 8 * q4); O[dt] = __builtin_amdgcn_mfma_f32_16x16x32_bf16(vb, pa, O[dt], 0, 0, 0); } }
    LDS_WAIT();
}

template <int MODE>
__device__ __forceinline__ void attn_pair_fast(const LAS bf16_t* KtA, const LAS bf16_t* KtB, LAS bf16_t* Pw, const bf16x8 (&qa)[2], const f32x4 bv0, int jA, int jB, int t0, int th, float slope2,
                                               u64 tselA, u64 tselB, f32x4 (&O)[4], float mrow, float& lrow, int lane) {
    const int cl = lane & 15, q4 = lane >> 4; constexpr int TS = 72, PP = 136;
    f32x4 s[8];
#pragma unroll
    for (int nt = 0; nt < 8; ++nt) { const LAS bf16_t* Kt = (nt < 4) ? KtA : KtB; s[nt] = bv0;
#pragma unroll
        for (int ks = 0; ks < 2; ++ks) { const bf16x8 kb = *(const LAS bf16x8*)(Kt + (16 * (nt & 3) + cl) * TS + 32 * ks + 8 * q4); s[nt] = __builtin_amdgcn_mfma_f32_16x16x32_bf16(kb, qa[ks], s[nt], 0, 0, 0); } }
    const float o16 = slope2 * 16.f, bA = slope2 * (float)(64 * jA - (t0 + 31)), bB = slope2 * (float)(64 * jB - (t0 + 31));
    bool okA = true, okB = true; if (MODE == 0) { okA = ((tselA >> (16 * th + cl)) & 1ull) != 0ull; okB = ((tselB >> (16 * th + cl)) & 1ull) != 0ull; }
    const float refA = okA ? (mrow - bA) : INFINITY, refB = okB ? (mrow - bB) : INFINITY;
    float rs = 0.f;
    unsigned pw[8][2];
#pragma unroll
    for (int nt = 0; nt < 8; ++nt) { float p[4]; const float refn = ((nt < 4) ? refA : refB) - (float)(nt & 3) * o16;
#pragma unroll
        for (int j = 0; j < 4; ++j) { p[j] = ex2(s[nt][j] - refn); rs += p[j]; }
        pw[nt][0] = pg8::cvt_pk_bf16(p[0], p[1]); pw[nt][1] = pg8::cvt_pk_bf16(p[2], p[3]); }
    rs += __shfl_xor(rs, 16); rs += __shfl_xor(rs, 32);
    lrow += rs;
#pragma unroll
    for (int ks = 0; ks < 4; ++ks) { const bf16x8 pa = __builtin_bit_cast(bf16x8, (u32x4){pw[2 * ks][0], pw[2 * ks][1], pw[2 * ks + 1][0], pw[2 * ks + 1][1]}); const LAS bf16_t* VTt = ((ks < 2) ? KtA : KtB) + 4608;
#pragma unroll
        for (int dt = 0; dt < 4; ++dt) { const bf16x8 vb = *(const LAS bf16x8*)(VTt + (16 * dt + cl) * TS + 32 * (ks & 1) + 8 * q4); O[dt] = __builtin_amdgcn_mfma_f32_16x16x32_bf16(vb, pa, O[dt], 0, 0, 0); } }
    LDS_WAIT();
}

constexpr int ATT_SET0 = 70656, ATT_SET1 = 107520, ATT_QL = 144384;
template <int MODE>
__device__ __forceinline__ void attn_branch(LAS unsigned char* lds, LAS bf16_t* Pw, const bf16_t* KV, const bf16_t* VT2, const float* GATEB, const bf16x8 (&qa)[2], f32x4 (&outacc)[4],
                                            u64 uni, u64 tselv, int b, int bg, int h, int t0, int th, float slope2
#if TSEG
                                            , unsigned long long& tseg_acc
#endif
                                            ) {
#if TSEG
    unsigned long long tseg_t = 0;
#endif
    const int tid = threadIdx.x, lane = tid & 63; constexpr int TS = 72;
    const size_t PLANE = (size_t)8 * 4 * 4096 * 64;
    f32x4 O[4]; float mrow = -INFINITY, lrow = 0.f;
#pragma unroll
    for (int j = 0; j < 4; ++j) O[j] = (f32x4){0.f, 0.f, 0.f, 0.f};
    const float k0f = (float)(4 * (lane >> 4)); const f32x4 bv0 = (f32x4){slope2 * k0f, slope2 * (k0f + 1.f), slope2 * (k0f + 2.f), slope2 * (k0f + 3.f)};
    const int jhi = (t0 + 31) >> 6; int jlo = 0; if (MODE == 1) { jlo = t0 - 511; jlo = jlo < 0 ? 0 : (jlo >> 6); }
    u64 rem = (MODE == 0) ? uni : ((jhi >= 63 ? ~0ull : ((1ull << (jhi + 1)) - 1ull)) & ~((1ull << jlo) - 1ull));
    const bf16_t* Ksrc = KV + (size_t)(MODE == 0 ? 2 : 4) * PLANE + (size_t)bg * 4096 * 64;
    const bf16_t* Vsrc = VT2 + ((size_t)MODE * 32 + bg) * 4096 * 64;
    const size_t toff = (size_t)tid * 8;
    const int loff = (tid >> 3) * TS + 8 * (tid & 7);
    u32x4 pkA, pvA, pkB, pvB;
    int a0 = -1, b0_ = -1, a1 = -1, b1 = -1;
#define ATT_TAKE(x) do { if (rem) { x = 63 - __builtin_clzll(rem); rem &= ~(1ull << x); } else x = -1; } while (0)
#define ATT_LOAD(ja, jb_) do { if ((ja) >= 0) { pkA = *(const u32x4*)(Ksrc + (size_t)(ja) * 4096 + toff); pvA = *(const u32x4*)(Vsrc + (size_t)(ja) * 4096 + toff); } \
                               if ((jb_) >= 0) { pkB = *(const u32x4*)(Ksrc + (size_t)(jb_) * 4096 + toff); pvB = *(const u32x4*)(Vsrc + (size_t)(jb_) * 4096 + toff); } } while (0)
#define ATT_PUT(setp, ja, jb_) do { if ((ja) >= 0) { *(LAS u32x4*)((setp) + loff) = pkA; *(LAS u32x4*)((setp) + 4608 + loff) = pvA; } \
                                    if ((jb_) >= 0) { *(LAS u32x4*)((setp) + 9216 + loff) = pkB; *(LAS u32x4*)((setp) + 13824 + loff) = pvB; } } while (0)
    ATT_TAKE(a0); ATT_TAKE(b0_);
    ATT_LOAD(a0, b0_);
    { LAS bf16_t* set0 = (LAS bf16_t*)(lds + ATT_SET0); ATT_PUT(set0, a0, b0_); }
    ATT_TAKE(a1); ATT_TAKE(b1);
    ATT_LOAD(a1, b1);
    LDS_BARRIER();
    int buf = 0;
#pragma unroll 1
    while (a0 >= 0) {
        LAS bf16_t* cur = (LAS bf16_t*)(lds + (buf ? ATT_SET1 : ATT_SET0)); LAS bf16_t* nxt = (LAS bf16_t*)(lds + (buf ? ATT_SET0 : ATT_SET1));
        int a2 = -1, b2 = -1;
        TS_B(10);
        if (a1 >= 0) { ATT_PUT(nxt, a1, b1); ATT_TAKE(a2); ATT_TAKE(b2); ATT_LOAD(a2, b2); }
        TS_E(10); TS_B(11);
        u64 tsA = ~0ull, tsB = ~0ull;
        if (MODE == 0) { tsA = ((u64)(unsigned)__builtin_amdgcn_readlane((int)(tselv >> 32), a0) << 32) | (unsigned)__builtin_amdgcn_readlane((int)(unsigned)tselv, a0);
            if (b0_ >= 0) tsB = ((u64)(unsigned)__builtin_amdgcn_readlane((int)(tselv >> 32), b0_) << 32) | (unsigned)__builtin_amdgcn_readlane((int)(unsigned)tselv, b0_); }
        const bool useA = ((tsA >> (16 * th)) & 0xFFFFull) != 0ull, useB = b0_ >= 0 && ((tsB >> (16 * th)) & 0xFFFFull) != 0ull;
        const bool edgeA = (64 * a0 + 63 > t0) || (MODE == 1 && (t0 + 31 - 64 * a0 >= 512));
        const bool edgeB = b0_ >= 0 && ((64 * b0_ + 63 > t0) || (MODE == 1 && (t0 + 31 - 64 * b0_ >= 512)));
        if (useA && useB && !edgeA && !edgeB) {
            const bool rA = MODE == 1 || ((tsA >> (16 * th + (lane & 15))) & 1ull), rB = MODE == 1 || ((tsB >> (16 * th + (lane & 15))) & 1ull);
            if (__any((rA || rB) && mrow == -INFINITY)) attn_pair<MODE>(cur, cur + 9216, Pw, qa, bv0, a0, b0_, t0, th, slope2, tsA, tsB, O, mrow, lrow, lane);
            else attn_pair_fast<MODE>(cur, cur + 9216, Pw, qa, bv0, a0, b0_, t0, th, slope2, tsA, tsB, O, mrow, lrow, lane); }
        else {
            if (useA) { if (edgeA) attn_tile2<MODE, true>(cur, cur + 4608, Pw, qa, bv0, a0, t0, th, slope2, tsA, O, mrow, lrow, lane); else attn_tile2<MODE, false>(cur, cur + 4608, Pw, qa, bv0, a0, t0, th, slope2, tsA, O, mrow, lrow, lane); LDS_WAIT(); }
            if (useB) { if (edgeB) attn_tile2<MODE, true>(cur + 9216, cur + 13824, Pw, qa, bv0, b0_, t0, th, slope2, tsB, O, mrow, lrow, lane); else attn_tile2<MODE, false>(cur + 9216, cur + 13824, Pw, qa, bv0, b0_, t0, th, slope2, tsB, O, mrow, lrow, lane); }
        }
        TS_E(11); TS_B(12);
        LDS_BARRIER();
        TS_E(12);
        a0 = a1; b0_ = b1; a1 = a2; b1 = b2; buf ^= 1;
    }
#undef ATT_TAKE
#undef ATT_LOAD
#undef ATT_PUT
    { const float gt = GATEB[((size_t)b * SEQ + t0 + 16 * th + (lane & 15)) * 48 + h * 3 + 1 + MODE];
      const float gsc = gt / (lrow > 0.f ? lrow : 1.0f);
#pragma unroll
      for (int dt = 0; dt < 4; ++dt) outacc[dt] = outacc[dt] + O[dt] * gsc; }
}

template <int NT>
__device__ __forceinline__ void cmp_scores(const LAS bf16_t* BUF0, unsigned (&pw)[16][2], LAS float* impw, const bf16x8 (&qa)[2], int t, float slope2, int lane) {
    constexpr int TS = 72, PS = 264, IP = 66;
    const int cl = lane & 15, q4 = lane >> 4;
    const int cmaxl = (t >= 31) ? (((t - 31) >> 4) < 254 ? ((t - 31) >> 4) : 254) : -1;
    f32x4 bq; { const float b0 = slope2 * (float)(16 * (4 * q4) + 31 - t); bq = (f32x4){b0, b0 + 16.f * slope2, b0 + 32.f * slope2, b0 + 48.f * slope2}; }
    const float o256 = 256.f * slope2;
    f32x4 s[NT]; float cm = -INFINITY;
#pragma unroll
    for (int nt = 0; nt < NT; ++nt) { s[nt] = bq + (float)nt * o256;
#pragma unroll
        for (int ks = 0; ks < 2; ++ks) { const bf16x8 kb = *(const LAS bf16x8*)(BUF0 + (16 * nt + cl) * TS + 32 * ks + 8 * q4); s[nt] = __builtin_amdgcn_mfma_f32_16x16x32_bf16(kb, qa[ks], s[nt], 0, 0, 0); } }
#pragma unroll
    for (int nt = 0; nt < NT; ++nt) {
        if (nt >= NT - 5) {
#pragma unroll
            for (int j = 0; j < 4; ++j) { const bool ok = (16 * nt + 4 * q4 + j) <= cmaxl; s[nt][j] = ok ? s[nt][j] : -INFINITY; } }
        cm = fmaxf(cm, fmaxf(fmaxf(s[nt][0], s[nt][1]), fmaxf(s[nt][2], s[nt][3]))); }
    cm = fmaxf(cm, __shfl_xor(cm, 16)); cm = fmaxf(cm, __shfl_xor(cm, 32));
    cm = (cm == -INFINITY) ? 0.f : cm;
    float cs = 0.f;
#pragma unroll
    for (int nt = 0; nt < NT; ++nt)
#pragma unroll
        for (int j = 0; j < 4; ++j) { const float e = ex2(s[nt][j] - cm); s[nt][j] = e; cs += e; }
    cs += __shfl_xor(cs, 16); cs += __shfl_xor(cs, 32);
    const float cinv = 1.0f / (cs > 0.f ? cs : 1.0f);
#pragma unroll
    for (int nt = 0; nt < NT; ++nt) { float p[4];
#pragma unroll
        for (int j = 0; j < 4; ++j) { p[j] = s[nt][j] * cinv; s[nt][j] = p[j]; }
        pw[nt][0] = pg8::cvt_pk_bf16(p[0], p[1]); pw[nt][1] = pg8::cvt_pk_bf16(p[2], p[3]);
        impw[cl * IP + 4 * nt + q4] = (p[0] + p[1]) + (p[2] + p[3]); }
#pragma unroll
    for (int nt = 0; nt < NT; ++nt) { if (nt < 15 || q4 < 3) __hip_atomic_fetch_add(impw + cl * IP + 4 * nt + q4 + 1, s[nt][3], __ATOMIC_RELAXED, __HIP_MEMORY_SCOPE_WORKGROUP); }
}
template <int NK>
__device__ __forceinline__ void cmp_pv(const LAS bf16_t* BUF0, const unsigned (&pw)[16][2], f32x4 (&oc)[4], int lane) {
    constexpr int PS = 264; const int cl = lane & 15, q4 = lane >> 4;
#pragma unroll
    for (int ks = 0; ks < NK; ++ks) { const bf16x8 pa = __builtin_bit_cast(bf16x8, (u32x4){pw[2 * ks][0], pw[2 * ks][1], pw[2 * ks + 1][0], pw[2 * ks + 1][1]});
#pragma unroll
        for (int dt = 0; dt < 4; ++dt) { const bf16x8 vb = *(const LAS bf16x8*)(BUF0 + (16 * dt + cl) * PS + 32 * ks + 8 * q4); oc[dt] = __builtin_amdgcn_mfma_f32_16x16x32_bf16(vb, pa, oc[dt], 0, 0, 0); } }
}

__device__ __forceinline__ void attn_phase(LAS unsigned char* lds, const bf16_t* KV, const bf16_t* VT2, const bf16_t* QB, const float* GATEB, const bf16_t* KC, const bf16_t* VCT, bf16_t* OB, int wgc, int G) {
    const int tid = threadIdx.x, wave = __builtin_amdgcn_readfirstlane(tid >> 6), lane = tid & 63, cl = lane & 15, q4 = lane >> 4;
    constexpr int TS = 72, PS = 264, IP = 66;
    LAS bf16_t* KCs = (LAS bf16_t*)(lds + 0);
    LAS bf16_t* VCTs = (LAS bf16_t*)(lds + 36864);
    LAS bf16_t* Pw = (LAS bf16_t*)(lds + ATT_SET0);
    LAS float* IMP = (LAS float*)(lds + ATT_SET1);
    LAS u64* SEL = (LAS u64*)(lds + ATT_SET1 + 33792);
    const float LOG2E = 1.4426950408889634f;
#if TSEG
    unsigned long long tseg_acc = 0, tseg_t = 0;
#endif
    const int nj = G < 8 ? G : 8, nslot = G / nj, js0 = wgc % nj, slot = wgc / nj, cb = (128 - js0 + nj - 1) / nj;
    int bg_loaded = -1;
    for (int it = 0; slot < nslot; ++it) {
        const int bg = slot + (it / cb) * nslot; if (bg >= 32) break;
        const int uu = js0 + (it % cb) * nj, i = uu >> 3, js = uu & 7;
        const int qt = 8 * i + ((i & 1) ? 7 - js : js);
        if (bg != bg_loaded) { bg_loaded = bg;
            __syncthreads();
#pragma unroll
            for (int k = 0; k < 4; ++k) { const int id = tid + 512 * k, row = id >> 3, cc = id & 7; *(LAS u32x4*)(KCs + row * TS + 8 * cc) = *(const u32x4*)(KC + ((size_t)bg * 256 + row) * 64 + 8 * cc); }
#pragma unroll
            for (int k = 0; k < 4; ++k) { const int id = tid + 512 * k, d = id >> 5, cc = id & 31; *(LAS u32x4*)(VCTs + d * PS + 8 * cc) = *(const u32x4*)(VCT + ((size_t)bg * 64 + d) * 256 + 8 * cc); }
            __syncthreads(); }
        const int b = bg >> 2, g = bg & 3, t0 = qt * 32;
        TS_B(1);
        const int r = wave >> 1, th = wave & 1, h = 4 * g + r;
        const float slope2 = exp2f(-0.5f * (float)(h + 1)) * LOG2E;
        LAS unsigned char* ql = lds + ATT_QL + wave * 2048;
#define ATT_QDMA(bg_, qt_) do { const bf16_t* qsrc = QB + ((size_t)((bg_) >> 2) * SEQ + (qt_) * 32 + 16 * th + (lane >> 3)) * 1024 + (4 * ((bg_) & 3) + r) * 64 + 8 * (lane & 7); \
            __builtin_amdgcn_global_load_lds((const unsigned*)qsrc, (LAS unsigned*)ql, 16, 0, 0); __builtin_amdgcn_global_load_lds((const unsigned*)(qsrc + 8 * 1024), (LAS unsigned*)(ql + 1024), 16, 0, 0); } while (0)
        if (it == 0) ATT_QDMA(bg, qt);
        asm volatile("s_waitcnt vmcnt(0)" ::: "memory");
        bf16x8 qa[2];
        qa[0] = *(const LAS bf16x8*)(ql + cl * 128 + 16 * q4); qa[1] = *(const LAS bf16x8*)(ql + cl * 128 + 64 + 16 * q4);
        LDS_WAIT();
        { const int it1 = it + 1, bgn = slot + (it1 / cb) * nslot, uun = js0 + (it1 % cb) * nj, in_ = uun >> 3, jsn = uun & 7;
          if (bgn < 32) ATT_QDMA(bgn, 8 * in_ + ((in_ & 1) ? 7 - jsn : jsn)); }
#undef ATT_QDMA
        f32x4 outacc[4];
        TS_E(1); TS_B(2);
        const int ng = (t0 >> 10) + 1;
        unsigned cpw[16][2];
        {   LAS float* impw = IMP + wave * (16 * IP);
            const int t = t0 + 16 * th + cl;
            if (ng == 1) cmp_scores<4>(KCs, cpw, impw, qa, t, slope2, lane);
            else if (ng == 2) cmp_scores<8>(KCs, cpw, impw, qa, t, slope2, lane);
            else if (ng == 3) cmp_scores<12>(KCs, cpw, impw, qa, t, slope2, lane);
            else cmp_scores<16>(KCs, cpw, impw, qa, t, slope2, lane);
        }
        TS_E(2); TS_B(3);
        __syncthreads();
        TS_E(3); TS_B(4);
        {   u64 key[4], pre[4];
#pragma unroll
            for (int e = 0; e < 4; ++e) { const int tk = 4 * wave + e, tt = t0 + tk, cur = tt >> 6;
                float v = 0.f;
#pragma unroll
                for (int rr = 0; rr < 4; ++rr) v += IMP[((2 * rr + (tk >> 4)) * 16 + (tk & 15)) * IP + lane];
                const bool forced = (lane == 0) || (lane == cur) || (lane == cur - 1);
                v = fmaxf(v, 0.f); if (forced) v = 1e4f;
                const bool valid = lane <= cur;
                key[e] = valid ? (((u64)__builtin_bit_cast(unsigned, v) << 6) | (u64)(63 - lane)) + 1ull : 0ull;
                pre[e] = 0ull; }
            int open = 0;
#pragma unroll
            for (int e = 0; e < 4; ++e) open |= (((t0 + 4 * wave + e) >> 6) >= 16) ? (1 << e) : 0;
#pragma unroll 1
            for (int bit = 36; bit >= 0 && open; --bit) { const u64 bm = 1ull << bit;
#pragma unroll
                for (int e = 0; e < 4; ++e) { const u64 cand = pre[e] | bm; const int cnt = __popcll(__ballot(key[e] >= cand)); pre[e] = (cnt >= 16) ? cand : pre[e]; if (cnt == 16) open &= ~(1 << e); } }
#pragma unroll
            for (int e = 0; e < 4; ++e) { const u64 msk = __ballot(key[e] >= (pre[e] ? pre[e] : 1ull)); if (lane == 0) SEL[4 * wave + e] = msk; }
        }
        TS_E(4); TS_B(6);
        {
            f32x4 oc[4];
#pragma unroll
            for (int dt = 0; dt < 4; ++dt) oc[dt] = (f32x4){0.f, 0.f, 0.f, 0.f};
            if (ng == 1) cmp_pv<2>(VCTs, cpw, oc, lane); else if (ng == 2) cmp_pv<4>(VCTs, cpw, oc, lane); else if (ng == 3) cmp_pv<6>(VCTs, cpw, oc, lane); else cmp_pv<8>(VCTs, cpw, oc, lane);
            const float gc = GATEB[((size_t)b * SEQ + t0 + 16 * th + cl) * 48 + h * 3];
#pragma unroll
            for (int dt = 0; dt < 4; ++dt) outacc[dt] = oc[dt] * gc;
        }
        TS_E(6); TS_B(5);
        __syncthreads();
        TS_E(5); TS_B(7);
        u64 tselv = 0ull;
#pragma unroll 8
        for (int tk = 0; tk < 32; ++tk) { const u64 sv = SEL[tk]; tselv |= ((sv >> lane) & 1ull) << tk; }
        const u64 uni = __ballot(tselv != 0ull);
        TS_E(7); TS_B(8);
#if TSEG
        attn_branch<0>(lds, Pw, KV, VT2, GATEB, qa, outacc, uni, tselv, b, bg, h, t0, th, slope2, tseg_acc);
#else
        attn_branch<0>(lds, Pw, KV, VT2, GATEB, qa, outacc, uni, tselv, b, bg, h, t0, th, slope2);
#endif
        TS_E(8); TS_B(9);
#if TSEG
        attn_branch<1>(lds, Pw, KV, VT2, GATEB, qa, outacc, uni, tselv, b, bg, h, t0, th, slope2, tseg_acc);
#else
        attn_branch<1>(lds, Pw, KV, VT2, GATEB, qa, outacc, uni, tselv, b, bg, h, t0, th, slope2);
#endif
        TS_E(9);
        { bf16_t* op = OB + ((size_t)b * SEQ + t0 + 16 * th + cl) * 1024 + h * 64 + 4 * q4;
#pragma unroll
          for (int dt = 0; dt < 4; ++dt) { u32x2 w; w.x = pg8::cvt_pk_bf16(outacc[dt][0], outacc[dt][1]); w.y = pg8::cvt_pk_bf16(outacc[dt][2], outacc[dt][3]); *(u32x2*)(op + 16 * dt) = w; } }
    }
#if TSEG
    { const unsigned long long w0 = __builtin_amdgcn_s_memrealtime(); while (__builtin_amdgcn_s_memrealtime() - w0 < 2 * tseg_acc) __builtin_amdgcn_s_sleep(8); }
#endif
}

constexpr int NPHASE = 20;
__global__ void __launch_bounds__(NTHR, 2) yoco_fwd(Args args) {
    extern __shared__ __attribute__((aligned(16))) unsigned char lds_raw[];
    LAS unsigned char* lds = (LAS unsigned char*)lds_raw;
    volatile LAS unsigned* MISC = (volatile LAS unsigned*)(lds + MISC_OFF);
    const int tid = threadIdx.x, lane = tid & 63, wave = __builtin_amdgcn_readfirstlane(tid >> 6);
    const int G = gridDim.x, bx = blockIdx.x;
    const int vcu = (G % 8 == 0) ? (bx % 8) * (G / 8) + bx / 8 : bx;
    const int gw = vcu * NWAVES + wave, NGW = G * NWAVES;
    unsigned char* ws = args.ws;
    unsigned* ctl = (unsigned*)(ws + WS_CTL);
    if (tid < 64) MISC[tid] = 0u;
    __syncthreads();
    XcdBarrier bar; bar.bar = ctl + CW_BAR; bar.x = 0; bar.st = MISC + 60;
    if (!MK_PER_PHASE) bar = xcd_barrier_post(ctl + CW_BAR, MISC + 60);
    const int lo = args.ph_lo, hi = args.ph_hi;
#ifndef PHMASK
#define PHMASK 0xFFFFFFu
#endif
#ifndef PROBE_SKIP
#define PROBE_SKIP 0
#endif
constexpr unsigned PHSKIP = 0u;
#define IN(k) ((((PHMASK & ~PHSKIP) >> (k)) & 1u) && lo <= (k) && (k) < hi)
#ifndef P0REP
#define P0REP 0
#endif
#ifndef REPMASK
#define REPMASK 0x0u
#endif
#define PH(k) for (int _r = 0, _n = IN(k) ? ((((REPMASK) >> (k)) & 1u) ? 2 : 1) : 0; _r < _n; ++_r)
#ifndef PHT
#define PHT -1
#endif
#if PHT >= 0
    unsigned long long pht_t = __builtin_amdgcn_s_memrealtime();
#define SEAM(k) do { if (PHT == (k)) { const unsigned long long d_ = __builtin_amdgcn_s_memrealtime() - pht_t, w0_ = __builtin_amdgcn_s_memrealtime(); while (__builtin_amdgcn_s_memrealtime() - w0_ < d_) __builtin_amdgcn_s_sleep(8); } \
        if (lo <= (k) && (k) + 1 < hi) xcd_barrier(bar); pht_t = __builtin_amdgcn_s_memrealtime(); } while (0)
#else
#define SEAM(k) do { if (lo <= (k) && (k) + 1 < hi) xcd_barrier(bar); } while (0)
#endif

    const float* x = A_IN(I_X);
    float* xs = args.out;
    bf16_t* XH = (bf16_t*)(ws + WS_XH);
    float* GA = (float*)(ws + WS_GA);
    float* bias1 = (float*)(ws + WS_SMALL);
    unsigned* EIDX = (unsigned*)(ws + WS_SMALL + 8192);
    float* EW = (float*)(ws + WS_SMALL + 8192 + 131072);
    u32x2* ROWINFO = (u32x2*)(ws + WS_ROWINFO);

    PH(0) {
        for (int _q = 0; _q < ((P0REP & 1) ? 2 : 1); ++_q) p0_weights(ws, lds, gw, NGW, wave, lane, G != 256);
        __syncthreads();
        LAS float* Wg = (LAS float*)lds;
        for (int i = tid; i < 8192; i += NTHR) { const int k = i >> 3, e = i & 7; Wg[(e >> 2) * 4096 + ((((k >> 8) * 4 + (k & 3)) * 64 + ((k & 255) >> 2)) << 2) + (e & 3)] = A_IN(I_A_W_IN)[(size_t)k * NPROJ_SRC + 4096 + e] * A_IN(I_NORM_MIX)[k]; }
        __syncthreads();
        for (int _q = 0; _q < ((P0REP & 2) ? 2 : 1); ++_q) {
        f32x4 vn[4]; if (gw < M) load_row(x + (size_t)gw * D, lane, vn);
        for (int m = gw; m < M; m += NGW) {
            f32x4 v[4];
#pragma unroll
            for (int j = 0; j < 4; ++j) v[j] = vn[j];
            load_row(x + (size_t)(m + NGW < M ? m + NGW : m) * D, lane, vn);
            const float rstd = row_rstd(v);
            store_row_bf16(XH + (size_t)m * D, lane, v, rstd);
            float gsum[8];
#pragma unroll
            for (int e = 0; e < 8; ++e) gsum[e] = 0.f;
#pragma unroll
            for (int j = 0; j < 4; ++j)
#pragma unroll
                for (int c = 0; c < 4; ++c) { const f32x4 w0 = *(const LAS f32x4*)(Wg + (((j * 4 + c) * 64 + lane) << 2)), w1 = *(const LAS f32x4*)(Wg + 4096 + (((j * 4 + c) * 64 + lane) << 2)); const float xv = v[j][c];
                    gsum[0] += xv * w0.x; gsum[1] += xv * w0.y; gsum[2] += xv * w0.z; gsum[3] += xv * w0.w; gsum[4] += xv * w1.x; gsum[5] += xv * w1.y; gsum[6] += xv * w1.z; gsum[7] += xv * w1.w; }
#pragma unroll
            for (int e = 0; e < 8; ++e) gsum[e] = wave_sum(gsum[e]) * rstd + A_IN(I_A_B_GATE)[e];
            if (lane == 0) {
#pragma unroll
                for (int e = 0; e < 4; ++e) GA[(size_t)m * 8 + e] = gsum[e];
#pragma unroll
                for (int e = 4; e < 8; ++e) { const float g = gsum[e]; GA[(size_t)m * 8 + e] = fminf(g, 0.f) - log1pf(__expf(-fabsf(g))); } }
        }
        }
        __syncthreads();
        for (int it = bx; it < 256; it += G) { const int c = it >> 7, nb = (it >> 4) & 7, fc = it & 15, n = nb * 32 + (tid & 31), fs = tid >> 5; float s = 0.f;
#pragma unroll
            for (int k = 0; k < 8; ++k) { const int f = fc * 128 + fs * 8 + k; s += A_IN(I_B_CMP_POS)[((f >> 6) * 2 + c) * 64 + (f & 63)] * A_IN(I_B_CMP_W1)[((size_t)c * 2048 + f) * 256 + n]; }
            LAS float* red = (LAS float*)lds; __syncthreads(); red[tid] = s; __syncthreads();
            if (tid < 32) { float t = 0.f; for (int k = 0; k < 16; ++k) t += red[k * 32 + tid]; ((float*)(ws + WS_SMALL + 401408))[(c * 256 + n) * 16 + fc] = t; }
            __syncthreads(); }
    }
    SEAM(0);
    PH(1) { if (bx == 0) { const float* bp = (const float*)(ws + WS_SMALL + 401408) + tid * 16; float t = 0.f; for (int k = 0; k < 16; ++k) t += bp[k]; bias1[tid] = t; }
        pg8::PlainOrder S; S.init(XH, (const bf16_t*)(ws + WS_WIN), M, NPROJ, D, D, G, bx); pg8::EpiProjSplit E{(bf16_t*)(ws + WS_PROJ3), (bf16_t*)(ws + WS_OG)};
        pg8::gemm_phase(lds, pg8::Dims{D, D, D}, S, E); }
    SEAM(1);
    PH(2) scanprep_phase(lds, (const bf16_t*)(ws + WS_PROJ3), GA, A_IN(I_A_CONV), ws + WS_IMG, vcu, G);
    SEAM(2);
    PH(3) scan_phase(lds, ws + WS_IMG, (float*)(ws + WS_HS), (float*)(ws + WS_DN), vcu, G, ws);
    SEAM(3);
    PH(4) {
        const float* HS = (const float*)(ws + WS_HS); const float* DN = (const float*)(ws + WS_DN); const bf16_t* OG = (const bf16_t*)(ws + WS_OG); bf16_t* HN = (bf16_t*)(ws + WS_HN);
        f32x4 vn[4], dnn; u32x2 ogn[4];
#define P4_LOAD(mm) do { load_row(HS + (size_t)(mm) * D, lane, vn); dnn = *(const f32x4*)(DN + (size_t)(mm) * 4); \
            _Pragma("unroll") for (int j = 0; j < 4; ++j) ogn[j] = *(const u32x2*)(OG + (size_t)(mm) * D + 4 * lane + 256 * j); } while (0)
        P4_LOAD(gw < M ? gw : 0);
        f32x4 gvv[4];
#pragma unroll
        for (int j = 0; j < 4; ++j) gvv[j] = *((const f32x4*)A_IN(I_A_NORM_H) + lane + 64 * j);
        for (int m = gw; m < M; m += NGW) { f32x4 v[4]; u32x2 og[4]; const f32x4 dn = dnn;
#pragma unroll
            for (int j = 0; j < 4; ++j) { v[j] = vn[j]; og[j] = ogn[j]; }
            P4_LOAD(m + NGW < M ? m + NGW : m);
            u64* o8 = (u64*)(HN + (size_t)m * D) + lane;
#pragma unroll
            for (int j = 0; j < 4; ++j) { v[j] = v[j] * (1.0f / dn[j]); float s = (v[j].x * v[j].x + v[j].y * v[j].y) + (v[j].z * v[j].z + v[j].w * v[j].w); s = wave_sum(s);
                const float rs = 1.0f / sqrtf(s * (1.f / 256.f) + EPS);
                const u32x2 oraw = og[j]; const f32x4 gv = gvv[j];
                const float o0 = v[j].x * rs * gv.x * sigmoidf_(bflo(oraw.x)), o1 = v[j].y * rs * gv.y * sigmoidf_(bfhi(oraw.x)), o2 = v[j].z * rs * gv.z * sigmoidf_(bflo(oraw.y)), o3 = v[j].w * rs * gv.w * sigmoidf_(bfhi(oraw.y));
                o8[64 * j] = (u64)pk2(o0, o1) | ((u64)pk2(o2, o3) << 32); } }
#undef P4_LOAD
    }
    SEAM(4);
    PH(5) { pg8::PlainOrder S; S.init((const bf16_t*)(ws + WS_HN), (const bf16_t*)(ws + WS_WOUTA), M, D, D, D, G, bx); pg8::EpiRes16<false, true> E{x, XH, (float*)(ws + WS_SSP), D};
        pg8::gemm_phase(lds, pg8::Dims{D, D, D}, S, E); }
    SEAM(5);
    PH(6) { const float* sp = (const float*)(ws + WS_SSP); float* rs = (float*)(ws + WS_RS);
        for (int r = bx * NTHR + tid; r < M; r += G * NTHR) rs[r] = pg8::row_rs16(sp, r); }
    SEAM(6);
    PH(7) { pg8::PlainOrder S; S.init(XH, (const bf16_t*)(ws + WS_WGU), M, 2 * FFD, D, D, G, bx); pg8::EpiSwiGLU E{(bf16_t*)(ws + WS_ACT), FFD, (const float*)(ws + WS_RS)};
        if (EXPT && _r == 1) { S.same = 11; E.O = (bf16_t*)(ws + WS_END2); }
#if TPROBE
        float* tkp = (float*)(ws + WS_END2 + 2 * MiB); const unsigned long long tp0 = __builtin_amdgcn_s_memrealtime();
        pg8::gemm_phase(lds, pg8::Dims{D, D, D, 127, 127, bx == 0 ? tkp : nullptr}, S, E);
        if (bx == 0 && tid == 0) tkp[2] = (float)(__builtin_amdgcn_s_memrealtime() - tp0);
#else
        pg8::gemm_phase(lds, pg8::Dims{D, D, D}, S, E);
#endif
    }
    SEAM(7);
    PH(8) { pg8::PlainOrder S; S.init((const bf16_t*)(ws + WS_ACT), (const bf16_t*)(ws + WS_WDOWN), M, D, FFD, FFD, G, bx); pg8::EpiRes16<true, true> E{nullptr, XH, (float*)(ws + WS_SSP), D};
        pg8::gemm_phase(lds, pg8::Dims{FFD, FFD, FFD}, S, E); }
    SEAM(8);
    PH(9) { const float* sp = (const float*)(ws + WS_SSP); float* rs = (float*)(ws + WS_RS);
        for (int r = bx * NTHR + tid; r < M; r += G * NTHR) rs[r] = pg8::row_rs16(sp, r); }
    SEAM(9);
    PH(10) { pg8::PlainOrder S; S.init(XH, (const bf16_t*)(ws + WS_WKVQ), M, NKVQ, D, D, G, bx); pg8::EpiKVQ E{(bf16_t*)(ws + WS_KV), (bf16_t*)(ws + WS_QB), (float*)(ws + WS_GATEB), A_IN(I_B_B_GATE), (const float*)(ws + WS_RS)};
        pg8::gemm_phase(lds, pg8::Dims{D, D, D}, S, E); }
    SEAM(10);
    PH(11) {
        struct CmpOrder { int G, c; const char* A; const char* B;
            __device__ __forceinline__ bool next(int i, pg8::Unit& u) const { const int L = i * G + c; if (L >= 64) return false; u.pm = L; u.pn = 0; u.a = A + (size_t)L * 256 * 1024 * 2; u.b = B + (size_t)(L >> 5) * 256 * 2048 * 2; return true; } };
        CmpOrder S{G, bx, (const char*)(ws + WS_KV), (const char*)(ws + WS_WCMP1)}; pg8::EpiCmp E{(bf16_t*)(ws + WS_HID), bias1};
        if (bx < 64 || G <= 64) pg8::gemm_phase(lds, pg8::Dims{2048, 1024, 2048}, S, E);
        if (bx >= 64 || G <= 64) {
        { LAS bf16_t* T = (LAS bf16_t*)lds; const size_t PLANE = (size_t)8 * 4 * 4096 * 64;
          for (int it = (G <= 64) ? bx : bx - 64; it < 4096; it += (G <= 64) ? G : G - 64) { const int mode = it >> 11, rest = it & 2047;
              const bf16_t* src = (const bf16_t*)(ws + WS_KV) + (size_t)(mode == 0 ? 3 : 5) * PLANE + (size_t)rest * 4096; bf16_t* dst = (bf16_t*)(ws + WS_VT2) + ((size_t)mode * 2048 + rest) * 4096;
              const int row = tid >> 3, cc = tid & 7; const u32x4 raw = *(const u32x4*)(src + (size_t)tid * 8);
              const int prow = (row & 32) | (((row >> 2) & 3) << 3) | (((row >> 4) & 1) << 2) | (row & 3);
              __syncthreads();
              T[(8 * cc + 0) * 72 + prow] = (bf16_t)(raw.x & 0xffff); T[(8 * cc + 1) * 72 + prow] = (bf16_t)(raw.x >> 16); T[(8 * cc + 2) * 72 + prow] = (bf16_t)(raw.y & 0xffff); T[(8 * cc + 3) * 72 + prow] = (bf16_t)(raw.y >> 16);
              T[(8 * cc + 4) * 72 + prow] = (bf16_t)(raw.z & 0xffff); T[(8 * cc + 5) * 72 + prow] = (bf16_t)(raw.z >> 16); T[(8 * cc + 6) * 72 + prow] = (bf16_t)(raw.w & 0xffff); T[(8 * cc + 7) * 72 + prow] = (bf16_t)(raw.w >> 16);
              __syncthreads();
              *(u32x4*)(dst + (size_t)tid * 8) = *(const LAS u32x4*)(T + row * 72 + 8 * cc); } }
        } }
    SEAM(11);
    PH(12) { const bf16_t* HID = (const bf16_t*)(ws + WS_HID); const bf16_t* W2T = (const bf16_t*)(ws + WS_W2T);
        if (gw < 512) { const int c = gw >> 8, r0 = 32 * (gw & 255); const int cl = lane & 15, q4 = lane >> 4;
            f32x4 acc[2][4];
#pragma unroll
            for (int rt = 0; rt < 2; ++rt)
#pragma unroll
                for (int dt = 0; dt < 4; ++dt) acc[rt][dt] = (f32x4){0.f, 0.f, 0.f, 0.f};
            const bf16_t* hp = HID + ((size_t)c * 8192 + r0 + cl) * 256 + 8 * q4; const bf16_t* wp = W2T + ((size_t)c * 64 + cl) * 256 + 8 * q4;
#pragma unroll 2
            for (int ks = 0; ks < 8; ++ks) { bf16x8 a[2], w[4];
#pragma unroll
                for (int rt = 0; rt < 2; ++rt) a[rt] = *(const bf16x8*)(hp + (size_t)rt * 16 * 256 + 32 * ks);
#pragma unroll
                for (int dt = 0; dt < 4; ++dt) w[dt] = *(const bf16x8*)(wp + (size_t)dt * 16 * 256 + 32 * ks);
#pragma unroll
                for (int rt = 0; rt < 2; ++rt)
#pragma unroll
                    for (int dt = 0; dt < 4; ++dt) acc[rt][dt] = (c == 0) ? __builtin_amdgcn_mfma_f32_16x16x32_bf16(w[dt], a[rt], acc[rt][dt], 0, 0, 0) : __builtin_amdgcn_mfma_f32_16x16x32_bf16(a[rt], w[dt], acc[rt][dt], 0, 0, 0); }
#pragma unroll
            for (int rt = 0; rt < 2; ++rt)
#pragma unroll
                for (int dt = 0; dt < 4; ++dt) { u32x2 p; p.x = pk2(acc[rt][dt][0], acc[rt][dt][1]); p.y = pk2(acc[rt][dt][2], acc[rt][dt][3]);
                    if (c == 0) *(u32x2*)((bf16_t*)(ws + WS_KC) + (size_t)(r0 + 16 * rt + cl) * 64 + 16 * dt + 4 * q4) = p;
                    else { const int R = r0 + 16 * rt + 4 * q4, cidx = R & 255, pc = (cidx & ~31) | (((cidx >> 2) & 3) << 3) | (((cidx >> 4) & 1) << 2);
                        *(u32x2*)((bf16_t*)(ws + WS_VC) + ((size_t)(R >> 8) * 64 + 16 * dt + cl) * 256 + pc) = p; } }
        }
    }
    SEAM(12);
    PH(13) attn_phase(lds, (const bf16_t*)(ws + WS_KV), (const bf16_t*)(ws + WS_VT2), (const bf16_t*)(ws + WS_QB), (const float*)(ws + WS_GATEB), (const bf16_t*)(ws + WS_KC), (const bf16_t*)(ws + WS_VC), (bf16_t*)(ws + WS_OB), vcu, G);
    SEAM(13);
    PH(14) { pg8::PlainOrder S; S.init((const bf16_t*)(ws + WS_OB), (const bf16_t*)(ws + WS_WOUTB), M, D, D, D, G, bx); pg8::EpiRes16<true, false> E{nullptr, XH, nullptr, D};
        pg8::gemm_phase(lds, pg8::Dims{D, D, D}, S, E); }
    SEAM(14);
    PH(15) {
        LAS float* Wr = (LAS float*)lds;
        for (int i = tid; i < 8192; i += NTHR) { const int k = i >> 3, e = i & 7; Wr[(e >> 2) * 4096 + ((((k >> 8) * 4 + (k & 3)) * 64 + ((k & 255) >> 2)) << 2) + (e & 3)] = A_IN(I_M_ROUTER)[i] * A_IN(I_NORM_FFN)[1024 + k]; }
        __syncthreads();
        u32x2 rn[4];
#pragma unroll
        for (int j = 0; j < 4; ++j) rn[j] = *(const u32x2*)(XH + (size_t)(gw < M ? gw : 0) * D + 4 * lane + 256 * j);
        for (int m = gw; m < M; m += NGW) {
            f32x4 v[4];
#pragma unroll
            for (int j = 0; j < 4; ++j) v[j] = (f32x4){bflo(rn[j].x), bfhi(rn[j].x), bflo(rn[j].y), bfhi(rn[j].y)};
#pragma unroll
            for (int j = 0; j < 4; ++j) rn[j] = *(const u32x2*)(XH + (size_t)(m + NGW < M ? m + NGW : m) * D + 4 * lane + 256 * j);
            const float rstd = row_rstd(v);
            if (lane == 0) ((float*)(ws + WS_RS))[m] = rstd;
            float gsum[8];
#pragma unroll
            for (int e = 0; e < 8; ++e) gsum[e] = 0.f;
#pragma unroll
            for (int j = 0; j < 4; ++j)
#pragma unroll
                for (int c = 0; c < 4; ++c) { const f32x4 w0 = *(const LAS f32x4*)(Wr + (((j * 4 + c) * 64 + lane) << 2)), w1 = *(const LAS f32x4*)(Wr + 4096 + (((j * 4 + c) * 64 + lane) << 2)); const float xv = v[j][c];
                    gsum[0] += xv * w0.x; gsum[1] += xv * w0.y; gsum[2] += xv * w0.z; gsum[3] += xv * w0.w; gsum[4] += xv * w1.x; gsum[5] += xv * w1.y; gsum[6] += xv * w1.z; gsum[7] += xv * w1.w; }
#pragma unroll
            for (int e = 0; e < 8; ++e) gsum[e] = wave_sum(gsum[e]) * rstd;
            if (lane == 0) { int e1 = 0; float v1 = gsum[0];
#pragma unroll
                for (int e = 1; e < 8; ++e) if (gsum[e] > v1) { v1 = gsum[e]; e1 = e; }
                int e2 = -1; float v2 = -INFINITY;
#pragma unroll
                for (int e = 0; e < 8; ++e) if (e != e1 && gsum[e] > v2) { v2 = gsum[e]; e2 = e; }
                const float ex = __expf(v2 - v1), w1 = 1.0f / (1.0f + ex), w2 = ex * w1;
                EIDX[m] = (unsigned)e1 | ((unsigned)e2 << 8); EW[2 * (size_t)m] = w1; EW[2 * (size_t)m + 1] = w2;
                int* cc = (int*)(ws + WS_CTL + 524288) + (m >> 7) * 8; atomicAdd(cc + e1, 1); atomicAdd(cc + e2, 1); }
        }
    }
    SEAM(15);
    volatile LAS int* tb = (volatile LAS int*)(lds + MISC_OFF);
    PH(16) {
        LAS int* cnt_all = (LAS int*)lds;
        LAS int* posl = (LAS int*)(lds + 256);
        bf16_t* XG = (bf16_t*)(ws + WS_XG);
        for (int ch = bx; ch < M / 128; ch += G) {
            __syncthreads();
            if (tid < 16) cnt_all[tid] = 0;
            __syncthreads();
            int ct[8], cb[8];
#pragma unroll
            for (int e = 0; e < 8; ++e) { ct[e] = 0; cb[e] = 0; }
            if (tid < M / 128) { const int* cc = (const int*)(ws + WS_CTL + 524288) + tid * 8; const bool before = tid < ch;
#pragma unroll
                for (int e = 0; e < 8; ++e) { const int hit = cc[e]; ct[e] = hit; cb[e] = before ? hit : 0; } }
#pragma unroll
            for (int e = 0; e < 8; ++e) { int a = ct[e], b2 = cb[e];
#pragma unroll
                for (int o = 1; o < 64; o <<= 1) { a += __shfl_xor(a, o); b2 += __shfl_xor(b2, o); }
                if (lane == 0) { atomicAdd((int*)&cnt_all[e], a); atomicAdd((int*)&cnt_all[8 + e], b2); } }
            __syncthreads();
            if (wave == 0) {
                int base[8]; int run = 0;
#pragma unroll
                for (int e = 0; e < 8; ++e) { base[e] = run * 256 + cnt_all[8 + e]; run += (cnt_all[e] + 255) >> 8; }
#pragma unroll 1
                for (int half = 0; half < 2; ++half) { const int m = ch * 128 + half * 64 + lane; const unsigned ei = EIDX[m]; const int e1 = ei & 255, e2 = (ei >> 8) & 255;
                    int p1 = 0, p2 = 0;
#pragma unroll
                    for (int e = 0; e < 8; ++e) { const u64 mk = __ballot(e1 == e || e2 == e); const int rk = __popcll(mk & ((1ull << lane) - 1ull));
                        if (e1 == e) p1 = base[e] + rk; if (e2 == e) p2 = base[e] + rk; base[e] += __popcll(mk); }
                    posl[(half * 64 + lane) * 2] = p1; posl[(half * 64 + lane) * 2 + 1] = p2;
                    ROWINFO[p1] = (u32x2){(unsigned)m << 1, __builtin_bit_cast(unsigned, EW[2 * (size_t)m])};
                    ROWINFO[p2] = (u32x2){((unsigned)m << 1) | 1u, __builtin_bit_cast(unsigned, EW[2 * (size_t)m + 1])}; }
                if (ch == 0 && lane < 8) ((int*)(ws + WS_SMALL + 4096))[lane] = cnt_all[lane];
            }
            __syncthreads();
            for (int rr = wave; rr < 256; rr += NWAVES) { const int m = ch * 128 + (rr >> 1); const int p = posl[rr]; const float s16 = ((const float*)(ws + WS_RS))[m] * 16.f;
                const u32x4 a0 = ((const u32x4*)(XH + (size_t)m * D))[2 * lane], a1 = ((const u32x4*)(XH + (size_t)m * D))[2 * lane + 1];
                u32x4 o; o.x = pk_fp8x4(bflo(a0.x) * s16, bfhi(a0.x) * s16, bflo(a0.y) * s16, bfhi(a0.y) * s16); o.y = pk_fp8x4(bflo(a0.z) * s16, bfhi(a0.z) * s16, bflo(a0.w) * s16, bfhi(a0.w) * s16);
                o.z = pk_fp8x4(bflo(a1.x) * s16, bfhi(a1.x) * s16, bflo(a1.y) * s16, bfhi(a1.y) * s16); o.w = pk_fp8x4(bflo(a1.z) * s16, bfhi(a1.z) * s16, bflo(a1.w) * s16, bfhi(a1.w) * s16);
                ((u32x4*)((unsigned char*)XG + (size_t)p * D))[lane] = o; }
        }
    }
    SEAM(16);
    if (IN(17) || IN(18)) {
        __syncthreads();
        if (tid == 0) { const int* cg = (const int*)(ws + WS_SMALL + 4096); int run = 0;
            for (int e = 0; e < 8; ++e) { const int c = cg[e]; tb[e] = run; tb[16 + e] = c; run += (c + 255) >> 8; } tb[8] = run; }
        __syncthreads();
    }
    PH(17) { MoeOrder S{2 * FE / 256, G, bx, (const char*)(ws + WS_XG), (const char*)(ws + WS_MGU), (size_t)256 * D, (size_t)2 * FE * D, (size_t)256 * D, tb};
        pg8::EpiSwiGLU8 E{ws + WS_ACTS, FE, 8.f}; pg8::gemm_phase<pg8::EpiSwiGLU8, MoeOrder, true, true, true>(lds, pg8::Dims{D / 2, D / 2, D / 2, 127 - 4, 127 - 7}, S, E); }
    SEAM(17);
    PH(18) { MoeOrder S{D / 256, G, bx, (const char*)(ws + WS_ACTS), (const char*)(ws + WS_MDOWN), (size_t)256 * FE, (size_t)D * FE, (size_t)256 * FE, tb};
        EpiMoeDown E{(bf16_t*)(ws + WS_Y1), ROWINFO, EW, tb}; pg8::gemm_phase<EpiMoeDown, MoeOrder, true, true, true>(lds, pg8::Dims{FE / 2, FE / 2, FE / 2, 127 - 3, 127 - 8}, S, E); }
    SEAM(18);
    PH(19) { const bf16_t* Yb = (const bf16_t*)(ws + WS_Y1); const unsigned bad = xb_ld(ctl + CW_BAR + XB_TMO);
#if TPROBE
        const float* tkp = (const float*)(ws + WS_END2 + 2 * MiB); const float pfac = 1.0f + 0.25f * (tkp[TPROBE - 1] / tkp[2]);
#else
        const float pfac = 1.0f;
#endif
        u32x2 xn[4], y0n[4], y1n[4]; f32x4 gfin[4];
#define P19_LOAD(mm) do { _Pragma("unroll") for (int j = 0; j < 4; ++j) { xn[j] = *(const u32x2*)(XH + (size_t)(mm) * D + 4 * lane + 256 * j); \
            y0n[j] = *(const u32x2*)(Yb + (size_t)(mm) * D + 4 * lane + 256 * j); y1n[j] = *(const u32x2*)(Yb + ((size_t)M + (mm)) * D + 4 * lane + 256 * j); } } while (0)
        P19_LOAD(gw < M ? gw : 0);
#pragma unroll
        for (int j = 0; j < 4; ++j) gfin[j] = *((const f32x4*)A_IN(I_NORM_FINAL) + lane + 64 * j);
        for (int m = gw; m < M; m += NGW) { f32x4 v[4]; u32x2 y0[4], y1[4];
#pragma unroll
            for (int j = 0; j < 4; ++j) { v[j] = (f32x4){bflo(xn[j].x), bfhi(xn[j].x), bflo(xn[j].y), bfhi(xn[j].y)}; y0[j] = y0n[j]; y1[j] = y1n[j]; }
            P19_LOAD(m + NGW < M ? m + NGW : m);
#pragma unroll
            for (int j = 0; j < 4; ++j) v[j] = v[j] + ((f32x4){bflo(y0[j].x), bfhi(y0[j].x), bflo(y0[j].y), bfhi(y0[j].y)} + (f32x4){bflo(y1[j].x), bfhi(y1[j].x), bflo(y1[j].y), bfhi(y1[j].y)});
            const float rstd = bad ? __builtin_nanf("") : row_rstd(v); f32x4* o = (f32x4*)(xs + (size_t)m * D) + lane;
#pragma unroll
            for (int j = 0; j < 4; ++j) o[64 * j] = v[j] * (rstd * pfac) * gfin[j]; }
#undef P19_LOAD
    }
#undef IN
#undef SEAM
}

extern "C" void kernel_launch(void* const* d_in, const int* in_sizes, int n_in, void* d_out, int out_size, void* d_ws, size_t ws_size, hipStream_t stream) {
    static int grid = 0;
    if (grid == 0) {
        if (n_in != 22 || out_size != M * D || ws_size < WS_END2) { fprintf(stderr, "kernel_launch: unexpected shapes (n_in %d, out %d, ws %zu < %zu)\n", n_in, out_size, ws_size, (size_t)WS_END); grid = -1; return; }
        int dev = 0, cus = 0, per_cu = 0;
        if (hipGetDevice(&dev) != hipSuccess || hipDeviceGetAttribute(&cus, hipDeviceAttributeMultiprocessorCount, dev) != hipSuccess) { grid = -1; return; }
        if (hipFuncSetAttribute((const void*)yoco_fwd, hipFuncAttributeMaxDynamicSharedMemorySize, LDS_BYTES) != hipSuccess) { fprintf(stderr, "kernel_launch: hipFuncSetAttribute failed\n"); grid = -1; return; }
        if (hipOccupancyMaxActiveBlocksPerMultiprocessor(&per_cu, (const void*)yoco_fwd, NTHR, LDS_BYTES) != hipSuccess || per_cu < 1) fprintf(stderr, "kernel_launch: occupancy query says %d\n", per_cu);
        (void)hipGetLastError();
        grid = cus;
    }
    if (grid < 0) return;
    (void)hipMemsetAsync((char*)d_ws + WS_CTL, 0, CTL_ZERO_BYTES, stream);
    Args a{};
    for (int i = 0; i < 22; ++i) a.in[i] = (const float*)d_in[i];
    a.out = (float*)d_out; a.ws = (unsigned char*)d_ws;
#if MK_PER_PHASE
    for (int p = 0; p < NPHASE; ++p) { a.ph_lo = p; a.ph_hi = p + 1; hipLaunchKernelGGL(yoco_fwd, dim3(grid), dim3(NTHR), LDS_BYTES, stream, a); }
#else
    a.ph_lo = 0; a.ph_hi = NPHASE; hipLaunchKernelGGL(yoco_fwd, dim3(grid), dim3(NTHR), LDS_BYTES, stream, a);
#endif
}
```

```cpp
#include <hip/hip_runtime.h>
#include <cstdio>
#include <cstdint>

#ifndef MK_PER_PHASE
#define MK_PER_PHASE 0
#endif

#define LAS __attribute__((address_space(3)))
#define GAS __attribute__((address_space(1)))
typedef unsigned short bf16_t;
typedef short bf16x8 __attribute__((ext_vector_type(8)));
typedef float f32x4 __attribute__((ext_vector_type(4)));
typedef float f32x2 __attribute__((ext_vector_type(2)));
typedef unsigned u32x4 __attribute__((ext_vector_type(4)));
typedef unsigned u32x2 __attribute__((ext_vector_type(2)));
typedef unsigned long long u64;

constexpr int BATCH = 8, SEQ = 4096, D = 1024, M = BATCH * SEQ;
constexpr int A_HEADS = 4, A_HD = 256, NPROJ = 4096, NPROJ_SRC = 4104;
constexpr int FFD = 2816, NE = 8, FE = 3584;
constexpr int KVG = 4, HD = 64, NH = 16, NKVQ = 2816, NQSRC = 1072;
constexpr float EPS = 1e-6f;
constexpr int MOE_MAXT = 264;
constexpr int MOE_ROWS = MOE_MAXT * 256;

constexpr size_t MiB = 1u << 20;
constexpr size_t WS_CTL = 0, CTL_ZERO_BYTES = 1 * MiB;
constexpr size_t WS_SMALL = 1 * MiB;
constexpr size_t WS_WIN = 2 * MiB, WS_WOUTA = 10 * MiB, WS_WGU = 12 * MiB, WS_WDOWN = 23 * MiB, WS_WKVQ = 29 * MiB, WS_WCMP1 = 35 * MiB, WS_WOUTB = 37 * MiB;
constexpr size_t WS_MGU = 40 * MiB, WS_MDOWN = 152 * MiB, WS_XH = 208 * MiB, WS_GA = 272 * MiB, WS_ROWINFO = 273 * MiB, WS_BIG = 274 * MiB;
constexpr size_t WS_PROJ3 = WS_BIG, WS_OG = WS_BIG + 192 * MiB, WS_IMG = WS_BIG + 256 * MiB, WS_DN = WS_BIG + 536 * MiB, WS_HS = WS_BIG, WS_HN = WS_BIG + 128 * MiB;
constexpr size_t IMG_Q = 0, IMG_K = 34816, IMG_KT = 67584, IMG_VT = 100352, IMG_G = 141312, IMG_STRIDE = 142080;
static_assert((size_t)2048 * IMG_STRIDE <= 280 * MiB, "scan images");
constexpr size_t WS_ACT = WS_BIG;
constexpr size_t WS_KV = WS_BIG, WS_QB = WS_BIG + 96 * MiB, WS_GATEB = WS_BIG + 160 * MiB, WS_HID = WS_BIG + 166 * MiB, WS_KC = WS_BIG + 174 * MiB, WS_VC = WS_BIG + 175 * MiB, WS_OB = WS_BIG + 176 * MiB, WS_VT2 = WS_BIG + 240 * MiB;
constexpr size_t WS_XG = WS_BIG, WS_ACTS = WS_BIG + 132 * MiB, WS_Y1 = WS_BIG;
constexpr size_t WS_END = WS_BIG + 594 * MiB;
constexpr size_t WS_W2T = WS_SMALL + 524288;
constexpr size_t WS_SSP = WS_END, WS_RS = WS_END + 2 * MiB, WS_END2 = WS_END + 3 * MiB;
static_assert((size_t)MOE_ROWS * 1024 * 2 <= 132 * MiB && (size_t)MOE_ROWS * FE * 2 <= 462 * MiB, "moe buffers");
constexpr int CW_BAR = 4096;

constexpr int NWAVES = 8, NTHR = 512;
constexpr int LDS_BYTES = 163840;
constexpr int MISC_OFF = 163840 - 256;

__device__ __forceinline__ unsigned f2bf(float f) { unsigned u = __builtin_bit_cast(unsigned, f); return (u + 0x7fffu + ((u >> 16) & 1u)) >> 16; }
__device__ __forceinline__ unsigned pk2(float lo, float hi) { return f2bf(lo) | (f2bf(hi) << 16); }
__device__ __forceinline__ float bf2f(unsigned short b) { return __builtin_bit_cast(float, ((unsigned)b) << 16); }
__device__ __forceinline__ float bflo(unsigned w) { return __builtin_bit_cast(float, w << 16); }
__device__ __forceinline__ float bfhi(unsigned w) { return __builtin_bit_cast(float, w & 0xffff0000u); }
__device__ __forceinline__ float wave_sum(float v) {
#pragma unroll
    for (int o = 1; o < 64; o <<= 1) v += __shfl_xor(v, o);
    return v;
}
__device__ __forceinline__ float sigmoidf_(float x) { return __builtin_amdgcn_rcpf(1.0f + __builtin_amdgcn_exp2f(-1.4426950408889634f * x)); }
__device__ __forceinline__ float siluf_(float x) { return x * __builtin_amdgcn_rcpf(1.0f + __builtin_amdgcn_exp2f(-1.4426950408889634f * x)); }
__device__ __forceinline__ float ex2(float x) { return __builtin_amdgcn_exp2f(x); }
__device__ __forceinline__ unsigned pk_fp8x4(float a, float b, float c, float d) { unsigned w = 0u; w = __builtin_amdgcn_cvt_pk_fp8_f32(a, b, w, false); w = __builtin_amdgcn_cvt_pk_fp8_f32(c, d, w, true); return w; }
#define LDS_WAIT() asm volatile("s_waitcnt lgkmcnt(0)" ::: "memory")
#define LDS_BARRIER() do { asm volatile("s_waitcnt lgkmcnt(0)" ::: "memory"); __builtin_amdgcn_s_barrier(); asm volatile("" ::: "memory"); } while (0)

#define XB_TMO      128
#define XB_XCNT(j)  (256  + 64 * (j))
#define XB_XSUB(j)  (1280 + 64 * (j))
#define XB_XGEN(j)  (2304 + 64 * (j))
#define XB_TOP      3328
#define XB_TOPGEN   3392
#define XCD_BAR_WORDS 3456
#define XB_SPIN_CAP (1u << 22)
__device__ __forceinline__ unsigned xb_ld(unsigned* p)              { return __hip_atomic_load(p, __ATOMIC_RELAXED, __HIP_MEMORY_SCOPE_AGENT); }
__device__ __forceinline__ unsigned xb_add(unsigned* p, unsigned v) { return __hip_atomic_fetch_add(p, v, __ATOMIC_RELAXED, __HIP_MEMORY_SCOPE_AGENT); }
__device__ __forceinline__ unsigned xb_xcc_id() { return (unsigned)__builtin_amdgcn_s_getreg((3 << 11) | 20) & 0xFu; }
#define XB_SPIN(cond, bar) do { unsigned _sp = 0; while (cond) { __builtin_amdgcn_s_sleep(1); \
    if ((++_sp & 255u) == 0u) { if (xb_ld(&(bar)[XB_TMO])) break; if (_sp > XB_SPIN_CAP) { atomicAdd(&(bar)[XB_TMO], 1u); break; } } } } while (0)
struct XcdBarrier { unsigned* bar; unsigned x; volatile LAS unsigned* st; };
__device__ __forceinline__ XcdBarrier xcd_barrier_post(unsigned* bar, volatile LAS unsigned* st) {
    XcdBarrier b; b.bar = bar; b.x = xb_xcc_id(); b.st = st;
    if (threadIdx.x == 0) (void)xb_add(&bar[XB_XCNT(b.x)], 1u);
    return b;
}
__device__ __forceinline__ void xcd_barrier_complete(unsigned* bar, unsigned x, unsigned& nloc, unsigned& nx) {
    const unsigned G = gridDim.x * gridDim.y * gridDim.z;
    unsigned sum, cnt, mine, sp = 0u;
    for (;;) {
        sum = 0u; cnt = 0u; mine = 0u;
#pragma unroll
        for (unsigned j = 0; j < 16; ++j) { const unsigned c = xb_ld(&bar[XB_XCNT(j)]); sum += c; cnt += (c > 0u) ? 1u : 0u; mine = (j == x) ? c : mine; }
        if (sum == G) break;
        __builtin_amdgcn_s_sleep(1);
        if ((++sp & 255u) == 0u) { if (xb_ld(&bar[XB_TMO])) break; if (sp > XB_SPIN_CAP) { atomicAdd(&bar[XB_TMO], 1u); break; } }
    }
    nloc = mine > 0u ? mine : 1u; nx = cnt > 0u ? cnt : 1u;
}
__device__ __forceinline__ void xcd_barrier(const XcdBarrier& b) {
    asm volatile("s_waitcnt vmcnt(0)" ::: "memory");
    __syncthreads();
    if (threadIdx.x == 0) {
        unsigned* bar = b.bar;
        __builtin_amdgcn_s_waitcnt(0);
        unsigned nloc = b.st[0], nx = b.st[1];
        if (nloc == 0u) { xcd_barrier_complete(bar, b.x, nloc, nx); b.st[0] = nloc; b.st[1] = nx; }
        const unsigned old = xb_add(&bar[XB_XSUB(b.x)], 1u);
        const unsigned gen = old / nloc;
        if (old + 1u == (gen + 1u) * nloc) {
            __builtin_amdgcn_fence(__ATOMIC_RELEASE, "agent");
            asm volatile("s_waitcnt vmcnt(0)" ::: "memory");
            const unsigned og = xb_add(&bar[XB_TOP], 1u);
            const unsigned tg = og / nx;
            if (og + 1u == (tg + 1u) * nx) xb_add(&bar[XB_TOPGEN], 1u);
            else XB_SPIN(xb_ld(&bar[XB_TOPGEN]) == tg, bar);
            __builtin_amdgcn_fence(__ATOMIC_ACQUIRE, "agent");
            xb_add(&bar[XB_XGEN(b.x)], 1u);
            asm volatile("s_waitcnt vmcnt(0)" ::: "memory");
        } else {
            XB_SPIN(xb_ld(&bar[XB_XGEN(b.x)]) == gen, bar);
            __builtin_amdgcn_fence(__ATOMIC_ACQUIRE, "agent");
            asm volatile("s_waitcnt vmcnt(0)" ::: "memory");
        }
    }
    __syncthreads();
}

#ifndef EXPT
#define EXPT 0
#endif
#ifndef TSEG
#define TSEG 0
#endif
#if TSEG
#define TS_B(k) do { if (TSEG & (1 << (k))) tseg_t = __builtin_amdgcn_s_memrealtime(); } while (0)
#define TS_E(k) do { if (TSEG & (1 << (k))) tseg_acc += __builtin_amdgcn_s_memrealtime() - tseg_t; } while (0)
#else
#define TS_B(k)
#define TS_E(k)
#endif
#ifndef TPROBE
#define TPROBE 0
#endif
namespace pg8 {
constexpr int BM = 256, BK = 64, HALF = 128, HTB = HALF * BK * 2, STAGE_BYTES = 8 * HTB, NXCD = 8, WGM = 8;
__host__ __device__ __forceinline__ int lds_byte(int r, int c) { const int st = (r >> 4) * 2 + (c >> 5), rr = r & 15, cc = c & 31, ob = rr * 64 + cc * 2; return st * 1024 + (ob ^ (((ob >> 9) & 1) << 5)); }
__host__ __device__ __forceinline__ void stage_rc(int b, int& R, int& C) { const int st = b / 1024, sb = b % 1024, swz = sb ^ (((sb >> 9) & 1) << 5); R = (st >> 1) * 16 + swz / 64; C = (st & 1) * 32 + (swz % 64) / 2; }
__host__ __device__ __forceinline__ int perm32(int rho) { const int n = rho >> 4, i = rho & 15; return 8 * (i >> 2) + 4 * n + (i & 3); }
struct Unit { int pm, pn; const char* a; const char* b; };
struct Dims { int K, lda, ldb; int sa = 127, sb = 127; float* tk = nullptr; };
typedef __bf16 bf16x2_t __attribute__((ext_vector_type(2)));
__device__ __forceinline__ unsigned cvt_pk_bf16(float lo, float hi) { const f32x2 v = {lo, hi}; const bf16x2_t b = __builtin_convertvector(v, bf16x2_t); return __builtin_bit_cast(unsigned, b); }

__device__ __forceinline__ bool tile_order(int i, int G, int c, int nM, int nN, int& pm, int& pn) {
    const int nwg = nM * nN; const long L = (long)i * G + c; if (L >= nwg) return false;
    int wgid = (int)L; { const int q = nwg / NXCD, r = nwg % NXCD, xcd = wgid % NXCD, off = wgid / NXCD; wgid = (xcd < r ? xcd * (q + 1) : r * (q + 1) + (xcd - r) * q) + off; }
    const int nig = WGM * nN, gid = wgid / nig, fm = gid * WGM, gsz = (nM - fm) < WGM ? (nM - fm) : WGM;
    pm = fm + ((wgid % nig) % gsz); pn = (wgid % nig) / gsz; return true;
}
struct PlainOrder {
    int nM, nN, G, c; const char* A; const char* B; size_t tA, tB; int same = 0;
    __device__ __forceinline__ void init(const bf16_t* A_, const bf16_t* B_, int M_, int N_, int lda, int ldb, int G_, int c_) { nM = M_ / BM; nN = N_ / BM; G = G_; c = c_; A = (const char*)A_; B = (const char*)B_; tA = (size_t)BM * lda * 2; tB = (size_t)BM * ldb * 2; }
    __device__ __forceinline__ bool next(int i, Unit& u) const { if (EXPT && same) { if (i >= same) return false; u.pm = 0; u.pn = i; u.a = A; u.b = B + (size_t)i * tB; return true; }
        if (!tile_order(i, G, c, nM, nN, u.pm, u.pn)) return false; u.a = A + (size_t)u.pm * tA; u.b = B + (size_t)u.pn * tB; return true; }
};

template <class Epi, class Sched, bool ALIGN_EPI = true, bool SP2 = true, bool FP8 = false>
__device__ __forceinline__ void gemm_phase(LAS unsigned char* lds, const Dims g, const Sched& S, const Epi& E) {
    const int tid = threadIdx.x, wid = __builtin_amdgcn_readfirstlane(tid >> 6), lane = tid & 63, wr = wid >> 2, wc = wid & 3, fr = lane & 15, fq = lane >> 4;
    const int K = g.K, nt = K / BK;
    unsigned voffA[2], voffB[2];
#pragma unroll
    for (int i = 0; i < 2; ++i) { int R, C; stage_rc(tid * 16 + i * 8192, R, C); const int Rb = Epi::PERM ? ((R & ~31) + perm32(R & 31)) : R;
        voffA[i] = (unsigned)(R * g.lda + C) * 2u; voffB[i] = (unsigned)(Rb * g.ldb + C) * 2u; }
    const size_t kstep = (size_t)(BK * 2);
    const size_t hstepA = (size_t)HALF * g.lda * 2, hstepB = (size_t)HALF * g.ldb * 2;
    const unsigned ldsw = (unsigned)wid * 1024u;
    const int aoff = lds_byte(wr * 64 + fr, fq * 8), boff = lds_byte(wc * 32 + fr, fq * 8);
#define PG8_SA(b, h) (((b) * 2 + (h)) * HTB)
#define PG8_SB(b, h) ((4 + (b) * 2 + (h)) * HTB)
#define PG8_STAGE(bufoff, gbase, voff) do { _Pragma("unroll") for (int _i = 0; _i < 2; ++_i) \
        __builtin_amdgcn_global_load_lds((const unsigned*)((const char*)(gbase) + (voff)[_i]), (LAS unsigned*)(lds + (bufoff) + ldsw + _i * 8192), 16, 0, 0); } while (0)
    typedef int v8i_t __attribute__((ext_vector_type(8))); typedef int v4i_t __attribute__((ext_vector_type(4)));
#define PG8_RD8(p) __builtin_shufflevector(*(const LAS v4i_t*)(p), *(const LAS v4i_t*)((p) + 1024), 0, 1, 2, 3, 4, 5, 6, 7)
#define PG8_LDA(dst, b, h) do { if constexpr (FP8) { _Pragma("unroll") for (int m = 0; m < 4; ++m) dst##8[m] = PG8_RD8(lds + PG8_SA(b, h) + aoff + m * 2048); } \
        else { _Pragma("unroll") for (int m = 0; m < 4; ++m) _Pragma("unroll") for (int k = 0; k < 2; ++k) dst[m][k] = *(const LAS bf16x8*)(lds + PG8_SA(b, h) + aoff + m * 2048 + k * 1024); } } while (0)
#define PG8_LDB(dst, b, h) do { if constexpr (FP8) { _Pragma("unroll") for (int n = 0; n < 2; ++n) dst##8[n] = PG8_RD8(lds + PG8_SB(b, h) + boff + n * 2048); } \
        else { _Pragma("unroll") for (int n = 0; n < 2; ++n) _Pragma("unroll") for (int k = 0; k < 2; ++k) dst[n][k] = *(const LAS bf16x8*)(lds + PG8_SB(b, h) + boff + n * 2048 + k * 1024); } } while (0)
#define PG8_MMA(ai, bj, At, Bt) do { __builtin_amdgcn_s_setprio(1); \
        if constexpr (FP8) { _Pragma("unroll") for (int m = 0; m < 4; ++m) _Pragma("unroll") for (int n = 0; n < 2; ++n) \
            asm volatile("v_mfma_scale_f32_16x16x128_f8f6f4 %0, %1, %2, %0, %3, %4 op_sel_hi:[0,0,0]" : "+v"(acc[ai][bj][m][n]) : "v"(Bt##8[n]), "v"(At##8[m]), "v"(sbv), "v"(sav)); } \
        else { _Pragma("unroll") for (int m = 0; m < 4; ++m) _Pragma("unroll") for (int n = 0; n < 2; ++n) _Pragma("unroll") for (int k = 0; k < 2; ++k) \
            acc[ai][bj][m][n] = __builtin_amdgcn_mfma_f32_16x16x32_bf16(Bt[n][k], At[m][k], acc[ai][bj][m][n], 0, 0, 0); } \
        __builtin_amdgcn_s_setprio(0); } while (0)
#define PG8_WAIT_V(n) asm volatile("s_waitcnt vmcnt(" #n ")" ::: "memory")
#define PG8_WAIT_L(n) asm volatile("s_waitcnt lgkmcnt(" #n ")" ::: "memory")
#define PG8_BAR __builtin_amdgcn_s_barrier()
#define PG8_SCHED __builtin_amdgcn_sched_barrier(0)
    Unit cur, nxt; int ui = 0;
    if (!S.next(0, cur)) return;
    f32x4 acc[2][2][4][2];
#pragma unroll
    for (int a = 0; a < 2; ++a)
#pragma unroll
        for (int b = 0; b < 2; ++b)
#pragma unroll
            for (int m = 0; m < 4; ++m)
#pragma unroll
                for (int n = 0; n < 2; ++n) acc[a][b][m][n] = (f32x4){0.f, 0.f, 0.f, 0.f};
    bf16x8 At[4][2], B0[2][2], B1[2][2]; v8i_t At8[4], B08[2], B18[2];
    const int sbv = g.sb, sav = g.sa;
    const char* cA = cur.a; const char* cB = cur.b;
    if constexpr (SP2) {
        PG8_STAGE(PG8_SB(0, 0), cB, voffB); PG8_STAGE(PG8_SB(0, 1), cB + hstepB, voffB); PG8_STAGE(PG8_SA(0, 0), cA, voffA); PG8_STAGE(PG8_SA(0, 1), cA + hstepA, voffA);
        if (wr == 1) PG8_BAR;
        PG8_WAIT_V(2); PG8_BAR;
        PG8_STAGE(PG8_SB(1, 0), cB + kstep, voffB); PG8_STAGE(PG8_SA(1, 0), cA + kstep, voffA); PG8_STAGE(PG8_SB(1, 1), cB + hstepB + kstep, voffB);
        PG8_WAIT_V(6); PG8_BAR;
    } else {
        PG8_STAGE(PG8_SB(0, 0), cB, voffB); PG8_STAGE(PG8_SA(0, 0), cA, voffA); PG8_STAGE(PG8_SB(0, 1), cB + hstepB, voffB); PG8_STAGE(PG8_SA(0, 1), cA + hstepA, voffA);
        if (wr == 1) PG8_BAR;
        PG8_WAIT_V(4); PG8_BAR;
        PG8_STAGE(PG8_SB(1, 0), cB + kstep, voffB); PG8_STAGE(PG8_SA(1, 0), cA + kstep, voffA); PG8_STAGE(PG8_SB(1, 1), cB + hstepB + kstep, voffB);
        PG8_WAIT_V(6); PG8_BAR;
    }
#if TPROBE
    unsigned long long tk_acc = 0, te_acc = 0;
#endif
    for (;;) {
        const bool has_next = S.next(ui + 1, nxt);
#if TPROBE
        const unsigned long long tk0 = __builtin_amdgcn_s_memrealtime();
#endif
        const char* nA = has_next ? nxt.a : cA; const char* nB = has_next ? nxt.b : cB;
#pragma unroll 1
        for (int t = 0; t < nt; t += 2) {
            const bool last = (t == nt - 2);
            const char* a1 = cA + (size_t)(t + 1) * kstep;
            const char* a2 = last ? nA : cA + (size_t)(t + 2) * kstep; const char* b2 = last ? nB : cB + (size_t)(t + 2) * kstep;
            const char* a3 = a2 + kstep; const char* b3 = b2 + kstep;
            if constexpr (SP2) {
            PG8_LDB(B0, 0, 0); PG8_LDB(B1, 0, 1); PG8_SCHED; PG8_LDA(At, 0, 0); PG8_STAGE(PG8_SA(1, 1), a1 + hstepA, voffA);
            PG8_WAIT_V(8); PG8_WAIT_L(0); PG8_BAR; PG8_MMA(0, 0, At, B0); PG8_MMA(0, 1, At, B1); PG8_BAR; PG8_SCHED;
            PG8_LDA(At, 0, 1); PG8_STAGE(PG8_SB(0, 0), b2, voffB); PG8_STAGE(PG8_SB(0, 1), b2 + hstepB, voffB); PG8_STAGE(PG8_SA(0, 0), a2, voffA);
            PG8_WAIT_V(8); PG8_WAIT_L(0); PG8_BAR; PG8_MMA(1, 0, At, B0); PG8_MMA(1, 1, At, B1); PG8_BAR; PG8_SCHED;
            PG8_LDB(B0, 1, 0); PG8_LDB(B1, 1, 1); PG8_SCHED; PG8_LDA(At, 1, 0); PG8_STAGE(PG8_SA(0, 1), a2 + hstepA, voffA);
            PG8_WAIT_V(8); PG8_WAIT_L(0); PG8_BAR; PG8_MMA(0, 0, At, B0); PG8_MMA(0, 1, At, B1); PG8_BAR; PG8_SCHED;
            PG8_LDA(At, 1, 1); PG8_STAGE(PG8_SB(1, 0), b3, voffB); PG8_STAGE(PG8_SB(1, 1), b3 + hstepB, voffB); PG8_STAGE(PG8_SA(1, 0), a3, voffA);
            PG8_WAIT_V(8); PG8_WAIT_L(0); PG8_BAR; PG8_MMA(1, 0, At, B0); PG8_MMA(1, 1, At, B1); PG8_BAR; PG8_SCHED;
            } else {
            PG8_LDB(B0, 0, 0); PG8_SCHED; PG8_LDA(At, 0, 0); PG8_STAGE(PG8_SA(1, 1), a1 + hstepA, voffA);
            PG8_WAIT_L(8); PG8_BAR; PG8_WAIT_L(0); PG8_MMA(0, 0, At, B0); PG8_BAR; PG8_SCHED;
            PG8_LDB(B1, 0, 1); PG8_STAGE(PG8_SB(0, 0), b2, voffB);
            PG8_BAR; PG8_WAIT_L(0); PG8_MMA(0, 1, At, B1); PG8_BAR;
            PG8_LDA(At, 0, 1); PG8_STAGE(PG8_SA(0, 0), a2, voffA);
            PG8_BAR; PG8_WAIT_L(0); PG8_MMA(1, 0, At, B0); PG8_BAR; PG8_SCHED;
            PG8_STAGE(PG8_SB(0, 1), b2 + hstepB, voffB);
            PG8_WAIT_V(6); PG8_BAR; PG8_MMA(1, 1, At, B1); PG8_BAR;
            PG8_LDB(B0, 1, 0); PG8_SCHED; PG8_LDA(At, 1, 0); PG8_STAGE(PG8_SA(0, 1), a2 + hstepA, voffA);
            PG8_WAIT_L(8); PG8_BAR; PG8_WAIT_L(0); PG8_MMA(0, 0, At, B0); PG8_BAR; PG8_SCHED;
            PG8_LDB(B1, 1, 1); PG8_STAGE(PG8_SB(1, 0), b3, voffB);
            PG8_BAR; PG8_WAIT_L(0); PG8_MMA(0, 1, At, B1); PG8_BAR;
            PG8_LDA(At, 1, 1); PG8_STAGE(PG8_SA(1, 0), a3, voffA);
            PG8_BAR; PG8_WAIT_L(0); PG8_MMA(1, 0, At, B0); PG8_BAR; PG8_SCHED;
            PG8_STAGE(PG8_SB(1, 1), b3 + hstepB, voffB);
            PG8_WAIT_V(6); PG8_BAR; PG8_MMA(1, 1, At, B1); PG8_BAR;
            }
        }
#if TPROBE
        const unsigned long long tk1 = __builtin_amdgcn_s_memrealtime(); tk_acc += tk1 - tk0;
#endif
        if constexpr (ALIGN_EPI) { if (wr == 0) PG8_BAR; }
        if constexpr (FP8) asm volatile("s_nop 15\n\ts_nop 15" ::: "memory");
        E(acc, cur, wr, wc, fr, fq);
#if TPROBE
        te_acc += __builtin_amdgcn_s_memrealtime() - tk1;
#endif
        if (!has_next) break;
#pragma unroll
        for (int a = 0; a < 2; ++a)
#pragma unroll
            for (int b = 0; b < 2; ++b)
#pragma unroll
                for (int m = 0; m < 4; ++m)
#pragma unroll
                    for (int n = 0; n < 2; ++n) acc[a][b][m][n] = (f32x4){0.f, 0.f, 0.f, 0.f};
        cur = nxt; cA = nA; cB = nB; ++ui;
        if constexpr (ALIGN_EPI) { if (wr == 1) PG8_BAR; }
    }
    PG8_WAIT_V(0);
    if constexpr (!ALIGN_EPI) { if (wr == 0) PG8_BAR; }
    PG8_BAR;
#if TPROBE
    if (g.tk && tid == 0) { g.tk[0] = (float)tk_acc; g.tk[1] = (float)te_acc; }
#endif
#undef PG8_SA
#undef PG8_SB
#undef PG8_STAGE
#undef PG8_LDA
#undef PG8_LDB
#undef PG8_MMA
#undef PG8_RD8
#undef PG8_WAIT_V
#undef PG8_WAIT_L
#undef PG8_BAR
#undef PG8_SCHED
}

typedef const f32x4 (&AccRef)[2][2][4][2];
struct EpiBf16Plain {
    static constexpr bool PERM = true;
    bf16_t* O; int ldc;
    __device__ __forceinline__ void operator()(AccRef acc, const Unit& u, int wr, int wc, int fr, int fq) const {
        const int row0 = u.pm * BM + wr * 64 + fr, col0 = u.pn * BM + wc * 32 + 8 * fq;
#pragma unroll
        for (int ai = 0; ai < 2; ++ai)
#pragma unroll
            for (int m = 0; m < 4; ++m) { bf16_t* rowp = O + (size_t)(row0 + ai * HALF + m * 16) * ldc + col0;
#pragma unroll
                for (int bj = 0; bj < 2; ++bj) { const f32x4 v0 = acc[ai][bj][m][0], v1 = acc[ai][bj][m][1];
                    u32x4 w; w.x = cvt_pk_bf16(v0[0], v0[1]); w.y = cvt_pk_bf16(v0[2], v0[3]); w.z = cvt_pk_bf16(v1[0], v1[1]); w.w = cvt_pk_bf16(v1[2], v1[3]);
                    *(u32x4*)(rowp + bj * HALF) = w; } }
    }
};
struct EpiProjSplit {
    static constexpr bool PERM = true;
    bf16_t* P3; bf16_t* OG;
    __device__ __forceinline__ void operator()(AccRef acc, const Unit& u, int wr, int wc, int fr, int fq) const {
        const int row0 = u.pm * BM + wr * 64 + fr; const bool og = u.pn >= 12; const int ldc = og ? 1024 : 3072; bf16_t* base = (og ? OG + (u.pn - 12) * BM : P3 + u.pn * BM) + wc * 32 + 8 * fq;
#pragma unroll
        for (int ai = 0; ai < 2; ++ai)
#pragma unroll
            for (int m = 0; m < 4; ++m) { bf16_t* rowp = base + (size_t)(row0 + ai * HALF + m * 16) * ldc;
#pragma unroll
                for (int bj = 0; bj < 2; ++bj) { const f32x4 v0 = acc[ai][bj][m][0], v1 = acc[ai][bj][m][1];
                    u32x4 w; w.x = cvt_pk_bf16(v0[0], v0[1]); w.y = cvt_pk_bf16(v0[2], v0[3]); w.z = cvt_pk_bf16(v1[0], v1[1]); w.w = cvt_pk_bf16(v1[2], v1[3]);
                    *(u32x4*)(rowp + bj * HALF) = w; } }
    }
};
struct EpiResF32 {
    static constexpr bool PERM = false;
    const float* base; float* out; int ldc;
    __device__ __forceinline__ void operator()(AccRef acc, const Unit& u, int wr, int wc, int fr, int fq) const {
        const int row0 = u.pm * BM + wr * 64 + fr, col0 = u.pn * BM + wc * 32 + 4 * fq;
#pragma unroll
        for (int ai = 0; ai < 2; ++ai)
#pragma unroll
            for (int m = 0; m < 4; ++m) { const size_t off = (size_t)(row0 + ai * HALF + m * 16) * ldc + col0;
#pragma unroll
                for (int bj = 0; bj < 2; ++bj)
#pragma unroll
                    for (int n = 0; n < 2; ++n) { const f32x4 bs = *(const f32x4*)(base + off + bj * HALF + n * 16); *(f32x4*)(out + off + bj * HALF + n * 16) = bs + acc[ai][bj][m][n]; } }
    }
};
__device__ __forceinline__ float row_rs16(const float* ss, int row) { const f32x4* p = (const f32x4*)(ss + (size_t)row * 16); const f32x4 a = p[0], b = p[1], c = p[2], d = p[3];
    const float t = (((a[0] + a[1]) + (a[2] + a[3])) + ((b[0] + b[1]) + (b[2] + b[3]))) + (((c[0] + c[1]) + (c[2] + c[3])) + ((d[0] + d[1]) + (d[2] + d[3]))); return 1.0f / sqrtf(t * (1.f / 1024.f) + EPS); }
struct EpiResF32Stat {
    static constexpr bool PERM = false;
    const float* base; float* out; bf16_t* XHo; float* SS; int ldc;
    __device__ __forceinline__ void operator()(AccRef acc, const Unit& u, int wr, int wc, int fr, int fq) const {
        const int row0 = u.pm * BM + wr * 64 + fr, col0 = u.pn * BM + wc * 32 + 4 * fq;
#pragma unroll
        for (int ai = 0; ai < 2; ++ai)
#pragma unroll
            for (int m = 0; m < 4; ++m) { const int row = row0 + ai * HALF + m * 16; const size_t off = (size_t)row * ldc + col0; float ss = 0.f;
#pragma unroll
                for (int bj = 0; bj < 2; ++bj)
#pragma unroll
                    for (int n = 0; n < 2; ++n) { const f32x4 o = *(const f32x4*)(base + off + bj * HALF + n * 16) + acc[ai][bj][m][n]; *(f32x4*)(out + off + bj * HALF + n * 16) = o;
                        ss += (o[0] * o[0] + o[1] * o[1]) + (o[2] * o[2] + o[3] * o[3]);
                        u32x2 w; w.x = cvt_pk_bf16(o[0], o[1]); w.y = cvt_pk_bf16(o[2], o[3]); *(u32x2*)(XHo + off + bj * HALF + n * 16) = w; }
                ss += __shfl_xor(ss, 16); ss += __shfl_xor(ss, 32);
                if (fq == 0) SS[(size_t)row * 16 + u.pn * 4 + wc] = ss; }
    }
};
template <bool BASE16, bool STAT>
struct EpiRes16 {
    static constexpr bool PERM = true;
    const float* base32; bf16_t* XHo; float* SS; int ldc;
    __device__ __forceinline__ void operator()(AccRef acc, const Unit& u, int wr, int wc, int fr, int fq) const {
        const int row0 = u.pm * BM + wr * 64 + fr, col0 = u.pn * BM + wc * 32 + 8 * fq;
#pragma unroll
        for (int ai = 0; ai < 2; ++ai)
#pragma unroll
            for (int m = 0; m < 4; ++m) { const int row = row0 + ai * HALF + m * 16; const size_t off = (size_t)row * ldc + col0; float ss = 0.f;
#pragma unroll
                for (int bj = 0; bj < 2; ++bj) { f32x4 b0, b1;
                    if constexpr (BASE16) { const u32x4 r = *(const u32x4*)(XHo + off + bj * HALF); b0 = (f32x4){bflo(r.x), bfhi(r.x), bflo(r.y), bfhi(r.y)}; b1 = (f32x4){bflo(r.z), bfhi(r.z), bflo(r.w), bfhi(r.w)}; }
                    else { b0 = *(const f32x4*)(base32 + off + bj * HALF); b1 = *(const f32x4*)(base32 + off + bj * HALF + 4); }
                    const f32x4 o0 = b0 + acc[ai][bj][m][0], o1 = b1 + acc[ai][bj][m][1];
                    if constexpr (STAT) ss += ((o0[0] * o0[0] + o0[1] * o0[1]) + (o0[2] * o0[2] + o0[3] * o0[3])) + ((o1[0] * o1[0] + o1[1] * o1[1]) + (o1[2] * o1[2] + o1[3] * o1[3]));
                    u32x4 w; w.x = cvt_pk_bf16(o0[0], o0[1]); w.y = cvt_pk_bf16(o0[2], o0[3]); w.z = cvt_pk_bf16(o1[0], o1[1]); w.w = cvt_pk_bf16(o1[2], o1[3]);
                    *(u32x4*)(XHo + off + bj * HALF) = w; }
                if constexpr (STAT) { ss += __shfl_xor(ss, 16); ss += __shfl_xor(ss, 32);
                    if (fq == 0) SS[(size_t)row * 16 + u.pn * 4 + wc] = ss; } }
    }
};
struct EpiSwiGLU {
    static constexpr bool PERM = true;
    bf16_t* O; int ldc; const float* rsv;
    __device__ __forceinline__ void operator()(AccRef acc, const Unit& u, int wr, int wc, int fr, int fq) const {
        const int row0 = u.pm * BM + wr * 64 + fr, col0 = u.pn * HALF + wc * 32 + 8 * fq;
#pragma unroll
        for (int ai = 0; ai < 2; ++ai)
#pragma unroll
            for (int m = 0; m < 4; ++m) { const int row = row0 + ai * HALF + m * 16; bf16_t* rowp = O + (size_t)row * ldc + col0; const float rs = rsv ? rsv[row] : 1.0f;
                float o[8];
#pragma unroll
                for (int n = 0; n < 2; ++n)
#pragma unroll
                    for (int j = 0; j < 4; ++j) { const float gv = acc[ai][0][m][n][j] * rs, uv = acc[ai][1][m][n][j] * rs; o[n * 4 + j] = siluf_(gv) * uv; }
                u32x4 w; w.x = cvt_pk_bf16(o[0], o[1]); w.y = cvt_pk_bf16(o[2], o[3]); w.z = cvt_pk_bf16(o[4], o[5]); w.w = cvt_pk_bf16(o[6], o[7]);
                *(u32x4*)rowp = w; }
    }
};
struct EpiSwiGLU8 {
    static constexpr bool PERM = true;
    unsigned char* O8; int ldc; float oscale;
    __device__ __forceinline__ void operator()(AccRef acc, const Unit& u, int wr, int wc, int fr, int fq) const {
        const int row0 = u.pm * BM + wr * 64 + fr, col0 = u.pn * HALF + wc * 32 + 8 * fq;
#pragma unroll
        for (int ai = 0; ai < 2; ++ai)
#pragma unroll
            for (int m = 0; m < 4; ++m) { unsigned char* rowp = O8 + (size_t)(row0 + ai * HALF + m * 16) * ldc + col0;
                float o[8];
#pragma unroll
                for (int n = 0; n < 2; ++n)
#pragma unroll
                    for (int j = 0; j < 4; ++j) { const float gv = acc[ai][0][m][n][j], uv = acc[ai][1][m][n][j]; o[n * 4 + j] = siluf_(gv) * uv * oscale; }
                u32x2 w; w.x = pk_fp8x4(o[0], o[1], o[2], o[3]); w.y = pk_fp8x4(o[4], o[5], o[6], o[7]);
                *(u32x2*)rowp = w; }
    }
};
struct EpiKVQ {
    static constexpr bool PERM = true;
    bf16_t* KV; bf16_t* Q; float* GATE; const float* bgate; const float* rsv;
    __device__ __forceinline__ void operator()(AccRef acc, const Unit& u, int wr, int wc, int fr, int fq) const {
        const int row0 = u.pm * BM + wr * 64 + fr, cin = wc * 32 + 8 * fq;
#pragma unroll
        for (int ai = 0; ai < 2; ++ai)
#pragma unroll
            for (int m = 0; m < 4; ++m) { const int row = row0 + ai * HALF + m * 16; const float rs = rsv[row];
#pragma unroll
                for (int bj = 0; bj < 2; ++bj) { const f32x4 v0 = acc[ai][bj][m][0] * rs, v1 = acc[ai][bj][m][1] * rs; const int col = cin + bj * HALF;
                    if (u.pn < 6) { const int b = row >> 12, t = row & 4095, g = col >> 6, d = col & 63;
                        u32x4 w; w.x = cvt_pk_bf16(v0[0], v0[1]); w.y = cvt_pk_bf16(v0[2], v0[3]); w.z = cvt_pk_bf16(v1[0], v1[1]); w.w = cvt_pk_bf16(v1[2], v1[3]);
                        *(u32x4*)(KV + ((((size_t)u.pn * 8 + b) * 4 + g) * 4096 + t) * 64 + d) = w;
                    } else if (u.pn < 10) { const float s = 0.125f * 1.4426950408889634f;
                        u32x4 w; w.x = cvt_pk_bf16(v0[0] * s, v0[1] * s); w.y = cvt_pk_bf16(v0[2] * s, v0[3] * s); w.z = cvt_pk_bf16(v1[0] * s, v1[1] * s); w.w = cvt_pk_bf16(v1[2] * s, v1[3] * s);
                        *(u32x4*)(Q + (size_t)row * 1024 + (u.pn - 6) * 256 + col) = w;
                    } else if (col < 48) { const f32x4 b0 = *(const f32x4*)(bgate + col), b1 = *(const f32x4*)(bgate + col + 4);
                        f32x4 o0, o1;
#pragma unroll
                        for (int j = 0; j < 4; ++j) { o0[j] = sigmoidf_(v0[j] + b0[j]); o1[j] = sigmoidf_(v1[j] + b1[j]); }
                        *(f32x4*)(GATE + (size_t)row * 48 + col) = o0; *(f32x4*)(GATE + (size_t)row * 48 + col + 4) = o1; } } }
    }
};
struct EpiCmp {
    static constexpr bool PERM = true;
    bf16_t* O; const float* bias;
    __device__ __forceinline__ void operator()(AccRef acc, const Unit& u, int wr, int wc, int fr, int fq) const {
        const int row0 = u.pm * BM + wr * 64 + fr, col0 = wc * 32 + 8 * fq; const float* bp = bias + (u.pm >> 5) * 256 + col0;
#pragma unroll
        for (int ai = 0; ai < 2; ++ai)
#pragma unroll
            for (int m = 0; m < 4; ++m) { bf16_t* rowp = O + (size_t)(row0 + ai * HALF + m * 16) * 256 + col0;
#pragma unroll
                for (int bj = 0; bj < 2; ++bj) { const f32x4 b0 = *(const f32x4*)(bp + bj * HALF), b1 = *(const f32x4*)(bp + bj * HALF + 4);
                    const f32x4 v0 = acc[ai][bj][m][0] + b0, v1 = acc[ai][bj][m][1] + b1;
                    u32x4 w; w.x = cvt_pk_bf16(siluf_(v0[0]), siluf_(v0[1])); w.y = cvt_pk_bf16(siluf_(v0[2]), siluf_(v0[3])); w.z = cvt_pk_bf16(siluf_(v1[0]), siluf_(v1[1])); w.w = cvt_pk_bf16(siluf_(v1[2]), siluf_(v1[3]));
                    *(u32x4*)(rowp + bj * HALF) = w; } }
    }
};
}

struct MoeOrder {
    int nN, G, c; const char* A; const char* B; size_t tA, tBe, tBn; volatile LAS int* tb;
    __device__ __forceinline__ int expert_of(int pm) const { int e = 0;
#pragma unroll
        for (int i = 1; i < 8; ++i) e += (pm >= __builtin_amdgcn_readfirstlane(tb[i])) ? 1 : 0;
        return e; }
    __device__ __forceinline__ bool next(int i, pg8::Unit& u) const {
        const int nM = __builtin_amdgcn_readfirstlane(tb[8]);
        if (!pg8::tile_order(i, G, c, nM, nN, u.pm, u.pn)) return false;
        u.a = A + (size_t)u.pm * tA; u.b = B + (size_t)expert_of(u.pm) * tBe + (size_t)u.pn * tBn; return true; }
};
struct EpiMoeDown {
    static constexpr bool PERM = true;
    bf16_t* Y; const u32x2* rowinfo; const float* ew; volatile LAS int* tb;
    __device__ __forceinline__ void operator()(pg8::AccRef acc, const pg8::Unit& u, int wr, int wc, int fr, int fq) const {
        int e = 0;
#pragma unroll
        for (int i = 1; i < 8; ++i) e += (u.pm >= __builtin_amdgcn_readfirstlane(tb[i])) ? 1 : 0;
        const int nvalid = __builtin_amdgcn_readfirstlane(tb[16 + e]) - (u.pm - __builtin_amdgcn_readfirstlane(tb[e])) * 256;
        int rin0 = wr * 64 + fr; const int col0 = u.pn * 256 + wc * 32 + 8 * fq;
        asm volatile("" : "+v"(rin0));
#pragma unroll
        for (int ai = 0; ai < 2; ++ai)
#pragma unroll
            for (int m = 0; m < 4; ++m) { const int rin = rin0 + ai * 128 + m * 16;
                if (rin < nvalid) { const unsigned info = ((const unsigned*)rowinfo)[2 * ((size_t)u.pm * 256 + rin)]; const float w = ew[info];
                    bf16_t* dst = Y + ((size_t)(info & 1u) * M + (info >> 1)) * 1024 + col0;
#pragma unroll
                    for (int bj = 0; bj < 2; ++bj) { const f32x4 v0 = acc[ai][bj][m][0] * w, v1 = acc[ai][bj][m][1] * w;
                        u32x4 o; o.x = pg8::cvt_pk_bf16(v0[0], v0[1]); o.y = pg8::cvt_pk_bf16(v0[2], v0[3]); o.z = pg8::cvt_pk_bf16(v1[0], v1[1]); o.w = pg8::cvt_pk_bf16(v1[2], v1[3]);
                        *(u32x4*)(dst + bj * 128) = o; } } }
    }
};

__device__ __forceinline__ void conv_item(const float* W, int ld, int srcc0, int nvalid, bf16_t* WT, int ldd, int dstr0, const float* gain, int k0, int lane) {
    const int n4 = lane & 7, c = lane >> 3;
    f32x4 v[8];
#pragma unroll
    for (int i = 0; i < 8; ++i) { v[i] = (f32x4){0.f, 0.f, 0.f, 0.f};
        if (4 * n4 < nvalid) { v[i] = *(const f32x4*)(W + (size_t)(k0 + 8 * c + i) * ld + srcc0 + 4 * n4); if (gain) v[i] = v[i] * gain[k0 + 8 * c + i]; } }
#pragma unroll
    for (int j = 0; j < 4; ++j) { u32x4 o; o.x = pk2(v[0][j], v[1][j]); o.y = pk2(v[2][j], v[3][j]); o.z = pk2(v[4][j], v[5][j]); o.w = pk2(v[6][j], v[7][j]);
        *(u32x4*)(WT + (size_t)(dstr0 + 4 * n4 + j) * ldd + k0 + 8 * c) = o; }
}

struct W8 { const float* src; const float* gain; unsigned char* dst; int ld, ldd; float scale, gm, ga; };
__device__ __forceinline__ void conv8_load(const W8& d, int lane, f32x4 (&v)[16], f32x4 (&g)[4]) {
    const int n4 = lane & 7, c = lane >> 3;
#pragma unroll
    for (int i = 0; i < 16; ++i) v[i] = *(const f32x4*)(d.src + (size_t)(16 * c + i) * d.ld + 4 * n4);
#pragma unroll
    for (int q = 0; q < 4; ++q) g[q] = *(const f32x4*)(d.gain + 16 * c + 4 * q);
}
__device__ __forceinline__ void conv8_store(const W8& d, int lane, const f32x4 (&v)[16], const f32x4 (&g)[4]) {
    const int n4 = lane & 7, c = lane >> 3;
    f32x4 gs[4];
#pragma unroll
    for (int q = 0; q < 4; ++q) gs[q] = (g[q] * d.gm + d.ga) * d.scale;
#pragma unroll
    for (int j = 0; j < 4; ++j) { u32x4 o;
        o.x = pk_fp8x4(v[0][j] * gs[0].x, v[1][j] * gs[0].y, v[2][j] * gs[0].z, v[3][j] * gs[0].w);
        o.y = pk_fp8x4(v[4][j] * gs[1].x, v[5][j] * gs[1].y, v[6][j] * gs[1].z, v[7][j] * gs[1].w);
        o.z = pk_fp8x4(v[8][j] * gs[2].x, v[9][j] * gs[2].y, v[10][j] * gs[2].z, v[11][j] * gs[2].w);
        o.w = pk_fp8x4(v[12][j] * gs[3].x, v[13][j] * gs[3].y, v[14][j] * gs[3].z, v[15][j] * gs[3].w);
        *(u32x4*)(d.dst + (size_t)(4 * n4 + j) * d.ldd + 16 * c) = o; }
}

struct Args { const float* in[22]; float* out; unsigned char* ws; int ph_lo, ph_hi; };
typedef const __attribute__((address_space(4))) Args* CArgsP;
__device__ __forceinline__ CArgsP argp() { CArgsP p = (CArgsP)__builtin_amdgcn_kernarg_segment_ptr(); asm volatile("" : "+s"(p)); return p; }
#define A_IN(i) ((const float*)argp()->in[i])
enum { I_X = 0, I_NORM_MIX, I_NORM_FFN, I_A_W_IN, I_A_B_GATE, I_A_CONV, I_A_NORM_H, I_A_W_OUT, I_NORM_KV, I_B_W_KV, I_B_CMP_POS, I_B_CMP_W1, I_B_CMP_W2,
       I_B_W_Q, I_B_B_GATE, I_B_W_OUT, I_F_W_GU, I_F_W_DOWN, I_M_ROUTER, I_M_W_GU, I_M_W_DOWN, I_NORM_FINAL };

__device__ __forceinline__ W8 w8_decode(unsigned char* ws, int r) {
    constexpr int N8 = 8 * 8 * 224;
    W8 d;
    if (r < N8) { const int e = r / (8 * 224), rr = r % (8 * 224), kb = rr / 224, db = rr % 224, tile = db >> 3, w = db & 7; const int sc = (w < 4) ? (128 * tile + 32 * w) : (FE + 128 * tile + 32 * (w - 4));
        d.src = A_IN(I_M_W_GU) + (size_t)e * 1024 * 2 * FE + (size_t)(128 * kb) * (2 * FE) + sc; d.ld = 2 * FE; d.gain = A_IN(I_NORM_FFN) + 1024 + 128 * kb; d.scale = 128.f; d.gm = 1.f; d.ga = 0.f;
        d.dst = ws + WS_MGU + (size_t)e * 2 * FE * 1024 + (size_t)(32 * db) * 1024 + 128 * kb; d.ldd = 1024; }
    else { r -= N8; const int e = r / (28 * 32), rr = r % (28 * 32), kb = rr / 32, db = rr % 32;
        d.src = A_IN(I_M_W_DOWN) + (size_t)e * FE * 1024 + (size_t)(128 * kb) * 1024 + 32 * db; d.ld = 1024; d.gain = A_IN(I_NORM_FFN); d.scale = 256.f; d.gm = 0.f; d.ga = 1.f;
        d.dst = ws + WS_MDOWN + (size_t)e * 1024 * FE + (size_t)(32 * db) * FE + 128 * kb; d.ldd = FE; }
    return d;
}
__device__ __forceinline__ void p0_item16(unsigned char* ws, int r, int lane) {
    constexpr int N1 = 16 * 128, N2 = 16 * 32, N3 = 16 * 176, N4 = 44 * 32, N5 = 16 * 88, N6 = 2 * 32 * 8;
    if (r < N1) { const int kb = r / 128, db = r % 128; conv_item(A_IN(I_A_W_IN), NPROJ_SRC, 32 * db, 32, (bf16_t*)(ws + WS_WIN), 1024, 32 * db, A_IN(I_NORM_MIX), 64 * kb, lane); return; } r -= N1;
    if (r < N2) { const int kb = r / 32, db = r % 32; conv_item(A_IN(I_A_W_OUT), 1024, 32 * db, 32, (bf16_t*)(ws + WS_WOUTA), 1024, 32 * db, nullptr, 64 * kb, lane); return; } r -= N2;
    if (r < N3) { const int kb = r / 176, db = r % 176, tile = db >> 3, w = db & 7; const int sc = (w < 4) ? (128 * tile + 32 * w) : (FFD + 128 * tile + 32 * (w - 4));
        conv_item(A_IN(I_F_W_GU), 2 * FFD, sc, 32, (bf16_t*)(ws + WS_WGU), 1024, 32 * db, A_IN(I_NORM_FFN), 64 * kb, lane); return; } r -= N3;
    if (r < N4) { const int kb = r / 32, db = r % 32; conv_item(A_IN(I_F_W_DOWN), 1024, 32 * db, 32, (bf16_t*)(ws + WS_WDOWN), FFD, 32 * db, nullptr, 64 * kb, lane); return; } r -= N4;
    if (r < N5) { const int kb = r / 88, db = r % 88;
        if (db < 48) conv_item(A_IN(I_B_W_KV), 1536, 32 * db, 32, (bf16_t*)(ws + WS_WKVQ), 1024, 32 * db, A_IN(I_NORM_KV), 64 * kb, lane);
        else { const int sc = 32 * (db - 48); int nv = NQSRC - sc; nv = nv < 0 ? 0 : (nv > 32 ? 32 : nv);
            conv_item(A_IN(I_B_W_Q), NQSRC, sc, nv, (bf16_t*)(ws + WS_WKVQ), 1024, 32 * db, A_IN(I_NORM_MIX) + 1024, 64 * kb, lane); }
        return; } r -= N5;
    if (r < N6) { const int c = r / 256, rr = r % 256, kb = rr / 8, db = rr % 8; conv_item(A_IN(I_B_CMP_W1) + (size_t)c * 2048 * 256, 256, 32 * db, 32, (bf16_t*)(ws + WS_WCMP1) + (size_t)c * 256 * 2048, 2048, 32 * db, nullptr, 64 * kb, lane); return; } r -= N6;
    if (r < 16 * 32) { const int kb = r / 32, db = r % 32; conv_item(A_IN(I_B_W_OUT), 1024, 32 * db, 32, (bf16_t*)(ws + WS_WOUTB), 1024, 32 * db, nullptr, 64 * kb, lane); return; } r -= 16 * 32;
    { const int c = r >> 3, kb = (r >> 1) & 3, db = r & 1;
        conv_item(A_IN(I_B_CMP_W2) + (size_t)c * 256 * 64, 64, 32 * db, 32, (bf16_t*)(ws + WS_W2T) + (size_t)c * 64 * 256, 256, 32 * db, nullptr, 64 * kb, lane); }
}
__device__ __forceinline__ void p0_weights(unsigned char* ws, LAS unsigned char* lds, int gw, int NGW, int wave, int lane, bool moe) {
    constexpr int N1 = 16 * 128, N2 = 16 * 32, N3 = 16 * 176, N4 = 44 * 32, N5 = 16 * 88, N6 = 2 * 32 * 8, N7 = 16 * 32;
    constexpr int NB16 = N1 + N2 + N3 + N4 + N5 + N6 + N7 + 16, NT8 = 8 * 8 * 224 + 8 * 28 * 32;
    if (moe) {   f32x4 va[16], ga[4], vb[16], gb[4]; W8 da, db;
        int it = gw;
        da = w8_decode(ws, it); conv8_load(da, lane, va, ga);
        for (;;) {
            int nx = it + NGW; db = w8_decode(ws, nx < NT8 ? nx : NT8 - 1); if (nx >= NT8) db.ld = 0;
            conv8_load(db, lane, vb, gb); __builtin_amdgcn_sched_barrier(0);
            conv8_store(da, lane, va, ga);
            if (nx >= NT8) break;
            it = nx; nx = it + NGW; da = w8_decode(ws, nx < NT8 ? nx : NT8 - 1); if (nx >= NT8) da.ld = 0;
            conv8_load(da, lane, va, ga); __builtin_amdgcn_sched_barrier(0);
            conv8_store(db, lane, vb, gb);
            if (nx >= NT8) break;
            it = nx; }
    }
    for (int it = gw; it < NB16; it += NGW) p0_item16(ws, it, lane);
}

constexpr int NMINI = 8 * 32 * 224 + 8 * 112 * 32;
__device__ __forceinline__ W8 mini_decode(unsigned char* ws, int r) {
    W8 d;
    if (r < 8 * 32 * 224) { const int e = r / (32 * 224), rr = r % (32 * 224), kb = rr / 224, db = rr % 224, tile = db >> 3, w = db & 7; const int sc = (w < 4) ? (128 * tile + 32 * w) : (FE + 128 * tile + 32 * (w - 4));
        d.src = A_IN(I_M_W_GU) + (size_t)e * 1024 * 2 * FE + (size_t)(32 * kb) * (2 * FE) + sc; d.ld = 2 * FE; d.gain = A_IN(I_NORM_FFN) + 1024 + 32 * kb; d.scale = 128.f; d.gm = 1.f; d.ga = 0.f;
        d.dst = ws + WS_MGU + (size_t)e * 2 * FE * 1024 + (size_t)(32 * db) * 1024 + 32 * kb; d.ldd = 1024; }
    else { r -= 8 * 32 * 224; const int e = r / (112 * 32), rr = r % (112 * 32), kb = rr / 32, db = rr % 32;
        d.src = A_IN(I_M_W_DOWN) + (size_t)e * FE * 1024 + (size_t)(32 * kb) * 1024 + 32 * db; d.ld = 1024; d.gain = A_IN(I_NORM_FFN); d.scale = 256.f; d.gm = 0.f; d.ga = 1.f;
        d.dst = ws + WS_MDOWN + (size_t)e * 1024 * FE + (size_t)(32 * db) * FE + 32 * kb; d.ldd = FE; }
    return d;
}
__device__ __forceinline__ void mini_load(const W8& d, int lane, f32x4 (&v)[4], f32x4& g) {
    const int n4 = lane & 7, c = lane >> 3;
#pragma unroll
    for (int i = 0; i < 4; ++i) v[i] = *(const f32x4*)(d.src + (size_t)(4 * c + i) * d.ld + 4 * n4);
    g = *(const f32x4*)(d.gain + 4 * c);
}
__device__ __forceinline__ void mini_store(const W8& d, int lane, const f32x4 (&v)[4], const f32x4 g) {
    const int n4 = lane & 7, c = lane >> 3; const f32x4 gs = (g * d.gm + d.ga) * d.scale;
#pragma unroll
    for (int j = 0; j < 4; ++j) *(unsigned*)(d.dst + (size_t)(4 * n4 + j) * d.ldd + 4 * c) = pk_fp8x4(v[0][j] * gs.x, v[1][j] * gs.y, v[2][j] * gs.z, v[3][j] * gs.w);
}

__device__ __forceinline__ void load_row(const float* row, int lane, f32x4 (&v)[4]) {
    const f32x4* xr = (const f32x4*)row + lane;
#pragma unroll
    for (int j = 0; j < 4; ++j) v[j] = xr[64 * j];
}
__device__ __forceinline__ float row_rstd(const f32x4 (&v)[4]) {
    float s = 0.f;
#pragma unroll
    for (int j = 0; j < 4; ++j) s += (v[j].x * v[j].x + v[j].y * v[j].y) + (v[j].z * v[j].z + v[j].w * v[j].w);
    return 1.0f / sqrtf(wave_sum(s) * (1.f / 1024.f) + EPS);
}
__device__ __forceinline__ void store_row_bf16(bf16_t* orow, int lane, const f32x4 (&v)[4], float sc) {
    u64* o8 = (u64*)orow + lane;
#pragma unroll
    for (int j = 0; j < 4; ++j) o8[64 * j] = (u64)pk2(v[j].x * sc, v[j].y * sc) | ((u64)pk2(v[j].z * sc, v[j].w * sc) << 32);
}

__device__ __forceinline__ f32x4 mma_lds(const LAS bf16_t* A, int lda, const LAS bf16_t* Bt, int ldb, int K, f32x4 acc, int lane) {
    const int r = lane & 15, q = lane >> 4;
    const LAS bf16_t* ap = A + r * lda + 8 * q; const LAS bf16_t* bp = Bt + r * ldb + 8 * q;
    for (int k = 0; k < K; k += 32) { const bf16x8 a = *(const LAS bf16x8*)(ap + k), b = *(const LAS bf16x8*)(bp + k); acc = __builtin_amdgcn_mfma_f32_16x16x32_bf16(a, b, acc, 0, 0, 0); }
    return acc;
}

__device__ __forceinline__ void scanprep_phase(LAS unsigned char* lds, const bf16_t* P3, const float* GA, const float* conv_w, unsigned char* IMG, int vcu, int G) {
    const int tid = threadIdx.x, wave = __builtin_amdgcn_readfirstlane(tid >> 6), lane = tid & 63;
    constexpr int QS = 272, LDP = 3072;
    LAS bf16_t* Qs = (LAS bf16_t*)(lds + 0);
    LAS bf16_t* Kd = (LAS bf16_t*)(lds + 34816);
    LAS float* fg = (LAS float*)(lds + 67584);
    LAS float* cw = (LAS float*)(lds + 68352);
    const bool same_h = (G & 255) == 0; int h_loaded = -1;
    for (int item = vcu; item < 2048; item += G) {
        const int b = item >> 8, h = (item >> 6) & 3, ci = item & 63, t0 = ci * 64; const size_t rb = (size_t)b * SEQ + t0;
        unsigned char* img = IMG + (size_t)item * IMG_STRIDE;
        const int cg = tid & 31, rg = tid >> 5;
        u32x4 rawq[7], rawk[7];
#pragma unroll
        for (int r7 = 0; r7 < 7; ++r7) { const int tt = 4 * rg - 3 + r7; rawq[r7] = (u32x4){0u, 0u, 0u, 0u}; rawk[r7] = (u32x4){0u, 0u, 0u, 0u};
            if (t0 + tt >= 0) { const bf16_t* p = P3 + (rb + tt) * LDP + h * 256 + 8 * cg; rawq[r7] = *(const u32x4*)p; rawk[r7] = *(const u32x4*)(p + 1024); } }
        const int vv = tid & 255, hf = tid >> 8; unsigned short ev[32];
        { const bf16_t* vp = P3 + (rb + 32 * hf) * LDP + 2048 + h * 256 + vv;
#pragma unroll
          for (int i = 0; i < 32; ++i) ev[i] = vp[(size_t)i * LDP]; }
        float gli = 0.f, glf = 0.f; if (wave == 7) { gli = GA[(rb + lane) * 8 + h]; glf = GA[(rb + lane) * 8 + 4 + h]; }
        __syncthreads();
        if (h != h_loaded || !same_h) {
            for (int i = tid; i < 2048; i += NTHR) { const int j = i >> 8, kk = i & 255; cw[i] = conv_w[(j & 3) * 2048 + (j >> 2) * 1024 + h * 256 + kk]; }
            for (int i = tid; i < 64 * 16; i += NTHR) { const int r = i >> 4, c = i & 15; Qs[r * QS + 256 + c] = 0; }
            h_loaded = h; __syncthreads(); }
        { bf16_t* op = (bf16_t*)(img + IMG_VT) + vv * 80 + 32 * hf;
#pragma unroll
          for (int g8 = 0; g8 < 4; ++g8) { u32x4 w; w.x = ev[8 * g8] | ((unsigned)ev[8 * g8 + 1] << 16); w.y = ev[8 * g8 + 2] | ((unsigned)ev[8 * g8 + 3] << 16); w.z = ev[8 * g8 + 4] | ((unsigned)ev[8 * g8 + 5] << 16); w.w = ev[8 * g8 + 6] | ((unsigned)ev[8 * g8 + 7] << 16);
              *(u32x4*)(op + 8 * g8) = w; }
          *(u32x4*)((bf16_t*)(img + IMG_VT) + vv * 80 + 64 + 8 * hf) = (u32x4){0u, 0u, 0u, 0u}; }
        {
#pragma unroll
          for (int which = 0; which < 2; ++which) {
            float x[7][8];
#pragma unroll
            for (int r7 = 0; r7 < 7; ++r7) { const u32x4 raw = which ? rawk[r7] : rawq[r7];
                x[r7][0] = bflo(raw.x); x[r7][1] = bfhi(raw.x); x[r7][2] = bflo(raw.y); x[r7][3] = bfhi(raw.y); x[r7][4] = bflo(raw.z); x[r7][5] = bfhi(raw.z); x[r7][6] = bflo(raw.w); x[r7][7] = bfhi(raw.w); }
            float w[4][8];
#pragma unroll
            for (int tap = 0; tap < 4; ++tap) { const f32x4 w0 = *(const LAS f32x4*)(cw + (which * 4 + tap) * 256 + 8 * cg), w1 = *(const LAS f32x4*)(cw + (which * 4 + tap) * 256 + 8 * cg + 4);
                w[tap][0] = w0.x; w[tap][1] = w0.y; w[tap][2] = w0.z; w[tap][3] = w0.w; w[tap][4] = w1.x; w[tap][5] = w1.y; w[tap][6] = w1.z; w[tap][7] = w1.w; }
            const float sc = which ? 0.0625f : 1.0f;
#pragma unroll
            for (int j = 0; j < 4; ++j) { float o[8];
#pragma unroll
                for (int c = 0; c < 8; ++c) o[c] = (w[0][c] * x[j][c] + w[1][c] * x[j + 1][c] + w[2][c] * x[j + 2][c] + w[3][c] * x[j + 3][c]) * sc;
                u32x4 p; p.x = pg8::cvt_pk_bf16(o[0], o[1]); p.y = pg8::cvt_pk_bf16(o[2], o[3]); p.z = pg8::cvt_pk_bf16(o[4], o[5]); p.w = pg8::cvt_pk_bf16(o[6], o[7]);
                if (which) *(LAS u32x4*)(Kd + (4 * rg + j) * 256 + 8 * cg) = p; else *(LAS u32x4*)(Qs + (4 * rg + j) * QS + 8 * cg) = p; }
          }
          if (wave == 7) { const float li = gli, lf = glf;
              float bc = lf;
#pragma unroll
              for (int o = 1; o < 64; o <<= 1) { const float t = __shfl_up(bc, o); if (lane >= o) bc += t; }
              const float uu = li - bc; float pm = uu;
#pragma unroll
              for (int o = 1; o < 64; o <<= 1) { const float t = __shfl_up(pm, o); if (lane >= o) pm = fmaxf(pm, t); }
              fg[lane] = bc; fg[64 + lane] = uu; fg[128 + lane] = pm; }
        }
        __syncthreads();
        { const int k = tid & 255; bf16_t* op = (bf16_t*)(img + IMG_KT) + k * 64 + 32 * hf;
#pragma unroll
          for (int g8 = 0; g8 < 4; ++g8) { unsigned short e[8];
#pragma unroll
              for (int i = 0; i < 8; ++i) e[i] = Kd[(32 * hf + 8 * g8 + i) * 256 + k];
              u32x4 w; w.x = e[0] | ((unsigned)e[1] << 16); w.y = e[2] | ((unsigned)e[3] << 16); w.z = e[4] | ((unsigned)e[5] << 16); w.w = e[6] | ((unsigned)e[7] << 16);
              *(u32x4*)(op + 8 * g8) = w; } }
        for (int i = tid; i < 67584 / 16; i += NTHR) *(u32x4*)(img + (size_t)i * 16) = *(const LAS u32x4*)(lds + i * 16);
        if (tid < 48) *(u32x4*)(img + IMG_G + tid * 16) = *(const LAS u32x4*)(lds + 67584 + tid * 16);
    }
}

__device__ __forceinline__ void scan_phase(LAS unsigned char* lds, const unsigned char* IMG, float* HS, float* DN, int vcu, int G, unsigned char* ws) {
    const int tid = threadIdx.x, wave = __builtin_amdgcn_readfirstlane(tid >> 6), lane = tid & 63, cl = lane & 15, q4 = lane >> 4;
    constexpr int QS = 272, TS = 80;
    LAS bf16_t* Qs = (LAS bf16_t*)(lds + 0);
    LAS bf16_t* Cbs = (LAS bf16_t*)(lds + 34816);
    LAS bf16_t* VTs = (LAS bf16_t*)(lds + 52768);
    LAS bf16_t* VaTs = (LAS bf16_t*)(lds + 58048);
    LAS bf16_t* Sws = (LAS bf16_t*)(lds + 63328);
    LAS float* fg = (LAS float*)(lds + 73568);
    const int r2 = cl ? 32 : 32;
    for (int u = vcu; u < 256; u += G) {
        const int b = u >> 5, h = (u >> 3) & 3, vs = u & 7;
        const unsigned char* img0 = IMG + (size_t)((b * 4 + h) * 64) * IMG_STRIDE;
        __syncthreads();
        for (int i = tid; i < 33 * QS; i += NTHR) Cbs[i] = 0;
        for (int i = tid; i < TS; i += NTHR) { VTs[32 * TS + i] = (i < 64) ? (bf16_t)0x3F80 : (bf16_t)0; VaTs[32 * TS + i] = 0; }
        f32x4 Cacc[2][3];
#pragma unroll
        for (int kk = 0; kk < 2; ++kk)
#pragma unroll
            for (int vt = 0; vt < 3; ++vt) Cacc[kk][vt] = (f32x4){0.f, 0.f, 0.f, 0.f};
        float mstate = 0.f;
        u32x4 pfq[5], pfv, pfg;
        bf16x8 kfr[8], ktf[2][2];
#define SCAN_LOAD(ci_) do { const unsigned char* ip = img0 + (size_t)(ci_) * IMG_STRIDE; \
            _Pragma("unroll") for (int k = 0; k < 5; ++k) { const int id = tid + 512 * k; if (id < 2176) pfq[k] = *(const u32x4*)(ip + (size_t)id * 16); } \
            if (tid < 320) pfv = *(const u32x4*)(ip + IMG_VT + vs * 5120 + tid * 16); \
            if (tid < 48) pfg = *(const u32x4*)(ip + IMG_G + tid * 16); } while (0)
#define SCAN_LOAD_K(ci_) do { if (wave >= 4) { const bf16_t* kp = (const bf16_t*)(img0 + (size_t)(ci_) * IMG_STRIDE + IMG_K) + (16 * (wave - 4) + cl) * 256 + 8 * q4; \
            _Pragma("unroll") for (int ks = 0; ks < 8; ++ks) kfr[ks] = *(const bf16x8*)(kp + 32 * ks); } } while (0)
#define SCAN_LOAD_KT(ci_) do { const bf16_t* kp = (const bf16_t*)(img0 + (size_t)(ci_) * IMG_STRIDE + IMG_KT) + (32 * wave + cl) * 64 + 8 * q4; \
            _Pragma("unroll") for (int kk = 0; kk < 2; ++kk) _Pragma("unroll") for (int ks = 0; ks < 2; ++ks) ktf[kk][ks] = *(const bf16x8*)(kp + kk * 1024 + 32 * ks); } while (0)
        SCAN_LOAD(0); SCAN_LOAD_K(0); SCAN_LOAD_KT(0);
        W8 cvd = mini_decode(ws, 0); f32x4 cvv[4], cvg;
#pragma unroll
        for (int i = 0; i < 4; ++i) cvv[i] = (f32x4){0.f, 0.f, 0.f, 0.f};
        cvg = (f32x4){0.f, 0.f, 0.f, 0.f};
        for (int ci = 0; ci < 64; ++ci) {
            const size_t rb = (size_t)b * SEQ + ci * 64;
#pragma unroll
            for (int k = 0; k < 5; ++k) { const int id = tid + 512 * k; if (id < 2176) *(LAS u32x4*)(lds + id * 16) = pfq[k]; }
            if (tid < 320) *(LAS u32x4*)((LAS unsigned char*)VTs + tid * 16) = pfv;
            if (tid < 48) *(LAS u32x4*)((LAS unsigned char*)fg + tid * 16) = pfg;
            if (ci + 1 < 64) SCAN_LOAD(ci + 1);
            if (G == 256 && ci >= 1 && ci <= 42) mini_store(cvd, lane, cvv, cvg);
            cvd = mini_decode(ws, (ci < 42 ? ci : 41) * 2048 + vcu * 8 + wave); if (!(G == 256 && ci < 42)) cvd.ld = 0;
            mini_load(cvd, lane, cvv, cvg);
            LDS_BARRIER();
            const float pm63 = fg[128 + 63], bc63 = fg[63];
            const float M63 = fmaxf(mstate, pm63), aprev = ex2((mstate - M63) * 1.4426950408889634f);
            f32x4 hacc[3];
            if (wave < 4) {
                const int ti = wave;
#pragma unroll
                for (int vt = 0; vt < 3; ++vt) hacc[vt] = (f32x4){0.f, 0.f, 0.f, 0.f};
#pragma unroll
                for (int ks = 0; ks < 8; ++ks) { const bf16x8 a = *(const LAS bf16x8*)(Qs + (16 * ti + cl) * QS + 32 * ks + 8 * q4);
                    const bf16x8 b0 = *(const LAS bf16x8*)(Cbs + cl * QS + 32 * ks + 8 * q4), b1 = *(const LAS bf16x8*)(Cbs + (16 + cl) * QS + 32 * ks + 8 * q4), b2 = *(const LAS bf16x8*)(Cbs + r2 * QS + 32 * ks + 8 * q4);
                    hacc[0] = __builtin_amdgcn_mfma_f32_16x16x32_bf16(a, b0, hacc[0], 0, 0, 0); hacc[1] = __builtin_amdgcn_mfma_f32_16x16x32_bf16(a, b1, hacc[1], 0, 0, 0); hacc[2] = __builtin_amdgcn_mfma_f32_16x16x32_bf16(a, b2, hacc[2], 0, 0, 0); }
#pragma unroll
                for (int j = 0; j < 4; ++j) { const float wint = ex2((mstate - fmaxf(mstate, fg[128 + 16 * ti + 4 * q4 + j])) * 1.4426950408889634f); hacc[0][j] *= wint; hacc[1][j] *= wint; hacc[2][j] *= wint; }
            } else {
                const int si = wave - 4; f32x4 us4;
#pragma unroll
                for (int j = 0; j < 4; ++j) us4[j] = fg[64 + 16 * si + 4 * q4 + j];
#pragma unroll
                for (int ti = 0; ti < 4; ++ti) { u32x2 w = (u32x2){0u, 0u};
                    if (ti >= si) { f32x4 sacc = (f32x4){0.f, 0.f, 0.f, 0.f};
#pragma unroll
                        for (int ks = 0; ks < 8; ++ks) { const bf16x8 qb = *(const LAS bf16x8*)(Qs + (16 * ti + cl) * QS + 32 * ks + 8 * q4); sacc = __builtin_amdgcn_mfma_f32_16x16x32_bf16(kfr[ks], qb, sacc, 0, 0, 0); }
                        const int t = 16 * ti + cl; const float Mt = fmaxf(mstate, fg[128 + t]); float p[4];
#pragma unroll
                        for (int j = 0; j < 4; ++j) { const int s_ = 16 * si + 4 * q4 + j; p[j] = (s_ <= t) ? sacc[j] * ex2((us4[j] - Mt) * 1.4426950408889634f) : 0.f; }
                        w.x = pg8::cvt_pk_bf16(p[0], p[1]); w.y = pg8::cvt_pk_bf16(p[2], p[3]); }
                    *(LAS u32x2*)(Sws + (16 * ti + cl) * TS + 16 * si + 4 * q4) = w; }
                if (ci + 1 < 64) SCAN_LOAD_K(ci + 1);
            }
            if (tid < 264) { const int v = tid >> 3, s8 = (tid & 7) * 8; const u32x4 raw = *(const LAS u32x4*)(VTs + v * TS + s8); float a[8];
#pragma unroll
                for (int i = 0; i < 8; ++i) a[i] = ex2((fg[64 + s8 + i] - M63) * 1.4426950408889634f);
                u32x4 w; w.x = pg8::cvt_pk_bf16(bflo(raw.x) * a[0], bfhi(raw.x) * a[1]); w.y = pg8::cvt_pk_bf16(bflo(raw.y) * a[2], bfhi(raw.y) * a[3]); w.z = pg8::cvt_pk_bf16(bflo(raw.z) * a[4], bfhi(raw.z) * a[5]); w.w = pg8::cvt_pk_bf16(bflo(raw.w) * a[6], bfhi(raw.w) * a[7]);
                *(LAS u32x4*)(VaTs + v * TS + s8) = w; }
            LDS_BARRIER();
            if (wave < 4) {
                const int ti = wave;
#pragma unroll
                for (int ks = 0; ks < 2; ++ks) { const bf16x8 a = *(const LAS bf16x8*)(Sws + (16 * ti + cl) * TS + 32 * ks + 8 * q4);
                    const bf16x8 b0 = *(const LAS bf16x8*)(VTs + cl * TS + 32 * ks + 8 * q4), b1 = *(const LAS bf16x8*)(VTs + (16 + cl) * TS + 32 * ks + 8 * q4), b2 = *(const LAS bf16x8*)(VTs + r2 * TS + 32 * ks + 8 * q4);
                    hacc[0] = __builtin_amdgcn_mfma_f32_16x16x32_bf16(a, b0, hacc[0], 0, 0, 0); hacc[1] = __builtin_amdgcn_mfma_f32_16x16x32_bf16(a, b1, hacc[1], 0, 0, 0); hacc[2] = __builtin_amdgcn_mfma_f32_16x16x32_bf16(a, b2, hacc[2], 0, 0, 0); }
#pragma unroll
                for (int j = 0; j < 4; ++j) { const int t = 16 * ti + 4 * q4 + j; float* hp = HS + (rb + t) * 1024 + h * 256 + vs * 32 + cl; hp[0] = hacc[0][j]; hp[16] = hacc[1][j];
                    if (vs == 0 && cl == 0) { const float Mtt = fmaxf(mstate, fg[128 + t]); DN[(rb + t) * 4 + h] = fmaxf(fabsf(hacc[2][j]), ex2(-(fg[t] + Mtt) * 1.4426950408889634f)); } }
            }
#pragma unroll
            for (int kk = 0; kk < 2; ++kk)
#pragma unroll
                for (int vt = 0; vt < 3; ++vt) Cacc[kk][vt] = Cacc[kk][vt] * aprev;
#pragma unroll
            for (int ks = 0; ks < 2; ++ks) { const bf16x8 b0 = *(const LAS bf16x8*)(VaTs + cl * TS + 32 * ks + 8 * q4), b1 = *(const LAS bf16x8*)(VaTs + (16 + cl) * TS + 32 * ks + 8 * q4), b2 = *(const LAS bf16x8*)(VaTs + r2 * TS + 32 * ks + 8 * q4);
#pragma unroll
                for (int kk = 0; kk < 2; ++kk) { Cacc[kk][0] = __builtin_amdgcn_mfma_f32_16x16x32_bf16(ktf[kk][ks], b0, Cacc[kk][0], 0, 0, 0); Cacc[kk][1] = __builtin_amdgcn_mfma_f32_16x16x32_bf16(ktf[kk][ks], b1, Cacc[kk][1], 0, 0, 0);
                    Cacc[kk][2] = __builtin_amdgcn_mfma_f32_16x16x32_bf16(ktf[kk][ks], b2, Cacc[kk][2], 0, 0, 0); } }
#pragma unroll
            for (int kk = 0; kk < 2; ++kk)
#pragma unroll
                for (int vt = 0; vt < 3; ++vt) { if (vt < 2 || cl == 0) { u32x2 w; w.x = pg8::cvt_pk_bf16(Cacc[kk][vt][0], Cacc[kk][vt][1]); w.y = pg8::cvt_pk_bf16(Cacc[kk][vt][2], Cacc[kk][vt][3]);
                        *(LAS u32x2*)(Cbs + (16 * vt + cl) * QS + 32 * wave + 16 * kk + 4 * q4) = w; } }
            if (ci + 1 < 64) SCAN_LOAD_KT(ci + 1);
            mstate = bc63 + M63;
            LDS_BARRIER();
        }
#undef SCAN_LOAD
#undef SCAN_LOAD_K
#undef SCAN_LOAD_KT
    }
}

template <int MODE, bool EDGE>
__device__ __forceinline__ void attn_tile2(const LAS bf16_t* Kt, const LAS bf16_t* VTt, LAS bf16_t* Pw, const bf16x8 (&qa)[2], const f32x4 bv0, int jb, int t0, int th, float slope2,
                                           u64 tsel, f32x4 (&O)[4], float& mrow, float& lrow, int lane) {
    const int cl = lane & 15, q4 = lane >> 4; constexpr int TS = 72;
    f32x4 s[4];
#pragma unroll
    for (int nt = 0; nt < 4; ++nt) { s[nt] = bv0;
#pragma unroll
        for (int ks = 0; ks < 2; ++ks) { const bf16x8 kb = *(const LAS bf16x8*)(Kt + (16 * nt + cl) * TS + 32 * ks + 8 * q4); s[nt] = __builtin_amdgcn_mfma_f32_16x16x32_bf16(kb, qa[ks], s[nt], 0, 0, 0); } }
    const float b0 = slope2 * (float)(64 * jb - (t0 + 31)), o16 = slope2 * 16.f;
    bool rowok = true; if (MODE == 0) rowok = ((tsel >> (16 * th + cl)) & 1ull) != 0ull;
    if (EDGE) { const int dbase = t0 + 16 * th + cl - (64 * jb + 4 * q4);
#pragma unroll
        for (int nt = 0; nt < 4; ++nt)
#pragma unroll
            for (int j = 0; j < 4; ++j) { const int dist = dbase - (16 * nt + j); const bool ok = dist >= 0 && (MODE == 0 || dist < 512); s[nt][j] = ok ? s[nt][j] : -INFINITY; } }
    float mx = fmaxf(fmaxf(s[0][0], s[0][1]), fmaxf(s[0][2], s[0][3]));
#pragma unroll
    for (int n = 1; n < 4; ++n) mx = fmaxf(mx, fmaxf(fmaxf(s[n][0], s[n][1]), fmaxf(s[n][2], s[n][3])) + (float)n * o16);
    mx = rowok ? mx + b0 : -INFINITY;
    mx = fmaxf(mx, __shfl_xor(mx, 16)); mx = fmaxf(mx, __shfl_xor(mx, 32));
    const float mold = mrow, mnew = fmaxf(mold, mx), msafe = (mnew == -INFINITY) ? 0.f : mnew;
    const float alpha = (mold == -INFINITY) ? 0.f : ex2(mold - msafe);
    const float ref = rowok ? (msafe - b0) : INFINITY;
    float rs = 0.f;
    unsigned pw[4][2];
#pragma unroll
    for (int nt = 0; nt < 4; ++nt) { float p[4]; const float refn = ref - (float)nt * o16;
#pragma unroll
        for (int j = 0; j < 4; ++j) { p[j] = ex2(s[nt][j] - refn); rs += p[j]; }
        pw[nt][0] = pg8::cvt_pk_bf16(p[0], p[1]); pw[nt][1] = pg8::cvt_pk_bf16(p[2], p[3]); }
    rs += __shfl_xor(rs, 16); rs += __shfl_xor(rs, 32);
    lrow = lrow * alpha + rs; mrow = mnew;
#pragma unroll
    for (int dt = 0; dt < 4; ++dt) O[dt] = O[dt] * alpha;
#pragma unroll
    for (int ks = 0; ks < 2; ++ks) { const bf16x8 pa = __builtin_bit_cast(bf16x8, (u32x4){pw[2 * ks][0], pw[2 * ks][1], pw[2 * ks + 1][0], pw[2 * ks + 1][1]});
#pragma unroll
        for (int dt = 0; dt < 4; ++dt) { const bf16x8 vb = *(const LAS bf16x8*)(VTt + (16 * dt + cl) * TS + 32 * ks + 8 * q4); O[dt] = __builtin_amdgcn_mfma_f32_16x16x32_bf16(vb, pa, O[dt], 0, 0, 0); } }
}

template <int MODE>
__device__ __forceinline__ void attn_pair(const LAS bf16_t* KtA, const LAS bf16_t* KtB, LAS bf16_t* Pw, const bf16x8 (&qa)[2], const f32x4 bv0, int jA, int jB, int t0, int th, float slope2,
                                          u64 tselA, u64 tselB, f32x4 (&O)[4], float& mrow, float& lrow, int lane) {
    const int cl = lane & 15, q4 = lane >> 4; constexpr int TS = 72, PP = 136;
    f32x4 s[8];
#pragma unroll
    for (int nt = 0; nt < 8; ++nt) { const LAS bf16_t* Kt = (nt < 4) ? KtA : KtB; s[nt] = bv0;
#pragma unroll
        for (int ks = 0; ks < 2; ++ks) { const bf16x8 kb = *(const LAS bf16x8*)(Kt + (16 * (nt & 3) + cl) * TS + 32 * ks + 8 * q4); s[nt] = __builtin_amdgcn_mfma_f32_16x16x32_bf16(kb, qa[ks], s[nt], 0, 0, 0); } }
    const float o16 = slope2 * 16.f, bA = slope2 * (float)(64 * jA - (t0 + 31)), bB = slope2 * (float)(64 * jB - (t0 + 31));
    bool okA = true, okB = true; if (MODE == 0) { okA = ((tselA >> (16 * th + cl)) & 1ull) != 0ull; okB = ((tselB >> (16 * th + cl)) & 1ull) != 0ull; }
    float mA = fmaxf(fmaxf(s[0][0], s[0][1]), fmaxf(s[0][2], s[0][3])), mB = fmaxf(fmaxf(s[4][0], s[4][1]), fmaxf(s[4][2], s[4][3]));
#pragma unroll
    for (int n = 1; n < 4; ++n) { mA = fmaxf(mA, fmaxf(fmaxf(s[n][0], s[n][1]), fmaxf(s[n][2], s[n][3])) + (float)n * o16); mB = fmaxf(mB, fmaxf(fmaxf(s[4 + n][0], s[4 + n][1]), fmaxf(s[4 + n][2], s[4 + n][3])) + (float)n * o16); }
    float mx = fmaxf(okA ? mA + bA : -INFINITY, okB ? mB + bB : -INFINITY);
    mx = fmaxf(mx, __shfl_xor(mx, 16)); mx = fmaxf(mx, __shfl_xor(mx, 32));
    const float mold = mrow, mnew = fmaxf(mold, mx), msafe = (mnew == -INFINITY) ? 0.f : mnew;
    const float alpha = (mold == -INFINITY) ? 0.f : ex2(mold - msafe);
    const float refA = okA ? (msafe - bA) : INFINITY, refB = okB ? (msafe - bB) : INFINITY;
    float rs = 0.f;
    unsigned pw[8][2];
#pragma unroll
    for (int nt = 0; nt < 8; ++nt) { float p[4]; const float refn = ((nt < 4) ? refA : refB) - (float)(nt & 3) * o16;
#pragma unroll
        for (int j = 0; j < 4; ++j) { p[j] = ex2(s[nt][j] - refn); rs += p[j]; }
        pw[nt][0] = pg8::cvt_pk_bf16(p[0], p[1]); pw[nt][1] = pg8::cvt_pk_bf16(p[2], p[3]); }
    rs += __shfl_xor(rs, 16); rs += __shfl_xor(rs, 32);
    lrow = lrow * alpha + rs; mrow = mnew;
#pragma unroll
    for (int dt = 0; dt < 4; ++dt) O[dt] = O[dt] * alpha;
#pragma unroll
    for (int ks = 0; ks < 4; ++ks) { const bf16x8 pa = __builtin_bit_cast(bf16x8, (u32x4){pw[2 * ks][0], pw[2 * ks][1], pw[2 * ks + 1][0], pw[2 * ks + 1][1]}); const LAS bf16_t* VTt = ((ks < 2) ? KtA : KtB) + 4608;
#pragma unroll
        for (int dt = 0; dt < 4; ++dt) { const bf16x8 vb = *(const LAS bf16x8*)(VTt + (16 * dt + cl) * TS + 32 * (ks & 1) + 8 * q4); O[dt] = __builtin_amdgcn_mfma_f32_16x16x32_bf16(vb, pa, O[dt], 0, 0, 0); } }
    LDS_WAIT();
}

template <int MODE>
__device__ __forceinline__ void attn_pair_fast(const LAS bf16_t* KtA, const LAS bf16_t* KtB, LAS bf16_t* Pw, const bf16x8 (&qa)[2], const f32x4 bv0, int jA, int jB, int t0, int th, float slope2,
                                               u64 tselA, u64 tselB, f32x4 (&O)[4], float mrow, float& lrow, int lane) {
    const int cl = lane & 15, q4 = lane >> 4; constexpr int TS = 72, PP = 136;
    f32x4 s[8];
#pragma unroll
    for (int nt = 0; nt < 8; ++nt) { const LAS bf16_t* Kt = (nt < 4) ? KtA : KtB; s[nt] = bv0;
#pragma unroll
        for (int ks = 0; ks < 2; ++ks) { const bf16x8 kb = *(const LAS bf16x8*)(Kt + (16 * (nt & 3) + cl) * TS + 32 * ks + 8 * q4); s[nt] = __builtin_amdgcn_mfma_f32_16x16x32_bf16(kb, qa[ks], s[nt], 0, 0, 0); } }
    const float o16 = slope2 * 16.f, bA = slope2 * (float)(64 * jA - (t0 + 31)), bB = slope2 * (float)(64 * jB - (t0 + 31));
    bool okA = true, okB = true; if (MODE == 0) { okA = ((tselA >> (16 * th + cl)) & 1ull) != 0ull; okB = ((tselB >> (16 * th + cl)) & 1ull) != 0ull; }
    const float refA = okA ? (mrow - bA) : INFINITY, refB = okB ? (mrow - bB) : INFINITY;
    float rs = 0.f;
    unsigned pw[8][2];
#pragma unroll
    for (int nt = 0; nt < 8; ++nt) { float p[4]; const float refn = ((nt < 4) ? refA : refB) - (float)(nt & 3) * o16;
#pragma unroll
        for (int j = 0; j < 4; ++j) { p[j] = ex2(s[nt][j] - refn); rs += p[j]; }
        pw[nt][0] = pg8::cvt_pk_bf16(p[0], p[1]); pw[nt][1] = pg8::cvt_pk_bf16(p[2], p[3]); }
    rs += __shfl_xor(rs, 16); rs += __shfl_xor(rs, 32);
    lrow += rs;
#pragma unroll
    for (int ks = 0; ks < 4; ++ks) { const bf16x8 pa = __builtin_bit_cast(bf16x8, (u32x4){pw[2 * ks][0], pw[2 * ks][1], pw[2 * ks + 1][0], pw[2 * ks + 1][1]}); const LAS bf16_t* VTt = ((ks < 2) ? KtA : KtB) + 4608;
#pragma unroll
        for (int dt = 0; dt < 4; ++dt) { const bf16x8 vb = *(const LAS bf16x8*)(VTt + (16 * dt + cl) * TS + 32 * (ks & 1) + 8 * q4); O[dt] = __builtin_amdgcn_mfma_f32_16x16x32_bf16(vb, pa, O[dt], 0, 0, 0); } }
    LDS_WAIT();
}

constexpr int ATT_SET0 = 70656, ATT_SET1 = 107520, ATT_QL = 144384;
template <int MODE>
__device__ __forceinline__ void attn_branch(LAS unsigned char* lds, LAS bf16_t* Pw, const bf16_t* KV, const bf16_t* VT2, const float* GATEB, const bf16x8 (&qa)[2], f32x4 (&outacc)[4],
                                            u64 uni, u64 tselv, int b, int bg, int h, int t0, int th, float slope2
#if TSEG
                                            , unsigned long long& tseg_acc
#endif
                                            ) {
#if TSEG
    unsigned long long tseg_t = 0;
#endif
    const int tid = threadIdx.x, lane = tid & 63; constexpr int TS = 72;
    const size_t PLANE = (size_t)8 * 4 * 4096 * 64;
    f32x4 O[4]; float mrow = -INFINITY, lrow = 0.f;
#pragma unroll
    for (int j = 0; j < 4; ++j) O[j] = (f32x4){0.f, 0.f, 0.f, 0.f};
    const float k0f = (float)(4 * (lane >> 4)); const f32x4 bv0 = (f32x4){slope2 * k0f, slope2 * (k0f + 1.f), slope2 * (k0f + 2.f), slope2 * (k0f + 3.f)};
    const int jhi = (t0 + 31) >> 6; int jlo = 0; if (MODE == 1) { jlo = t0 - 511; jlo = jlo < 0 ? 0 : (jlo >> 6); }
    u64 rem = (MODE == 0) ? uni : ((jhi >= 63 ? ~0ull : ((1ull << (jhi + 1)) - 1ull)) & ~((1ull << jlo) - 1ull));
    const bf16_t* Ksrc = KV + (size_t)(MODE == 0 ? 2 : 4) * PLANE + (size_t)bg * 4096 * 64;
    const bf16_t* Vsrc = VT2 + ((size_t)MODE * 32 + bg) * 4096 * 64;
    const size_t toff = (size_t)tid * 8;
    const int loff = (tid >> 3) * TS + 8 * (tid & 7);
    u32x4 pkA, pvA, pkB, pvB;
    int a0 = -1, b0_ = -1, a1 = -1, b1 = -1;
#define ATT_TAKE(x) do { if (rem) { x = 63 - __builtin_clzll(rem); rem &= ~(1ull << x); } else x = -1; } while (0)
#define ATT_LOAD(ja, jb_) do { if ((ja) >= 0) { pkA = *(const u32x4*)(Ksrc + (size_t)(ja) * 4096 + toff); pvA = *(const u32x4*)(Vsrc + (size_t)(ja) * 4096 + toff); } \
                               if ((jb_) >= 0) { pkB = *(const u32x4*)(Ksrc + (size_t)(jb_) * 4096 + toff); pvB = *(const u32x4*)(Vsrc + (size_t)(jb_) * 4096 + toff); } } while (0)
#define ATT_PUT(setp, ja, jb_) do { if ((ja) >= 0) { *(LAS u32x4*)((setp) + loff) = pkA; *(LAS u32x4*)((setp) + 4608 + loff) = pvA; } \
                                    if ((jb_) >= 0) { *(LAS u32x4*)((setp) + 9216 + loff) = pkB; *(LAS u32x4*)((setp) + 13824 + loff) = pvB; } } while (0)
    ATT_TAKE(a0); ATT_TAKE(b0_);
    ATT_LOAD(a0, b0_);
    { LAS bf16_t* set0 = (LAS bf16_t*)(lds + ATT_SET0); ATT_PUT(set0, a0, b0_); }
    ATT_TAKE(a1); ATT_TAKE(b1);
    ATT_LOAD(a1, b1);
    LDS_BARRIER();
    int buf = 0;
#pragma unroll 1
    while (a0 >= 0) {
        LAS bf16_t* cur = (LAS bf16_t*)(lds + (buf ? ATT_SET1 : ATT_SET0)); LAS bf16_t* nxt = (LAS bf16_t*)(lds + (buf ? ATT_SET0 : ATT_SET1));
        int a2 = -1, b2 = -1;
        TS_B(10);
        if (a1 >= 0) { ATT_PUT(nxt, a1, b1); ATT_TAKE(a2); ATT_TAKE(b2); ATT_LOAD(a2, b2); }
        TS_E(10); TS_B(11);
        u64 tsA = ~0ull, tsB = ~0ull;
        if (MODE == 0) { tsA = ((u64)(unsigned)__builtin_amdgcn_readlane((int)(tselv >> 32), a0) << 32) | (unsigned)__builtin_amdgcn_readlane((int)(unsigned)tselv, a0);
            if (b0_ >= 0) tsB = ((u64)(unsigned)__builtin_amdgcn_readlane((int)(tselv >> 32), b0_) << 32) | (unsigned)__builtin_amdgcn_readlane((int)(unsigned)tselv, b0_); }
        const bool useA = ((tsA >> (16 * th)) & 0xFFFFull) != 0ull, useB = b0_ >= 0 && ((tsB >> (16 * th)) & 0xFFFFull) != 0ull;
        const bool edgeA = (64 * a0 + 63 > t0) || (MODE == 1 && (t0 + 31 - 64 * a0 >= 512));
        const bool edgeB = b0_ >= 0 && ((64 * b0_ + 63 > t0) || (MODE == 1 && (t0 + 31 - 64 * b0_ >= 512)));
        if (useA && useB && !edgeA && !edgeB) {
            const bool rA = MODE == 1 || ((tsA >> (16 * th + (lane & 15))) & 1ull), rB = MODE == 1 || ((tsB >> (16 * th + (lane & 15))) & 1ull);
            if (__any((rA || rB) && mrow == -INFINITY)) attn_pair<MODE>(cur, cur + 9216, Pw, qa, bv0, a0, b0_, t0, th, slope2, tsA, tsB, O, mrow, lrow, lane);
            else attn_pair_fast<MODE>(cur, cur + 9216, Pw, qa, bv0, a0, b0_, t0, th, slope2, tsA, tsB, O, mrow, lrow, lane); }
        else {
            if (useA) { if (edgeA) attn_tile2<MODE, true>(cur, cur + 4608, Pw, qa, bv0, a0, t0, th, slope2, tsA, O, mrow, lrow, lane); else attn_tile2<MODE, false>(cur, cur + 4608, Pw, qa, bv0, a0, t0, th, slope2, tsA, O, mrow, lrow, lane); LDS_WAIT(); }
            if (useB) { if (edgeB) attn_tile2<MODE, true>(cur + 9216, cur + 13824, Pw, qa, bv0, b0_, t0, th, slope2, tsB, O, mrow, lrow, lane); else attn_tile2<MODE, false>(cur + 9216, cur + 13824, Pw, qa, bv0, b0_, t0, th, slope2, tsB, O, mrow, lrow, lane); }
        }
        TS_E(11); TS_B(12);
        LDS_BARRIER();
        TS_E(12);
        a0 = a1; b0_ = b1; a1 = a2; b1 = b2; buf ^= 1;
    }
#undef ATT_TAKE
#undef ATT_LOAD
#undef ATT_PUT
    { const float gt = GATEB[((size_t)b * SEQ + t0 + 16 * th + (lane & 15)) * 48 + h * 3 + 1 + MODE];
      const float gsc = gt / (lrow > 0.f ? lrow : 1.0f);
#pragma unroll
      for (int dt = 0; dt < 4; ++dt) outacc[dt] = outacc[dt] + O[dt] * gsc; }
}

template <int NT>
__device__ __forceinline__ void cmp_scores(const LAS bf16_t* BUF0, unsigned (&pw)[16][2], LAS float* impw, const bf16x8 (&qa)[2], int t, float slope2, int lane) {
    constexpr int TS = 72, PS = 264, IP = 66;
    const int cl = lane & 15, q4 = lane >> 4;
    const int cmaxl = (t >= 31) ? (((t - 31) >> 4) < 254 ? ((t - 31) >> 4) : 254) : -1;
    f32x4 bq; { const float b0 = slope2 * (float)(16 * (4 * q4) + 31 - t); bq = (f32x4){b0, b0 + 16.f * slope2, b0 + 32.f * slope2, b0 + 48.f * slope2}; }
    const float o256 = 256.f * slope2;
    f32x4 s[NT]; float cm = -INFINITY;
#pragma unroll
    for (int nt = 0; nt < NT; ++nt) { s[nt] = bq + (float)nt * o256;
#pragma unroll
        for (int ks = 0; ks < 2; ++ks) { const bf16x8 kb = *(const LAS bf16x8*)(BUF0 + (16 * nt + cl) * TS + 32 * ks + 8 * q4); s[nt] = __builtin_amdgcn_mfma_f32_16x16x32_bf16(kb, qa[ks], s[nt], 0, 0, 0); } }
#pragma unroll
    for (int nt = 0; nt < NT; ++nt) {
        if (nt >= NT - 5) {
#pragma unroll
            for (int j = 0; j < 4; ++j) { const bool ok = (16 * nt + 4 * q4 + j) <= cmaxl; s[nt][j] = ok ? s[nt][j] : -INFINITY; } }
        cm = fmaxf(cm, fmaxf(fmaxf(s[nt][0], s[nt][1]), fmaxf(s[nt][2], s[nt][3]))); }
    cm = fmaxf(cm, __shfl_xor(cm, 16)); cm = fmaxf(cm, __shfl_xor(cm, 32));
    cm = (cm == -INFINITY) ? 0.f : cm;
    float cs = 0.f;
#pragma unroll
    for (int nt = 0; nt < NT; ++nt)
#pragma unroll
        for (int j = 0; j < 4; ++j) { const float e = ex2(s[nt][j] - cm); s[nt][j] = e; cs += e; }
    cs += __shfl_xor(cs, 16); cs += __shfl_xor(cs, 32);
    const float cinv = 1.0f / (cs > 0.f ? cs : 1.0f);
    float rprev = 0.f;
#pragma unroll
    for (int nt = 0; nt < NT; ++nt) { float p[4];
#pragma unroll
        for (int j = 0; j < 4; ++j) p[j] = s[nt][j] * cinv;
        pw[nt][0] = pg8::cvt_pk_bf16(p[0], p[1]); pw[nt][1] = pg8::cvt_pk_bf16(p[2], p[3]);
        const float rot = __shfl(p[3], (lane + 48) & 63);
        impw[cl * IP + 4 * nt + q4] = ((p[0] + p[1]) + (p[2] + p[3])) + ((q4 == 0) ? rprev : rot);
        rprev = rot; }
}
template <int NK>
__device__ __forceinline__ void cmp_pv(const LAS bf16_t* BUF0, const unsigned (&pw)[16][2], f32x4 (&oc)[4], int lane) {
    constexpr int PS = 264; const int cl = lane & 15, q4 = lane >> 4;
#pragma unroll
    for (int ks = 0; ks < NK; ++ks) { const bf16x8 pa = __builtin_bit_cast(bf16x8, (u32x4){pw[2 * ks][0], pw[2 * ks][1], pw[2 * ks + 1][0], pw[2 * ks + 1][1]});
#pragma unroll
        for (int dt = 0; dt < 4; ++dt) { const bf16x8 vb = *(const LAS bf16x8*)(BUF0 + (16 * dt + cl) * PS + 32 * ks + 8 * q4); oc[dt] = __builtin_amdgcn_mfma_f32_16x16x32_bf16(vb, pa, oc[dt], 0, 0, 0); } }
}

__device__ __forceinline__ void attn_phase(LAS unsigned char* lds, const bf16_t* KV, const bf16_t* VT2, const bf16_t* QB, const float* GATEB, const bf16_t* KC, const bf16_t* VCT, bf16_t* OB, int wgc, int G) {
    const int tid = threadIdx.x, wave = __builtin_amdgcn_readfirstlane(tid >> 6), lane = tid & 63, cl = lane & 15, q4 = lane >> 4;
    constexpr int TS = 72, PS = 264, IP = 66;
    LAS bf16_t* KCs = (LAS bf16_t*)(lds + 0);
    LAS bf16_t* VCTs = (LAS bf16_t*)(lds + 36864);
    LAS bf16_t* Pw = (LAS bf16_t*)(lds + ATT_SET0);
    LAS float* IMP = (LAS float*)(lds + ATT_SET1);
    LAS u64* SEL = (LAS u64*)(lds + ATT_SET1 + 33792);
    const float LOG2E = 1.4426950408889634f;
#if TSEG
    unsigned long long tseg_acc = 0, tseg_t = 0;
#endif
    const int nj = G < 8 ? G : 8, nslot = G / nj, js0 = wgc % nj, slot = wgc / nj, cb = (128 - js0 + nj - 1) / nj;
    int bg_loaded = -1;
    for (int it = 0; slot < nslot; ++it) {
        const int bg = slot + (it / cb) * nslot; if (bg >= 32) break;
        const int uu = js0 + (it % cb) * nj, i = uu >> 3, js = uu & 7;
        const int qt = 8 * i + ((i & 1) ? 7 - js : js);
        if (bg != bg_loaded) { bg_loaded = bg;
            __syncthreads();
#pragma unroll
            for (int k = 0; k < 4; ++k) { const int id = tid + 512 * k, row = id >> 3, cc = id & 7; *(LAS u32x4*)(KCs + row * TS + 8 * cc) = *(const u32x4*)(KC + ((size_t)bg * 256 + row) * 64 + 8 * cc); }
#pragma unroll
            for (int k = 0; k < 4; ++k) { const int id = tid + 512 * k, d = id >> 5, cc = id & 31; *(LAS u32x4*)(VCTs + d * PS + 8 * cc) = *(const u32x4*)(VCT + ((size_t)bg * 64 + d) * 256 + 8 * cc); }
            __syncthreads(); }
        const int b = bg >> 2, g = bg & 3, t0 = qt * 32;
        TS_B(1);
        const int r = wave >> 1, th = wave & 1, h = 4 * g + r;
        const float slope2 = exp2f(-0.5f * (float)(h + 1)) * LOG2E;
        LAS unsigned char* ql = lds + ATT_QL + wave * 2048;
#define ATT_QDMA(bg_, qt_) do { const bf16_t* qsrc = QB + ((size_t)((bg_) >> 2) * SEQ + (qt_) * 32 + 16 * th + (lane >> 3)) * 1024 + (4 * ((bg_) & 3) + r) * 64 + 8 * (lane & 7); \
            __builtin_amdgcn_global_load_lds((const unsigned*)qsrc, (LAS unsigned*)ql, 16, 0, 0); __builtin_amdgcn_global_load_lds((const unsigned*)(qsrc + 8 * 1024), (LAS unsigned*)(ql + 1024), 16, 0, 0); } while (0)
        if (it == 0) ATT_QDMA(bg, qt);
        asm volatile("s_waitcnt vmcnt(0)" ::: "memory");
        bf16x8 qa[2];
        qa[0] = *(const LAS bf16x8*)(ql + cl * 128 + 16 * q4); qa[1] = *(const LAS bf16x8*)(ql + cl * 128 + 64 + 16 * q4);
        LDS_WAIT();
        { const int it1 = it + 1, bgn = slot + (it1 / cb) * nslot, uun = js0 + (it1 % cb) * nj, in_ = uun >> 3, jsn = uun & 7;
          if (bgn < 32) ATT_QDMA(bgn, 8 * in_ + ((in_ & 1) ? 7 - jsn : jsn)); }
#undef ATT_QDMA
        f32x4 outacc[4];
        TS_E(1); TS_B(2);
        const int ng = (t0 >> 10) + 1;
        unsigned cpw[16][2];
        {   LAS float* impw = IMP + wave * (16 * IP);
            const int t = t0 + 16 * th + cl;
            if (ng == 1) cmp_scores<4>(KCs, cpw, impw, qa, t, slope2, lane);
            else if (ng == 2) cmp_scores<8>(KCs, cpw, impw, qa, t, slope2, lane);
            else if (ng == 3) cmp_scores<12>(KCs, cpw, impw, qa, t, slope2, lane);
            else cmp_scores<16>(KCs, cpw, impw, qa, t, slope2, lane);
        }
        TS_E(2); TS_B(3);
        __syncthreads();
        TS_E(3); TS_B(4);
        {   u64 key[4], pre[4], dmsk[4]; int open = 0;
#pragma unroll
            for (int e = 0; e < 4; ++e) { const int tk = 4 * wave + e, tt = t0 + tk, cur = tt >> 6;
                float v = 0.f;
#pragma unroll
                for (int rr = 0; rr < 4; ++rr) v += IMP[((2 * rr + (tk >> 4)) * 16 + (tk & 15)) * IP + lane];
                const bool forced = (lane == 0) || (lane == cur) || (lane == cur - 1);
                v = fmaxf(v, 0.f); if (forced) v = 1e4f;
                const bool valid = lane <= cur;
                key[e] = valid ? (((u64)__builtin_bit_cast(unsigned, v) << 6) | (u64)(63 - lane)) + 1ull : 0ull;
                pre[e] = 0ull;
                const u64 nzm = __ballot(valid && v > 0.f), zm = __ballot(valid && !(v > 0.f));
                const int nz = __builtin_popcount((unsigned)nzm) + __builtin_popcount((unsigned)(nzm >> 32));
                const int zrank = __builtin_amdgcn_mbcnt_hi((unsigned)(zm >> 32), __builtin_amdgcn_mbcnt_lo((unsigned)zm, 0u));
                dmsk[e] = nzm | __ballot(valid && !(v > 0.f) && zrank < 16 - nz);
                if (nz > 16) open |= 1 << e; }
            const int searched = open;
#pragma unroll 1
            for (int bit = 36; bit >= 0 && open; --bit) { const u64 bm = 1ull << bit;
#pragma unroll
                for (int e = 0; e < 4; ++e) { const u64 cand = pre[e] | bm; const u64 bal = __ballot(key[e] >= cand);
                    const unsigned cnt = (unsigned)__builtin_popcount((unsigned)bal) + (unsigned)__builtin_popcount((unsigned)(bal >> 32));
                    pre[e] = (cnt >= 16u) ? cand : pre[e]; if (cnt == 16u) open &= ~(1 << e); } }
#pragma unroll
            for (int e = 0; e < 4; ++e) { const u64 smsk = __ballot(key[e] >= (pre[e] ? pre[e] : 1ull)); const u64 msk = ((searched >> e) & 1) ? smsk : dmsk[e]; if (lane == 0) SEL[4 * wave + e] = msk; }
        }
        TS_E(4); TS_B(6);
        {
            f32x4 oc[4];
#pragma unroll
            for (int dt = 0; dt < 4; ++dt) oc[dt] = (f32x4){0.f, 0.f, 0.f, 0.f};
            if (ng == 1) cmp_pv<2>(VCTs, cpw, oc, lane); else if (ng == 2) cmp_pv<4>(VCTs, cpw, oc, lane); else if (ng == 3) cmp_pv<6>(VCTs, cpw, oc, lane); else cmp_pv<8>(VCTs, cpw, oc, lane);
            const float gc = GATEB[((size_t)b * SEQ + t0 + 16 * th + cl) * 48 + h * 3];
#pragma unroll
            for (int dt = 0; dt < 4; ++dt) outacc[dt] = oc[dt] * gc;
        }
        TS_E(6); TS_B(5);
        __syncthreads();
        TS_E(5); TS_B(7);
        u64 tselv = 0ull;
#pragma unroll 8
        for (int tk = 0; tk < 32; ++tk) { const u64 sv = SEL[tk]; tselv |= ((sv >> lane) & 1ull) << tk; }
        const u64 uni = __ballot(tselv != 0ull);
        TS_E(7); TS_B(8);
#if TSEG
        attn_branch<0>(lds, Pw, KV, VT2, GATEB, qa, outacc, uni, tselv, b, bg, h, t0, th, slope2, tseg_acc);
#else
        attn_branch<0>(lds, Pw, KV, VT2, GATEB, qa, outacc, uni, tselv, b, bg, h, t0, th, slope2);
#endif
        TS_E(8); TS_B(9);
#if TSEG
        attn_branch<1>(lds, Pw, KV, VT2, GATEB, qa, outacc, uni, tselv, b, bg, h, t0, th, slope2, tseg_acc);
#else
        attn_branch<1>(lds, Pw, KV, VT2, GATEB, qa, outacc, uni, tselv, b, bg, h, t0, th, slope2);
#endif
        TS_E(9);
        { bf16_t* op = OB + ((size_t)b * SEQ + t0 + 16 * th + cl) * 1024 + h * 64 + 4 * q4;
#pragma unroll
          for (int dt = 0; dt < 4; ++dt) { u32x2 w; w.x = pg8::cvt_pk_bf16(outacc[dt][0], outacc[dt][1]); w.y = pg8::cvt_pk_bf16(outacc[dt][2], outacc[dt][3]); *(u32x2*)(op + 16 * dt) = w; } }
    }
#if TSEG
    { const unsigned long long w0 = __builtin_amdgcn_s_memrealtime(); while (__builtin_amdgcn_s_memrealtime() - w0 < 2 * tseg_acc) __builtin_amdgcn_s_sleep(8); }
#endif
}

constexpr int NPHASE = 20;
__global__ void __launch_bounds__(NTHR, 2) yoco_fwd(Args args) {
    extern __shared__ __attribute__((aligned(16))) unsigned char lds_raw[];
    LAS unsigned char* lds = (LAS unsigned char*)lds_raw;
    volatile LAS unsigned* MISC = (volatile LAS unsigned*)(lds + MISC_OFF);
    const int tid = threadIdx.x, lane = tid & 63, wave = __builtin_amdgcn_readfirstlane(tid >> 6);
    const int G = gridDim.x, bx = blockIdx.x;
    const int vcu = (G % 8 == 0) ? (bx % 8) * (G / 8) + bx / 8 : bx;
    const int gw = vcu * NWAVES + wave, NGW = G * NWAVES;
    unsigned char* ws = args.ws;
    unsigned* ctl = (unsigned*)(ws + WS_CTL);
    if (tid < 64) MISC[tid] = 0u;
    __syncthreads();
    XcdBarrier bar; bar.bar = ctl + CW_BAR; bar.x = 0; bar.st = MISC + 60;
    if (!MK_PER_PHASE) bar = xcd_barrier_post(ctl + CW_BAR, MISC + 60);
    const int lo = args.ph_lo, hi = args.ph_hi;
#ifndef PHMASK
#define PHMASK 0xFFFFFFu
#endif
#ifndef PROBE_SKIP
#define PROBE_SKIP 0
#endif
constexpr unsigned PHSKIP = 0u;
#define IN(k) ((((PHMASK & ~PHSKIP) >> (k)) & 1u) && lo <= (k) && (k) < hi)
#ifndef P0REP
#define P0REP 0
#endif
#ifndef REPMASK
#define REPMASK 0x0u
#endif
#define PH(k) for (int _r = 0, _n = IN(k) ? ((((REPMASK) >> (k)) & 1u) ? 2 : 1) : 0; _r < _n; ++_r)
#ifndef PHT
#define PHT -1
#endif
#if PHT >= 0
    unsigned long long pht_t = __builtin_amdgcn_s_memrealtime();
#define SEAM(k) do { if (PHT == (k)) { const unsigned long long d_ = __builtin_amdgcn_s_memrealtime() - pht_t, w0_ = __builtin_amdgcn_s_memrealtime(); while (__builtin_amdgcn_s_memrealtime() - w0_ < d_) __builtin_amdgcn_s_sleep(8); } \
        if (lo <= (k) && (k) + 1 < hi) xcd_barrier(bar); pht_t = __builtin_amdgcn_s_memrealtime(); } while (0)
#else
#define SEAM(k) do { if (lo <= (k) && (k) + 1 < hi) xcd_barrier(bar); } while (0)
#endif

    const float* x = A_IN(I_X);
    float* xs = args.out;
    bf16_t* XH = (bf16_t*)(ws + WS_XH);
    float* GA = (float*)(ws + WS_GA);
    float* bias1 = (float*)(ws + WS_SMALL);
    unsigned* EIDX = (unsigned*)(ws + WS_SMALL + 8192);
    float* EW = (float*)(ws + WS_SMALL + 8192 + 131072);
    u32x2* ROWINFO = (u32x2*)(ws + WS_ROWINFO);

    PH(0) {
        for (int _q = 0; _q < ((P0REP & 1) ? 2 : 1); ++_q) p0_weights(ws, lds, gw, NGW, wave, lane, G != 256);
        __syncthreads();
        LAS float* Wg = (LAS float*)lds;
        for (int i = tid; i < 8192; i += NTHR) { const int k = i >> 3, e = i & 7; Wg[(e >> 2) * 4096 + ((((k >> 8) * 4 + (k & 3)) * 64 + ((k & 255) >> 2)) << 2) + (e & 3)] = A_IN(I_A_W_IN)[(size_t)k * NPROJ_SRC + 4096 + e] * A_IN(I_NORM_MIX)[k]; }
        __syncthreads();
        for (int _q = 0; _q < ((P0REP & 2) ? 2 : 1); ++_q) {
        f32x4 vn[4]; if (gw < M) load_row(x + (size_t)gw * D, lane, vn);
        for (int m = gw; m < M; m += NGW) {
            f32x4 v[4];
#pragma unroll
            for (int j = 0; j < 4; ++j) v[j] = vn[j];
            load_row(x + (size_t)(m + NGW < M ? m + NGW : m) * D, lane, vn);
            const float rstd = row_rstd(v);
            store_row_bf16(XH + (size_t)m * D, lane, v, rstd);
            float gsum[8];
#pragma unroll
            for (int e = 0; e < 8; ++e) gsum[e] = 0.f;
#pragma unroll
            for (int j = 0; j < 4; ++j)
#pragma unroll
                for (int c = 0; c < 4; ++c) { const f32x4 w0 = *(const LAS f32x4*)(Wg + (((j * 4 + c) * 64 + lane) << 2)), w1 = *(const LAS f32x4*)(Wg + 4096 + (((j * 4 + c) * 64 + lane) << 2)); const float xv = v[j][c];
                    gsum[0] += xv * w0.x; gsum[1] += xv * w0.y; gsum[2] += xv * w0.z; gsum[3] += xv * w0.w; gsum[4] += xv * w1.x; gsum[5] += xv * w1.y; gsum[6] += xv * w1.z; gsum[7] += xv * w1.w; }
#pragma unroll
            for (int e = 0; e < 8; ++e) gsum[e] = wave_sum(gsum[e]) * rstd + A_IN(I_A_B_GATE)[e];
            if (lane == 0) {
#pragma unroll
                for (int e = 0; e < 4; ++e) GA[(size_t)m * 8 + e] = gsum[e];
#pragma unroll
                for (int e = 4; e < 8; ++e) { const float g = gsum[e]; GA[(size_t)m * 8 + e] = fminf(g, 0.f) - log1pf(__expf(-fabsf(g))); } }
        }
        }
        __syncthreads();
        for (int it = bx; it < 256; it += G) { const int c = it >> 7, nb = (it >> 4) & 7, fc = it & 15, n = nb * 32 + (tid & 31), fs = tid >> 5; float s = 0.f;
#pragma unroll
            for (int k = 0; k < 8; ++k) { const int f = fc * 128 + fs * 8 + k; s += A_IN(I_B_CMP_POS)[((f >> 6) * 2 + c) * 64 + (f & 63)] * A_IN(I_B_CMP_W1)[((size_t)c * 2048 + f) * 256 + n]; }
            LAS float* red = (LAS float*)lds; __syncthreads(); red[tid] = s; __syncthreads();
            if (tid < 32) { float t = 0.f; for (int k = 0; k < 16; ++k) t += red[k * 32 + tid]; ((float*)(ws + WS_SMALL + 401408))[(c * 256 + n) * 16 + fc] = t; }
            __syncthreads(); }
    }
    SEAM(0);
    PH(1) { if (bx == 0) { const float* bp = (const float*)(ws + WS_SMALL + 401408) + tid * 16; float t = 0.f; for (int k = 0; k < 16; ++k) t += bp[k]; bias1[tid] = t; }
        pg8::PlainOrder S; S.init(XH, (const bf16_t*)(ws + WS_WIN), M, NPROJ, D, D, G, bx); pg8::EpiProjSplit E{(bf16_t*)(ws + WS_PROJ3), (bf16_t*)(ws + WS_OG)};
        pg8::gemm_phase(lds, pg8::Dims{D, D, D}, S, E); }
    SEAM(1);
    PH(2) scanprep_phase(lds, (const bf16_t*)(ws + WS_PROJ3), GA, A_IN(I_A_CONV), ws + WS_IMG, vcu, G);
    SEAM(2);
    PH(3) scan_phase(lds, ws + WS_IMG, (float*)(ws + WS_HS), (float*)(ws + WS_DN), vcu, G, ws);
    SEAM(3);
    PH(4) {
        const float* HS = (const float*)(ws + WS_HS); const float* DN = (const float*)(ws + WS_DN); const bf16_t* OG = (const bf16_t*)(ws + WS_OG); bf16_t* HN = (bf16_t*)(ws + WS_HN);
        f32x4 vn[4], dnn; u32x2 ogn[4];
#define P4_LOAD(mm) do { load_row(HS + (size_t)(mm) * D, lane, vn); dnn = *(const f32x4*)(DN + (size_t)(mm) * 4); \
            _Pragma("unroll") for (int j = 0; j < 4; ++j) ogn[j] = *(const u32x2*)(OG + (size_t)(mm) * D + 4 * lane + 256 * j); } while (0)
        P4_LOAD(gw < M ? gw : 0);
        f32x4 gvv[4];
#pragma unroll
        for (int j = 0; j < 4; ++j) gvv[j] = *((const f32x4*)A_IN(I_A_NORM_H) + lane + 64 * j);
        for (int m = gw; m < M; m += NGW) { f32x4 v[4]; u32x2 og[4]; const f32x4 dn = dnn;
#pragma unroll
            for (int j = 0; j < 4; ++j) { v[j] = vn[j]; og[j] = ogn[j]; }
            P4_LOAD(m + NGW < M ? m + NGW : m);
            u64* o8 = (u64*)(HN + (size_t)m * D) + lane;
#pragma unroll
            for (int j = 0; j < 4; ++j) { v[j] = v[j] * (1.0f / dn[j]); float s = (v[j].x * v[j].x + v[j].y * v[j].y) + (v[j].z * v[j].z + v[j].w * v[j].w); s = wave_sum(s);
                const float rs = 1.0f / sqrtf(s * (1.f / 256.f) + EPS);
                const u32x2 oraw = og[j]; const f32x4 gv = gvv[j];
                const float o0 = v[j].x * rs * gv.x * sigmoidf_(bflo(oraw.x)), o1 = v[j].y * rs * gv.y * sigmoidf_(bfhi(oraw.x)), o2 = v[j].z * rs * gv.z * sigmoidf_(bflo(oraw.y)), o3 = v[j].w * rs * gv.w * sigmoidf_(bfhi(oraw.y));
                o8[64 * j] = (u64)pk2(o0, o1) | ((u64)pk2(o2, o3) << 32); } }
#undef P4_LOAD
    }
    SEAM(4);
    PH(5) { pg8::PlainOrder S; S.init((const bf16_t*)(ws + WS_HN), (const bf16_t*)(ws + WS_WOUTA), M, D, D, D, G, bx); pg8::EpiRes16<false, true> E{x, XH, (float*)(ws + WS_SSP), D};
        pg8::gemm_phase(lds, pg8::Dims{D, D, D}, S, E); }
    SEAM(5);
    PH(6) { const float* sp = (const float*)(ws + WS_SSP); float* rs = (float*)(ws + WS_RS);
        for (int r = bx * NTHR + tid; r < M; r += G * NTHR) rs[r] = pg8::row_rs16(sp, r); }
    SEAM(6);
    PH(7) { pg8::PlainOrder S; S.init(XH, (const bf16_t*)(ws + WS_WGU), M, 2 * FFD, D, D, G, bx); pg8::EpiSwiGLU E{(bf16_t*)(ws + WS_ACT), FFD, (const float*)(ws + WS_RS)};
        if (EXPT && _r == 1) { S.same = 11; E.O = (bf16_t*)(ws + WS_END2); }
#if TPROBE
        float* tkp = (float*)(ws + WS_END2 + 2 * MiB); const unsigned long long tp0 = __builtin_amdgcn_s_memrealtime();
        pg8::gemm_phase(lds, pg8::Dims{D, D, D, 127, 127, bx == 0 ? tkp : nullptr}, S, E);
        if (bx == 0 && tid == 0) tkp[2] = (float)(__builtin_amdgcn_s_memrealtime() - tp0);
#else
        pg8::gemm_phase(lds, pg8::Dims{D, D, D}, S, E);
#endif
    }
    SEAM(7);
    PH(8) { pg8::PlainOrder S; S.init((const bf16_t*)(ws + WS_ACT), (const bf16_t*)(ws + WS_WDOWN), M, D, FFD, FFD, G, bx); pg8::EpiRes16<true, true> E{nullptr, XH, (float*)(ws + WS_SSP), D};
        pg8::gemm_phase(lds, pg8::Dims{FFD, FFD, FFD}, S, E); }
    SEAM(8);
    PH(9) { const float* sp = (const float*)(ws + WS_SSP); float* rs = (float*)(ws + WS_RS);
        for (int r = bx * NTHR + tid; r < M; r += G * NTHR) rs[r] = pg8::row_rs16(sp, r); }
    SEAM(9);
    PH(10) { pg8::PlainOrder S; S.init(XH, (const bf16_t*)(ws + WS_WKVQ), M, NKVQ, D, D, G, bx); pg8::EpiKVQ E{(bf16_t*)(ws + WS_KV), (bf16_t*)(ws + WS_QB), (float*)(ws + WS_GATEB), A_IN(I_B_B_GATE), (const float*)(ws + WS_RS)};
        pg8::gemm_phase(lds, pg8::Dims{D, D, D}, S, E); }
    SEAM(10);
    PH(11) {
        struct CmpOrder { int G, c; const char* A; const char* B;
            __device__ __forceinline__ bool next(int i, pg8::Unit& u) const { const int L = i * G + c; if (L >= 64) return false; u.pm = L; u.pn = 0; u.a = A + (size_t)L * 256 * 1024 * 2; u.b = B + (size_t)(L >> 5) * 256 * 2048 * 2; return true; } };
        CmpOrder S{G, bx, (const char*)(ws + WS_KV), (const char*)(ws + WS_WCMP1)}; pg8::EpiCmp E{(bf16_t*)(ws + WS_HID), bias1};
        if (bx < 64 || G <= 64) pg8::gemm_phase(lds, pg8::Dims{2048, 1024, 2048}, S, E);
        if (bx >= 64 || G <= 64) {
        { LAS bf16_t* T = (LAS bf16_t*)lds; const size_t PLANE = (size_t)8 * 4 * 4096 * 64;
          for (int it = (G <= 64) ? bx : bx - 64; it < 4096; it += (G <= 64) ? G : G - 64) { const int mode = it >> 11, rest = it & 2047;
              const bf16_t* src = (const bf16_t*)(ws + WS_KV) + (size_t)(mode == 0 ? 3 : 5) * PLANE + (size_t)rest * 4096; bf16_t* dst = (bf16_t*)(ws + WS_VT2) + ((size_t)mode * 2048 + rest) * 4096;
              const int row = tid >> 3, cc = tid & 7; const u32x4 raw = *(const u32x4*)(src + (size_t)tid * 8);
              const int prow = (row & 32) | (((row >> 2) & 3) << 3) | (((row >> 4) & 1) << 2) | (row & 3);
              __syncthreads();
              T[(8 * cc + 0) * 72 + prow] = (bf16_t)(raw.x & 0xffff); T[(8 * cc + 1) * 72 + prow] = (bf16_t)(raw.x >> 16); T[(8 * cc + 2) * 72 + prow] = (bf16_t)(raw.y & 0xffff); T[(8 * cc + 3) * 72 + prow] = (bf16_t)(raw.y >> 16);
              T[(8 * cc + 4) * 72 + prow] = (bf16_t)(raw.z & 0xffff); T[(8 * cc + 5) * 72 + prow] = (bf16_t)(raw.z >> 16); T[(8 * cc + 6) * 72 + prow] = (bf16_t)(raw.w & 0xffff); T[(8 * cc + 7) * 72 + prow] = (bf16_t)(raw.w >> 16);
              __syncthreads();
              *(u32x4*)(dst + (size_t)tid * 8) = *(const LAS u32x4*)(T + row * 72 + 8 * cc); } }
        } }
    SEAM(11);
    PH(12) { const bf16_t* HID = (const bf16_t*)(ws + WS_HID); const bf16_t* W2T = (const bf16_t*)(ws + WS_W2T);
        if (gw < 512) { const int c = gw >> 8, r0 = 32 * (gw & 255); const int cl = lane & 15, q4 = lane >> 4;
            f32x4 acc[2][4];
#pragma unroll
            for (int rt = 0; rt < 2; ++rt)
#pragma unroll
                for (int dt = 0; dt < 4; ++dt) acc[rt][dt] = (f32x4){0.f, 0.f, 0.f, 0.f};
            const bf16_t* hp = HID + ((size_t)c * 8192 + r0 + cl) * 256 + 8 * q4; const bf16_t* wp = W2T + ((size_t)c * 64 + cl) * 256 + 8 * q4;
#pragma unroll 2
            for (int ks = 0; ks < 8; ++ks) { bf16x8 a[2], w[4];
#pragma unroll
                for (int rt = 0; rt < 2; ++rt) a[rt] = *(const bf16x8*)(hp + (size_t)rt * 16 * 256 + 32 * ks);
#pragma unroll
                for (int dt = 0; dt < 4; ++dt) w[dt] = *(const bf16x8*)(wp + (size_t)dt * 16 * 256 + 32 * ks);
#pragma unroll
                for (int rt = 0; rt < 2; ++rt)
#pragma unroll
                    for (int dt = 0; dt < 4; ++dt) acc[rt][dt] = (c == 0) ? __builtin_amdgcn_mfma_f32_16x16x32_bf16(w[dt], a[rt], acc[rt][dt], 0, 0, 0) : __builtin_amdgcn_mfma_f32_16x16x32_bf16(a[rt], w[dt], acc[rt][dt], 0, 0, 0); }
#pragma unroll
            for (int rt = 0; rt < 2; ++rt)
#pragma unroll
                for (int dt = 0; dt < 4; ++dt) { u32x2 p; p.x = pk2(acc[rt][dt][0], acc[rt][dt][1]); p.y = pk2(acc[rt][dt][2], acc[rt][dt][3]);
                    if (c == 0) *(u32x2*)((bf16_t*)(ws + WS_KC) + (size_t)(r0 + 16 * rt + cl) * 64 + 16 * dt + 4 * q4) = p;
                    else { const int R = r0 + 16 * rt + 4 * q4, cidx = R & 255, pc = (cidx & ~31) | (((cidx >> 2) & 3) << 3) | (((cidx >> 4) & 1) << 2);
                        *(u32x2*)((bf16_t*)(ws + WS_VC) + ((size_t)(R >> 8) * 64 + 16 * dt + cl) * 256 + pc) = p; } }
        }
    }
    SEAM(12);
    PH(13) attn_phase(lds, (const bf16_t*)(ws + WS_KV), (const bf16_t*)(ws + WS_VT2), (const bf16_t*)(ws + WS_QB), (const float*)(ws + WS_GATEB), (const bf16_t*)(ws + WS_KC), (const bf16_t*)(ws + WS_VC), (bf16_t*)(ws + WS_OB), vcu, G);
    SEAM(13);
    PH(14) { pg8::PlainOrder S; S.init((const bf16_t*)(ws + WS_OB), (const bf16_t*)(ws + WS_WOUTB), M, D, D, D, G, bx); pg8::EpiRes16<true, false> E{nullptr, XH, nullptr, D};
        pg8::gemm_phase(lds, pg8::Dims{D, D, D}, S, E); }
    SEAM(14);
    PH(15) {
        LAS float* Wr = (LAS float*)lds;
        for (int i = tid; i < 8192; i += NTHR) { const int k = i >> 3, e = i & 7; Wr[(e >> 2) * 4096 + ((((k >> 8) * 4 + (k & 3)) * 64 + ((k & 255) >> 2)) << 2) + (e & 3)] = A_IN(I_M_ROUTER)[i] * A_IN(I_NORM_FFN)[1024 + k]; }
        __syncthreads();
        u32x2 rn[4];
#pragma unroll
        for (int j = 0; j < 4; ++j) rn[j] = *(const u32x2*)(XH + (size_t)(gw < M ? gw : 0) * D + 4 * lane + 256 * j);
        for (int m = gw; m < M; m += NGW) {
            f32x4 v[4];
#pragma unroll
            for (int j = 0; j < 4; ++j) v[j] = (f32x4){bflo(rn[j].x), bfhi(rn[j].x), bflo(rn[j].y), bfhi(rn[j].y)};
#pragma unroll
            for (int j = 0; j < 4; ++j) rn[j] = *(const u32x2*)(XH + (size_t)(m + NGW < M ? m + NGW : m) * D + 4 * lane + 256 * j);
            const float rstd = row_rstd(v);
            if (lane == 0) ((float*)(ws + WS_RS))[m] = rstd;
            float gsum[8];
#pragma unroll
            for (int e = 0; e < 8; ++e) gsum[e] = 0.f;
#pragma unroll
            for (int j = 0; j < 4; ++j)
#pragma unroll
                for (int c = 0; c < 4; ++c) { const f32x4 w0 = *(const LAS f32x4*)(Wr + (((j * 4 + c) * 64 + lane) << 2)), w1 = *(const LAS f32x4*)(Wr + 4096 + (((j * 4 + c) * 64 + lane) << 2)); const float xv = v[j][c];
                    gsum[0] += xv * w0.x; gsum[1] += xv * w0.y; gsum[2] += xv * w0.z; gsum[3] += xv * w0.w; gsum[4] += xv * w1.x; gsum[5] += xv * w1.y; gsum[6] += xv * w1.z; gsum[7] += xv * w1.w; }
#pragma unroll
            for (int e = 0; e < 8; ++e) gsum[e] = wave_sum(gsum[e]) * rstd;
            if (lane == 0) { int e1 = 0; float v1 = gsum[0];
#pragma unroll
                for (int e = 1; e < 8; ++e) if (gsum[e] > v1) { v1 = gsum[e]; e1 = e; }
                int e2 = -1; float v2 = -INFINITY;
#pragma unroll
                for (int e = 0; e < 8; ++e) if (e != e1 && gsum[e] > v2) { v2 = gsum[e]; e2 = e; }
                const float ex = __expf(v2 - v1), w1 = 1.0f / (1.0f + ex), w2 = ex * w1;
                EIDX[m] = (unsigned)e1 | ((unsigned)e2 << 8); EW[2 * (size_t)m] = w1; EW[2 * (size_t)m + 1] = w2;
                int* cc = (int*)(ws + WS_CTL + 524288) + (m >> 7) * 8; atomicAdd(cc + e1, 1); atomicAdd(cc + e2, 1); }
        }
    }
    SEAM(15);
    volatile LAS int* tb = (volatile LAS int*)(lds + MISC_OFF);
    PH(16) {
        LAS int* cnt_all = (LAS int*)lds;
        LAS int* posl = (LAS int*)(lds + 256);
        bf16_t* XG = (bf16_t*)(ws + WS_XG);
        for (int ch = bx; ch < M / 128; ch += G) {
            __syncthreads();
            if (tid < 16) cnt_all[tid] = 0;
            __syncthreads();
            int ct[8], cb[8];
#pragma unroll
            for (int e = 0; e < 8; ++e) { ct[e] = 0; cb[e] = 0; }
            if (tid < M / 128) { const int* cc = (const int*)(ws + WS_CTL + 524288) + tid * 8; const bool before = tid < ch;
#pragma unroll
                for (int e = 0; e < 8; ++e) { const int hit = cc[e]; ct[e] = hit; cb[e] = before ? hit : 0; } }
#pragma unroll
            for (int e = 0; e < 8; ++e) { int a = ct[e], b2 = cb[e];
#pragma unroll
                for (int o = 1; o < 64; o <<= 1) { a += __shfl_xor(a, o); b2 += __shfl_xor(b2, o); }
                if (lane == 0) { atomicAdd((int*)&cnt_all[e], a); atomicAdd((int*)&cnt_all[8 + e], b2); } }
            __syncthreads();
            if (wave == 0) {
                int base[8]; int run = 0;
#pragma unroll
                for (int e = 0; e < 8; ++e) { base[e] = run * 256 + cnt_all[8 + e]; run += (cnt_all[e] + 255) >> 8; }
#pragma unroll 1
                for (int half = 0; half < 2; ++half) { const int m = ch * 128 + half * 64 + lane; const unsigned ei = EIDX[m]; const int e1 = ei & 255, e2 = (ei >> 8) & 255;
                    int p1 = 0, p2 = 0;
#pragma unroll
                    for (int e = 0; e < 8; ++e) { const u64 mk = __ballot(e1 == e || e2 == e); const int rk = __popcll(mk & ((1ull << lane) - 1ull));
                        if (e1 == e) p1 = base[e] + rk; if (e2 == e) p2 = base[e] + rk; base[e] += __popcll(mk); }
                    posl[(half * 64 + lane) * 2] = p1; posl[(half * 64 + lane) * 2 + 1] = p2;
                    ROWINFO[p1] = (u32x2){(unsigned)m << 1, __builtin_bit_cast(unsigned, EW[2 * (size_t)m])};
                    ROWINFO[p2] = (u32x2){((unsigned)m << 1) | 1u, __builtin_bit_cast(unsigned, EW[2 * (size_t)m + 1])}; }
                if (ch == 0 && lane < 8) ((int*)(ws + WS_SMALL + 4096))[lane] = cnt_all[lane];
            }
            __syncthreads();
            for (int rr = wave; rr < 256; rr += NWAVES) { const int m = ch * 128 + (rr >> 1); const int p = posl[rr]; const float s16 = ((const float*)(ws + WS_RS))[m] * 16.f;
                const u32x4 a0 = ((const u32x4*)(XH + (size_t)m * D))[2 * lane], a1 = ((const u32x4*)(XH + (size_t)m * D))[2 * lane + 1];
                u32x4 o; o.x = pk_fp8x4(bflo(a0.x) * s16, bfhi(a0.x) * s16, bflo(a0.y) * s16, bfhi(a0.y) * s16); o.y = pk_fp8x4(bflo(a0.z) * s16, bfhi(a0.z) * s16, bflo(a0.w) * s16, bfhi(a0.w) * s16);
                o.z = pk_fp8x4(bflo(a1.x) * s16, bfhi(a1.x) * s16, bflo(a1.y) * s16, bfhi(a1.y) * s16); o.w = pk_fp8x4(bflo(a1.z) * s16, bfhi(a1.z) * s16, bflo(a1.w) * s16, bfhi(a1.w) * s16);
                ((u32x4*)((unsigned char*)XG + (size_t)p * D))[lane] = o; }
        }
    }
    SEAM(16);
    if (IN(17) || IN(18)) {
        __syncthreads();
        if (tid == 0) { const int* cg = (const int*)(ws + WS_SMALL + 4096); int run = 0;
            for (int e = 0; e < 8; ++e) { const int c = cg[e]; tb[e] = run; tb[16 + e] = c; run += (c + 255) >> 8; } tb[8] = run; }
        __syncthreads();
    }
    PH(17) { MoeOrder S{2 * FE / 256, G, bx, (const char*)(ws + WS_XG), (const char*)(ws + WS_MGU), (size_t)256 * D, (size_t)2 * FE * D, (size_t)256 * D, tb};
        pg8::EpiSwiGLU8 E{ws + WS_ACTS, FE, 8.f}; pg8::gemm_phase<pg8::EpiSwiGLU8, MoeOrder, true, true, true>(lds, pg8::Dims{D / 2, D / 2, D / 2, 127 - 4, 127 - 7}, S, E); }
    SEAM(17);
    PH(18) { MoeOrder S{D / 256, G, bx, (const char*)(ws + WS_ACTS), (const char*)(ws + WS_MDOWN), (size_t)256 * FE, (size_t)D * FE, (size_t)256 * FE, tb};
        EpiMoeDown E{(bf16_t*)(ws + WS_Y1), ROWINFO, EW, tb}; pg8::gemm_phase<EpiMoeDown, MoeOrder, true, true, true>(lds, pg8::Dims{FE / 2, FE / 2, FE / 2, 127 - 3, 127 - 8}, S, E); }
    SEAM(18);
    PH(19) { const bf16_t* Yb = (const bf16_t*)(ws + WS_Y1); const unsigned bad = xb_ld(ctl + CW_BAR + XB_TMO);
#if TPROBE
        const float* tkp = (const float*)(ws + WS_END2 + 2 * MiB); const float pfac = 1.0f + 0.25f * (tkp[TPROBE - 1] / tkp[2]);
#else
        const float pfac = 1.0f;
#endif
        u32x2 xn[4], y0n[4], y1n[4]; f32x4 gfin[4];
#define P19_LOAD(mm) do { _Pragma("unroll") for (int j = 0; j < 4; ++j) { xn[j] = *(const u32x2*)(XH + (size_t)(mm) * D + 4 * lane + 256 * j); \
            y0n[j] = *(const u32x2*)(Yb + (size_t)(mm) * D + 4 * lane + 256 * j); y1n[j] = *(const u32x2*)(Yb + ((size_t)M + (mm)) * D + 4 * lane + 256 * j); } } while (0)
        P19_LOAD(gw < M ? gw : 0);
#pragma unroll
        for (int j = 0; j < 4; ++j) gfin[j] = *((const f32x4*)A_IN(I_NORM_FINAL) + lane + 64 * j);
        for (int m = gw; m < M; m += NGW) { f32x4 v[4]; u32x2 y0[4], y1[4];
#pragma unroll
            for (int j = 0; j < 4; ++j) { v[j] = (f32x4){bflo(xn[j].x), bfhi(xn[j].x), bflo(xn[j].y), bfhi(xn[j].y)}; y0[j] = y0n[j]; y1[j] = y1n[j]; }
            P19_LOAD(m + NGW < M ? m + NGW : m);
#pragma unroll
            for (int j = 0; j < 4; ++j) v[j] = v[j] + ((f32x4){bflo(y0[j].x), bfhi(y0[j].x), bflo(y0[j].y), bfhi(y0[j].y)} + (f32x4){bflo(y1[j].x), bfhi(y1[j].x), bflo(y1[j].y), bfhi(y1[j].y)});
            const float rstd = bad ? __builtin_nanf("") : row_rstd(v); f32x4* o = (f32x4*)(xs + (size_t)m * D) + lane;
#pragma unroll
            for (int j = 0; j < 4; ++j) o[64 * j] = v[j] * (rstd * pfac) * gfin[j]; }
#undef P19_LOAD
    }
#undef IN
#undef SEAM
}

extern "C" void kernel_launch(void* const* d_in, const int* in_sizes, int n_in, void* d_out, int out_size, void* d_ws, size_t ws_size, hipStream_t stream) {
    static int grid = 0;
    if (grid == 0) {
        if (n_in != 22 || out_size != M * D || ws_size < WS_END2) { fprintf(stderr, "kernel_launch: unexpected shapes (n_in %d, out %d, ws %zu < %zu)\n", n_in, out_size, ws_size, (size_t)WS_END); grid = -1; return; }
        int dev = 0, cus = 0, per_cu = 0;
        if (hipGetDevice(&dev) != hipSuccess || hipDeviceGetAttribute(&cus, hipDeviceAttributeMultiprocessorCount, dev) != hipSuccess) { grid = -1; return; }
        if (hipFuncSetAttribute((const void*)yoco_fwd, hipFuncAttributeMaxDynamicSharedMemorySize, LDS_BYTES) != hipSuccess) { fprintf(stderr, "kernel_launch: hipFuncSetAttribute failed\n"); grid = -1; return; }
        if (hipOccupancyMaxActiveBlocksPerMultiprocessor(&per_cu, (const void*)yoco_fwd, NTHR, LDS_BYTES) != hipSuccess || per_cu < 1) fprintf(stderr, "kernel_launch: occupancy query says %d\n", per_cu);
        (void)hipGetLastError();
        grid = cus;
    }
    if (grid < 0) return;
    (void)hipMemsetAsync((char*)d_ws + WS_CTL, 0, CTL_ZERO_BYTES, stream);
    Args a{};
    for (int i = 0; i < 22; ++i) a.in[i] = (const float*)d_in[i];
    a.out = (float*)d_out; a.ws = (unsigned char*)d_ws;
#if MK_PER_PHASE
    for (int p = 0; p < NPHASE; ++p) { a.ph_lo = p; a.ph_hi = p + 1; hipLaunchKernelGGL(yoco_fwd, dim3(grid), dim3(NTHR), LDS_BYTES, stream, a); }
#else
    a.ph_lo = 0; a.ph_hi = NPHASE; hipLaunchKernelGGL(yoco_fwd, dim3(grid), dim3(NTHR), LDS_BYTES, stream, a);
#endif
}
```

```cpp
#include <hip/hip_runtime.h>
#include <cstdio>
#include <cstdint>

#ifndef MK_PER_PHASE
#define MK_PER_PHASE 0
#endif

#define LAS __attribute__((address_space(3)))
#define GAS __attribute__((address_space(1)))
typedef unsigned short bf16_t;
typedef short bf16x8 __attribute__((ext_vector_type(8)));
typedef float f32x4 __attribute__((ext_vector_type(4)));
typedef float f32x2 __attribute__((ext_vector_type(2)));
typedef unsigned u32x4 __attribute__((ext_vector_type(4)));
typedef unsigned u32x2 __attribute__((ext_vector_type(2)));
typedef unsigned long long u64;

constexpr int BATCH = 8, SEQ = 4096, D = 1024, M = BATCH * SEQ;
constexpr int A_HEADS = 4, A_HD = 256, NPROJ = 4096, NPROJ_SRC = 4104;
constexpr int FFD = 2816, NE = 8, FE = 3584;
constexpr int KVG = 4, HD = 64, NH = 16, NKVQ = 2816, NQSRC = 1072;
constexpr float EPS = 1e-6f;
constexpr int MOE_MAXT = 264;
constexpr int MOE_ROWS = MOE_MAXT * 256;

constexpr size_t MiB = 1u << 20;
constexpr size_t WS_CTL = 0, CTL_ZERO_BYTES = 32768;
constexpr size_t WS_SMALL = 1 * MiB;
constexpr size_t WS_WIN = 2 * MiB, WS_WOUTA = 10 * MiB, WS_WGU = 12 * MiB, WS_WDOWN = 23 * MiB, WS_WKVQ = 29 * MiB, WS_WCMP1 = 35 * MiB, WS_WOUTB = 37 * MiB;
constexpr size_t WS_MGU = 40 * MiB, WS_MDOWN = 152 * MiB, WS_XH = 208 * MiB, WS_GA = 272 * MiB, WS_ROWINFO = 273 * MiB, WS_BIG = 274 * MiB;
constexpr size_t WS_PROJ3 = WS_BIG, WS_OG = WS_BIG + 192 * MiB, WS_IMG = WS_BIG + 256 * MiB, WS_DN = WS_BIG + 536 * MiB, WS_HS = WS_BIG, WS_HN = WS_BIG + 128 * MiB;
constexpr size_t IMG_Q = 0, IMG_K = 34816, IMG_KT = 67584, IMG_VT = 100352, IMG_G = 141312, IMG_STRIDE = 142080;
static_assert((size_t)2048 * IMG_STRIDE <= 280 * MiB, "scan images");
constexpr size_t WS_XH8 = WS_BIG + 128 * MiB;
constexpr size_t WS_ACT = WS_BIG;
constexpr size_t WS_KV = WS_BIG, WS_QB = WS_BIG + 96 * MiB, WS_GATEB = WS_BIG + 160 * MiB, WS_HID = WS_BIG + 166 * MiB, WS_KC = WS_BIG + 174 * MiB, WS_VC = WS_BIG + 175 * MiB, WS_OB = WS_BIG + 176 * MiB, WS_VT2 = WS_BIG + 240 * MiB;
constexpr size_t WS_XG = WS_BIG, WS_ACTS = WS_BIG + 132 * MiB, WS_Y1 = WS_BIG;
constexpr size_t WS_END = WS_BIG + 594 * MiB;
constexpr size_t WS_HIDP = WS_BIG + 176 * MiB;
constexpr size_t WS_W2T = WS_SMALL + 524288;
constexpr size_t WS_SSP = WS_END, WS_RS = WS_END + 2 * MiB, WS_END2 = WS_END + 3 * MiB;
static_assert((size_t)MOE_ROWS * 1024 * 2 <= 132 * MiB && (size_t)MOE_ROWS * FE * 2 <= 462 * MiB, "moe buffers");
constexpr int CW_BAR = 4096;

constexpr int NWAVES = 8, NTHR = 512;
constexpr int LDS_BYTES = 163840;
constexpr int MISC_OFF = 163840 - 256;

__device__ __forceinline__ unsigned f2bf(float f) { unsigned u = __builtin_bit_cast(unsigned, f); return (u + 0x7fffu + ((u >> 16) & 1u)) >> 16; }
__device__ __forceinline__ unsigned pk2(float lo, float hi) { return f2bf(lo) | (f2bf(hi) << 16); }
__device__ __forceinline__ float bf2f(unsigned short b) { return __builtin_bit_cast(float, ((unsigned)b) << 16); }
__device__ __forceinline__ float bflo(unsigned w) { return __builtin_bit_cast(float, w << 16); }
__device__ __forceinline__ float bfhi(unsigned w) { return __builtin_bit_cast(float, w & 0xffff0000u); }
__device__ __forceinline__ float wave_sum(float v) {
#define WS_DPP(x, ctrl, rmask) __builtin_bit_cast(float, __builtin_amdgcn_update_dpp(0, __builtin_bit_cast(int, x), ctrl, rmask, 0xF, false))
    v += WS_DPP(v, 0xB1, 0xF);
    v += WS_DPP(v, 0x4E, 0xF);
    v += WS_DPP(v, 0x141, 0xF);
    v += WS_DPP(v, 0x140, 0xF);
    v += WS_DPP(v, 0x142, 0xA);
    v += WS_DPP(v, 0x143, 0xC);
#undef WS_DPP
    return __builtin_bit_cast(float, __builtin_amdgcn_readlane(__builtin_bit_cast(int, v), 63));
}
__device__ __forceinline__ float sigmoidf_(float x) { return __builtin_amdgcn_rcpf(1.0f + __builtin_amdgcn_exp2f(-1.4426950408889634f * x)); }
__device__ __forceinline__ float siluf_(float x) { return x * __builtin_amdgcn_rcpf(1.0f + __builtin_amdgcn_exp2f(-1.4426950408889634f * x)); }
__device__ __forceinline__ float ex2(float x) { return __builtin_amdgcn_exp2f(x); }
__device__ __forceinline__ unsigned pk_fp8x4(float a, float b, float c, float d) { unsigned w = 0u; w = __builtin_amdgcn_cvt_pk_fp8_f32(a, b, w, false); w = __builtin_amdgcn_cvt_pk_fp8_f32(c, d, w, true); return w; }
#define LDS_WAIT() asm volatile("s_waitcnt lgkmcnt(0)" ::: "memory")
#define LDS_BARRIER() do { asm volatile("s_waitcnt lgkmcnt(0)" ::: "memory"); __builtin_amdgcn_s_barrier(); asm volatile("" ::: "memory"); } while (0)

#define XB_TMO      128
#define XB_XCNT(j)  (256  + 64 * (j))
#define XB_XSUB(j)  (1280 + 64 * (j))
#define XB_XGEN(j)  (2304 + 64 * (j))
#define XB_TOP      3328
#define XB_TOPGEN   3392
#define XCD_BAR_WORDS 3456
#define XB_SPIN_CAP (1u << 22)
__device__ __forceinline__ unsigned xb_ld(unsigned* p)              { return __hip_atomic_load(p, __ATOMIC_RELAXED, __HIP_MEMORY_SCOPE_AGENT); }
__device__ __forceinline__ unsigned xb_add(unsigned* p, unsigned v) { return __hip_atomic_fetch_add(p, v, __ATOMIC_RELAXED, __HIP_MEMORY_SCOPE_AGENT); }
__device__ __forceinline__ unsigned xb_xcc_id() { return (unsigned)__builtin_amdgcn_s_getreg((3 << 11) | 20) & 0xFu; }
#define XB_SPIN(cond, bar) do { unsigned _sp = 0; while (cond) { __builtin_amdgcn_s_sleep(1); \
    if ((++_sp & 255u) == 0u) { if (xb_ld(&(bar)[XB_TMO])) break; if (_sp > XB_SPIN_CAP) { atomicAdd(&(bar)[XB_TMO], 1u); break; } } } } while (0)
struct XcdBarrier { unsigned* bar; unsigned x; volatile LAS unsigned* st; };
__device__ __forceinline__ XcdBarrier xcd_barrier_post(unsigned* bar, volatile LAS unsigned* st) {
    XcdBarrier b; b.bar = bar; b.x = xb_xcc_id(); b.st = st;
    if (threadIdx.x == 0) (void)xb_add(&bar[XB_XCNT(b.x)], 1u);
    return b;
}
__device__ __forceinline__ void xcd_barrier_complete(unsigned* bar, unsigned x, unsigned& nloc, unsigned& nx) {
    const unsigned G = gridDim.x * gridDim.y * gridDim.z;
    unsigned sum, cnt, mine, sp = 0u;
    for (;;) {
        sum = 0u; cnt = 0u; mine = 0u;
#pragma unroll
        for (unsigned j = 0; j < 16; ++j) { const unsigned c = xb_ld(&bar[XB_XCNT(j)]); sum += c; cnt += (c > 0u) ? 1u : 0u; mine = (j == x) ? c : mine; }
        if (sum == G) break;
        __builtin_amdgcn_s_sleep(1);
        if ((++sp & 255u) == 0u) { if (xb_ld(&bar[XB_TMO])) break; if (sp > XB_SPIN_CAP) { atomicAdd(&bar[XB_TMO], 1u); break; } }
    }
    nloc = mine > 0u ? mine : 1u; nx = cnt > 0u ? cnt : 1u;
}
__device__ __forceinline__ void xcd_barrier(const XcdBarrier& b) {
    asm volatile("s_waitcnt vmcnt(0)" ::: "memory");
    __syncthreads();
    if (threadIdx.x == 0) {
        unsigned* bar = b.bar;
        __builtin_amdgcn_s_waitcnt(0);
        unsigned nloc = b.st[0], nx = b.st[1];
        if (nloc == 0u) { xcd_barrier_complete(bar, b.x, nloc, nx); b.st[0] = nloc; b.st[1] = nx; }
        const unsigned old = xb_add(&bar[XB_XSUB(b.x)], 1u);
        const unsigned gen = old / nloc;
        if (old + 1u == (gen + 1u) * nloc) {
            __builtin_amdgcn_fence(__ATOMIC_RELEASE, "agent");
            asm volatile("s_waitcnt vmcnt(0)" ::: "memory");
            const unsigned og = xb_add(&bar[XB_TOP], 1u);
            const unsigned tg = og / nx;
            if (og + 1u == (tg + 1u) * nx) xb_add(&bar[XB_TOPGEN], 1u);
            else XB_SPIN(xb_ld(&bar[XB_TOPGEN]) == tg, bar);
            __builtin_amdgcn_fence(__ATOMIC_ACQUIRE, "agent");
            xb_add(&bar[XB_XGEN(b.x)], 1u);
            asm volatile("s_waitcnt vmcnt(0)" ::: "memory");
        } else {
            XB_SPIN(xb_ld(&bar[XB_XGEN(b.x)]) == gen, bar);
            __builtin_amdgcn_fence(__ATOMIC_ACQUIRE, "agent");
            asm volatile("s_waitcnt vmcnt(0)" ::: "memory");
        }
    }
    __syncthreads();
}

#ifndef EXPT
#define EXPT 0
#endif
#ifndef TSEG
#define TSEG 0
#endif
#if TSEG
#define TS_B(k) do { if (TSEG & (1 << (k))) tseg_t = __builtin_amdgcn_s_memrealtime(); } while (0)
#define TS_E(k) do { if (TSEG & (1 << (k))) tseg_acc += __builtin_amdgcn_s_memrealtime() - tseg_t; } while (0)
#else
#define TS_B(k)
#define TS_E(k)
#endif
#ifndef TPROBE
#define TPROBE 0
#endif
namespace pg8 {
constexpr int BM = 256, BK = 64, HALF = 128, HTB = HALF * BK * 2, STAGE_BYTES = 8 * HTB, NXCD = 8, WGM = 8;
__host__ __device__ __forceinline__ int lds_byte(int r, int c) { const int st = (r >> 4) * 2 + (c >> 5), rr = r & 15, cc = c & 31, ob = rr * 64 + cc * 2; return st * 1024 + (ob ^ (((ob >> 9) & 1) << 5)); }
__host__ __device__ __forceinline__ void stage_rc(int b, int& R, int& C) { const int st = b / 1024, sb = b % 1024, swz = sb ^ (((sb >> 9) & 1) << 5); R = (st >> 1) * 16 + swz / 64; C = (st & 1) * 32 + (swz % 64) / 2; }
__host__ __device__ __forceinline__ int perm32(int rho) { const int n = rho >> 4, i = rho & 15; return 8 * (i >> 2) + 4 * n + (i & 3); }
struct Unit { int pm, pn; const char* a; const char* b; };
struct Dims { int K, lda, ldb; int sa = 127, sb = 127; float* tk = nullptr; };
typedef __bf16 bf16x2_t __attribute__((ext_vector_type(2)));
__device__ __forceinline__ unsigned cvt_pk_bf16(float lo, float hi) { const f32x2 v = {lo, hi}; const bf16x2_t b = __builtin_convertvector(v, bf16x2_t); return __builtin_bit_cast(unsigned, b); }

__device__ __forceinline__ bool tile_order(int i, int G, int c, int nM, int nN, int& pm, int& pn) {
    const int nwg = nM * nN; const long L = (long)i * G + c; if (L >= nwg) return false;
    int wgid = (int)L; { const int q = nwg / NXCD, r = nwg % NXCD, xcd = wgid % NXCD, off = wgid / NXCD; wgid = (xcd < r ? xcd * (q + 1) : r * (q + 1) + (xcd - r) * q) + off; }
    const int nig = WGM * nN, gid = wgid / nig, fm = gid * WGM, gsz = (nM - fm) < WGM ? (nM - fm) : WGM;
    pm = fm + ((wgid % nig) % gsz); pn = (wgid % nig) / gsz; return true;
}
struct PlainOrder {
    int nM, nN, G, c; const char* A; const char* B; size_t tA, tB; int same = 0;
    __device__ __forceinline__ void init(const bf16_t* A_, const bf16_t* B_, int M_, int N_, int lda, int ldb, int G_, int c_) { nM = M_ / BM; nN = N_ / BM; G = G_; c = c_; A = (const char*)A_; B = (const char*)B_; tA = (size_t)BM * lda * 2; tB = (size_t)BM * ldb * 2; }
    __device__ __forceinline__ bool next(int i, Unit& u) const { if (EXPT && same) { if (i >= same) return false; u.pm = 0; u.pn = i; u.a = A; u.b = B + (size_t)i * tB; return true; }
        if (!tile_order(i, G, c, nM, nN, u.pm, u.pn)) return false; u.a = A + (size_t)u.pm * tA; u.b = B + (size_t)u.pn * tB; return true; }
};

template <class Epi, class Sched, bool ALIGN_EPI = true, bool SP2 = true, bool FP8 = false>
__device__ __forceinline__ void gemm_phase(LAS unsigned char* lds, const Dims g, const Sched& S, const Epi& E) {
    const int tid = threadIdx.x, wid = __builtin_amdgcn_readfirstlane(tid >> 6), lane = tid & 63, wr = wid >> 2, wc = wid & 3, fr = lane & 15, fq = lane >> 4;
    const int K = g.K, nt = K / BK;
    unsigned voffA[2], voffB[2];
#pragma unroll
    for (int i = 0; i < 2; ++i) { int R, C; stage_rc(tid * 16 + i * 8192, R, C); const int Rb = Epi::PERM ? ((R & ~31) + perm32(R & 31)) : R;
        voffA[i] = (unsigned)(R * g.lda + C) * 2u; voffB[i] = (unsigned)(Rb * g.ldb + C) * 2u; }
    const size_t kstep = (size_t)(BK * 2);
    const size_t hstepA = (size_t)HALF * g.lda * 2, hstepB = (size_t)HALF * g.ldb * 2;
    const unsigned ldsw = (unsigned)wid * 1024u;
    const int aoff = lds_byte(wr * 64 + fr, fq * 8), boff = lds_byte(wc * 32 + fr, fq * 8);
#define PG8_SA(b, h) (((b) * 2 + (h)) * HTB)
#define PG8_SB(b, h) ((4 + (b) * 2 + (h)) * HTB)
#define PG8_STAGE(bufoff, gbase, voff) do { _Pragma("unroll") for (int _i = 0; _i < 2; ++_i) \
        __builtin_amdgcn_global_load_lds((const unsigned*)((const char*)(gbase) + (voff)[_i]), (LAS unsigned*)(lds + (bufoff) + ldsw + _i * 8192), 16, 0, 0); } while (0)
    typedef int v8i_t __attribute__((ext_vector_type(8))); typedef int v4i_t __attribute__((ext_vector_type(4)));
#define PG8_RD8(p) __builtin_shufflevector(*(const LAS v4i_t*)(p), *(const LAS v4i_t*)((p) + 1024), 0, 1, 2, 3, 4, 5, 6, 7)
#define PG8_LDA(dst, b, h) do { if constexpr (FP8) { _Pragma("unroll") for (int m = 0; m < 4; ++m) dst##8[m] = PG8_RD8(lds + PG8_SA(b, h) + aoff + m * 2048); } \
        else { _Pragma("unroll") for (int m = 0; m < 4; ++m) _Pragma("unroll") for (int k = 0; k < 2; ++k) dst[m][k] = *(const LAS bf16x8*)(lds + PG8_SA(b, h) + aoff + m * 2048 + k * 1024); } } while (0)
#define PG8_LDB(dst, b, h) do { if constexpr (FP8) { _Pragma("unroll") for (int n = 0; n < 2; ++n) dst##8[n] = PG8_RD8(lds + PG8_SB(b, h) + boff + n * 2048); } \
        else { _Pragma("unroll") for (int n = 0; n < 2; ++n) _Pragma("unroll") for (int k = 0; k < 2; ++k) dst[n][k] = *(const LAS bf16x8*)(lds + PG8_SB(b, h) + boff + n * 2048 + k * 1024); } } while (0)
#define PG8_MMA(ai, bj, At, Bt) do { __builtin_amdgcn_s_setprio(1); \
        if constexpr (FP8) { _Pragma("unroll") for (int m = 0; m < 4; ++m) _Pragma("unroll") for (int n = 0; n < 2; ++n) \
            asm volatile("v_mfma_scale_f32_16x16x128_f8f6f4 %0, %1, %2, %0, %3, %4 op_sel_hi:[0,0,0]" : "+v"(acc[ai][bj][m][n]) : "v"(Bt##8[n]), "v"(At##8[m]), "v"(sbv), "v"(sav)); } \
        else { _Pragma("unroll") for (int m = 0; m < 4; ++m) _Pragma("unroll") for (int n = 0; n < 2; ++n) _Pragma("unroll") for (int k = 0; k < 2; ++k) \
            acc[ai][bj][m][n] = __builtin_amdgcn_mfma_f32_16x16x32_bf16(Bt[n][k], At[m][k], acc[ai][bj][m][n], 0, 0, 0); } \
        __builtin_amdgcn_s_setprio(0); } while (0)
#define PG8_WAIT_V(n) asm volatile("s_waitcnt vmcnt(" #n ")" ::: "memory")
#define PG8_WAIT_L(n) asm volatile("s_waitcnt lgkmcnt(" #n ")" ::: "memory")
#define PG8_BAR __builtin_amdgcn_s_barrier()
#define PG8_SCHED __builtin_amdgcn_sched_barrier(0)
    Unit cur, nxt; int ui = 0;
    if (!S.next(0, cur)) return;
    f32x4 acc[2][2][4][2];
#pragma unroll
    for (int a = 0; a < 2; ++a)
#pragma unroll
        for (int b = 0; b < 2; ++b)
#pragma unroll
            for (int m = 0; m < 4; ++m)
#pragma unroll
                for (int n = 0; n < 2; ++n) acc[a][b][m][n] = (f32x4){0.f, 0.f, 0.f, 0.f};
    bf16x8 At[4][2], B0[2][2], B1[2][2]; v8i_t At8[4], B08[2], B18[2];
    const int sbv = g.sb, sav = g.sa;
    const char* cA = cur.a; const char* cB = cur.b;
    if constexpr (SP2) {
        PG8_STAGE(PG8_SB(0, 0), cB, voffB); PG8_STAGE(PG8_SB(0, 1), cB + hstepB, voffB); PG8_STAGE(PG8_SA(0, 0), cA, voffA); PG8_STAGE(PG8_SA(0, 1), cA + hstepA, voffA);
        if (wr == 1) PG8_BAR;
        PG8_WAIT_V(2); PG8_BAR;
        PG8_STAGE(PG8_SB(1, 0), cB + kstep, voffB); PG8_STAGE(PG8_SA(1, 0), cA + kstep, voffA); PG8_STAGE(PG8_SB(1, 1), cB + hstepB + kstep, voffB);
        PG8_WAIT_V(6); PG8_BAR;
    } else {
        PG8_STAGE(PG8_SB(0, 0), cB, voffB); PG8_STAGE(PG8_SA(0, 0), cA, voffA); PG8_STAGE(PG8_SB(0, 1), cB + hstepB, voffB); PG8_STAGE(PG8_SA(0, 1), cA + hstepA, voffA);
        if (wr == 1) PG8_BAR;
        PG8_WAIT_V(4); PG8_BAR;
        PG8_STAGE(PG8_SB(1, 0), cB + kstep, voffB); PG8_STAGE(PG8_SA(1, 0), cA + kstep, voffA); PG8_STAGE(PG8_SB(1, 1), cB + hstepB + kstep, voffB);
        PG8_WAIT_V(6); PG8_BAR;
    }
#if TPROBE
    unsigned long long tk_acc = 0, te_acc = 0;
#endif
    for (;;) {
        const bool has_next = S.next(ui + 1, nxt);
#if TPROBE
        const unsigned long long tk0 = __builtin_amdgcn_s_memrealtime();
#endif
        const char* nA = has_next ? nxt.a : cA; const char* nB = has_next ? nxt.b : cB;
#pragma unroll 1
        for (int t = 0; t < nt; t += 2) {
            const bool last = (t == nt - 2);
            const char* a1 = cA + (size_t)(t + 1) * kstep;
            const char* a2 = last ? nA : cA + (size_t)(t + 2) * kstep; const char* b2 = last ? nB : cB + (size_t)(t + 2) * kstep;
            const char* a3 = a2 + kstep; const char* b3 = b2 + kstep;
            if constexpr (SP2) {
            PG8_LDB(B0, 0, 0); PG8_LDB(B1, 0, 1); PG8_SCHED; PG8_LDA(At, 0, 0); PG8_STAGE(PG8_SA(1, 1), a1 + hstepA, voffA);
            PG8_WAIT_V(8); PG8_WAIT_L(0); PG8_BAR; PG8_MMA(0, 0, At, B0); PG8_MMA(0, 1, At, B1); PG8_BAR; PG8_SCHED;
            PG8_LDA(At, 0, 1); PG8_STAGE(PG8_SB(0, 0), b2, voffB); PG8_STAGE(PG8_SB(0, 1), b2 + hstepB, voffB); PG8_STAGE(PG8_SA(0, 0), a2, voffA);
            PG8_WAIT_V(8); PG8_WAIT_L(0); PG8_BAR; PG8_MMA(1, 0, At, B0); PG8_MMA(1, 1, At, B1); PG8_BAR; PG8_SCHED;
            PG8_LDB(B0, 1, 0); PG8_LDB(B1, 1, 1); PG8_SCHED; PG8_LDA(At, 1, 0); PG8_STAGE(PG8_SA(0, 1), a2 + hstepA, voffA);
            PG8_WAIT_V(8); PG8_WAIT_L(0); PG8_BAR; PG8_MMA(0, 0, At, B0); PG8_MMA(0, 1, At, B1); PG8_BAR; PG8_SCHED;
            PG8_LDA(At, 1, 1); PG8_STAGE(PG8_SB(1, 0), b3, voffB); PG8_STAGE(PG8_SB(1, 1), b3 + hstepB, voffB); PG8_STAGE(PG8_SA(1, 0), a3, voffA);
            PG8_WAIT_V(8); PG8_WAIT_L(0); PG8_BAR; PG8_MMA(1, 0, At, B0); PG8_MMA(1, 1, At, B1); PG8_BAR; PG8_SCHED;
            } else {
            PG8_LDB(B0, 0, 0); PG8_SCHED; PG8_LDA(At, 0, 0); PG8_STAGE(PG8_SA(1, 1), a1 + hstepA, voffA);
            PG8_WAIT_L(8); PG8_BAR; PG8_WAIT_L(0); PG8_MMA(0, 0, At, B0); PG8_BAR; PG8_SCHED;
            PG8_LDB(B1, 0, 1); PG8_STAGE(PG8_SB(0, 0), b2, voffB);
            PG8_BAR; PG8_WAIT_L(0); PG8_MMA(0, 1, At, B1); PG8_BAR;
            PG8_LDA(At, 0, 1); PG8_STAGE(PG8_SA(0, 0), a2, voffA);
            PG8_BAR; PG8_WAIT_L(0); PG8_MMA(1, 0, At, B0); PG8_BAR; PG8_SCHED;
            PG8_STAGE(PG8_SB(0, 1), b2 + hstepB, voffB);
            PG8_WAIT_V(6); PG8_BAR; PG8_MMA(1, 1, At, B1); PG8_BAR;
            PG8_LDB(B0, 1, 0); PG8_SCHED; PG8_LDA(At, 1, 0); PG8_STAGE(PG8_SA(0, 1), a2 + hstepA, voffA);
            PG8_WAIT_L(8); PG8_BAR; PG8_WAIT_L(0); PG8_MMA(0, 0, At, B0); PG8_BAR; PG8_SCHED;
            PG8_LDB(B1, 1, 1); PG8_STAGE(PG8_SB(1, 0), b3, voffB);
            PG8_BAR; PG8_WAIT_L(0); PG8_MMA(0, 1, At, B1); PG8_BAR;
            PG8_LDA(At, 1, 1); PG8_STAGE(PG8_SA(1, 0), a3, voffA);
            PG8_BAR; PG8_WAIT_L(0); PG8_MMA(1, 0, At, B0); PG8_BAR; PG8_SCHED;
            PG8_STAGE(PG8_SB(1, 1), b3 + hstepB, voffB);
            PG8_WAIT_V(6); PG8_BAR; PG8_MMA(1, 1, At, B1); PG8_BAR;
            }
        }
#if TPROBE
        const unsigned long long tk1 = __builtin_amdgcn_s_memrealtime(); tk_acc += tk1 - tk0;
#endif
        if constexpr (ALIGN_EPI) { if (wr == 0) PG8_BAR; }
        if constexpr (FP8) { __builtin_amdgcn_sched_barrier(0); asm volatile("s_nop 15\n\ts_nop 15" ::: "memory"); __builtin_amdgcn_sched_barrier(0); }
        E(acc, cur, wr, wc, fr, fq);
#if TPROBE
        te_acc += __builtin_amdgcn_s_memrealtime() - tk1;
#endif
        if (!has_next) break;
#pragma unroll
        for (int a = 0; a < 2; ++a)
#pragma unroll
            for (int b = 0; b < 2; ++b)
#pragma unroll
                for (int m = 0; m < 4; ++m)
#pragma unroll
                    for (int n = 0; n < 2; ++n) acc[a][b][m][n] = (f32x4){0.f, 0.f, 0.f, 0.f};
        cur = nxt; cA = nA; cB = nB; ++ui;
        if constexpr (ALIGN_EPI) { if (wr == 1) PG8_BAR; }
    }
    PG8_WAIT_V(0);
    if constexpr (!ALIGN_EPI) { if (wr == 0) PG8_BAR; }
    PG8_BAR;
#if TPROBE
    if (g.tk && tid == 0) { g.tk[0] = (float)tk_acc; g.tk[1] = (float)te_acc; }
#endif
#undef PG8_SA
#undef PG8_SB
#undef PG8_STAGE
#undef PG8_LDA
#undef PG8_LDB
#undef PG8_MMA
#undef PG8_RD8
#undef PG8_WAIT_V
#undef PG8_WAIT_L
#undef PG8_BAR
#undef PG8_SCHED
}

typedef const f32x4 (&AccRef)[2][2][4][2];
struct EpiBf16Plain {
    static constexpr bool PERM = true;
    bf16_t* O; int ldc;
    __device__ __forceinline__ void operator()(AccRef acc, const Unit& u, int wr, int wc, int fr, int fq) const {
        const int row0 = u.pm * BM + wr * 64 + fr, col0 = u.pn * BM + wc * 32 + 8 * fq;
#pragma unroll
        for (int ai = 0; ai < 2; ++ai)
#pragma unroll
            for (int m = 0; m < 4; ++m) { bf16_t* rowp = O + (size_t)(row0 + ai * HALF + m * 16) * ldc + col0;
#pragma unroll
                for (int bj = 0; bj < 2; ++bj) { const f32x4 v0 = acc[ai][bj][m][0], v1 = acc[ai][bj][m][1];
                    u32x4 w; w.x = cvt_pk_bf16(v0[0], v0[1]); w.y = cvt_pk_bf16(v0[2], v0[3]); w.z = cvt_pk_bf16(v1[0], v1[1]); w.w = cvt_pk_bf16(v1[2], v1[3]);
                    *(u32x4*)(rowp + bj * HALF) = w; } }
    }
};
struct EpiProjSplit {
    static constexpr bool PERM = true;
    bf16_t* P3; bf16_t* OG;
    __device__ __forceinline__ void operator()(AccRef acc, const Unit& u, int wr, int wc, int fr, int fq) const {
        const int row0 = u.pm * BM + wr * 64 + fr; const bool og = u.pn >= 12; const int ldc = og ? 1024 : 3072; bf16_t* base = (og ? OG + (u.pn - 12) * BM : P3 + u.pn * BM) + wc * 32 + 8 * fq;
#pragma unroll
        for (int ai = 0; ai < 2; ++ai)
#pragma unroll
            for (int m = 0; m < 4; ++m) { bf16_t* rowp = base + (size_t)(row0 + ai * HALF + m * 16) * ldc;
#pragma unroll
                for (int bj = 0; bj < 2; ++bj) { const f32x4 v0 = acc[ai][bj][m][0], v1 = acc[ai][bj][m][1];
                    u32x4 w; w.x = cvt_pk_bf16(v0[0], v0[1]); w.y = cvt_pk_bf16(v0[2], v0[3]); w.z = cvt_pk_bf16(v1[0], v1[1]); w.w = cvt_pk_bf16(v1[2], v1[3]);
                    *(u32x4*)(rowp + bj * HALF) = w; } }
    }
};
struct EpiResF32 {
    static constexpr bool PERM = false;
    const float* base; float* out; int ldc;
    __device__ __forceinline__ void operator()(AccRef acc, const Unit& u, int wr, int wc, int fr, int fq) const {
        const int row0 = u.pm * BM + wr * 64 + fr, col0 = u.pn * BM + wc * 32 + 4 * fq;
#pragma unroll
        for (int ai = 0; ai < 2; ++ai)
#pragma unroll
            for (int m = 0; m < 4; ++m) { const size_t off = (size_t)(row0 + ai * HALF + m * 16) * ldc + col0;
#pragma unroll
                for (int bj = 0; bj < 2; ++bj)
#pragma unroll
                    for (int n = 0; n < 2; ++n) { const f32x4 bs = *(const f32x4*)(base + off + bj * HALF + n * 16); *(f32x4*)(out + off + bj * HALF + n * 16) = bs + acc[ai][bj][m][n]; } }
    }
};
__device__ __forceinline__ float row_rs16(const float* ss, int row) { const f32x4* p = (const f32x4*)(ss + (size_t)row * 16); const f32x4 a = p[0], b = p[1], c = p[2], d = p[3];
    const float t = (((a[0] + a[1]) + (a[2] + a[3])) + ((b[0] + b[1]) + (b[2] + b[3]))) + (((c[0] + c[1]) + (c[2] + c[3])) + ((d[0] + d[1]) + (d[2] + d[3]))); return 1.0f / sqrtf(t * (1.f / 1024.f) + EPS); }
struct EpiResF32Stat {
    static constexpr bool PERM = false;
    const float* base; float* out; bf16_t* XHo; float* SS; int ldc;
    __device__ __forceinline__ void operator()(AccRef acc, const Unit& u, int wr, int wc, int fr, int fq) const {
        const int row0 = u.pm * BM + wr * 64 + fr, col0 = u.pn * BM + wc * 32 + 4 * fq;
#pragma unroll
        for (int ai = 0; ai < 2; ++ai)
#pragma unroll
            for (int m = 0; m < 4; ++m) { const int row = row0 + ai * HALF + m * 16; const size_t off = (size_t)row * ldc + col0; float ss = 0.f;
#pragma unroll
                for (int bj = 0; bj < 2; ++bj)
#pragma unroll
                    for (int n = 0; n < 2; ++n) { const f32x4 o = *(const f32x4*)(base + off + bj * HALF + n * 16) + acc[ai][bj][m][n]; *(f32x4*)(out + off + bj * HALF + n * 16) = o;
                        ss += (o[0] * o[0] + o[1] * o[1]) + (o[2] * o[2] + o[3] * o[3]);
                        u32x2 w; w.x = cvt_pk_bf16(o[0], o[1]); w.y = cvt_pk_bf16(o[2], o[3]); *(u32x2*)(XHo + off + bj * HALF + n * 16) = w; }
                ss += __shfl_xor(ss, 16); ss += __shfl_xor(ss, 32);
                if (fq == 0) SS[(size_t)row * 16 + u.pn * 4 + wc] = ss; }
    }
};
template <bool BASE16, bool STAT>
struct EpiRes16 {
    static constexpr bool PERM = true;
    const float* base32; bf16_t* XHo; float* SS; int ldc; const float* bsc = nullptr;
    __device__ __forceinline__ void operator()(AccRef acc, const Unit& u, int wr, int wc, int fr, int fq) const {
        const int row0 = u.pm * BM + wr * 64 + fr, col0 = u.pn * BM + wc * 32 + 8 * fq;
#pragma unroll
        for (int ai = 0; ai < 2; ++ai)
#pragma unroll
            for (int m = 0; m < 4; ++m) { const int row = row0 + ai * HALF + m * 16; const size_t off = (size_t)row * ldc + col0; float ss = 0.f; const float binv = (BASE16 && bsc) ? 1.0f / bsc[row] : 1.0f;
#pragma unroll
                for (int bj = 0; bj < 2; ++bj) { f32x4 b0, b1;
                    if constexpr (BASE16) { const u32x4 r = *(const u32x4*)(XHo + off + bj * HALF); b0 = (f32x4){bflo(r.x), bfhi(r.x), bflo(r.y), bfhi(r.y)} * binv; b1 = (f32x4){bflo(r.z), bfhi(r.z), bflo(r.w), bfhi(r.w)} * binv; }
                    else { b0 = *(const f32x4*)(base32 + off + bj * HALF); b1 = *(const f32x4*)(base32 + off + bj * HALF + 4); }
                    const f32x4 o0 = b0 + acc[ai][bj][m][0], o1 = b1 + acc[ai][bj][m][1];
                    if constexpr (STAT) ss += ((o0[0] * o0[0] + o0[1] * o0[1]) + (o0[2] * o0[2] + o0[3] * o0[3])) + ((o1[0] * o1[0] + o1[1] * o1[1]) + (o1[2] * o1[2] + o1[3] * o1[3]));
                    u32x4 w; w.x = cvt_pk_bf16(o0[0], o0[1]); w.y = cvt_pk_bf16(o0[2], o0[3]); w.z = cvt_pk_bf16(o1[0], o1[1]); w.w = cvt_pk_bf16(o1[2], o1[3]);
                    *(u32x4*)(XHo + off + bj * HALF) = w; }
                if constexpr (STAT) { ss += __shfl_xor(ss, 16); ss += __shfl_xor(ss, 32);
                    if (fq == 0) SS[(size_t)row * 16 + u.pn * 4 + wc] = ss; } }
    }
};
struct EpiSwiGLU {
    static constexpr bool PERM = true;
    bf16_t* O; int ldc; const float* rsv;
    __device__ __forceinline__ void operator()(AccRef acc, const Unit& u, int wr, int wc, int fr, int fq) const {
        const int row0 = u.pm * BM + wr * 64 + fr, col0 = u.pn * HALF + wc * 32 + 8 * fq;
#pragma unroll
        for (int ai = 0; ai < 2; ++ai)
#pragma unroll
            for (int m = 0; m < 4; ++m) { const int row = row0 + ai * HALF + m * 16; bf16_t* rowp = O + (size_t)row * ldc + col0; const float rs = rsv ? rsv[row] : 1.0f;
                float o[8];
#pragma unroll
                for (int n = 0; n < 2; ++n)
#pragma unroll
                    for (int j = 0; j < 4; ++j) { const float gv = acc[ai][0][m][n][j] * rs, uv = acc[ai][1][m][n][j] * rs; o[n * 4 + j] = siluf_(gv) * uv; }
                u32x4 w; w.x = cvt_pk_bf16(o[0], o[1]); w.y = cvt_pk_bf16(o[2], o[3]); w.z = cvt_pk_bf16(o[4], o[5]); w.w = cvt_pk_bf16(o[6], o[7]);
                *(u32x4*)rowp = w; }
    }
};
struct EpiSwiGLU8 {
    static constexpr bool PERM = true;
    unsigned char* O8; int ldc; float oscale; const float* rsv = nullptr;
    __device__ __forceinline__ void operator()(AccRef acc, const Unit& u, int wr, int wc, int fr, int fq) const {
        const int row0 = u.pm * BM + wr * 64 + fr, col0 = u.pn * HALF + wc * 32 + 8 * fq;
#pragma unroll
        for (int ai = 0; ai < 2; ++ai)
#pragma unroll
            for (int m = 0; m < 4; ++m) { const int row = row0 + ai * HALF + m * 16; unsigned char* rowp = O8 + (size_t)row * ldc + col0; const float rs = rsv ? rsv[row] : 1.0f, us = rs * oscale;
                u32x2 w;
#pragma unroll
                for (int n = 0; n < 2; ++n) {
                    const f32x4 gv = acc[ai][0][m][n] * rs; f32x4 d = gv * -1.4426950408889634f;
                    d[0] = __builtin_amdgcn_exp2f(d[0]); d[1] = __builtin_amdgcn_exp2f(d[1]); d[2] = __builtin_amdgcn_exp2f(d[2]); d[3] = __builtin_amdgcn_exp2f(d[3]);
                    d = d + 1.0f;
                    d[0] = __builtin_amdgcn_rcpf(d[0]); d[1] = __builtin_amdgcn_rcpf(d[1]); d[2] = __builtin_amdgcn_rcpf(d[2]); d[3] = __builtin_amdgcn_rcpf(d[3]);
                    const f32x4 o = (gv * d) * (acc[ai][1][m][n] * us);
                    const unsigned pw8 = pk_fp8x4(o[0], o[1], o[2], o[3]); if (n == 0) w.x = pw8; else w.y = pw8; }
                *(u32x2*)rowp = w; }
    }
};
struct EpiKVQ {
    static constexpr bool PERM = true;
    bf16_t* KV; bf16_t* Q; float* GATE; const float* bgate; const float* rsv;
    __device__ __forceinline__ void operator()(AccRef acc, const Unit& u, int wr, int wc, int fr, int fq) const {
        const int row0 = u.pm * BM + wr * 64 + fr, cin = wc * 32 + 8 * fq;
#pragma unroll
        for (int ai = 0; ai < 2; ++ai)
#pragma unroll
            for (int m = 0; m < 4; ++m) { const int row = row0 + ai * HALF + m * 16; const float rs = rsv[row];
#pragma unroll
                for (int bj = 0; bj < 2; ++bj) { const f32x4 v0 = acc[ai][bj][m][0] * rs, v1 = acc[ai][bj][m][1] * rs; const int col = cin + bj * HALF;
                    if (u.pn < 6) { const int b = row >> 12, t = row & 4095, g = col >> 6, d = col & 63;
                        u32x4 w; w.x = cvt_pk_bf16(v0[0], v0[1]); w.y = cvt_pk_bf16(v0[2], v0[3]); w.z = cvt_pk_bf16(v1[0], v1[1]); w.w = cvt_pk_bf16(v1[2], v1[3]);
                        *(u32x4*)(KV + ((((size_t)u.pn * 8 + b) * 4 + g) * 4096 + t) * 64 + d) = w;
                    } else { const float s = 0.125f * 1.4426950408889634f;
                        u32x4 w; w.x = cvt_pk_bf16(v0[0] * s, v0[1] * s); w.y = cvt_pk_bf16(v0[2] * s, v0[3] * s); w.z = cvt_pk_bf16(v1[0] * s, v1[1] * s); w.w = cvt_pk_bf16(v1[2] * s, v1[3] * s);
                        *(u32x4*)(Q + (size_t)row * 1024 + (u.pn - 6) * 256 + col) = w;
                    } } }
    }
};
struct EpiF32Part {
    static constexpr bool PERM = false;
    float* P; int rows;
    __device__ __forceinline__ void operator()(AccRef acc, const Unit& u, int wr, int wc, int fr, int fq) const {
        const int row0 = u.pm * BM + wr * 64 + fr, col0 = wc * 32 + 4 * fq; float* base = P + (size_t)u.pn * rows * 256;
#pragma unroll
        for (int ai = 0; ai < 2; ++ai)
#pragma unroll
            for (int m = 0; m < 4; ++m) { float* rowp = base + (size_t)(row0 + ai * HALF + m * 16) * 256 + col0;
#pragma unroll
                for (int bj = 0; bj < 2; ++bj)
#pragma unroll
                    for (int n = 0; n < 2; ++n) *(f32x4*)(rowp + bj * HALF + n * 16) = acc[ai][bj][m][n]; }
    }
};
struct EpiCmp {
    static constexpr bool PERM = true;
    bf16_t* O; const float* bias;
    __device__ __forceinline__ void operator()(AccRef acc, const Unit& u, int wr, int wc, int fr, int fq) const {
        const int row0 = u.pm * BM + wr * 64 + fr, col0 = wc * 32 + 8 * fq; const float* bp = bias + (u.pm >> 5) * 256 + col0;
#pragma unroll
        for (int ai = 0; ai < 2; ++ai)
#pragma unroll
            for (int m = 0; m < 4; ++m) { bf16_t* rowp = O + (size_t)(row0 + ai * HALF + m * 16) * 256 + col0;
#pragma unroll
                for (int bj = 0; bj < 2; ++bj) { const f32x4 b0 = *(const f32x4*)(bp + bj * HALF), b1 = *(const f32x4*)(bp + bj * HALF + 4);
                    const f32x4 v0 = acc[ai][bj][m][0] + b0, v1 = acc[ai][bj][m][1] + b1;
                    u32x4 w; w.x = cvt_pk_bf16(siluf_(v0[0]), siluf_(v0[1])); w.y = cvt_pk_bf16(siluf_(v0[2]), siluf_(v0[3])); w.z = cvt_pk_bf16(siluf_(v1[0]), siluf_(v1[1])); w.w = cvt_pk_bf16(siluf_(v1[2]), siluf_(v1[3]));
                    *(u32x4*)(rowp + bj * HALF) = w; } }
    }
};
}

struct MoeOrder {
    int nN, G, c; const char* A; const char* B; size_t tA, tBe, tBn; volatile LAS int* tb;
    __device__ __forceinline__ int expert_of(int pm) const { int e = 0;
#pragma unroll
        for (int i = 1; i < 8; ++i) e += (pm >= __builtin_amdgcn_readfirstlane(tb[i])) ? 1 : 0;
        return e; }
    __device__ __forceinline__ bool next(int i, pg8::Unit& u) const {
        const int nM = __builtin_amdgcn_readfirstlane(tb[8]);
        if (!pg8::tile_order(i, G, c, nM, nN, u.pm, u.pn)) return false;
        u.a = A + (size_t)u.pm * tA; u.b = B + (size_t)expert_of(u.pm) * tBe + (size_t)u.pn * tBn; return true; }
};
struct EpiMoeDown {
    static constexpr bool PERM = true;
    bf16_t* Y; const u32x2* rowinfo; const float* ew; volatile LAS int* tb;
    __device__ __forceinline__ void operator()(pg8::AccRef acc, const pg8::Unit& u, int wr, int wc, int fr, int fq) const {
        int e = 0;
#pragma unroll
        for (int i = 1; i < 8; ++i) e += (u.pm >= __builtin_amdgcn_readfirstlane(tb[i])) ? 1 : 0;
        const int nvalid = __builtin_amdgcn_readfirstlane(tb[16 + e]) - (u.pm - __builtin_amdgcn_readfirstlane(tb[e])) * 256;
        int rin0 = wr * 64 + fr; const int col0 = u.pn * 256 + wc * 32 + 8 * fq;
        asm volatile("" : "+v"(rin0));
#pragma unroll
        for (int ai = 0; ai < 2; ++ai)
#pragma unroll
            for (int m = 0; m < 4; ++m) { const int rin = rin0 + ai * 128 + m * 16;
                if (rin < nvalid) { const unsigned info = ((const unsigned*)rowinfo)[2 * ((size_t)u.pm * 256 + rin)]; const float w = ew[info];
                    bf16_t* dst = Y + ((size_t)(info & 1u) * M + (info >> 1)) * 1024 + col0;
#pragma unroll
                    for (int bj = 0; bj < 2; ++bj) { const f32x4 v0 = acc[ai][bj][m][0] * w, v1 = acc[ai][bj][m][1] * w;
                        u32x4 o; o.x = pg8::cvt_pk_bf16(v0[0], v0[1]); o.y = pg8::cvt_pk_bf16(v0[2], v0[3]); o.z = pg8::cvt_pk_bf16(v1[0], v1[1]); o.w = pg8::cvt_pk_bf16(v1[2], v1[3]);
                        *(u32x4*)(dst + bj * 128) = o; } } }
    }
};

__device__ __forceinline__ void conv_item(const float* W, int ld, int srcc0, int nvalid, bf16_t* WT, int ldd, int dstr0, const float* gain, int k0, int lane) {
    const int n4 = lane & 7, c = lane >> 3;
    f32x4 v[8];
#pragma unroll
    for (int i = 0; i < 8; ++i) { v[i] = (f32x4){0.f, 0.f, 0.f, 0.f};
        if (4 * n4 < nvalid) { v[i] = *(const f32x4*)(W + (size_t)(k0 + 8 * c + i) * ld + srcc0 + 4 * n4); if (gain) v[i] = v[i] * gain[k0 + 8 * c + i]; } }
#pragma unroll
    for (int j = 0; j < 4; ++j) { u32x4 o; o.x = pk2(v[0][j], v[1][j]); o.y = pk2(v[2][j], v[3][j]); o.z = pk2(v[4][j], v[5][j]); o.w = pk2(v[6][j], v[7][j]);
        *(u32x4*)(WT + (size_t)(dstr0 + 4 * n4 + j) * ldd + k0 + 8 * c) = o; }
}

struct W8 { const float* src; const float* gain; unsigned char* dst; int ld, ldd; float scale, gm, ga; };
__device__ __forceinline__ void conv8_load(const W8& d, int lane, f32x4 (&v)[16], f32x4 (&g)[4]) {
    const int n4 = lane & 7, c = lane >> 3;
#pragma unroll
    for (int i = 0; i < 16; ++i) v[i] = *(const f32x4*)(d.src + (size_t)(16 * c + i) * d.ld + 4 * n4);
#pragma unroll
    for (int q = 0; q < 4; ++q) g[q] = *(const f32x4*)(d.gain + 16 * c + 4 * q);
}
__device__ __forceinline__ void conv8_store(const W8& d, int lane, const f32x4 (&v)[16], const f32x4 (&g)[4]) {
    const int n4 = lane & 7, c = lane >> 3;
    f32x4 gs[4];
#pragma unroll
    for (int q = 0; q < 4; ++q) gs[q] = (g[q] * d.gm + d.ga) * d.scale;
#pragma unroll
    for (int j = 0; j < 4; ++j) { u32x4 o;
        o.x = pk_fp8x4(v[0][j] * gs[0].x, v[1][j] * gs[0].y, v[2][j] * gs[0].z, v[3][j] * gs[0].w);
        o.y = pk_fp8x4(v[4][j] * gs[1].x, v[5][j] * gs[1].y, v[6][j] * gs[1].z, v[7][j] * gs[1].w);
        o.z = pk_fp8x4(v[8][j] * gs[2].x, v[9][j] * gs[2].y, v[10][j] * gs[2].z, v[11][j] * gs[2].w);
        o.w = pk_fp8x4(v[12][j] * gs[3].x, v[13][j] * gs[3].y, v[14][j] * gs[3].z, v[15][j] * gs[3].w);
        *(u32x4*)(d.dst + (size_t)(4 * n4 + j) * d.ldd + 16 * c) = o; }
}

struct Args { const float* in[22]; float* out; unsigned char* ws; int ph_lo, ph_hi; };
typedef const __attribute__((address_space(4))) Args* CArgsP;
__device__ __forceinline__ CArgsP argp() { CArgsP p = (CArgsP)__builtin_amdgcn_kernarg_segment_ptr(); asm volatile("" : "+s"(p)); return p; }
#define A_IN(i) ((const float*)argp()->in[i])
enum { I_X = 0, I_NORM_MIX, I_NORM_FFN, I_A_W_IN, I_A_B_GATE, I_A_CONV, I_A_NORM_H, I_A_W_OUT, I_NORM_KV, I_B_W_KV, I_B_CMP_POS, I_B_CMP_W1, I_B_CMP_W2,
       I_B_W_Q, I_B_B_GATE, I_B_W_OUT, I_F_W_GU, I_F_W_DOWN, I_M_ROUTER, I_M_W_GU, I_M_W_DOWN, I_NORM_FINAL };

__device__ __forceinline__ W8 w8_decode(unsigned char* ws, int r) {
    constexpr int N8 = 8 * 8 * 224;
    W8 d;
    if (r < N8) { const int e = r / (8 * 224), rr = r % (8 * 224), kb = rr / 224, db = rr % 224, tile = db >> 3, w = db & 7; const int sc = (w < 4) ? (128 * tile + 32 * w) : (FE + 128 * tile + 32 * (w - 4));
        d.src = A_IN(I_M_W_GU) + (size_t)e * 1024 * 2 * FE + (size_t)(128 * kb) * (2 * FE) + sc; d.ld = 2 * FE; d.gain = A_IN(I_NORM_FFN) + 1024 + 128 * kb; d.scale = 128.f; d.gm = 1.f; d.ga = 0.f;
        d.dst = ws + WS_MGU + (size_t)e * 2 * FE * 1024 + (size_t)(32 * db) * 1024 + 128 * kb; d.ldd = 1024; }
    else { r -= N8; const int e = r / (28 * 32), rr = r % (28 * 32), kb = rr / 32, db = rr % 32;
        d.src = A_IN(I_M_W_DOWN) + (size_t)e * FE * 1024 + (size_t)(128 * kb) * 1024 + 32 * db; d.ld = 1024; d.gain = A_IN(I_NORM_FFN); d.scale = 256.f; d.gm = 0.f; d.ga = 1.f;
        d.dst = ws + WS_MDOWN + (size_t)e * 1024 * FE + (size_t)(32 * db) * FE + 128 * kb; d.ldd = FE; }
    return d;
}
__device__ __forceinline__ void p0_item16(unsigned char* ws, int r, int lane) {
    constexpr int N1 = 16 * 128, N2 = 16 * 32, N5 = 16 * 88, N6 = 2 * 32 * 8;
    if (r < N1) { const int kb = r / 128, db = r % 128; conv_item(A_IN(I_A_W_IN), NPROJ_SRC, 32 * db, 32, (bf16_t*)(ws + WS_WIN), 1024, 32 * db, A_IN(I_NORM_MIX), 64 * kb, lane); return; } r -= N1;
    if (r < N2) { const int kb = r / 32, db = r % 32; conv_item(A_IN(I_A_W_OUT), 1024, 32 * db, 32, (bf16_t*)(ws + WS_WOUTA), 1024, 32 * db, nullptr, 64 * kb, lane); return; } r -= N2;
    if (r < N5) { const int kb = r / 88, db = r % 88;
        if (db < 48) conv_item(A_IN(I_B_W_KV), 1536, 32 * db, 32, (bf16_t*)(ws + WS_WKVQ), 1024, 32 * db, A_IN(I_NORM_KV), 64 * kb, lane);
        else { const int sc = 32 * (db - 48); int nv = NQSRC - sc; nv = nv < 0 ? 0 : (nv > 32 ? 32 : nv);
            conv_item(A_IN(I_B_W_Q), NQSRC, sc, nv, (bf16_t*)(ws + WS_WKVQ), 1024, 32 * db, A_IN(I_NORM_MIX) + 1024, 64 * kb, lane); }
        return; } r -= N5;
    if (r < N6) { const int c = r / 256, rr = r % 256, kb = rr / 8, db = rr % 8; conv_item(A_IN(I_B_CMP_W1) + (size_t)c * 2048 * 256, 256, 32 * db, 32, (bf16_t*)(ws + WS_WCMP1) + (size_t)c * 256 * 2048, 2048, 32 * db, nullptr, 64 * kb, lane); return; } r -= N6;
    if (r < 16 * 32) { const int kb = r / 32, db = r % 32; conv_item(A_IN(I_B_W_OUT), 1024, 32 * db, 32, (bf16_t*)(ws + WS_WOUTB), 1024, 32 * db, nullptr, 64 * kb, lane); return; } r -= 16 * 32;
    { const int c = r >> 3, kb = (r >> 1) & 3, db = r & 1;
        conv_item(A_IN(I_B_CMP_W2) + (size_t)c * 256 * 64, 64, 32 * db, 32, (bf16_t*)(ws + WS_W2T) + (size_t)c * 64 * 256, 256, 32 * db, nullptr, 64 * kb, lane); }
}
__device__ __forceinline__ void p0_weights(unsigned char* ws, LAS unsigned char* lds, int gw, int NGW, int wave, int lane, bool moe) {
    constexpr int N1 = 16 * 128, N2 = 16 * 32, N5 = 16 * 88, N6 = 2 * 32 * 8, N7 = 16 * 32;
    constexpr int NB16 = N1 + N2 + N5 + N6 + N7 + 16, NT8 = 8 * 8 * 224 + 8 * 28 * 32;
    if (moe) {   f32x4 va[16], ga[4], vb[16], gb[4]; W8 da, db;
        int it = gw;
        da = w8_decode(ws, it); conv8_load(da, lane, va, ga);
        for (;;) {
            int nx = it + NGW; db = w8_decode(ws, nx < NT8 ? nx : NT8 - 1); if (nx >= NT8) db.ld = 0;
            conv8_load(db, lane, vb, gb); __builtin_amdgcn_sched_barrier(0);
            conv8_store(da, lane, va, ga);
            if (nx >= NT8) break;
            it = nx; nx = it + NGW; da = w8_decode(ws, nx < NT8 ? nx : NT8 - 1); if (nx >= NT8) da.ld = 0;
            conv8_load(da, lane, va, ga); __builtin_amdgcn_sched_barrier(0);
            conv8_store(db, lane, vb, gb);
            if (nx >= NT8) break;
            it = nx; }
    }
    for (int it = gw; it < NB16; it += NGW) p0_item16(ws, it, lane);
    for (int it = gw; it < 8 * 176; it += NGW) { const int kb = it / 176, db = it % 176, tile = db >> 3, w = db & 7; const int sc = (w < 4) ? (128 * tile + 32 * w) : (FFD + 128 * tile + 32 * (w - 4)); W8 d;
        d.src = A_IN(I_F_W_GU) + (size_t)(128 * kb) * (2 * FFD) + sc; d.ld = 2 * FFD; d.gain = A_IN(I_NORM_FFN) + 128 * kb; d.scale = 128.f; d.gm = 1.f; d.ga = 0.f;
        d.dst = ws + WS_WGU + (size_t)(32 * db) * 1024 + 128 * kb; d.ldd = 1024;
        f32x4 v[16], g[4]; conv8_load(d, lane, v, g); conv8_store(d, lane, v, g); }
    for (int it = gw; it < 22 * 32; it += NGW) { const int kb = it / 32, db = it % 32; W8 d;
        d.src = A_IN(I_F_W_DOWN) + (size_t)(128 * kb) * 1024 + 32 * db; d.ld = 1024; d.gain = A_IN(I_NORM_FFN); d.scale = 256.f; d.gm = 0.f; d.ga = 1.f;
        d.dst = ws + WS_WDOWN + (size_t)(32 * db) * FFD + 128 * kb; d.ldd = FFD;
        f32x4 v[16], g[4]; conv8_load(d, lane, v, g); conv8_store(d, lane, v, g); }
}

constexpr int NMINI = 8 * 32 * 224 + 8 * 112 * 32;
__device__ __forceinline__ W8 mini_decode(unsigned char* ws, int r) {
    W8 d;
    if (r < 8 * 32 * 224) { const int e = r / (32 * 224), rr = r % (32 * 224), kb = rr / 224, db = rr % 224, tile = db >> 3, w = db & 7; const int sc = (w < 4) ? (128 * tile + 32 * w) : (FE + 128 * tile + 32 * (w - 4));
        d.src = A_IN(I_M_W_GU) + (size_t)e * 1024 * 2 * FE + (size_t)(32 * kb) * (2 * FE) + sc; d.ld = 2 * FE; d.gain = A_IN(I_NORM_FFN) + 1024 + 32 * kb; d.scale = 128.f; d.gm = 1.f; d.ga = 0.f;
        d.dst = ws + WS_MGU + (size_t)e * 2 * FE * 1024 + (size_t)(32 * db) * 1024 + 32 * kb; d.ldd = 1024; }
    else { r -= 8 * 32 * 224; const int e = r / (112 * 32), rr = r % (112 * 32), kb = rr / 32, db = rr % 32;
        d.src = A_IN(I_M_W_DOWN) + (size_t)e * FE * 1024 + (size_t)(32 * kb) * 1024 + 32 * db; d.ld = 1024; d.gain = A_IN(I_NORM_FFN); d.scale = 256.f; d.gm = 0.f; d.ga = 1.f;
        d.dst = ws + WS_MDOWN + (size_t)e * 1024 * FE + (size_t)(32 * db) * FE + 32 * kb; d.ldd = FE; }
    return d;
}
__device__ __forceinline__ void mini_load(const W8& d, int lane, f32x4 (&v)[4], f32x4& g) {
    const int n4 = lane & 7, c = lane >> 3;
#pragma unroll
    for (int i = 0; i < 4; ++i) v[i] = *(const f32x4*)(d.src + (size_t)(4 * c + i) * d.ld + 4 * n4);
    g = *(const f32x4*)(d.gain + 4 * c);
}
__device__ __forceinline__ void mini_store(const W8& d, int lane, const f32x4 (&v)[4], const f32x4 g) {
    const int n4 = lane & 7, c = lane >> 3; const f32x4 gs = (g * d.gm + d.ga) * d.scale;
#pragma unroll
    for (int j = 0; j < 4; ++j) *(unsigned*)(d.dst + (size_t)(4 * n4 + j) * d.ldd + 4 * c) = pk_fp8x4(v[0][j] * gs.x, v[1][j] * gs.y, v[2][j] * gs.z, v[3][j] * gs.w);
}

__device__ __forceinline__ void load_row(const float* row, int lane, f32x4 (&v)[4]) {
    const f32x4* xr = (const f32x4*)row + lane;
#pragma unroll
    for (int j = 0; j < 4; ++j) v[j] = xr[64 * j];
}
__device__ __forceinline__ float row_rstd(const f32x4 (&v)[4]) {
    float s = 0.f;
#pragma unroll
    for (int j = 0; j < 4; ++j) s += (v[j].x * v[j].x + v[j].y * v[j].y) + (v[j].z * v[j].z + v[j].w * v[j].w);
    return 1.0f / sqrtf(wave_sum(s) * (1.f / 1024.f) + EPS);
}
__device__ __forceinline__ void store_row_bf16(bf16_t* orow, int lane, const f32x4 (&v)[4], float sc) {
    u64* o8 = (u64*)orow + lane;
#pragma unroll
    for (int j = 0; j < 4; ++j) o8[64 * j] = (u64)pk2(v[j].x * sc, v[j].y * sc) | ((u64)pk2(v[j].z * sc, v[j].w * sc) << 32);
}

__device__ __forceinline__ f32x4 mma_lds(const LAS bf16_t* A, int lda, const LAS bf16_t* Bt, int ldb, int K, f32x4 acc, int lane) {
    const int r = lane & 15, q = lane >> 4;
    const LAS bf16_t* ap = A + r * lda + 8 * q; const LAS bf16_t* bp = Bt + r * ldb + 8 * q;
    for (int k = 0; k < K; k += 32) { const bf16x8 a = *(const LAS bf16x8*)(ap + k), b = *(const LAS bf16x8*)(bp + k); acc = __builtin_amdgcn_mfma_f32_16x16x32_bf16(a, b, acc, 0, 0, 0); }
    return acc;
}

__device__ __forceinline__ void scanprep_phase(LAS unsigned char* lds, const bf16_t* P3, const float* GA, const float* conv_w, unsigned char* IMG, int vcu, int G) {
    const int tid = threadIdx.x, wave = __builtin_amdgcn_readfirstlane(tid >> 6), lane = tid & 63;
    constexpr int QS = 272, LDP = 3072;
    LAS bf16_t* Qs = (LAS bf16_t*)(lds + 0);
    LAS bf16_t* Kd = (LAS bf16_t*)(lds + 34816);
    LAS float* fg = (LAS float*)(lds + 67584);
    LAS float* cw = (LAS float*)(lds + 68352);
    const bool same_h = (G & 255) == 0; int h_loaded = -1;
    const int cg = tid & 31, rg = tid >> 5, vv = tid & 255, hf = tid >> 8;
    u32x4 nq[7], nk[7]; unsigned short nev[32]; float ngli = 0.f, nglf = 0.f;
#define PREP_LOAD(it_) do { const int b_ = (it_) >> 8, h_ = ((it_) >> 6) & 3, t0_ = ((it_) & 63) * 64; const size_t rb_ = (size_t)b_ * SEQ + t0_; \
        _Pragma("unroll") for (int r7 = 0; r7 < 7; ++r7) { const int tt = 4 * rg - 3 + r7; const int tc = (t0_ + tt >= 0) ? tt : 0;        \
            const bf16_t* p = P3 + (rb_ + tc) * LDP + h_ * 256 + 8 * cg; nq[r7] = *(const u32x4*)p; nk[r7] = *(const u32x4*)(p + 1024); } \
        { const bf16_t* vp = P3 + (rb_ + 32 * hf) * LDP + 2048 + h_ * 256 + vv; _Pragma("unroll") for (int i = 0; i < 32; ++i) nev[i] = vp[(size_t)i * LDP]; } \
        { const int gl_ = (wave == 7) ? lane : 0; ngli = GA[(rb_ + gl_) * 8 + h_]; nglf = GA[(rb_ + gl_) * 8 + 4 + h_]; } } while (0)
    if (vcu < 2048) PREP_LOAD(vcu);
    for (int item = vcu; item < 2048; item += G) {
        const int b = item >> 8, h = (item >> 6) & 3, ci = item & 63, t0 = ci * 64; const size_t rb = (size_t)b * SEQ + t0;
        unsigned char* img = IMG + (size_t)item * IMG_STRIDE;
        u32x4 rawq[7], rawk[7]; unsigned short ev[32];
#pragma unroll
        for (int r7 = 0; r7 < 7; ++r7) { const int tt = 4 * rg - 3 + r7; const bool okr = t0 + tt >= 0; rawq[r7] = okr ? nq[r7] : (u32x4){0u, 0u, 0u, 0u}; rawk[r7] = okr ? nk[r7] : (u32x4){0u, 0u, 0u, 0u}; }
#pragma unroll
        for (int i = 0; i < 32; ++i) ev[i] = nev[i];
        const float gli = ngli, glf = nglf;
        __syncthreads();
        if (h != h_loaded || !same_h) {
            for (int i = tid; i < 2048; i += NTHR) { const int j = i >> 8, kk = i & 255; cw[i] = conv_w[(j & 3) * 2048 + (j >> 2) * 1024 + h * 256 + kk]; }
            for (int i = tid; i < 64 * 16; i += NTHR) { const int r = i >> 4, c = i & 15; Qs[r * QS + 256 + c] = 0; }
            h_loaded = h; __syncthreads(); }
        { bf16_t* op = (bf16_t*)(img + IMG_VT) + vv * 80 + 32 * hf;
#pragma unroll
          for (int g8 = 0; g8 < 4; ++g8) { u32x4 w; w.x = ev[8 * g8] | ((unsigned)ev[8 * g8 + 1] << 16); w.y = ev[8 * g8 + 2] | ((unsigned)ev[8 * g8 + 3] << 16); w.z = ev[8 * g8 + 4] | ((unsigned)ev[8 * g8 + 5] << 16); w.w = ev[8 * g8 + 6] | ((unsigned)ev[8 * g8 + 7] << 16);
              *(u32x4*)(op + 8 * g8) = w; }
          *(u32x4*)((bf16_t*)(img + IMG_VT) + vv * 80 + 64 + 8 * hf) = (u32x4){0u, 0u, 0u, 0u}; }
        {
#pragma unroll
          for (int which = 0; which < 2; ++which) {
            float x[7][8];
#pragma unroll
            for (int r7 = 0; r7 < 7; ++r7) { const u32x4 raw = which ? rawk[r7] : rawq[r7];
                x[r7][0] = bflo(raw.x); x[r7][1] = bfhi(raw.x); x[r7][2] = bflo(raw.y); x[r7][3] = bfhi(raw.y); x[r7][4] = bflo(raw.z); x[r7][5] = bfhi(raw.z); x[r7][6] = bflo(raw.w); x[r7][7] = bfhi(raw.w); }
            float w[4][8];
#pragma unroll
            for (int tap = 0; tap < 4; ++tap) { const f32x4 w0 = *(const LAS f32x4*)(cw + (which * 4 + tap) * 256 + 8 * cg), w1 = *(const LAS f32x4*)(cw + (which * 4 + tap) * 256 + 8 * cg + 4);
                w[tap][0] = w0.x; w[tap][1] = w0.y; w[tap][2] = w0.z; w[tap][3] = w0.w; w[tap][4] = w1.x; w[tap][5] = w1.y; w[tap][6] = w1.z; w[tap][7] = w1.w; }
            const float sc = which ? 0.0625f : 1.0f;
#pragma unroll
            for (int j = 0; j < 4; ++j) { float o[8];
#pragma unroll
                for (int c = 0; c < 8; ++c) o[c] = (w[0][c] * x[j][c] + w[1][c] * x[j + 1][c] + w[2][c] * x[j + 2][c] + w[3][c] * x[j + 3][c]) * sc;
                u32x4 p; p.x = pg8::cvt_pk_bf16(o[0], o[1]); p.y = pg8::cvt_pk_bf16(o[2], o[3]); p.z = pg8::cvt_pk_bf16(o[4], o[5]); p.w = pg8::cvt_pk_bf16(o[6], o[7]);
                if (which) *(LAS u32x4*)(Kd + (4 * rg + j) * 256 + 8 * cg) = p; else *(LAS u32x4*)(Qs + (4 * rg + j) * QS + 8 * cg) = p; }
          }
          if (wave == 7) { const float li = gli, lf = glf;
              float bc = lf;
#pragma unroll
              for (int o = 1; o < 64; o <<= 1) { const float t = __shfl_up(bc, o); if (lane >= o) bc += t; }
              const float uu = li - bc; float pm = uu;
#pragma unroll
              for (int o = 1; o < 64; o <<= 1) { const float t = __shfl_up(pm, o); if (lane >= o) pm = fmaxf(pm, t); }
              fg[lane] = bc; fg[64 + lane] = uu; fg[128 + lane] = pm; }
        }
        __syncthreads();
        PREP_LOAD((item + G < 2048) ? item + G : item);
        { const int k = tid & 255; bf16_t* op = (bf16_t*)(img + IMG_KT) + k * 64 + 32 * hf;
#pragma unroll
          for (int g8 = 0; g8 < 4; ++g8) { unsigned short e[8];
#pragma unroll
              for (int i = 0; i < 8; ++i) e[i] = Kd[(32 * hf + 8 * g8 + i) * 256 + k];
              u32x4 w; w.x = e[0] | ((unsigned)e[1] << 16); w.y = e[2] | ((unsigned)e[3] << 16); w.z = e[4] | ((unsigned)e[5] << 16); w.w = e[6] | ((unsigned)e[7] << 16);
              *(u32x4*)(op + 8 * g8) = w; } }
        for (int i = tid; i < 67584 / 16; i += NTHR) *(u32x4*)(img + (size_t)i * 16) = *(const LAS u32x4*)(lds + i * 16);
        if (tid < 48) *(u32x4*)(img + IMG_G + tid * 16) = *(const LAS u32x4*)(lds + 67584 + tid * 16);
    }
}

__device__ __forceinline__ void scan_phase(LAS unsigned char* lds, const unsigned char* IMG, float* HS, float* DN, int vcu, int G, unsigned char* ws) {
    const int tid = threadIdx.x, wave = __builtin_amdgcn_readfirstlane(tid >> 6), lane = tid & 63, cl = lane & 15, q4 = lane >> 4;
    constexpr int QS = 272, TS = 80;
    LAS bf16_t* Qs = (LAS bf16_t*)(lds + 0);
    LAS bf16_t* Cbs = (LAS bf16_t*)(lds + 34816);
    LAS bf16_t* VTs = (LAS bf16_t*)(lds + 52768);
    LAS bf16_t* VaTs = (LAS bf16_t*)(lds + 58048);
    LAS bf16_t* Sws = (LAS bf16_t*)(lds + 63328);
    LAS float* fg = (LAS float*)(lds + 73568);
    const int r2 = cl ? 32 : 32;
    for (int u = vcu; u < 256; u += G) {
        const int b = u >> 5, h = (u >> 3) & 3, vs = u & 7;
        const unsigned char* img0 = IMG + (size_t)((b * 4 + h) * 64) * IMG_STRIDE;
        __syncthreads();
        for (int i = tid; i < 33 * QS; i += NTHR) Cbs[i] = 0;
        for (int i = tid; i < TS; i += NTHR) { VTs[32 * TS + i] = (i < 64) ? (bf16_t)0x3F80 : (bf16_t)0; VaTs[32 * TS + i] = 0; }
        f32x4 Cacc[2][3];
#pragma unroll
        for (int kk = 0; kk < 2; ++kk)
#pragma unroll
            for (int vt = 0; vt < 3; ++vt) Cacc[kk][vt] = (f32x4){0.f, 0.f, 0.f, 0.f};
        float mstate = 0.f;
        u32x4 pfq[5], pfv, pfg;
        bf16x8 kfr[8], ktf[2][2];
#define SCAN_LOAD(ci_) do { const unsigned char* ip = img0 + (size_t)(ci_) * IMG_STRIDE; \
            _Pragma("unroll") for (int k = 0; k < 5; ++k) { const int id = tid + 512 * k; if (id < 2176) pfq[k] = *(const u32x4*)(ip + (size_t)id * 16); } \
            if (tid < 320) pfv = *(const u32x4*)(ip + IMG_VT + vs * 5120 + tid * 16); \
            if (tid < 48) pfg = *(const u32x4*)(ip + IMG_G + tid * 16); } while (0)
#define SCAN_LOAD_K(ci_) do { if (wave >= 4) { const bf16_t* kp = (const bf16_t*)(img0 + (size_t)(ci_) * IMG_STRIDE + IMG_K) + (16 * (wave - 4) + cl) * 256 + 8 * q4; \
            _Pragma("unroll") for (int ks = 0; ks < 8; ++ks) kfr[ks] = *(const bf16x8*)(kp + 32 * ks); } } while (0)
#define SCAN_LOAD_KT(ci_) do { const bf16_t* kp = (const bf16_t*)(img0 + (size_t)(ci_) * IMG_STRIDE + IMG_KT) + (32 * wave + cl) * 64 + 8 * q4; \
            _Pragma("unroll") for (int kk = 0; kk < 2; ++kk) _Pragma("unroll") for (int ks = 0; ks < 2; ++ks) ktf[kk][ks] = *(const bf16x8*)(kp + kk * 1024 + 32 * ks); } while (0)
        SCAN_LOAD(0); SCAN_LOAD_K(0); SCAN_LOAD_KT(0);
        W8 cvd = mini_decode(ws, 0); f32x4 cvv[4], cvg;
#pragma unroll
        for (int i = 0; i < 4; ++i) cvv[i] = (f32x4){0.f, 0.f, 0.f, 0.f};
        cvg = (f32x4){0.f, 0.f, 0.f, 0.f};
        for (int ci = 0; ci < 64; ++ci) {
            const size_t rb = (size_t)b * SEQ + ci * 64;
#pragma unroll
            for (int k = 0; k < 5; ++k) { const int id = tid + 512 * k; if (id < 2176) *(LAS u32x4*)(lds + id * 16) = pfq[k]; }
            if (tid < 320) *(LAS u32x4*)((LAS unsigned char*)VTs + tid * 16) = pfv;
            if (tid < 48) *(LAS u32x4*)((LAS unsigned char*)fg + tid * 16) = pfg;
            if (ci + 1 < 64) SCAN_LOAD(ci + 1);
            LDS_BARRIER();
            const float pm63 = fg[128 + 63], bc63 = fg[63];
            const float M63 = fmaxf(mstate, pm63), aprev = ex2((mstate - M63) * 1.4426950408889634f);
            f32x4 hacc[3];
            if (wave < 4) {
                const int ti = wave;
#pragma unroll
                for (int vt = 0; vt < 3; ++vt) hacc[vt] = (f32x4){0.f, 0.f, 0.f, 0.f};
#pragma unroll
                for (int k2 = 0; k2 < 8; k2 += 2) { bf16x8 a[2], b0[2], b1[2], b2[2];
#pragma unroll
                    for (int u2 = 0; u2 < 2; ++u2) { const int ks = k2 + u2; a[u2] = *(const LAS bf16x8*)(Qs + (16 * ti + cl) * QS + 32 * ks + 8 * q4);
                        b0[u2] = *(const LAS bf16x8*)(Cbs + cl * QS + 32 * ks + 8 * q4); b1[u2] = *(const LAS bf16x8*)(Cbs + (16 + cl) * QS + 32 * ks + 8 * q4); b2[u2] = *(const LAS bf16x8*)(Cbs + r2 * QS + 32 * ks + 8 * q4); }
                    __builtin_amdgcn_sched_group_barrier(0x100, 8, 0);
#pragma unroll
                    for (int u2 = 0; u2 < 2; ++u2) { hacc[0] = __builtin_amdgcn_mfma_f32_16x16x32_bf16(a[u2], b0[u2], hacc[0], 0, 0, 0); hacc[1] = __builtin_amdgcn_mfma_f32_16x16x32_bf16(a[u2], b1[u2], hacc[1], 0, 0, 0); hacc[2] = __builtin_amdgcn_mfma_f32_16x16x32_bf16(a[u2], b2[u2], hacc[2], 0, 0, 0); } }
#pragma unroll
                for (int j = 0; j < 4; ++j) { const float wint = ex2((mstate - fmaxf(mstate, fg[128 + 16 * ti + 4 * q4 + j])) * 1.4426950408889634f); hacc[0][j] *= wint; hacc[1][j] *= wint; hacc[2][j] *= wint; }
            } else {
                const int si = wave - 4; f32x4 us4;
#pragma unroll
                for (int j = 0; j < 4; ++j) us4[j] = fg[64 + 16 * si + 4 * q4 + j];
#pragma unroll
                for (int ti = 0; ti < 4; ++ti) { u32x2 w = (u32x2){0u, 0u};
                    if (ti >= si) { f32x4 sacc = (f32x4){0.f, 0.f, 0.f, 0.f};
#pragma unroll
                        for (int k4 = 0; k4 < 8; k4 += 4) { bf16x8 qb[4];
#pragma unroll
                            for (int u4 = 0; u4 < 4; ++u4) qb[u4] = *(const LAS bf16x8*)(Qs + (16 * ti + cl) * QS + 32 * (k4 + u4) + 8 * q4);
                            __builtin_amdgcn_sched_group_barrier(0x100, 4, 0);
#pragma unroll
                            for (int u4 = 0; u4 < 4; ++u4) sacc = __builtin_amdgcn_mfma_f32_16x16x32_bf16(kfr[k4 + u4], qb[u4], sacc, 0, 0, 0); }
                        const int t = 16 * ti + cl; const float Mt = fmaxf(mstate, fg[128 + t]); float p[4];
#pragma unroll
                        for (int j = 0; j < 4; ++j) { const int s_ = 16 * si + 4 * q4 + j; p[j] = (s_ <= t) ? sacc[j] * ex2((us4[j] - Mt) * 1.4426950408889634f) : 0.f; }
                        w.x = pg8::cvt_pk_bf16(p[0], p[1]); w.y = pg8::cvt_pk_bf16(p[2], p[3]); }
                    *(LAS u32x2*)(Sws + (16 * ti + cl) * TS + 16 * si + 4 * q4) = w; }
                if (ci + 1 < 64) SCAN_LOAD_K(ci + 1);
            }
#define SCAN_VAT(task_) do { const int v = (task_) >> 3, s8 = ((task_) & 7) * 8; const u32x4 raw = *(const LAS u32x4*)(VTs + v * TS + s8); float a[8]; \
                _Pragma("unroll") for (int i = 0; i < 8; ++i) a[i] = ex2((fg[64 + s8 + i] - M63) * 1.4426950408889634f); \
                u32x4 w; w.x = pg8::cvt_pk_bf16(bflo(raw.x) * a[0], bfhi(raw.x) * a[1]); w.y = pg8::cvt_pk_bf16(bflo(raw.y) * a[2], bfhi(raw.y) * a[3]); w.z = pg8::cvt_pk_bf16(bflo(raw.z) * a[4], bfhi(raw.z) * a[5]); w.w = pg8::cvt_pk_bf16(bflo(raw.w) * a[6], bfhi(raw.w) * a[7]); \
                *(LAS u32x4*)(VaTs + v * TS + s8) = w; } while (0)
            if (tid >= 384) { SCAN_VAT(tid - 384); SCAN_VAT(tid - 384 + 128); }
            else if (tid >= 320 && tid < 328) SCAN_VAT(256 + tid - 320);
#undef SCAN_VAT
            LDS_BARRIER();
            if (wave < 4) {
                const int ti = wave;
#pragma unroll
                for (int ks = 0; ks < 2; ++ks) { const bf16x8 a = *(const LAS bf16x8*)(Sws + (16 * ti + cl) * TS + 32 * ks + 8 * q4);
                    const bf16x8 b0 = *(const LAS bf16x8*)(VTs + cl * TS + 32 * ks + 8 * q4), b1 = *(const LAS bf16x8*)(VTs + (16 + cl) * TS + 32 * ks + 8 * q4), b2 = *(const LAS bf16x8*)(VTs + r2 * TS + 32 * ks + 8 * q4);
                    hacc[0] = __builtin_amdgcn_mfma_f32_16x16x32_bf16(a, b0, hacc[0], 0, 0, 0); hacc[1] = __builtin_amdgcn_mfma_f32_16x16x32_bf16(a, b1, hacc[1], 0, 0, 0); hacc[2] = __builtin_amdgcn_mfma_f32_16x16x32_bf16(a, b2, hacc[2], 0, 0, 0); }
#pragma unroll
                for (int j = 0; j < 4; ++j) { const int t = 16 * ti + 4 * q4 + j; bf16_t* hp = (bf16_t*)HS + (rb + t) * 1024 + h * 256 + vs * 32 + cl; hp[0] = (bf16_t)f2bf(hacc[0][j]); hp[16] = (bf16_t)f2bf(hacc[1][j]);
                    if (vs == 0 && cl == 0) { const float Mtt = fmaxf(mstate, fg[128 + t]); DN[(rb + t) * 4 + h] = fmaxf(fabsf(hacc[2][j]), ex2(-(fg[t] + Mtt) * 1.4426950408889634f)); } }
            }
#pragma unroll
            for (int kk = 0; kk < 2; ++kk)
#pragma unroll
                for (int vt = 0; vt < 3; ++vt) Cacc[kk][vt] = Cacc[kk][vt] * aprev;
#pragma unroll
            for (int ks = 0; ks < 2; ++ks) { const bf16x8 b0 = *(const LAS bf16x8*)(VaTs + cl * TS + 32 * ks + 8 * q4), b1 = *(const LAS bf16x8*)(VaTs + (16 + cl) * TS + 32 * ks + 8 * q4), b2 = *(const LAS bf16x8*)(VaTs + r2 * TS + 32 * ks + 8 * q4);
#pragma unroll
                for (int kk = 0; kk < 2; ++kk) { Cacc[kk][0] = __builtin_amdgcn_mfma_f32_16x16x32_bf16(ktf[kk][ks], b0, Cacc[kk][0], 0, 0, 0); Cacc[kk][1] = __builtin_amdgcn_mfma_f32_16x16x32_bf16(ktf[kk][ks], b1, Cacc[kk][1], 0, 0, 0);
                    Cacc[kk][2] = __builtin_amdgcn_mfma_f32_16x16x32_bf16(ktf[kk][ks], b2, Cacc[kk][2], 0, 0, 0); } }
#pragma unroll
            for (int kk = 0; kk < 2; ++kk)
#pragma unroll
                for (int vt = 0; vt < 3; ++vt) { if (vt < 2 || cl == 0) { u32x2 w; w.x = pg8::cvt_pk_bf16(Cacc[kk][vt][0], Cacc[kk][vt][1]); w.y = pg8::cvt_pk_bf16(Cacc[kk][vt][2], Cacc[kk][vt][3]);
                        *(LAS u32x2*)(Cbs + (16 * vt + cl) * QS + 32 * wave + 16 * kk + 4 * q4) = w; } }
            if (ci + 1 < 64) SCAN_LOAD_KT(ci + 1);
            if (G == 256 && ci >= 1 && ci <= 42) mini_store(cvd, lane, cvv, cvg);
            cvd = mini_decode(ws, (ci < 42 ? ci : 41) * 2048 + vcu * 8 + wave); if (!(G == 256 && ci < 42)) cvd.ld = 0;
            mini_load(cvd, lane, cvv, cvg);
            mstate = bc63 + M63;
            LDS_BARRIER();
        }
#undef SCAN_LOAD
#undef SCAN_LOAD_K
#undef SCAN_LOAD_KT
    }
}

#define ATT_ONES (__builtin_bit_cast(bf16x8, (u32x4){0x3F803F80u, 0x3F803F80u, 0x3F803F80u, 0x3F803F80u}))
template <int MODE, bool EDGE>
__device__ __forceinline__ void attn_tile2(const LAS bf16_t* Kt, const LAS bf16_t* VTt, LAS bf16_t* Pw, const bf16x8 (&qa)[2], const f32x4 bv0, int jb, int t0, int th, float slope2,
                                           u64 tsel, f32x4 (&O)[4], float& mrow, f32x4& L4, int lane) {
    const int cl = lane & 15, q4 = lane >> 4; constexpr int TS = 72;
    f32x4 s[4];
#pragma unroll
    for (int nt = 0; nt < 4; ++nt) { s[nt] = bv0;
#pragma unroll
        for (int ks = 0; ks < 2; ++ks) { const bf16x8 kb = *(const LAS bf16x8*)(Kt + (16 * nt + cl) * TS + 32 * ks + 8 * q4); s[nt] = __builtin_amdgcn_mfma_f32_16x16x32_bf16(kb, qa[ks], s[nt], 0, 0, 0); } }
    const float b0 = slope2 * (float)(64 * jb - (t0 + 31)), o16 = slope2 * 16.f;
    bool rowok = true; if (MODE == 0) rowok = ((tsel >> (16 * th + cl)) & 1ull) != 0ull;
    if (EDGE) { const int dbase = t0 + 16 * th + cl - (64 * jb + 4 * q4);
#pragma unroll
        for (int nt = 0; nt < 4; ++nt)
#pragma unroll
            for (int j = 0; j < 4; ++j) { const int dist = dbase - (16 * nt + j); const bool ok = dist >= 0 && (MODE == 0 || dist < 512); s[nt][j] = ok ? s[nt][j] : -INFINITY; } }
    float mx = fmaxf(fmaxf(s[0][0], s[0][1]), fmaxf(s[0][2], s[0][3]));
#pragma unroll
    for (int n = 1; n < 4; ++n) mx = fmaxf(mx, fmaxf(fmaxf(s[n][0], s[n][1]), fmaxf(s[n][2], s[n][3])) + (float)n * o16);
    mx = rowok ? mx + b0 : -INFINITY;
    mx = fmaxf(mx, __shfl_xor(mx, 16)); mx = fmaxf(mx, __shfl_xor(mx, 32));
    const float mold = mrow, mnew = fmaxf(mold, mx), msafe = (mnew == -INFINITY) ? 0.f : mnew;
    const float alpha = (mold == -INFINITY) ? 0.f : ex2(mold - msafe);
    const float ref = rowok ? (msafe - b0) : INFINITY;
    unsigned pw[4][2];
#pragma unroll
    for (int nt = 0; nt < 4; ++nt) { float p[4]; const float refn = ref - (float)nt * o16;
#pragma unroll
        for (int j = 0; j < 4; ++j) p[j] = ex2(s[nt][j] - refn);
        pw[nt][0] = pg8::cvt_pk_bf16(p[0], p[1]); pw[nt][1] = pg8::cvt_pk_bf16(p[2], p[3]); }
    L4 = L4 * alpha; mrow = mnew;
#pragma unroll
    for (int dt = 0; dt < 4; ++dt) O[dt] = O[dt] * alpha;
#pragma unroll
    for (int ks = 0; ks < 2; ++ks) { const bf16x8 pa = __builtin_bit_cast(bf16x8, (u32x4){pw[2 * ks][0], pw[2 * ks][1], pw[2 * ks + 1][0], pw[2 * ks + 1][1]});
        L4 = __builtin_amdgcn_mfma_f32_16x16x32_bf16(ATT_ONES, pa, L4, 0, 0, 0);
#pragma unroll
        for (int dt = 0; dt < 4; ++dt) { const bf16x8 vb = *(const LAS bf16x8*)(VTt + (16 * dt + cl) * TS + 32 * ks + 8 * q4); O[dt] = __builtin_amdgcn_mfma_f32_16x16x32_bf16(vb, pa, O[dt], 0, 0, 0); } }
}

template <int MODE>
__device__ __forceinline__ void attn_pair(const LAS bf16_t* KtA, const LAS bf16_t* KtB, LAS bf16_t* Pw, const bf16x8 (&qa)[2], const f32x4 bv0, int jA, int jB, int t0, int th, float slope2,
                                          u64 tselA, u64 tselB, f32x4 (&O)[4], float& mrow, f32x4& L4, int lane) {
    const int cl = lane & 15, q4 = lane >> 4; constexpr int TS = 72, PP = 136;
    f32x4 s[8];
#pragma unroll
    for (int nt = 0; nt < 8; ++nt) { const LAS bf16_t* Kt = (nt < 4) ? KtA : KtB; s[nt] = bv0;
#pragma unroll
        for (int ks = 0; ks < 2; ++ks) { const bf16x8 kb = *(const LAS bf16x8*)(Kt + (16 * (nt & 3) + cl) * TS + 32 * ks + 8 * q4); s[nt] = __builtin_amdgcn_mfma_f32_16x16x32_bf16(kb, qa[ks], s[nt], 0, 0, 0); } }
    const float o16 = slope2 * 16.f, bA = slope2 * (float)(64 * jA - (t0 + 31)), bB = slope2 * (float)(64 * jB - (t0 + 31));
    bool okA = true, okB = true; if (MODE == 0) { okA = ((tselA >> (16 * th + cl)) & 1ull) != 0ull; okB = ((tselB >> (16 * th + cl)) & 1ull) != 0ull; }
    float mA = fmaxf(fmaxf(s[0][0], s[0][1]), fmaxf(s[0][2], s[0][3])), mB = fmaxf(fmaxf(s[4][0], s[4][1]), fmaxf(s[4][2], s[4][3]));
#pragma unroll
    for (int n = 1; n < 4; ++n) { mA = fmaxf(mA, fmaxf(fmaxf(s[n][0], s[n][1]), fmaxf(s[n][2], s[n][3])) + (float)n * o16); mB = fmaxf(mB, fmaxf(fmaxf(s[4 + n][0], s[4 + n][1]), fmaxf(s[4 + n][2], s[4 + n][3])) + (float)n * o16); }
    float mx = fmaxf(okA ? mA + bA : -INFINITY, okB ? mB + bB : -INFINITY);
    mx = fmaxf(mx, __shfl_xor(mx, 16)); mx = fmaxf(mx, __shfl_xor(mx, 32));
    const float mold = mrow, mnew = fmaxf(mold, mx), msafe = (mnew == -INFINITY) ? 0.f : mnew;
    const float alpha = (mold == -INFINITY) ? 0.f : ex2(mold - msafe);
    const float refA = okA ? (msafe - bA) : INFINITY, refB = okB ? (msafe - bB) : INFINITY;
    unsigned pw[8][2];
#pragma unroll
    for (int nt = 0; nt < 8; ++nt) { float p[4]; const float refn = ((nt < 4) ? refA : refB) - (float)(nt & 3) * o16;
#pragma unroll
        for (int j = 0; j < 4; ++j) p[j] = ex2(s[nt][j] - refn);
        pw[nt][0] = pg8::cvt_pk_bf16(p[0], p[1]); pw[nt][1] = pg8::cvt_pk_bf16(p[2], p[3]); }
    L4 = L4 * alpha; mrow = mnew;
#pragma unroll
    for (int dt = 0; dt < 4; ++dt) O[dt] = O[dt] * alpha;
#pragma unroll
    for (int ks = 0; ks < 4; ++ks) { const bf16x8 pa = __builtin_bit_cast(bf16x8, (u32x4){pw[2 * ks][0], pw[2 * ks][1], pw[2 * ks + 1][0], pw[2 * ks + 1][1]}); const LAS bf16_t* VTt = ((ks < 2) ? KtA : KtB) + 4608;
        L4 = __builtin_amdgcn_mfma_f32_16x16x32_bf16(ATT_ONES, pa, L4, 0, 0, 0);
#pragma unroll
        for (int dt = 0; dt < 4; ++dt) { const bf16x8 vb = *(const LAS bf16x8*)(VTt + (16 * dt + cl) * TS + 32 * (ks & 1) + 8 * q4); O[dt] = __builtin_amdgcn_mfma_f32_16x16x32_bf16(vb, pa, O[dt], 0, 0, 0); } }
    LDS_WAIT();
}

template <int MODE>
__device__ __forceinline__ void attn_pair_fast(const LAS bf16_t* KtA, const LAS bf16_t* KtB, LAS bf16_t* Pw, const bf16x8 (&qa)[2], const f32x4 bv0, int jA, int jB, int t0, int th, float slope2,
                                               u64 tselA, u64 tselB, f32x4 (&O)[4], float mrow, f32x4& L4, int lane) {
    const int cl = lane & 15, q4 = lane >> 4; constexpr int TS = 72;
    const float o16 = slope2 * 16.f, bA = slope2 * (float)(64 * jA - (t0 + 31)), bB = slope2 * (float)(64 * jB - (t0 + 31));
    bool okA = true, okB = true; if (MODE == 0) { okA = ((tselA >> (16 * th + cl)) & 1ull) != 0ull; okB = ((tselB >> (16 * th + cl)) & 1ull) != 0ull; }
    const float refA = okA ? (mrow - bA) : INFINITY, refB = okB ? (mrow - bB) : INFINITY;
    f32x4 s[8];
#pragma unroll
    for (int hq = 0; hq < 4; ++hq) { const LAS bf16_t* Kt = (hq >> 1) ? KtB : KtA; bf16x8 kf[2][2];
#pragma unroll
        for (int n2 = 0; n2 < 2; ++n2)
#pragma unroll
            for (int ks = 0; ks < 2; ++ks) kf[n2][ks] = *(const LAS bf16x8*)(Kt + (16 * (2 * (hq & 1) + n2) + cl) * TS + 32 * ks + 8 * q4);
#pragma unroll
        for (int n2 = 0; n2 < 2; ++n2) s[2 * hq + n2] = bv0 - (((hq >> 1) ? refB : refA) - (float)(2 * (hq & 1) + n2) * o16);
        __builtin_amdgcn_sched_group_barrier(0x100, 4, 0);
        __builtin_amdgcn_s_setprio(1);
#pragma unroll
        for (int n2 = 0; n2 < 2; ++n2)
#pragma unroll
            for (int ks = 0; ks < 2; ++ks) s[2 * hq + n2] = __builtin_amdgcn_mfma_f32_16x16x32_bf16(kf[n2][ks], qa[ks], s[2 * hq + n2], 0, 0, 0);
        __builtin_amdgcn_s_setprio(0);
    }
    unsigned pw[8][2];
#pragma unroll
    for (int nt = 0; nt < 8; ++nt) { float p[4];
#pragma unroll
        for (int j = 0; j < 4; ++j) p[j] = ex2(s[nt][j]);
        pw[nt][0] = pg8::cvt_pk_bf16(p[0], p[1]); pw[nt][1] = pg8::cvt_pk_bf16(p[2], p[3]); }
#pragma unroll
    for (int ks = 0; ks < 4; ++ks) { const bf16x8 pa = __builtin_bit_cast(bf16x8, (u32x4){pw[2 * ks][0], pw[2 * ks][1], pw[2 * ks + 1][0], pw[2 * ks + 1][1]}); const LAS bf16_t* VTt = ((ks < 2) ? KtA : KtB) + 4608;
        bf16x8 vf[4];
#pragma unroll
        for (int dt = 0; dt < 4; ++dt) vf[dt] = *(const LAS bf16x8*)(VTt + (16 * dt + cl) * TS + 32 * (ks & 1) + 8 * q4);
        __builtin_amdgcn_sched_group_barrier(0x100, 4, 0);
        L4 = __builtin_amdgcn_mfma_f32_16x16x32_bf16(ATT_ONES, pa, L4, 0, 0, 0);
#pragma unroll
        for (int dt = 0; dt < 4; ++dt) O[dt] = __builtin_amdgcn_mfma_f32_16x16x32_bf16(vf[dt], pa, O[dt], 0, 0, 0); }
    LDS_WAIT();
}

constexpr int ATT_SET0 = 70656, ATT_SET1 = 107520, ATT_QL = 144384;
template <int MODE>
__device__ __forceinline__ void attn_branch(LAS unsigned char* lds, LAS bf16_t* Pw, const bf16_t* KV, const bf16_t* VT2, const float* GATEB, const bf16x8 (&qa)[2], f32x4 (&outacc)[4],
                                            u64 uni, u64 tselv, int b, int bg, int h, int t0, int th, float slope2,
                                            u32x4 (&pk)[4], bool pre, const bf16_t* nK, const bf16_t* nV, int nja, int njb
#if TSEG
                                            , unsigned long long& tseg_acc
#endif
                                            ) {
#if TSEG
    unsigned long long tseg_t = 0;
#endif
    const int tid = threadIdx.x, lane = tid & 63; constexpr int TS = 72;
    const size_t PLANE = (size_t)8 * 4 * 4096 * 64;
    f32x4 O[4]; float mrow = -INFINITY; f32x4 L4 = (f32x4){0.f, 0.f, 0.f, 0.f};
#pragma unroll
    for (int j = 0; j < 4; ++j) O[j] = (f32x4){0.f, 0.f, 0.f, 0.f};
    const float k0f = (float)(4 * (lane >> 4)); const f32x4 bv0 = (f32x4){slope2 * k0f, slope2 * (k0f + 1.f), slope2 * (k0f + 2.f), slope2 * (k0f + 3.f)};
    const int jhi = (t0 + 31) >> 6; int jlo = 0; if (MODE == 1) { jlo = t0 - 511; jlo = jlo < 0 ? 0 : (jlo >> 6); }
    u64 rem = (MODE == 0) ? uni : ((jhi >= 63 ? ~0ull : ((1ull << (jhi + 1)) - 1ull)) & ~((1ull << jlo) - 1ull));
    const bf16_t* Ksrc = KV + (size_t)(MODE == 0 ? 2 : 4) * PLANE + (size_t)bg * 4096 * 64;
    const bf16_t* Vsrc = VT2 + ((size_t)MODE * 32 + bg) * 4096 * 64;
    const size_t toff = (size_t)tid * 8;
    const int loff = (tid >> 3) * TS + 8 * (tid & 7);
    u32x4& pkA = pk[0]; u32x4& pvA = pk[1]; u32x4& pkB = pk[2]; u32x4& pvB = pk[3];
    int a0 = -1, b0_ = -1, a1 = -1, b1 = -1;
    bool pfd = false;
#define ATT_NEXT() do { if (!pfd) { pfd = true; if (nja >= 0) { pkA = *(const u32x4*)(nK + (size_t)nja * 4096 + toff); pvA = *(const u32x4*)(nV + (size_t)nja * 4096 + toff); } \
                                            if (njb >= 0) { pkB = *(const u32x4*)(nK + (size_t)njb * 4096 + toff); pvB = *(const u32x4*)(nV + (size_t)njb * 4096 + toff); } } } while (0)
#define ATT_TAKE(x) do { if (rem) { x = 63 - __builtin_clzll(rem); rem &= ~(1ull << x); } else x = -1; } while (0)
#define ATT_LOAD(ja, jb_) do { if ((ja) >= 0) { pkA = *(const u32x4*)(Ksrc + (size_t)(ja) * 4096 + toff); pvA = *(const u32x4*)(Vsrc + (size_t)(ja) * 4096 + toff); } \
                               if ((jb_) >= 0) { pkB = *(const u32x4*)(Ksrc + (size_t)(jb_) * 4096 + toff); pvB = *(const u32x4*)(Vsrc + (size_t)(jb_) * 4096 + toff); } } while (0)
#define ATT_PUT(setp, ja, jb_) do { if ((ja) >= 0) { *(LAS u32x4*)((setp) + loff) = pkA; *(LAS u32x4*)((setp) + 4608 + loff) = pvA; } \
                                    if ((jb_) >= 0) { *(LAS u32x4*)((setp) + 9216 + loff) = pkB; *(LAS u32x4*)((setp) + 13824 + loff) = pvB; } } while (0)
    ATT_TAKE(a0); ATT_TAKE(b0_);
    if (!pre) ATT_LOAD(a0, b0_);
    { LAS bf16_t* set0 = (LAS bf16_t*)(lds + ATT_SET0); ATT_PUT(set0, a0, b0_); }
    ATT_TAKE(a1); ATT_TAKE(b1);
    if (a1 >= 0) ATT_LOAD(a1, b1); else ATT_NEXT();
    LDS_BARRIER();
    int buf = 0;
#pragma unroll 1
    while (a0 >= 0) {
        LAS bf16_t* cur = (LAS bf16_t*)(lds + (buf ? ATT_SET1 : ATT_SET0)); LAS bf16_t* nxt = (LAS bf16_t*)(lds + (buf ? ATT_SET0 : ATT_SET1));
        int a2 = -1, b2 = -1;
        TS_B(10);
        if (a1 >= 0) { ATT_PUT(nxt, a1, b1); ATT_TAKE(a2); ATT_TAKE(b2); if (a2 >= 0) ATT_LOAD(a2, b2); else ATT_NEXT(); }
        TS_E(10); TS_B(11);
        u64 tsA = ~0ull, tsB = ~0ull;
        if (MODE == 0) { tsA = ((u64)(unsigned)__builtin_amdgcn_readlane((int)(tselv >> 32), a0) << 32) | (unsigned)__builtin_amdgcn_readlane((int)(unsigned)tselv, a0);
            if (b0_ >= 0) tsB = ((u64)(unsigned)__builtin_amdgcn_readlane((int)(tselv >> 32), b0_) << 32) | (unsigned)__builtin_amdgcn_readlane((int)(unsigned)tselv, b0_); }
        const bool useA = ((tsA >> (16 * th)) & 0xFFFFull) != 0ull, useB = b0_ >= 0 && ((tsB >> (16 * th)) & 0xFFFFull) != 0ull;
        const bool edgeA = (64 * a0 + 63 > t0) || (MODE == 1 && (t0 + 31 - 64 * a0 >= 512));
        const bool edgeB = b0_ >= 0 && ((64 * b0_ + 63 > t0) || (MODE == 1 && (t0 + 31 - 64 * b0_ >= 512)));
        if (useA && useB && !edgeA && !edgeB) {
            const bool rA = MODE == 1 || ((tsA >> (16 * th + (lane & 15))) & 1ull), rB = MODE == 1 || ((tsB >> (16 * th + (lane & 15))) & 1ull);
            if (__any((rA || rB) && mrow == -INFINITY)) attn_pair<MODE>(cur, cur + 9216, Pw, qa, bv0, a0, b0_, t0, th, slope2, tsA, tsB, O, mrow, L4, lane);
            else attn_pair_fast<MODE>(cur, cur + 9216, Pw, qa, bv0, a0, b0_, t0, th, slope2, tsA, tsB, O, mrow, L4, lane); }
        else {
            if (useA) { if (edgeA) attn_tile2<MODE, true>(cur, cur + 4608, Pw, qa, bv0, a0, t0, th, slope2, tsA, O, mrow, L4, lane); else attn_tile2<MODE, false>(cur, cur + 4608, Pw, qa, bv0, a0, t0, th, slope2, tsA, O, mrow, L4, lane); LDS_WAIT(); }
            if (useB) { if (edgeB) attn_tile2<MODE, true>(cur + 9216, cur + 13824, Pw, qa, bv0, b0_, t0, th, slope2, tsB, O, mrow, L4, lane); else attn_tile2<MODE, false>(cur + 9216, cur + 13824, Pw, qa, bv0, b0_, t0, th, slope2, tsB, O, mrow, L4, lane); }
        }
        TS_E(11); TS_B(12);
        LDS_BARRIER();
        TS_E(12);
        a0 = a1; b0_ = b1; a1 = a2; b1 = b2; buf ^= 1;
    }
#undef ATT_TAKE
#undef ATT_LOAD
#undef ATT_PUT
#undef ATT_NEXT
    { const float gt = GATEB[((size_t)b * SEQ + t0 + 16 * th + (lane & 15)) * 48 + h * 3 + 1 + MODE];
      const float lrow = L4[0]; const float gsc = gt / (lrow > 0.f ? lrow : 1.0f);
#pragma unroll
      for (int dt = 0; dt < 4; ++dt) outacc[dt] = outacc[dt] + O[dt] * gsc; }
}

template <int NT>
__device__ __forceinline__ void cmp_scores(const LAS bf16_t* BUF0, unsigned (&pw)[16][2], LAS float* impw, const bf16x8 (&qa)[2], int t, float slope2, int lane) {
    constexpr int TS = 72, PS = 264, IP = 66;
    const int cl = lane & 15, q4 = lane >> 4;
    const int cmaxl = (t >= 31) ? (((t - 31) >> 4) < 254 ? ((t - 31) >> 4) : 254) : -1;
    f32x4 bq; { const float b0 = slope2 * (float)(16 * (4 * q4) + 31 - t); bq = (f32x4){b0, b0 + 16.f * slope2, b0 + 32.f * slope2, b0 + 48.f * slope2}; }
    const float o256 = 256.f * slope2;
    f32x4 s[NT]; float cm = -INFINITY;
#pragma unroll
    for (int nt = 0; nt < NT; ++nt) { s[nt] = bq + (float)nt * o256;
#pragma unroll
        for (int ks = 0; ks < 2; ++ks) { const bf16x8 kb = *(const LAS bf16x8*)(BUF0 + (16 * nt + cl) * TS + 32 * ks + 8 * q4); s[nt] = __builtin_amdgcn_mfma_f32_16x16x32_bf16(kb, qa[ks], s[nt], 0, 0, 0); } }
#pragma unroll
    for (int nt = 0; nt < NT; ++nt) {
        if (nt >= NT - 5) {
#pragma unroll
            for (int j = 0; j < 4; ++j) { const bool ok = (16 * nt + 4 * q4 + j) <= cmaxl; s[nt][j] = ok ? s[nt][j] : -INFINITY; } }
        cm = fmaxf(cm, fmaxf(fmaxf(s[nt][0], s[nt][1]), fmaxf(s[nt][2], s[nt][3]))); }
    cm = fmaxf(cm, __shfl_xor(cm, 16)); cm = fmaxf(cm, __shfl_xor(cm, 32));
    cm = (cm == -INFINITY) ? 0.f : cm;
    float cs = 0.f;
#pragma unroll
    for (int nt = 0; nt < NT; ++nt)
#pragma unroll
        for (int j = 0; j < 4; ++j) { const float e = ex2(s[nt][j] - cm); s[nt][j] = e; cs += e; }
    cs += __shfl_xor(cs, 16); cs += __shfl_xor(cs, 32);
    const float cinv = 1.0f / (cs > 0.f ? cs : 1.0f);
    float rprev = 0.f;
#pragma unroll
    for (int nt = 0; nt < NT; ++nt) { float p[4];
#pragma unroll
        for (int j = 0; j < 4; ++j) p[j] = s[nt][j] * cinv;
        pw[nt][0] = pg8::cvt_pk_bf16(p[0], p[1]); pw[nt][1] = pg8::cvt_pk_bf16(p[2], p[3]);
        const float rot = __shfl(p[3], (lane + 48) & 63);
        impw[cl * IP + 4 * nt + q4] = ((p[0] + p[1]) + (p[2] + p[3])) + ((q4 == 0) ? rprev : rot);
        rprev = rot; }
}
template <int NK>
__device__ __forceinline__ void cmp_pv(const LAS bf16_t* BUF0, const unsigned (&pw)[16][2], f32x4 (&oc)[4], int lane) {
    constexpr int PS = 264; const int cl = lane & 15, q4 = lane >> 4;
#pragma unroll
    for (int ks = 0; ks < NK; ++ks) { const bf16x8 pa = __builtin_bit_cast(bf16x8, (u32x4){pw[2 * ks][0], pw[2 * ks][1], pw[2 * ks + 1][0], pw[2 * ks + 1][1]});
#pragma unroll
        for (int dt = 0; dt < 4; ++dt) { const bf16x8 vb = *(const LAS bf16x8*)(BUF0 + (16 * dt + cl) * PS + 32 * ks + 8 * q4); oc[dt] = __builtin_amdgcn_mfma_f32_16x16x32_bf16(vb, pa, oc[dt], 0, 0, 0); } }
}

__device__ __forceinline__ void attn_phase(LAS unsigned char* lds, const bf16_t* KV, const bf16_t* VT2, const bf16_t* QB, const float* GATEB, const bf16_t* KC, const bf16_t* VCT, bf16_t* OB, int wgc, int G) {
    const int tid = threadIdx.x, wave = __builtin_amdgcn_readfirstlane(tid >> 6), lane = tid & 63, cl = lane & 15, q4 = lane >> 4;
    constexpr int TS = 72, PS = 264, IP = 66;
    LAS bf16_t* KCs = (LAS bf16_t*)(lds + 0);
    LAS bf16_t* VCTs = (LAS bf16_t*)(lds + 36864);
    LAS bf16_t* Pw = (LAS bf16_t*)(lds + ATT_SET0);
    LAS float* IMP = (LAS float*)(lds + ATT_SET1);
    LAS u64* SEL = (LAS u64*)(lds + ATT_SET1 + 33792);
    const float LOG2E = 1.4426950408889634f;
#if TSEG
    unsigned long long tseg_acc = 0, tseg_t = 0;
#endif
    const int nj = G < 8 ? G : 8, nslot = G / nj, js0 = wgc % nj, slot = wgc / nj, cb = (128 - js0 + nj - 1) / nj;
    int bg_loaded = -1;
    u32x4 tpk[4]; bool tpre = false;
#pragma unroll
    for (int q = 0; q < 4; ++q) tpk[q] = (u32x4){0u, 0u, 0u, 0u};
    for (int it = 0; slot < nslot; ++it) {
        const int bg = slot + (it / cb) * nslot; if (bg >= 32) break;
        const int uu = js0 + (it % cb) * nj, i = uu >> 3, js = uu & 7;
        const int qt = 8 * i + ((i & 1) ? 7 - js : js);
        if (bg != bg_loaded) { bg_loaded = bg;
            __syncthreads();
#pragma unroll
            for (int k = 0; k < 4; ++k) { const int id = tid + 512 * k, row = id >> 3, cc = id & 7; *(LAS u32x4*)(KCs + row * TS + 8 * cc) = *(const u32x4*)(KC + ((size_t)bg * 256 + row) * 64 + 8 * cc); }
#pragma unroll
            for (int k = 0; k < 4; ++k) { const int id = tid + 512 * k, d = id >> 5, cc = id & 31; *(LAS u32x4*)(VCTs + d * PS + 8 * cc) = *(const u32x4*)(VCT + ((size_t)bg * 64 + d) * 256 + 8 * cc); }
            __syncthreads(); }
        const int b = bg >> 2, g = bg & 3, t0 = qt * 32;
        TS_B(1);
        const int r = wave >> 1, th = wave & 1, h = 4 * g + r;
        const float slope2 = exp2f(-0.5f * (float)(h + 1)) * LOG2E;
        LAS unsigned char* ql = lds + ATT_QL + wave * 2048;
#define ATT_QDMA(bg_, qt_) do { const bf16_t* qsrc = QB + ((size_t)((bg_) >> 2) * SEQ + (qt_) * 32 + 16 * th + (lane >> 3)) * 1024 + (4 * ((bg_) & 3) + r) * 64 + 8 * (lane & 7); \
            __builtin_amdgcn_global_load_lds((const unsigned*)qsrc, (LAS unsigned*)ql, 16, 0, 0); __builtin_amdgcn_global_load_lds((const unsigned*)(qsrc + 8 * 1024), (LAS unsigned*)(ql + 1024), 16, 0, 0); } while (0)
        if (it == 0) { ATT_QDMA(bg, qt); asm volatile("s_waitcnt vmcnt(0)" ::: "memory"); }
        asm volatile("" ::: "memory");
        bf16x8 qa[2];
        qa[0] = *(const LAS bf16x8*)(ql + cl * 128 + 16 * q4); qa[1] = *(const LAS bf16x8*)(ql + cl * 128 + 64 + 16 * q4);
        LDS_WAIT();
        { const int it1 = it + 1, bgn = slot + (it1 / cb) * nslot, uun = js0 + (it1 % cb) * nj, in_ = uun >> 3, jsn = uun & 7;
          if (bgn < 32) ATT_QDMA(bgn, 8 * in_ + ((in_ & 1) ? 7 - jsn : jsn)); }
#undef ATT_QDMA
        f32x4 outacc[4];
        TS_E(1); TS_B(2);
        const int ng = (t0 >> 10) + 1;
        unsigned cpw[16][2];
        {   LAS float* impw = IMP + wave * (16 * IP);
            const int t = t0 + 16 * th + cl;
            if (ng == 1) cmp_scores<4>(KCs, cpw, impw, qa, t, slope2, lane);
            else if (ng == 2) cmp_scores<8>(KCs, cpw, impw, qa, t, slope2, lane);
            else if (ng == 3) cmp_scores<12>(KCs, cpw, impw, qa, t, slope2, lane);
            else cmp_scores<16>(KCs, cpw, impw, qa, t, slope2, lane);
        }
        TS_E(2); TS_B(3);
        __syncthreads();
        TS_E(3); TS_B(4);
        {   u64 key[4], pre[4], dmsk[4]; int open = 0;
#pragma unroll
            for (int e = 0; e < 4; ++e) { const int tk = 4 * wave + e, tt = t0 + tk, cur = tt >> 6;
                float v = 0.f;
#pragma unroll
                for (int rr = 0; rr < 4; ++rr) v += IMP[((2 * rr + (tk >> 4)) * 16 + (tk & 15)) * IP + lane];
                const bool forced = (lane == 0) || (lane == cur) || (lane == cur - 1);
                v = fmaxf(v, 0.f); if (forced) v = 1e4f;
                const bool valid = lane <= cur;
                key[e] = valid ? (((u64)__builtin_bit_cast(unsigned, v) << 6) | (u64)(63 - lane)) + 1ull : 0ull;
                pre[e] = 0ull;
                const u64 nzm = __ballot(valid && v > 0.f), zm = __ballot(valid && !(v > 0.f));
                const int nz = __builtin_popcount((unsigned)nzm) + __builtin_popcount((unsigned)(nzm >> 32));
                const int zrank = __builtin_amdgcn_mbcnt_hi((unsigned)(zm >> 32), __builtin_amdgcn_mbcnt_lo((unsigned)zm, 0u));
                dmsk[e] = nzm | __ballot(valid && !(v > 0.f) && zrank < 16 - nz);
                if (nz > 16) open |= 1 << e; }
            const int searched = open;
#pragma unroll 1
            for (int bit = 36; bit >= 0 && open; --bit) { const u64 bm = 1ull << bit;
#pragma unroll
                for (int e = 0; e < 4; ++e) { const u64 cand = pre[e] | bm; const u64 bal = __ballot(key[e] >= cand);
                    const unsigned cnt = (unsigned)__builtin_popcount((unsigned)bal) + (unsigned)__builtin_popcount((unsigned)(bal >> 32));
                    pre[e] = (cnt >= 16u) ? cand : pre[e]; if (cnt == 16u) open &= ~(1 << e); } }
#pragma unroll
            for (int e = 0; e < 4; ++e) { const u64 smsk = __ballot(key[e] >= (pre[e] ? pre[e] : 1ull)); const u64 msk = ((searched >> e) & 1) ? smsk : dmsk[e]; if (lane == 0) SEL[4 * wave + e] = msk; }
        }
        TS_E(4); TS_B(6);
        {
            f32x4 oc[4];
#pragma unroll
            for (int dt = 0; dt < 4; ++dt) oc[dt] = (f32x4){0.f, 0.f, 0.f, 0.f};
            if (ng == 1) cmp_pv<2>(VCTs, cpw, oc, lane); else if (ng == 2) cmp_pv<4>(VCTs, cpw, oc, lane); else if (ng == 3) cmp_pv<6>(VCTs, cpw, oc, lane); else cmp_pv<8>(VCTs, cpw, oc, lane);
            const float gc = GATEB[((size_t)b * SEQ + t0 + 16 * th + cl) * 48 + h * 3];
#pragma unroll
            for (int dt = 0; dt < 4; ++dt) outacc[dt] = oc[dt] * gc;
        }
        TS_E(6); TS_B(5);
        __syncthreads();
        TS_E(5); TS_B(7);
        u64 tselv = 0ull;
#pragma unroll 8
        for (int tk = 0; tk < 32; ++tk) { const u64 sv = SEL[tk]; tselv |= ((sv >> lane) & 1ull) << tk; }
        const u64 uni = __ballot(tselv != 0ull);
        TS_E(7); TS_B(8);
        {
            const size_t PLANE_ = (size_t)8 * 4 * 4096 * 64;
            const int wj = (t0 + 31) >> 6, wlo = (t0 - 511) < 0 ? 0 : ((t0 - 511) >> 6);
            const bf16_t* wK = KV + 4 * PLANE_ + (size_t)bg * 4096 * 64; const bf16_t* wV = VT2 + ((size_t)32 + bg) * 4096 * 64;
            const int it1 = it + 1, bgn = slot + (it1 / cb) * nslot, uun = js0 + (it1 % cb) * nj, in_ = uun >> 3, jsn = uun & 7, qtn = 8 * in_ + ((in_ & 1) ? 7 - jsn : jsn);
            const bool hasn = bgn < 32; const int bgs = hasn ? bgn : 0, cn = hasn ? (qtn >> 1) : -1;
            const bf16_t* sK = KV + 2 * PLANE_ + (size_t)bgs * 4096 * 64; const bf16_t* sV = VT2 + (size_t)bgs * 4096 * 64;
#if TSEG
            attn_branch<0>(lds, Pw, KV, VT2, GATEB, qa, outacc, uni, tselv, b, bg, h, t0, th, slope2, tpk, false, wK, wV, wj, (wj - 1 >= wlo) ? wj - 1 : -1, tseg_acc);
            TS_E(8); TS_B(9);
            attn_branch<1>(lds, Pw, KV, VT2, GATEB, qa, outacc, uni, tselv, b, bg, h, t0, th, slope2, tpk, true, sK, sV, -1, -1, tseg_acc);
#else
            attn_branch<0>(lds, Pw, KV, VT2, GATEB, qa, outacc, uni, tselv, b, bg, h, t0, th, slope2, tpk, false, wK, wV, wj, (wj - 1 >= wlo) ? wj - 1 : -1);
            attn_branch<1>(lds, Pw, KV, VT2, GATEB, qa, outacc, uni, tselv, b, bg, h, t0, th, slope2, tpk, true, sK, sV, -1, -1);
#endif
            tpre = false; (void)cn; }
        TS_E(9);
        { bf16_t* op = OB + ((size_t)b * SEQ + t0 + 16 * th + cl) * 1024 + h * 64 + 4 * q4;
#pragma unroll
          for (int dt = 0; dt < 4; ++dt) { u32x2 w; w.x = pg8::cvt_pk_bf16(outacc[dt][0], outacc[dt][1]); w.y = pg8::cvt_pk_bf16(outacc[dt][2], outacc[dt][3]); *(u32x2*)(op + 16 * dt) = w; } }
    }
#if TSEG
    { const unsigned long long w0 = __builtin_amdgcn_s_memrealtime(); while (__builtin_amdgcn_s_memrealtime() - w0 < 2 * tseg_acc) __builtin_amdgcn_s_sleep(8); }
#endif
}

constexpr int NPHASE = 20;
__global__ void __launch_bounds__(NTHR, 2) yoco_fwd(Args args) {
    extern __shared__ __attribute__((aligned(16))) unsigned char lds_raw[];
    LAS unsigned char* lds = (LAS unsigned char*)lds_raw;
    volatile LAS unsigned* MISC = (volatile LAS unsigned*)(lds + MISC_OFF);
    const int tid = threadIdx.x, lane = tid & 63, wave = __builtin_amdgcn_readfirstlane(tid >> 6);
    const int G = gridDim.x, bx = blockIdx.x;
    const int vcu = (G % 8 == 0) ? (bx % 8) * (G / 8) + bx / 8 : bx;
    const int gw = vcu * NWAVES + wave, NGW = G * NWAVES;
    unsigned char* ws = args.ws;
    unsigned* ctl = (unsigned*)(ws + WS_CTL);
    if (tid < 64) MISC[tid] = 0u;
    __syncthreads();
    XcdBarrier bar; bar.bar = ctl + CW_BAR; bar.x = 0; bar.st = MISC + 60;
    if (!MK_PER_PHASE) bar = xcd_barrier_post(ctl + CW_BAR, MISC + 60);
    const int lo = args.ph_lo, hi = args.ph_hi;
#ifndef PHMASK
#define PHMASK 0xFFFFFFu
#endif
#ifndef PROBE_SKIP
#define PROBE_SKIP 0
#endif
constexpr unsigned PHSKIP = 0u;
#define IN(k) ((((PHMASK & ~PHSKIP) >> (k)) & 1u) && lo <= (k) && (k) < hi)
#ifndef P0REP
#define P0REP 0
#endif
#ifndef REPMASK
#define REPMASK 0x0u
#endif
#define PH(k) for (int _r = 0, _n = IN(k) ? ((((REPMASK) >> (k)) & 1u) ? 2 : 1) : 0; _r < _n; ++_r)
#ifndef PHT
#define PHT -1
#endif
#if PHT >= 0
    unsigned long long pht_t = __builtin_amdgcn_s_memrealtime();
#define SEAM(k) do { if (PHT == (k)) { const unsigned long long d_ = __builtin_amdgcn_s_memrealtime() - pht_t, w0_ = __builtin_amdgcn_s_memrealtime(); while (__builtin_amdgcn_s_memrealtime() - w0_ < d_) __builtin_amdgcn_s_sleep(8); } \
        if (lo <= (k) && (k) + 1 < hi) xcd_barrier(bar); pht_t = __builtin_amdgcn_s_memrealtime(); } while (0)
#else
#define SEAM(k) do { if (lo <= (k) && (k) + 1 < hi) xcd_barrier(bar); } while (0)
#endif

    const float* x = A_IN(I_X);
    float* xs = args.out;
    bf16_t* XH = (bf16_t*)(ws + WS_XH);
    float* GA = (float*)(ws + WS_GA);
    float* bias1 = (float*)(ws + WS_SMALL);
    unsigned* EIDX = (unsigned*)(ws + WS_SMALL + 8192);
    float* EW = (float*)(ws + WS_SMALL + 8192 + 131072);
    u32x2* ROWINFO = (u32x2*)(ws + WS_ROWINFO);

    PH(0) {
        for (int _q = 0; _q < ((P0REP & 1) ? 2 : 1); ++_q) p0_weights(ws, lds, gw, NGW, wave, lane, G != 256);
        __syncthreads();
        LAS float* Wg = (LAS float*)lds;
        for (int i = tid; i < 8192; i += NTHR) { const int k = i >> 3, e = i & 7; Wg[(e >> 2) * 4096 + ((((k >> 8) * 4 + (k & 3)) * 64 + ((k & 255) >> 2)) << 2) + (e & 3)] = A_IN(I_A_W_IN)[(size_t)k * NPROJ_SRC + 4096 + e] * A_IN(I_NORM_MIX)[k]; }
        __syncthreads();
        for (int _q = 0; _q < ((P0REP & 2) ? 2 : 1); ++_q) {
        f32x4 vn[4]; if (gw < M) load_row(x + (size_t)gw * D, lane, vn);
        for (int m = gw; m < M; m += NGW) {
            f32x4 v[4];
#pragma unroll
            for (int j = 0; j < 4; ++j) v[j] = vn[j];
            load_row(x + (size_t)(m + NGW < M ? m + NGW : m) * D, lane, vn);
            const float rstd = row_rstd(v);
            store_row_bf16(XH + (size_t)m * D, lane, v, rstd);
            if (lane == 0) ((float*)(ws + WS_RS))[m] = rstd;
            float gsum[8];
#pragma unroll
            for (int e = 0; e < 8; ++e) gsum[e] = 0.f;
#pragma unroll
            for (int j = 0; j < 4; ++j)
#pragma unroll
                for (int c = 0; c < 4; ++c) { const f32x4 w0 = *(const LAS f32x4*)(Wg + (((j * 4 + c) * 64 + lane) << 2)), w1 = *(const LAS f32x4*)(Wg + 4096 + (((j * 4 + c) * 64 + lane) << 2)); const float xv = v[j][c];
                    gsum[0] += xv * w0.x; gsum[1] += xv * w0.y; gsum[2] += xv * w0.z; gsum[3] += xv * w0.w; gsum[4] += xv * w1.x; gsum[5] += xv * w1.y; gsum[6] += xv * w1.z; gsum[7] += xv * w1.w; }
#pragma unroll
            for (int e = 0; e < 8; ++e) gsum[e] = wave_sum(gsum[e]) * rstd + A_IN(I_A_B_GATE)[e];
            if (lane == 0) {
#pragma unroll
                for (int e = 0; e < 4; ++e) GA[(size_t)m * 8 + e] = gsum[e];
#pragma unroll
                for (int e = 4; e < 8; ++e) { const float g = gsum[e]; GA[(size_t)m * 8 + e] = fminf(g, 0.f) - log1pf(__expf(-fabsf(g))); } }
        }
        }
        __syncthreads();
        for (int it = bx; it < 256; it += G) { const int c = it >> 7, nb = (it >> 4) & 7, fc = it & 15, n = nb * 32 + (tid & 31), fs = tid >> 5; float s = 0.f;
#pragma unroll
            for (int k = 0; k < 8; ++k) { const int f = fc * 128 + fs * 8 + k; s += A_IN(I_B_CMP_POS)[((f >> 6) * 2 + c) * 64 + (f & 63)] * A_IN(I_B_CMP_W1)[((size_t)c * 2048 + f) * 256 + n]; }
            LAS float* red = (LAS float*)lds; __syncthreads(); red[tid] = s; __syncthreads();
            if (tid < 32) { float t = 0.f; for (int k = 0; k < 16; ++k) t += red[k * 32 + tid]; ((float*)(ws + WS_SMALL + 401408))[(c * 256 + n) * 16 + fc] = t; }
            __syncthreads(); }
    }
    SEAM(0);
    PH(1) { if (bx == 0) { const float* bp = (const float*)(ws + WS_SMALL + 401408) + tid * 16; float t = 0.f; for (int k = 0; k < 16; ++k) t += bp[k]; bias1[tid] = t; }
        pg8::PlainOrder S; S.init(XH, (const bf16_t*)(ws + WS_WIN), M, NPROJ, D, D, G, bx); pg8::EpiProjSplit E{(bf16_t*)(ws + WS_PROJ3), (bf16_t*)(ws + WS_OG)};
        pg8::gemm_phase(lds, pg8::Dims{D, D, D}, S, E); }
    SEAM(1);
    PH(2) scanprep_phase(lds, (const bf16_t*)(ws + WS_PROJ3), GA, A_IN(I_A_CONV), ws + WS_IMG, vcu, G);
    SEAM(2);
    PH(3) scan_phase(lds, ws + WS_IMG, (float*)(ws + WS_HS), (float*)(ws + WS_DN), vcu, G, ws);
    SEAM(3);
    PH(4) {
        const float* HS = (const float*)(ws + WS_HS); const float* DN = (const float*)(ws + WS_DN); const bf16_t* OG = (const bf16_t*)(ws + WS_OG); bf16_t* HN = (bf16_t*)(ws + WS_HN);
        f32x4 vn[4], dnn; u32x2 ogn[4];
#define P4_LOAD(mm) do { _Pragma("unroll") for (int j = 0; j < 4; ++j) { const u32x2 hr = *(const u32x2*)((const bf16_t*)HS + (size_t)(mm) * D + 4 * lane + 256 * j); vn[j] = (f32x4){bflo(hr.x), bfhi(hr.x), bflo(hr.y), bfhi(hr.y)}; } \
            dnn = *(const f32x4*)(DN + (size_t)(mm) * 4); \
            _Pragma("unroll") for (int j = 0; j < 4; ++j) ogn[j] = *(const u32x2*)(OG + (size_t)(mm) * D + 4 * lane + 256 * j); } while (0)
        P4_LOAD(gw < M ? gw : 0);
        f32x4 gvv[4];
#pragma unroll
        for (int j = 0; j < 4; ++j) gvv[j] = *((const f32x4*)A_IN(I_A_NORM_H) + lane + 64 * j);
        for (int m = gw; m < M; m += NGW) { f32x4 v[4]; u32x2 og[4]; const f32x4 dn = dnn;
#pragma unroll
            for (int j = 0; j < 4; ++j) { v[j] = vn[j]; og[j] = ogn[j]; }
            P4_LOAD(m + NGW < M ? m + NGW : m);
            u64* o8 = (u64*)(HN + (size_t)m * D) + lane;
#pragma unroll
            for (int j = 0; j < 4; ++j) { v[j] = v[j] * (1.0f / dn[j]); float s = (v[j].x * v[j].x + v[j].y * v[j].y) + (v[j].z * v[j].z + v[j].w * v[j].w); s = wave_sum(s);
                const float rs = 1.0f / sqrtf(s * (1.f / 256.f) + EPS);
                const u32x2 oraw = og[j]; const f32x4 gv = gvv[j];
                const float o0 = v[j].x * rs * gv.x * sigmoidf_(bflo(oraw.x)), o1 = v[j].y * rs * gv.y * sigmoidf_(bfhi(oraw.x)), o2 = v[j].z * rs * gv.z * sigmoidf_(bflo(oraw.y)), o3 = v[j].w * rs * gv.w * sigmoidf_(bfhi(oraw.y));
                o8[64 * j] = (u64)pk2(o0, o1) | ((u64)pk2(o2, o3) << 32); } }
#undef P4_LOAD
    }
    SEAM(4);
    PH(5) { pg8::PlainOrder S; S.init((const bf16_t*)(ws + WS_HN), (const bf16_t*)(ws + WS_WOUTA), M, D, D, D, G, bx); pg8::EpiRes16<true, true> E{nullptr, XH, (float*)(ws + WS_SSP), D, (const float*)(ws + WS_RS)};
        pg8::gemm_phase(lds, pg8::Dims{D, D, D}, S, E); }
    SEAM(5);
    PH(6) { const float* sp = (const float*)(ws + WS_SSP); float* rs = (float*)(ws + WS_RS);
        for (int m = gw; m < M; m += NGW) { const float rsm = pg8::row_rs16(sp, m); if (lane == 0) rs[m] = rsm;
            const u32x4 a0 = ((const u32x4*)(XH + (size_t)m * D))[2 * lane], a1 = ((const u32x4*)(XH + (size_t)m * D))[2 * lane + 1]; const float sc = rsm * 16.f; u32x4 o;
            o.x = pk_fp8x4(bflo(a0.x) * sc, bfhi(a0.x) * sc, bflo(a0.y) * sc, bfhi(a0.y) * sc); o.y = pk_fp8x4(bflo(a0.z) * sc, bfhi(a0.z) * sc, bflo(a0.w) * sc, bfhi(a0.w) * sc);
            o.z = pk_fp8x4(bflo(a1.x) * sc, bfhi(a1.x) * sc, bflo(a1.y) * sc, bfhi(a1.y) * sc); o.w = pk_fp8x4(bflo(a1.z) * sc, bfhi(a1.z) * sc, bflo(a1.w) * sc, bfhi(a1.w) * sc);
            ((u32x4*)(ws + WS_XH8 + (size_t)m * D))[lane] = o; } }
    SEAM(6);
    PH(7) { pg8::PlainOrder S; S.init((const bf16_t*)(ws + WS_XH8), (const bf16_t*)(ws + WS_WGU), M, 2 * FFD, D / 2, D / 2, G, bx); pg8::EpiSwiGLU8 E{ws + WS_ACT, FFD, 8.f, nullptr};
        pg8::gemm_phase<pg8::EpiSwiGLU8, pg8::PlainOrder, true, true, true>(lds, pg8::Dims{D / 2, D / 2, D / 2, 127 - 4, 127 - 7}, S, E);
    }
    SEAM(7);
    PH(8) { pg8::PlainOrder S; S.init((const bf16_t*)(ws + WS_ACT), (const bf16_t*)(ws + WS_WDOWN), M, D, FFD / 2, FFD / 2, G, bx); pg8::EpiRes16<true, true> E{nullptr, XH, (float*)(ws + WS_SSP), D};
        pg8::gemm_phase<pg8::EpiRes16<true, true>, pg8::PlainOrder, true, true, true>(lds, pg8::Dims{FFD / 2, FFD / 2, FFD / 2, 127 - 3, 127 - 8}, S, E); }
    SEAM(8);
    PH(9) { const float* sp = (const float*)(ws + WS_SSP); float* rs = (float*)(ws + WS_RS);
        for (int r = bx * NTHR + tid; r < M; r += G * NTHR) rs[r] = pg8::row_rs16(sp, r);
        for (int tsk = gw; tsk < M / 16; tsk += NGW) { const int r0 = 16 * tsk, cl = lane & 15, q4 = lane >> 4;
            const bf16_t* ap = XH + (size_t)(r0 + cl) * D + 8 * q4; const bf16_t* bp = (const bf16_t*)(ws + WS_WKVQ) + (size_t)(2560 + cl) * D + 8 * q4;
            f32x4 acc[3];
#pragma unroll
            for (int nt = 0; nt < 3; ++nt) acc[nt] = (f32x4){0.f, 0.f, 0.f, 0.f};
#pragma unroll 8
            for (int ks = 0; ks < 32; ++ks) { const bf16x8 a = *(const bf16x8*)(ap + 32 * ks);
#pragma unroll
                for (int nt = 0; nt < 3; ++nt) { const bf16x8 b = *(const bf16x8*)(bp + (size_t)nt * 16 * D + 32 * ks); acc[nt] = __builtin_amdgcn_mfma_f32_16x16x32_bf16(a, b, acc[nt], 0, 0, 0); } }
            float* gout = (float*)(ws + WS_GATEB);
#pragma unroll
            for (int j = 0; j < 4; ++j) { const int row = r0 + 4 * q4 + j; const float rsr = pg8::row_rs16(sp, row);
#pragma unroll
                for (int nt = 0; nt < 3; ++nt) gout[(size_t)row * 48 + 16 * nt + cl] = sigmoidf_(acc[nt][j] * rsr + A_IN(I_B_B_GATE)[16 * nt + cl]); } }
    }
    SEAM(9);
    PH(10) { pg8::PlainOrder S; S.init(XH, (const bf16_t*)(ws + WS_WKVQ), M, 2560, D, D, G, bx); pg8::EpiKVQ E{(bf16_t*)(ws + WS_KV), (bf16_t*)(ws + WS_QB), (float*)(ws + WS_GATEB), A_IN(I_B_B_GATE), (const float*)(ws + WS_RS)};
        pg8::gemm_phase(lds, pg8::Dims{D, D, D}, S, E); }
    SEAM(10);
    PH(11) {
        struct CmpOrder { int G, c; const char* A; const char* B;
            __device__ __forceinline__ bool next(int i, pg8::Unit& u) const { const int L = i * G + c; if (L >= 128) return false; u.pm = L >> 1; u.pn = L & 1;
                u.a = A + (size_t)u.pm * 256 * 1024 * 2 + (size_t)u.pn * 1024 * 2; u.b = B + (size_t)(u.pm >> 5) * 256 * 2048 * 2 + (size_t)u.pn * 1024 * 2; return true; } };
        const int NG = (G >= 256) ? 128 : G;
        CmpOrder S{NG, bx, (const char*)(ws + WS_KV), (const char*)(ws + WS_WCMP1)}; pg8::EpiF32Part E{(float*)(ws + WS_HIDP), 16384};
        if (bx < NG) pg8::gemm_phase(lds, pg8::Dims{1024, 1024, 2048}, S, E);
        if (bx >= NG || G < 256) {
        { LAS bf16_t* T = (LAS bf16_t*)lds; const size_t PLANE = (size_t)8 * 4 * 4096 * 64;
          const int row = tid >> 3, cc = tid & 7;
          const int prow = (row & 32) | (((row >> 2) & 3) << 3) | (((row >> 4) & 1) << 2) | (row & 3);
          for (int it4 = (G < 256) ? bx : bx - NG; it4 < 1024; it4 += (G < 256) ? G : G - NG) { u32x4 raw[4];
#pragma unroll
              for (int q = 0; q < 4; ++q) { const int it = 4 * it4 + q, mode = it >> 11, rest = it & 2047;
                  raw[q] = *(const u32x4*)((const bf16_t*)(ws + WS_KV) + (size_t)(mode == 0 ? 3 : 5) * PLANE + (size_t)rest * 4096 + (size_t)tid * 8); }
              __syncthreads();
#pragma unroll
              for (int q = 0; q < 4; ++q) { LAS bf16_t* Tq = T + q * 4608;
                  Tq[(8 * cc + 0) * 72 + prow] = (bf16_t)(raw[q].x & 0xffff); Tq[(8 * cc + 1) * 72 + prow] = (bf16_t)(raw[q].x >> 16); Tq[(8 * cc + 2) * 72 + prow] = (bf16_t)(raw[q].y & 0xffff); Tq[(8 * cc + 3) * 72 + prow] = (bf16_t)(raw[q].y >> 16);
                  Tq[(8 * cc + 4) * 72 + prow] = (bf16_t)(raw[q].z & 0xffff); Tq[(8 * cc + 5) * 72 + prow] = (bf16_t)(raw[q].z >> 16); Tq[(8 * cc + 6) * 72 + prow] = (bf16_t)(raw[q].w & 0xffff); Tq[(8 * cc + 7) * 72 + prow] = (bf16_t)(raw[q].w >> 16); }
              __syncthreads();
#pragma unroll
              for (int q = 0; q < 4; ++q) { const int it = 4 * it4 + q; *(u32x4*)((bf16_t*)(ws + WS_VT2) + (size_t)it * 4096 + (size_t)tid * 8) = *(const LAS u32x4*)(T + q * 4608 + row * 72 + 8 * cc); } } }
        } }
    SEAM(11);
    PH(12) { const float* HP = (const float*)(ws + WS_HIDP); const bf16_t* W2T = (const bf16_t*)(ws + WS_W2T);
        if (gw < 1024) { const int c = gw >> 9, r0 = 16 * (gw & 511); const int cl = lane & 15, q4 = lane >> 4;
            f32x4 acc[1][4];
#pragma unroll
            for (int rt = 0; rt < 1; ++rt)
#pragma unroll
                for (int dt = 0; dt < 4; ++dt) acc[rt][dt] = (f32x4){0.f, 0.f, 0.f, 0.f};
            const float* hp = HP + ((size_t)c * 8192 + r0 + cl) * 256 + 8 * q4; const bf16_t* wp = W2T + ((size_t)c * 64 + cl) * 256 + 8 * q4; const float* bp = bias1 + c * 256 + 8 * q4;
#pragma unroll 4
            for (int ks = 0; ks < 8; ++ks) { bf16x8 a[1], w[4];
#pragma unroll
                for (int rt = 0; rt < 1; ++rt) { const float* h0 = hp + (size_t)rt * 16 * 256 + 32 * ks; const float* h1 = h0 + (size_t)16384 * 256;
                    const f32x4 x0 = *(const f32x4*)h0 + *(const f32x4*)h1 + *(const f32x4*)(bp + 32 * ks), x1 = *(const f32x4*)(h0 + 4) + *(const f32x4*)(h1 + 4) + *(const f32x4*)(bp + 32 * ks + 4);
                    a[rt] = __builtin_bit_cast(bf16x8, (u32x4){pg8::cvt_pk_bf16(siluf_(x0[0]), siluf_(x0[1])), pg8::cvt_pk_bf16(siluf_(x0[2]), siluf_(x0[3])), pg8::cvt_pk_bf16(siluf_(x1[0]), siluf_(x1[1])), pg8::cvt_pk_bf16(siluf_(x1[2]), siluf_(x1[3]))}); }
#pragma unroll
                for (int dt = 0; dt < 4; ++dt) w[dt] = *(const bf16x8*)(wp + (size_t)dt * 16 * 256 + 32 * ks);
#pragma unroll
                for (int rt = 0; rt < 1; ++rt)
#pragma unroll
                    for (int dt = 0; dt < 4; ++dt) acc[rt][dt] = (c == 0) ? __builtin_amdgcn_mfma_f32_16x16x32_bf16(w[dt], a[rt], acc[rt][dt], 0, 0, 0) : __builtin_amdgcn_mfma_f32_16x16x32_bf16(a[rt], w[dt], acc[rt][dt], 0, 0, 0); }
#pragma unroll
            for (int rt = 0; rt < 1; ++rt)
#pragma unroll
                for (int dt = 0; dt < 4; ++dt) { u32x2 p; p.x = pk2(acc[rt][dt][0], acc[rt][dt][1]); p.y = pk2(acc[rt][dt][2], acc[rt][dt][3]);
                    if (c == 0) *(u32x2*)((bf16_t*)(ws + WS_KC) + (size_t)(r0 + 16 * rt + cl) * 64 + 16 * dt + 4 * q4) = p;
                    else { const int R = r0 + 16 * rt + 4 * q4, cidx = R & 255, pc = (cidx & ~31) | (((cidx >> 2) & 3) << 3) | (((cidx >> 4) & 1) << 2);
                        *(u32x2*)((bf16_t*)(ws + WS_VC) + ((size_t)(R >> 8) * 64 + 16 * dt + cl) * 256 + pc) = p; } }
        }
    }
    SEAM(12);
    PH(13) attn_phase(lds, (const bf16_t*)(ws + WS_KV), (const bf16_t*)(ws + WS_VT2), (const bf16_t*)(ws + WS_QB), (const float*)(ws + WS_GATEB), (const bf16_t*)(ws + WS_KC), (const bf16_t*)(ws + WS_VC), (bf16_t*)(ws + WS_OB), vcu, G);
    SEAM(13);
    PH(14) { pg8::PlainOrder S; S.init((const bf16_t*)(ws + WS_OB), (const bf16_t*)(ws + WS_WOUTB), M, D, D, D, G, bx); pg8::EpiRes16<true, false> E{nullptr, XH, nullptr, D};
        pg8::gemm_phase(lds, pg8::Dims{D, D, D}, S, E); }
    SEAM(14);
    PH(15) {
        LAS float* Wr = (LAS float*)lds;
        for (int i = tid; i < 8192; i += NTHR) { const int k = i >> 3, e = i & 7; Wr[(e >> 2) * 4096 + ((((k >> 8) * 4 + (k & 3)) * 64 + ((k & 255) >> 2)) << 2) + (e & 3)] = A_IN(I_M_ROUTER)[i] * A_IN(I_NORM_FFN)[1024 + k]; }
        __syncthreads();
        u32x2 rn[4];
#pragma unroll
        for (int j = 0; j < 4; ++j) rn[j] = *(const u32x2*)(XH + (size_t)(gw < M ? gw : 0) * D + 4 * lane + 256 * j);
        for (int m = gw; m < M; m += NGW) {
            f32x4 v[4];
#pragma unroll
            for (int j = 0; j < 4; ++j) v[j] = (f32x4){bflo(rn[j].x), bfhi(rn[j].x), bflo(rn[j].y), bfhi(rn[j].y)};
#pragma unroll
            for (int j = 0; j < 4; ++j) rn[j] = *(const u32x2*)(XH + (size_t)(m + NGW < M ? m + NGW : m) * D + 4 * lane + 256 * j);
            const float rstd = row_rstd(v);
            if (lane == 0) ((float*)(ws + WS_RS))[m] = rstd;
            float gsum[8];
#pragma unroll
            for (int e = 0; e < 8; ++e) gsum[e] = 0.f;
#pragma unroll
            for (int j = 0; j < 4; ++j)
#pragma unroll
                for (int c = 0; c < 4; ++c) { const f32x4 w0 = *(const LAS f32x4*)(Wr + (((j * 4 + c) * 64 + lane) << 2)), w1 = *(const LAS f32x4*)(Wr + 4096 + (((j * 4 + c) * 64 + lane) << 2)); const float xv = v[j][c];
                    gsum[0] += xv * w0.x; gsum[1] += xv * w0.y; gsum[2] += xv * w0.z; gsum[3] += xv * w0.w; gsum[4] += xv * w1.x; gsum[5] += xv * w1.y; gsum[6] += xv * w1.z; gsum[7] += xv * w1.w; }
#pragma unroll
            for (int e = 0; e < 8; ++e) gsum[e] = wave_sum(gsum[e]) * rstd;
            if (lane == 0) { int e1 = 0; float v1 = gsum[0];
#pragma unroll
                for (int e = 1; e < 8; ++e) if (gsum[e] > v1) { v1 = gsum[e]; e1 = e; }
                int e2 = -1; float v2 = -INFINITY;
#pragma unroll
                for (int e = 0; e < 8; ++e) if (e != e1 && gsum[e] > v2) { v2 = gsum[e]; e2 = e; }
                const float ex = __expf(v2 - v1), w1 = 1.0f / (1.0f + ex), w2 = ex * w1;
                EIDX[m] = (unsigned)e1 | ((unsigned)e2 << 8); EW[2 * (size_t)m] = w1; EW[2 * (size_t)m + 1] = w2;
 }
        }
    }
    SEAM(15);
    volatile LAS int* tb = (volatile LAS int*)(lds + MISC_OFF);
    PH(16) {
        LAS int* cnt_all = (LAS int*)lds;
        LAS int* posl = (LAS int*)(lds + 256);
        bf16_t* XG = (bf16_t*)(ws + WS_XG);
        for (int ch = bx; ch < M / 128; ch += G) {
            __syncthreads();
            if (tid < 16) cnt_all[tid] = 0;
            __syncthreads();
            int ct[8], cb[8];
#pragma unroll
            for (int e = 0; e < 8; ++e) { ct[e] = 0; cb[e] = 0; }
            {
                const u32x4* ep = (const u32x4*)(EIDX + 64 * tid); u64 packed = 0ull;
#pragma unroll
                for (int k = 0; k < 16; ++k) { const u32x4 q = ep[k];
                    packed += (1ull << (8 * (q.x & 255u))) + (1ull << (8 * ((q.x >> 8) & 255u))) + (1ull << (8 * (q.y & 255u))) + (1ull << (8 * ((q.y >> 8) & 255u)))
                            + (1ull << (8 * (q.z & 255u))) + (1ull << (8 * ((q.z >> 8) & 255u))) + (1ull << (8 * (q.w & 255u))) + (1ull << (8 * ((q.w >> 8) & 255u))); }
                const bool before = tid < 2 * ch;
#pragma unroll
                for (int e = 0; e < 8; ++e) { const int hit = (int)((packed >> (8 * e)) & 255ull); ct[e] = hit; cb[e] = before ? hit : 0; } }
#pragma unroll
            for (int e = 0; e < 8; ++e) { int a = ct[e], b2 = cb[e];
#pragma unroll
                for (int o = 1; o < 64; o <<= 1) { a += __shfl_xor(a, o); b2 += __shfl_xor(b2, o); }
                if (lane == 0) { atomicAdd((int*)&cnt_all[e], a); atomicAdd((int*)&cnt_all[8 + e], b2); } }
            __syncthreads();
            if (wave == 0) {
                int base[8]; int run = 0;
#pragma unroll
                for (int e = 0; e < 8; ++e) { base[e] = run * 256 + cnt_all[8 + e]; run += (cnt_all[e] + 255) >> 8; }
#pragma unroll 1
                for (int half = 0; half < 2; ++half) { const int m = ch * 128 + half * 64 + lane; const unsigned ei = EIDX[m]; const int e1 = ei & 255, e2 = (ei >> 8) & 255;
                    int p1 = 0, p2 = 0;
#pragma unroll
                    for (int e = 0; e < 8; ++e) { const u64 mk = __ballot(e1 == e || e2 == e); const int rk = __popcll(mk & ((1ull << lane) - 1ull));
                        if (e1 == e) p1 = base[e] + rk; if (e2 == e) p2 = base[e] + rk; base[e] += __popcll(mk); }
                    posl[(half * 64 + lane) * 2] = p1; posl[(half * 64 + lane) * 2 + 1] = p2;
                    ROWINFO[p1] = (u32x2){(unsigned)m << 1, __builtin_bit_cast(unsigned, EW[2 * (size_t)m])};
                    ROWINFO[p2] = (u32x2){((unsigned)m << 1) | 1u, __builtin_bit_cast(unsigned, EW[2 * (size_t)m + 1])}; }
                if (ch == 0 && lane < 8) ((int*)(ws + WS_SMALL + 4096))[lane] = cnt_all[lane];
            }
            __syncthreads();
#pragma unroll 1
            for (int r0 = 4 * wave; r0 < 256; r0 += 4 * NWAVES) { u32x4 a0[4], a1[4]; float s16[4]; int pp[4];
#pragma unroll
                for (int q = 0; q < 4; ++q) { const int rr = r0 + q, m = ch * 128 + (rr >> 1); pp[q] = posl[rr]; s16[q] = ((const float*)(ws + WS_RS))[m] * 16.f;
                    a0[q] = ((const u32x4*)(XH + (size_t)m * D))[2 * lane]; a1[q] = ((const u32x4*)(XH + (size_t)m * D))[2 * lane + 1]; }
#pragma unroll
                for (int q = 0; q < 4; ++q) { const float sc = s16[q]; u32x4 o;
                    o.x = pk_fp8x4(bflo(a0[q].x) * sc, bfhi(a0[q].x) * sc, bflo(a0[q].y) * sc, bfhi(a0[q].y) * sc); o.y = pk_fp8x4(bflo(a0[q].z) * sc, bfhi(a0[q].z) * sc, bflo(a0[q].w) * sc, bfhi(a0[q].w) * sc);
                    o.z = pk_fp8x4(bflo(a1[q].x) * sc, bfhi(a1[q].x) * sc, bflo(a1[q].y) * sc, bfhi(a1[q].y) * sc); o.w = pk_fp8x4(bflo(a1[q].z) * sc, bfhi(a1[q].z) * sc, bflo(a1[q].w) * sc, bfhi(a1[q].w) * sc);
                    ((u32x4*)((unsigned char*)XG + (size_t)pp[q] * D))[lane] = o; } }
        }
    }
    SEAM(16);
    if (IN(17) || IN(18)) {
        __syncthreads();
        if (tid == 0) { const int* cg = (const int*)(ws + WS_SMALL + 4096); int run = 0;
            for (int e = 0; e < 8; ++e) { const int c = cg[e]; tb[e] = run; tb[16 + e] = c; run += (c + 255) >> 8; } tb[8] = run; }
        __syncthreads();
    }
    PH(17) { MoeOrder S{2 * FE / 256, G, bx, (const char*)(ws + WS_XG), (const char*)(ws + WS_MGU), (size_t)256 * D, (size_t)2 * FE * D, (size_t)256 * D, tb};
        pg8::EpiSwiGLU8 E{ws + WS_ACTS, FE, 8.f}; pg8::gemm_phase<pg8::EpiSwiGLU8, MoeOrder, true, true, true>(lds, pg8::Dims{D / 2, D / 2, D / 2, 127 - 4, 127 - 7}, S, E); }
    SEAM(17);
    PH(18) { MoeOrder S{D / 256, G, bx, (const char*)(ws + WS_ACTS), (const char*)(ws + WS_MDOWN), (size_t)256 * FE, (size_t)D * FE, (size_t)256 * FE, tb};
        EpiMoeDown E{(bf16_t*)(ws + WS_Y1), ROWINFO, EW, tb}; pg8::gemm_phase<EpiMoeDown, MoeOrder, true, true, true>(lds, pg8::Dims{FE / 2, FE / 2, FE / 2, 127 - 3, 127 - 8}, S, E); }
    SEAM(18);
    PH(19) { const bf16_t* Yb = (const bf16_t*)(ws + WS_Y1); const unsigned bad = xb_ld(ctl + CW_BAR + XB_TMO);
#if TPROBE
        const float* tkp = (const float*)(ws + WS_END2 + 2 * MiB); const float pfac = 1.0f + 0.25f * (tkp[TPROBE - 1] / tkp[2]);
#else
        const float pfac = 1.0f;
#endif
        u32x2 xn[4], y0n[4], y1n[4]; f32x4 gfin[4];
#define P19_LOAD(mm) do { _Pragma("unroll") for (int j = 0; j < 4; ++j) { xn[j] = *(const u32x2*)(XH + (size_t)(mm) * D + 4 * lane + 256 * j); \
            y0n[j] = *(const u32x2*)(Yb + (size_t)(mm) * D + 4 * lane + 256 * j); y1n[j] = *(const u32x2*)(Yb + ((size_t)M + (mm)) * D + 4 * lane + 256 * j); } } while (0)
        P19_LOAD(gw < M ? gw : 0);
#pragma unroll
        for (int j = 0; j < 4; ++j) gfin[j] = *((const f32x4*)A_IN(I_NORM_FINAL) + lane + 64 * j);
        for (int m = gw; m < M; m += NGW) { f32x4 v[4]; u32x2 y0[4], y1[4];
#pragma unroll
            for (int j = 0; j < 4; ++j) { v[j] = (f32x4){bflo(xn[j].x), bfhi(xn[j].x), bflo(xn[j].y), bfhi(xn[j].y)}; y0[j] = y0n[j]; y1[j] = y1n[j]; }
            P19_LOAD(m + NGW < M ? m + NGW : m);
#pragma unroll
            for (int j = 0; j < 4; ++j) v[j] = v[j] + ((f32x4){bflo(y0[j].x), bfhi(y0[j].x), bflo(y0[j].y), bfhi(y0[j].y)} + (f32x4){bflo(y1[j].x), bfhi(y1[j].x), bflo(y1[j].y), bfhi(y1[j].y)});
            const float rstd = bad ? __builtin_nanf("") : row_rstd(v); f32x4* o = (f32x4*)(xs + (size_t)m * D) + lane;
#pragma unroll
            for (int j = 0; j < 4; ++j) o[64 * j] = v[j] * (rstd * pfac) * gfin[j]; }
#undef P19_LOAD
    }
#undef IN
#undef SEAM
}

extern "C" void kernel_launch(void* const* d_in, const int* in_sizes, int n_in, void* d_out, int out_size, void* d_ws, size_t ws_size, hipStream_t stream) {
    static int grid = 0;
    if (grid == 0) {
        if (n_in != 22 || out_size != M * D || ws_size < WS_END2) { fprintf(stderr, "kernel_launch: unexpected shapes (n_in %d, out %d, ws %zu < %zu)\n", n_in, out_size, ws_size, (size_t)WS_END); grid = -1; return; }
        int dev = 0, cus = 0, per_cu = 0;
        if (hipGetDevice(&dev) != hipSuccess || hipDeviceGetAttribute(&cus, hipDeviceAttributeMultiprocessorCount, dev) != hipSuccess) { grid = -1; return; }
        if (hipFuncSetAttribute((const void*)yoco_fwd, hipFuncAttributeMaxDynamicSharedMemorySize, LDS_BYTES) != hipSuccess) { fprintf(stderr, "kernel_launch: hipFuncSetAttribute failed\n"); grid = -1; return; }
        if (hipOccupancyMaxActiveBlocksPerMultiprocessor(&per_cu, (const void*)yoco_fwd, NTHR, LDS_BYTES) != hipSuccess || per_cu < 1) fprintf(stderr, "kernel_launch: occupancy query says %d\n", per_cu);
        (void)hipGetLastError();
        grid = cus;
    }
    if (grid < 0) return;
    (void)hipMemsetAsync((char*)d_ws + WS_CTL, 0, CTL_ZERO_BYTES, stream);
    Args a{};
    for (int i = 0; i < 22; ++i) a.in[i] = (const float*)d_in[i];
    a.out = (float*)d_out; a.ws = (unsigned char*)d_ws;
#if MK_PER_PHASE
    for (int p = 0; p < NPHASE; ++p) { a.ph_lo = p; a.ph_hi = p + 1; hipLaunchKernelGGL(yoco_fwd, dim3(grid), dim3(NTHR), LDS_BYTES, stream, a); }
#else
    a.ph_lo = 0; a.ph_hi = NPHASE; hipLaunchKernelGGL(yoco_fwd, dim3(grid), dim3(NTHR), LDS_BYTES, stream, a);
#endif
}
```
